# Optimizing an MI355X kernel written in HIP

```python
import math
import jax, jax.numpy as jnp
from jax import lax
import numpy as np

D_MODEL = 2048
BATCH = 1
SEQ = 8192
DEPTH = 2

F32 = jnp.float32
GRID_W = 64
CTX_LEN = 256
GROUP_W = 512
MIX_W = 4 * GROUP_W
CONV_W = GROUP_W
CONV_K = 3
DIFF_HEADS = 4
DIFF_QK_DIM = 64
DIFF_V_DIM = 2 * DIFF_QK_DIM
DIFF_QK_W = DIFF_HEADS * 2 * DIFF_QK_DIM
DIFF_V_W = DIFF_HEADS * DIFF_V_DIM
DIFF_SCALE = DIFF_QK_DIM ** -0.5
SSD_HEADS = 8
SSD_HEAD_DIM = 64
SSD_INNER = SSD_HEADS * SSD_HEAD_DIM
SSD_GROUPS = 2
SSD_STATE = 128
SSD_BC_W = SSD_GROUPS * SSD_STATE
SSD_XBC_W = SSD_INNER + 2 * SSD_BC_W
SSD_DT_W = 2 * SSD_HEADS
SSD_CONV_K = 3
SSD_CHUNK = 128
MLA_HEADS = 4
MLA_NOPE = 128
MLA_ROPE = 64
MLA_V = 128
MLA_Q_RANK = 384
MLA_KV_RANK = 256
MLA_SCALE = (MLA_NOPE + MLA_ROPE) ** -0.5
ROPE_DIM = 64
ROPE_BASE = 10000.0
Q_BLOCK = 128
D_FF = -(-8 * D_MODEL // (3 * 256)) * 256
ALPHA = (2 * DEPTH) ** 0.25
BETA = (8 * DEPTH) ** -0.25
LN_EPS = 1e-5
RMS_EPS = 1e-6
IN_SIZES = (CONV_W, CONV_W, CONV_W,
            DIFF_QK_W, DIFF_QK_W, DIFF_V_W,
            SSD_INNER, SSD_XBC_W, SSD_DT_W,
            MLA_Q_RANK, MLA_KV_RANK, MLA_ROPE)
IN_W = sum(IN_SIZES)
IN_SPLITS = tuple(int(v) for v in np.cumsum(IN_SIZES)[:-1])

kernel_name = 'hymba_style_hybrid_dit_block'


def _layer_norm(x, g, b):
    xf = x.astype(F32)
    xc = xf - jnp.mean(xf, axis=-1, keepdims=True)
    var = jnp.mean(xc * xc, axis=-1, keepdims=True)
    return (xc * lax.rsqrt(var + LN_EPS) * g + b).astype(x.dtype)


def _rms(x):
    xf = x.astype(F32)
    return (xf * lax.rsqrt(jnp.mean(xf * xf, axis=-1, keepdims=True) + RMS_EPS)).astype(x.dtype)


def _dwconv_centred(x, w):
    k, ch = w.shape
    return lax.conv_general_dilated(x, w[:, None, :].astype(x.dtype), window_strides=(1,),
                                    padding=[((k - 1) // 2, k // 2)],
                                    dimension_numbers=('NWC', 'WIO', 'NWC'),
                                    feature_group_count=ch)


def _rope_2d_tables(n_tokens, dim):
    n_rows = n_tokens // GRID_W
    row = jnp.repeat(jnp.arange(n_rows, dtype=F32), GRID_W)
    col = jnp.tile(jnp.arange(GRID_W, dtype=F32), n_rows)
    axis_dim = dim // 2
    inv_freq = jnp.power(ROPE_BASE, -jnp.arange(0, axis_dim, 2, dtype=F32) / axis_dim)
    ang_r = row[:, None] * inv_freq
    ang_c = col[:, None] * inv_freq
    ang = jnp.concatenate([ang_r, ang_r, ang_c, ang_c], axis=-1)
    return jnp.cos(ang), jnp.sin(ang)


def _apply_rope_2d(x, cos, sin):
    half = x.shape[-1] // 2
    qtr = half // 2
    def rot(v):
        return jnp.concatenate([-v[..., qtr:], v[..., :qtr]], axis=-1)
    rotated = jnp.concatenate([rot(x[..., :half]), rot(x[..., half:])], axis=-1)
    return (x * cos[:, None, :] + rotated * sin[:, None, :]).astype(x.dtype)


def _to_blocks(a):
    b, s = a.shape[:2]
    return jnp.moveaxis(a.reshape((b, s // Q_BLOCK, Q_BLOCK) + a.shape[2:]), 1, 0)


def _from_blocks(a):
    a = jnp.moveaxis(a, 0, 1)
    return a.reshape((a.shape[0], a.shape[1] * a.shape[2]) + a.shape[3:])


def _flip_seq(a, reverse):
    return jnp.flip(a, axis=1) if reverse else a


def _segsum(a):
    t = a.shape[-1]
    a_rep = jnp.broadcast_to(a[..., :, None], a.shape + (t,))
    seg = jnp.cumsum(jnp.where(jnp.tril(jnp.ones((t, t), bool), -1), a_rep, 0.0), axis=-2)
    return jnp.where(jnp.tril(jnp.ones((t, t), bool)), seg, -jnp.inf)


def _ssd_chunked(x, dt, a_neg, bm, cm, init_state, need_y):
    b, l, h, p = x.shape
    n = bm.shape[-1]
    nc = l // SSD_CHUNK
    xdt = (x.astype(F32) * dt[..., None]).reshape(b, nc, SSD_CHUNK, h, p)
    bc = bm.astype(F32).reshape(b, nc, SSD_CHUNK, h, n)
    a = jnp.moveaxis((dt * a_neg).reshape(b, nc, SSD_CHUNK, h), 3, 1)
    a_cum = jnp.cumsum(a, axis=-1)
    decay_to_end = jnp.exp(a_cum[..., -1:] - a_cum)
    states = jnp.einsum('bclhn,bhcl,bclhp->bchpn', bc, decay_to_end, xdt)
    states = jnp.concatenate([init_state.astype(F32)[:, None], states], axis=1)
    chunk_decay = jnp.exp(_segsum(jnp.pad(a_cum[..., -1], ((0, 0), (0, 0), (1, 0)))))
    states = jnp.einsum('bhzc,bchpn->bzhpn', chunk_decay, states)
    final_state = states[:, -1]
    if not need_y:
        return None, final_state
    cc = cm.astype(F32).reshape(b, nc, SSD_CHUNK, h, n)
    scores = jnp.einsum('bclhn,bcshn->bhcls', cc, bc) * jnp.exp(_segsum(a))
    y_diag = jnp.einsum('bhcls,bcshp->bclhp', scores, xdt)
    y_off = jnp.einsum('bclhn,bchpn,bhcl->bclhp', cc, states[:, :-1], jnp.exp(a_cum))
    return (y_diag + y_off).reshape(b, l, h, p), final_state


def _short_conv_mixer(lat, ctx, conv_w, need_ctx):
    def mix(bg, cg, u):
        return bg * _dwconv_centred(cg * u, conv_w)
    return mix(*lat), (mix(*ctx) if need_ctx else None)


def _diff_attention(lat, ctx, cos, sin, lam_params, subln_w, layer, need_ctx):
    q_l, k_l, v_l = lat
    q_c, k_c, v_c = ctx
    bsz, n_lat = q_l.shape[:2]
    n_ctx = q_c.shape[1]
    h, d = DIFF_HEADS, DIFF_QK_DIM
    lam_init = 0.8 - 0.6 * math.exp(-0.3 * layer)
    lp = lam_params.astype(F32)
    lam = jnp.exp(jnp.sum(lp[0] * lp[1])) - jnp.exp(jnp.sum(lp[2] * lp[3])) + lam_init

    def rope(a):
        return _apply_rope_2d(a.reshape(bsz, n_lat, 2 * h, d), cos, sin).reshape(bsz, n_lat, h, 2, d)

    k_ch = k_c.reshape(bsz, n_ctx, h, 2, d)
    v_ch = v_c.reshape(bsz, n_ctx, h, DIFF_V_DIM)
    keys = jnp.concatenate([rope(k_l), k_ch], axis=1)
    vals = jnp.concatenate([v_l.reshape(bsz, n_lat, h, DIFF_V_DIM), v_ch], axis=1)

    def attend(q, kk, vv):
        s = jnp.einsum('bqhmd,bkhmd->bhmqk', q, kk).astype(F32) * DIFF_SCALE
        p = jax.nn.softmax(s, axis=-1)
        attn = p[:, :, 0] - lam * p[:, :, 1]
        o = jnp.einsum('bhqk,bkhe->bqhe', attn.astype(vv.dtype), vv)
        o = _rms(o) * subln_w * (1.0 - lam_init)
        return o.reshape(o.shape[0], o.shape[1], h * DIFF_V_DIM)

    o_l = _from_blocks(lax.map(lambda qb: attend(qb, keys, vals), _to_blocks(rope(q_l))))
    o_c = attend(q_c.reshape(bsz, n_ctx, h, 2, d), k_ch, v_ch) if need_ctx else None
    return o_l, o_c


def _ssd_mixer(lat, ctx, conv_w, conv_b, dt_bias, a_log, d_skip, norm_w, need_ctx):
    a_neg = -jnp.exp(a_log.astype(F32))
    rep = SSD_HEADS // SSD_GROUPS

    def prep(z, xbc, dt_raw):
        b_, n_ = xbc.shape[:2]
        xbc = jax.nn.silu(_dwconv_centred(xbc, conv_w) + conv_b)
        xs, bm, cm = jnp.split(xbc, (SSD_INNER, SSD_INNER + SSD_BC_W), axis=-1)
        bm = jnp.repeat(bm.reshape(b_, n_, SSD_GROUPS, SSD_STATE), rep, axis=2)
        cm = jnp.repeat(cm.reshape(b_, n_, SSD_GROUPS, SSD_STATE), rep, axis=2)
        dt = jax.nn.softplus(dt_raw.reshape(b_, n_, 2, SSD_HEADS).astype(F32) + dt_bias.astype(F32))
        return z, xs.reshape(b_, n_, SSD_HEADS, SSD_HEAD_DIM), bm, cm, dt

    z_l, x_l, b_l, c_l, dt_l = prep(*lat)
    z_c, x_c, b_c, c_c, dt_c = prep(*ctx)
    bsz = x_l.shape[0]
    dsk = d_skip.astype(F32)[:, None]
    y_l = x_l.astype(F32) * dsk
    y_c = x_c.astype(F32) * dsk if need_ctx else None
    for direction in range(2):
        rev = direction == 1
        init = jnp.zeros((bsz, SSD_HEADS, SSD_HEAD_DIM, SSD_STATE), F32)
        yc_dir, ctx_state = _ssd_chunked(_flip_seq(x_c, rev), _flip_seq(dt_c[:, :, direction], rev), a_neg[direction],
                                         _flip_seq(b_c, rev), _flip_seq(c_c, rev), init, need_ctx)
        yl_dir, _ = _ssd_chunked(_flip_seq(x_l, rev), _flip_seq(dt_l[:, :, direction], rev), a_neg[direction],
                                 _flip_seq(b_l, rev), _flip_seq(c_l, rev), ctx_state, True)
        y_l = y_l + _flip_seq(yl_dir, rev)
        if need_ctx:
            y_c = y_c + _flip_seq(yc_dir, rev)

    def gate_norm(y, z):
        b_, n_ = z.shape[:2]
        g = y.reshape(b_, n_, SSD_INNER) * jax.nn.silu(z.astype(F32))
        g = _rms(g.reshape(b_, n_, SSD_GROUPS, SSD_INNER // SSD_GROUPS)).reshape(b_, n_, SSD_INNER)
        return (g * norm_w).astype(z.dtype)

    return gate_norm(y_l, z_l), (gate_norm(y_c, z_c) if need_ctx else None)


def _mla(lat, ctx, cos, sin, q_norm_w, kv_norm_w, w_q_up, w_kv_up, need_ctx):
    h = MLA_HEADS

    def queries(cq):
        b_, n_ = cq.shape[:2]
        q = ((_rms(cq) * q_norm_w) @ w_q_up).reshape(b_, n_, h, MLA_NOPE + MLA_ROPE)
        return q[..., :MLA_NOPE], q[..., MLA_NOPE:]

    def keys_values(ckv):
        b_, n_ = ckv.shape[:2]
        kv = ((_rms(ckv) * kv_norm_w) @ w_kv_up).reshape(b_, n_, h, MLA_NOPE + MLA_V)
        return kv[..., :MLA_NOPE], kv[..., MLA_NOPE:]

    cq_l, ckv_l, kr_l = lat
    cq_c, ckv_c, kr_c = ctx
    kn_l, v_l = keys_values(ckv_l)
    kn_c, v_c = keys_values(ckv_c)
    kr_l = _apply_rope_2d(kr_l[:, :, None, :], cos, sin)[:, :, 0]
    kn = jnp.concatenate([kn_l, kn_c], axis=1)
    kr = jnp.concatenate([kr_l, kr_c], axis=1)
    vv = jnp.concatenate([v_l, v_c], axis=1)

    def attend(qn, qr, k_n, k_r, v):
        s = (jnp.einsum('bqhd,bkhd->bhqk', qn, k_n) + jnp.einsum('bqhr,bkr->bhqk', qr, k_r)).astype(F32) * MLA_SCALE
        p = jax.nn.softmax(s, axis=-1)
        o = jnp.einsum('bhqk,bkhd->bqhd', p.astype(v.dtype), v)
        return o.reshape(o.shape[0], o.shape[1], h * MLA_V)

    qn_l, qr_l = queries(cq_l)
    qr_l = _apply_rope_2d(qr_l, cos, sin)
    o_l = _from_blocks(lax.map(lambda qb: attend(qb[0], qb[1], kn, kr, vv), (_to_blocks(qn_l), _to_blocks(qr_l))))
    if need_ctx:
        qn_c, qr_c = queries(cq_c)
        o_c = attend(qn_c, qr_c, kn_c, kr_c, v_c)
    else:
        o_c = None
    return o_l, o_c


def _token_mixers(h_lat, h_ctx, cos, sin, layer, need_ctx, w_in, conv_a_w, diff_lambda, diff_subln_w,
                  ssd_conv_w, ssd_conv_b, ssd_dt_bias, ssd_a_log, ssd_d, ssd_norm_w,
                  mla_q_norm_w, mla_kv_norm_w, w_q_up, w_kv_up, w_out):
    pl = jnp.split(h_lat @ w_in, IN_SPLITS, axis=-1)
    pc = jnp.split(h_ctx @ w_in, IN_SPLITS, axis=-1)
    a_l, a_c = _short_conv_mixer(pl[0:3], pc[0:3], conv_a_w, need_ctx)
    b_l, b_c = _diff_attention(pl[3:6], pc[3:6], cos, sin, diff_lambda, diff_subln_w, layer, need_ctx)
    c_l, c_c = _ssd_mixer(pl[6:9], pc[6:9], ssd_conv_w, ssd_conv_b, ssd_dt_bias, ssd_a_log, ssd_d, ssd_norm_w, need_ctx)
    d_l, d_c = _mla(pl[9:12], pc[9:12], cos, sin, mla_q_norm_w, mla_kv_norm_w, w_q_up, w_kv_up, need_ctx)
    y_l = jnp.concatenate([a_l, b_l, c_l, d_l], axis=-1) @ w_out
    y_c = (jnp.concatenate([a_c, b_c, c_c, d_c], axis=-1) @ w_out) if need_ctx else None
    return y_l, y_c


def _swiglu(h, w1, w2):
    g, u = jnp.split(h @ w1, 2, axis=-1)
    return (jax.nn.silu(g) * u) @ w2


def setup_inputs(seed: int = 0) -> dict:
    key = jax.random.key(seed)
    keys = iter(jax.random.split(key, 32))
    L = DEPTH

    def nrm(shape, scale):
        return jax.random.normal(next(keys), shape, F32) * scale

    def gain(shape):
        return 1.0 + nrm(shape, 0.02)

    dt0 = jnp.exp(jax.random.uniform(next(keys), (L, 2, SSD_HEADS), F32, math.log(1e-3), math.log(1e-1)))
    a_log = jnp.log(jax.random.uniform(next(keys), (L, 2, SSD_HEADS), F32, 1.0, 16.0))
    return {
        'x': nrm((BATCH, SEQ, D_MODEL), 1.0),
        'c': nrm((BATCH, D_MODEL), 1.0),
        'ctx': nrm((BATCH, CTX_LEN, D_MODEL), 1.0),
        'c_ctx': nrm((D_MODEL,), 1.0),
        'w_ada': nrm((L, D_MODEL, 6 * D_MODEL), 0.5 * D_MODEL ** -0.5),
        'b_ada': nrm((L, 6 * D_MODEL), 0.02),
        'w_in': nrm((L, D_MODEL, IN_W), D_MODEL ** -0.5),
        'conv_a_w': nrm((L, CONV_K, CONV_W), CONV_K ** -0.5),
        'diff_lambda': nrm((L, 4, DIFF_QK_DIM), 0.1),
        'diff_subln_w': gain((L, DIFF_V_DIM)),
        'ssd_conv_w': nrm((L, SSD_CONV_K, SSD_XBC_W), SSD_CONV_K ** -0.5),
        'ssd_conv_b': nrm((L, SSD_XBC_W), 0.02),
        'ssd_dt_bias': dt0 + jnp.log(-jnp.expm1(-dt0)),
        'ssd_a_log': a_log,
        'ssd_d': gain((L, SSD_HEADS)),
        'ssd_norm_w': gain((L, SSD_INNER)),
        'mla_q_norm_w': gain((L, MLA_Q_RANK)),
        'mla_kv_norm_w': gain((L, MLA_KV_RANK)),
        'w_q_up': nrm((L, MLA_Q_RANK, MLA_HEADS * (MLA_NOPE + MLA_ROPE)), MLA_Q_RANK ** -0.5),
        'w_kv_up': nrm((L, MLA_KV_RANK, MLA_HEADS * (MLA_NOPE + MLA_V)), MLA_KV_RANK ** -0.5),
        'w_out': nrm((L, MIX_W, D_MODEL), BETA * MIX_W ** -0.5),
        'ln1_g': gain((L, D_MODEL)),
        'ln1_b': nrm((L, D_MODEL), 0.02),
        'w_ffn_in': nrm((L, D_MODEL, 2 * D_FF), D_MODEL ** -0.5),
        'w_ffn_out': nrm((L, D_FF, D_MODEL), BETA * D_FF ** -0.5),
        'ln2_g': gain((L, D_MODEL)),
        'ln2_b': nrm((L, D_MODEL), 0.02),
    }


def reference(x, c, ctx, c_ctx, w_ada, b_ada, w_in, conv_a_w, diff_lambda, diff_subln_w,
              ssd_conv_w, ssd_conv_b, ssd_dt_bias, ssd_a_log, ssd_d, ssd_norm_w,
              mla_q_norm_w, mla_kv_norm_w, w_q_up, w_kv_up, w_out,
              ln1_g, ln1_b, w_ffn_in, w_ffn_out, ln2_g, ln2_b):
    cos, sin = _rope_2d_tables(x.shape[1], ROPE_DIM)
    for i in range(DEPTH):
        need_ctx = i < DEPTH - 1
        mod_l = (jax.nn.silu(c) @ w_ada[i] + b_ada[i])[:, None, :]
        mod_c = jax.nn.silu(c_ctx) @ w_ada[i] + b_ada[i]
        sh1, sc1, g1, sh2, sc2, g2 = jnp.split(mod_l, 6, axis=-1)
        csh1, csc1, cg1, csh2, csc2, cg2 = jnp.split(mod_c, 6, axis=-1)
        y_l, y_c = _token_mixers(x * (1.0 + sc1) + sh1, ctx * (1.0 + csc1) + csh1, cos, sin, i, need_ctx,
                                 w_in[i], conv_a_w[i], diff_lambda[i], diff_subln_w[i],
                                 ssd_conv_w[i], ssd_conv_b[i], ssd_dt_bias[i], ssd_a_log[i], ssd_d[i], ssd_norm_w[i],
                                 mla_q_norm_w[i], mla_kv_norm_w[i], w_q_up[i], w_kv_up[i], w_out[i])
        x = _layer_norm(ALPHA * x + g1 * y_l, ln1_g[i], ln1_b[i])
        x = _layer_norm(ALPHA * x + g2 * _swiglu(x * (1.0 + sc2) + sh2, w_ffn_in[i], w_ffn_out[i]), ln2_g[i], ln2_b[i])
        if need_ctx:
            ctx = _layer_norm(ALPHA * ctx + cg1 * y_c, ln1_g[i], ln1_b[i])
            ctx = _layer_norm(ALPHA * ctx + cg2 * _swiglu(ctx * (1.0 + csc2) + csh2, w_ffn_in[i], w_ffn_out[i]),
                              ln2_g[i], ln2_b[i])
    return x
```

```cpp
#include <hip/hip_runtime.h>
#include <hip/hip_cooperative_groups.h>
#include <cstdio>
#include <cstdint>
namespace cg = cooperative_groups;

#ifndef MK_ONE_LAUNCH
#define MK_ONE_LAUNCH 0
#endif

constexpr int DM = 2048, SEQ = 8192, NCTX = 256, MROWS = SEQ + NCTX;
constexpr int INW = 5376;
constexpr int DFF = 5632;
constexpr int NPH = 23;
constexpr int C_BG = 0, C_CG = 512, C_U = 1024, C_DQ = 1536, C_DK = 2048, C_DV = 2560, C_Z = 3072, C_XBC = 3584, C_CQ = 4608, C_CKV = 4992, C_KR = 5248, C_DT = 5312;
constexpr float ALPHA_F = 1.4142135623730951f;

__device__ __forceinline__ int ltid() { int t = threadIdx.x; asm volatile("" : "+v"(t)); return t; }
__device__ __forceinline__ int lbid() { int b = blockIdx.x; asm volatile("" : "+s"(b)); return b; }

namespace pg8 {
#define PG8_LAS __attribute__((address_space(3)))
typedef unsigned short bf16_t;
typedef short bf16x8 __attribute__((ext_vector_type(8)));
typedef float f32x4 __attribute__((ext_vector_type(4)));
typedef unsigned u32x4 __attribute__((ext_vector_type(4)));
constexpr int BM = 256, BK = 64, HALF = 128, HTB = HALF * BK * 2  , STAGE_BYTES = 8 * HTB, NXCD = 8, WGM = 8;

__host__ __device__ __forceinline__ int lds_byte(int r, int c) { const int st = (r >> 4) * 2 + (c >> 5), rr = r & 15, cc = c & 31, ob = rr * 64 + cc * 2; return st * 1024 + (ob ^ (((ob >> 9) & 1) << 5)); }
__host__ __device__ __forceinline__ void stage_rc(int b, int& R, int& C) { const int st = b / 1024, sb = b % 1024, swz = sb ^ (((sb >> 9) & 1) << 5); R = (st >> 1) * 16 + swz / 64; C = (st & 1) * 32 + (swz % 64) / 2; }
__host__ __device__ __forceinline__ int perm32(int rho) { const int n = rho >> 4, i = rho & 15; return 8 * (i >> 2) + 4 * n + (i & 3); }

struct Unit { int pm, pn; };
struct Gemm { const bf16_t* A; const bf16_t* Bt; int M, N, K; };

struct StaticOrder {
    int nM, nN, nwg, G, c;
    __host__ __device__ void init(int M, int N, int G_, int c_) { nM = M / BM; nN = N / BM; nwg = nM * nN; G = G_; c = c_; }
    __host__ __device__ bool next(int i, Unit& u) const {
        const long L = (long)i * G + c; if (L >= nwg) return false;
        int wgid = (int)L; { const int q = nwg / NXCD, r = nwg % NXCD, xcd = wgid % NXCD, off = wgid / NXCD; wgid = (xcd < r ? xcd * (q + 1) : r * (q + 1) + (xcd - r) * q) + off; }
        const int nig = WGM * nN, gid = wgid / nig, fm = gid * WGM, gsz = (nM - fm) < WGM ? (nM - fm) : WGM;
        u.pm = fm + ((wgid % nig) % gsz); u.pn = (wgid % nig) / gsz; return true;
    }
    __device__ __forceinline__ void a_ready(const Unit&) const {}
    __device__ __forceinline__ void done(const Unit&) const {}
};

__device__ __forceinline__ unsigned cvt_pk_bf16(float lo, float hi) { unsigned r; asm volatile("v_cvt_pk_bf16_f32 %0, %1, %2" : "=v"(r) : "v"(lo), "v"(hi)); return r; }
typedef float f32x2 __attribute__((ext_vector_type(2)));
typedef unsigned u32x2 __attribute__((ext_vector_type(2)));
typedef float f32x2 __attribute__((ext_vector_type(2)));
template <int MODE> struct EpiBf16R {
    static constexpr bool PERM = false, AFTER_DRAIN = false;
    bf16_t* O; bf16_t* O2; const f32x2* rope;
    __device__ __forceinline__ void operator()(const f32x4 (&acc)[2][2][4][2], const Unit& u, int wr, int wc, int fr, int fq) const {
        asm volatile("" : "+v"(fr), "+v"(fq));
#pragma unroll
        for (int bj = 0; bj < 2; ++bj) {
            const int cg0 = u.pn * BM + bj * HALF + wc * 32;
            bool dorope = false; int axis = 0; bf16_t* base = O; int ldc = 0, dcol = 0;
            if (MODE == 0) { dorope = (cg0 >= 1536 && cg0 < 2560) || (cg0 >= 5248 && cg0 < 5312); axis = (cg0 >> 5) & 1; ldc = 5376; dcol = cg0; }
            else if (MODE == 1) { const int w = cg0 % 192; dorope = w >= 128; axis = ((w - 128) >> 5) & 1; ldc = 768; dcol = cg0; }
            else { if (bj == 0) { base = O; ldc = 768; dcol = u.pn * 192 + wc * 32; } else { base = O2; ldc = 512; dcol = u.pn * 128 + wc * 32; } }
            dorope = dorope && (u.pm < 32);
#pragma unroll
            for (int ai = 0; ai < 2; ++ai)
#pragma unroll
                for (int m = 0; m < 4; ++m) {
                    const int row = u.pm * BM + ai * HALF + wr * 64 + m * 16 + fr;
                    f32x4 v0 = acc[ai][bj][m][0], v1 = acc[ai][bj][m][1];
                    if (dorope) {
                        const int pos = axis ? (row & 63) : (row >> 6);
                        const f32x2* rp = rope + pos * 16 + 4 * fq;
                        f32x4 o0, o1;
#pragma unroll
                        for (int i = 0; i < 4; ++i) { const f32x2 cs = rp[i]; o0[i] = v0[i] * cs.x - v1[i] * cs.y; o1[i] = v1[i] * cs.x + v0[i] * cs.y; }
                        v0 = o0; v1 = o1;
                    }
                    bf16_t* p = base + (size_t)row * ldc + dcol + 4 * fq;
                    u32x2 w0, w1; w0.x = cvt_pk_bf16(v0[0], v0[1]); w0.y = cvt_pk_bf16(v0[2], v0[3]); w1.x = cvt_pk_bf16(v1[0], v1[1]); w1.y = cvt_pk_bf16(v1[2], v1[3]);
                    *(u32x2*)p = w0; *(u32x2*)(p + 16) = w1;
                }
        }
    }
};
struct EpiResid {
    static constexpr bool PERM = false, AFTER_DRAIN = false;
    const float* xres; float* out; const float* gate_lat; const float* gate_ctx;
    __device__ __forceinline__ void operator()(const f32x4 (&acc)[2][2][4][2], const Unit& u, int wr, int wc, int fr, int fq) const {
        asm volatile("" : "+v"(fr), "+v"(fq));
        const int col0 = u.pn * BM + wc * 32 + 4 * fq;
        const float* gate = (u.pm >= 32) ? gate_ctx : gate_lat;
#pragma unroll
        for (int bj = 0; bj < 2; ++bj)
#pragma unroll
            for (int n = 0; n < 2; ++n) {
                const f32x4 gv = *(const f32x4*)(gate + col0 + bj * HALF + n * 16);
#pragma unroll
                for (int ai = 0; ai < 2; ++ai)
#pragma unroll
                    for (int m = 0; m < 4; ++m) {
                        const size_t off = (size_t)(u.pm * BM + ai * HALF + wr * 64 + m * 16 + fr) * 2048 + col0 + bj * HALF + n * 16;
                        const f32x4 xr = *(const f32x4*)(xres + off);
                        *(f32x4*)(out + off) = xr * 1.4142135623730951f + gv * acc[ai][bj][m][n];
                    }
            }
    }
};
struct EpiSwiglu {
    static constexpr bool PERM = true, AFTER_DRAIN = false;
    bf16_t* O;
    __device__ __forceinline__ void operator()(const f32x4 (&acc)[2][2][4][2], const Unit& u, int wr, int wc, int fr, int fq) const {
        asm volatile("" : "+v"(fr), "+v"(fq));
        const int col0 = u.pn * HALF + wc * 32 + 8 * fq;
#pragma unroll
        for (int ai = 0; ai < 2; ++ai)
#pragma unroll
            for (int m = 0; m < 4; ++m) {
                const int row = u.pm * BM + ai * HALF + wr * 64 + m * 16 + fr;
                float a[8];
#pragma unroll
                for (int n = 0; n < 2; ++n)
#pragma unroll
                    for (int i = 0; i < 4; ++i) { const float g = acc[ai][0][m][n][i], up = acc[ai][1][m][n][i]; a[n * 4 + i] = g / (1.0f + __expf(-g)) * up; }
                u32x4 w; w.x = cvt_pk_bf16(a[0], a[1]); w.y = cvt_pk_bf16(a[2], a[3]); w.z = cvt_pk_bf16(a[4], a[5]); w.w = cvt_pk_bf16(a[6], a[7]);
                *(u32x4*)(O + (size_t)row * 5632 + col0) = w;
            }
    }
};

template <class Epi, class Sched, bool ALIGN_EPI = false, bool SP2 = false>
__device__ __forceinline__ void gemm_phase(PG8_LAS unsigned char* lds, const Gemm g, const Sched& S, const Epi& E) {
    const int tid = ltid(), wid = __builtin_amdgcn_readfirstlane(tid >> 6), lane = tid & 63, wr = wid >> 2, wc = wid & 3, fr = lane & 15, fq = lane >> 4;
    const int K = g.K, nt = K / BK;
    unsigned voffA[2], voffB[2];
#pragma unroll
    for (int i = 0; i < 2; ++i) { int R, C; stage_rc(tid * 16 + i * 8192, R, C); const int Rb = Epi::PERM ? ((R & ~31) + perm32(R & 31)) : R;
        voffA[i] = (unsigned)(R * K + C) * 2u; voffB[i] = (unsigned)(Rb * K + C) * 2u; }
    const size_t kstep = (size_t)(BK * 2);
    const size_t hstep = (size_t)HALF * K * 2;
    const size_t tstep = 2 * hstep;
    const unsigned ldsw = (unsigned)wid * 1024u;
    const int aoff = lds_byte(wr * 64 + fr, fq * 8), boff = lds_byte(wc * 32 + fr, fq * 8);
#define PG8_SA(b, h) (((b) * 2 + (h)) * HTB)
#define PG8_SB(b, h) ((4 + (b) * 2 + (h)) * HTB)
#define PG8_STAGE(bufoff, gbase, voff) do { _Pragma("unroll") for (int _i = 0; _i < 2; ++_i) \
        __builtin_amdgcn_global_load_lds((const unsigned*)((const char*)(gbase) + (voff)[_i]), (PG8_LAS unsigned*)(lds + (bufoff) + ldsw + _i * 8192), 16, 0, 0); } while (0)
#define PG8_LDA(dst, b, h) do { _Pragma("unroll") for (int m = 0; m < 4; ++m) _Pragma("unroll") for (int k = 0; k < 2; ++k) dst[m][k] = *(const PG8_LAS bf16x8*)(lds + PG8_SA(b, h) + aoff + m * 2048 + k * 1024); } while (0)
#define PG8_LDB(dst, b, h) do { _Pragma("unroll") for (int n = 0; n < 2; ++n) _Pragma("unroll") for (int k = 0; k < 2; ++k) dst[n][k] = *(const PG8_LAS bf16x8*)(lds + PG8_SB(b, h) + boff + n * 2048 + k * 1024); } while (0)
#define PG8_MMA(ai, bj, At, Bt) do { __builtin_amdgcn_s_setprio(1); _Pragma("unroll") for (int m = 0; m < 4; ++m) _Pragma("unroll") for (int n = 0; n < 2; ++n) _Pragma("unroll") for (int k = 0; k < 2; ++k) \
        acc[ai][bj][m][n] = __builtin_amdgcn_mfma_f32_16x16x32_bf16(Bt[n][k], At[m][k], acc[ai][bj][m][n], 0, 0, 0); __builtin_amdgcn_s_setprio(0); } while (0)
#define PG8_WAIT_V(n) asm volatile("s_waitcnt vmcnt(" #n ")" ::: "memory")
#define PG8_WAIT_L(n) asm volatile("s_waitcnt lgkmcnt(" #n ")" ::: "memory")
#define PG8_BAR __builtin_amdgcn_s_barrier()
#define PG8_SCHED __builtin_amdgcn_sched_barrier(0)
    Unit cur, nxt; int ui = 0;
    if (!S.next(0, cur)) return;
    f32x4 acc[2][2][4][2];
#pragma unroll
    for (int a = 0; a < 2; ++a)
#pragma unroll
        for (int b = 0; b < 2; ++b)
#pragma unroll
            for (int m = 0; m < 4; ++m)
#pragma unroll
                for (int n = 0; n < 2; ++n) acc[a][b][m][n] = (f32x4){0.f, 0.f, 0.f, 0.f};
    bf16x8 At[4][2], B0[2][2], B1[2][2];
    const char* cA = (const char*)g.A + (size_t)cur.pm * tstep; const char* cB = (const char*)g.Bt + (size_t)cur.pn * tstep;
    S.a_ready(cur);
    if constexpr (SP2) {
        PG8_STAGE(PG8_SB(0, 0), cB, voffB); PG8_STAGE(PG8_SB(0, 1), cB + hstep, voffB); PG8_STAGE(PG8_SA(0, 0), cA, voffA); PG8_STAGE(PG8_SA(0, 1), cA + hstep, voffA);
        if (wr == 1) PG8_BAR;
        PG8_WAIT_V(2); PG8_BAR;
        PG8_STAGE(PG8_SB(1, 0), cB + kstep, voffB); PG8_STAGE(PG8_SA(1, 0), cA + kstep, voffA); PG8_STAGE(PG8_SB(1, 1), cB + hstep + kstep, voffB);
        PG8_WAIT_V(6); PG8_BAR;
    } else {
        PG8_STAGE(PG8_SB(0, 0), cB, voffB); PG8_STAGE(PG8_SA(0, 0), cA, voffA); PG8_STAGE(PG8_SB(0, 1), cB + hstep, voffB); PG8_STAGE(PG8_SA(0, 1), cA + hstep, voffA);
        if (wr == 1) PG8_BAR;
        PG8_WAIT_V(4); PG8_BAR;
        PG8_STAGE(PG8_SB(1, 0), cB + kstep, voffB); PG8_STAGE(PG8_SA(1, 0), cA + kstep, voffA); PG8_STAGE(PG8_SB(1, 1), cB + hstep + kstep, voffB);
        PG8_WAIT_V(6); PG8_BAR;
    }
    for (;;) {
        const bool has_next = S.next(ui + 1, nxt);
        const char* nA = has_next ? (const char*)g.A + (size_t)nxt.pm * tstep : cA; const char* nB = has_next ? (const char*)g.Bt + (size_t)nxt.pn * tstep : cB;
        for (int t = 0; t < nt; t += 2) {
            const bool last = (t == nt - 2);
            const char* a1 = cA + (size_t)(t + 1) * kstep;
            const char* a2 = last ? nA : cA + (size_t)(t + 2) * kstep; const char* b2 = last ? nB : cB + (size_t)(t + 2) * kstep;
            const char* a3 = a2 + kstep; const char* b3 = b2 + kstep;
            if (last && has_next) S.a_ready(nxt);
            if constexpr (SP2) {
            PG8_LDB(B0, 0, 0); PG8_LDB(B1, 0, 1); PG8_SCHED; PG8_LDA(At, 0, 0); PG8_STAGE(PG8_SA(1, 1), a1 + hstep, voffA);
            PG8_WAIT_V(8); PG8_WAIT_L(0); PG8_BAR; PG8_MMA(0, 0, At, B0); PG8_MMA(0, 1, At, B1); PG8_BAR; PG8_SCHED;
            PG8_LDA(At, 0, 1); PG8_STAGE(PG8_SB(0, 0), b2, voffB); PG8_STAGE(PG8_SB(0, 1), b2 + hstep, voffB); PG8_STAGE(PG8_SA(0, 0), a2, voffA);
            PG8_WAIT_V(8); PG8_WAIT_L(0); PG8_BAR; PG8_MMA(1, 0, At, B0); PG8_MMA(1, 1, At, B1); PG8_BAR; PG8_SCHED;
            PG8_LDB(B0, 1, 0); PG8_LDB(B1, 1, 1); PG8_SCHED; PG8_LDA(At, 1, 0); PG8_STAGE(PG8_SA(0, 1), a2 + hstep, voffA);
            PG8_WAIT_V(8); PG8_WAIT_L(0); PG8_BAR; PG8_MMA(0, 0, At, B0); PG8_MMA(0, 1, At, B1); PG8_BAR; PG8_SCHED;
            PG8_LDA(At, 1, 1); PG8_STAGE(PG8_SB(1, 0), b3, voffB); PG8_STAGE(PG8_SB(1, 1), b3 + hstep, voffB); PG8_STAGE(PG8_SA(1, 0), a3, voffA);
            PG8_WAIT_V(8); PG8_WAIT_L(0); PG8_BAR; PG8_MMA(1, 0, At, B0); PG8_MMA(1, 1, At, B1); PG8_BAR; PG8_SCHED;
            } else {
            PG8_LDB(B0, 0, 0); PG8_SCHED; PG8_LDA(At, 0, 0); PG8_STAGE(PG8_SA(1, 1), a1 + hstep, voffA);
            PG8_WAIT_L(8); PG8_BAR; PG8_WAIT_L(0); PG8_MMA(0, 0, At, B0); PG8_BAR; PG8_SCHED;
            PG8_LDB(B1, 0, 1); PG8_STAGE(PG8_SB(0, 0), b2, voffB);
            PG8_BAR; PG8_WAIT_L(0); PG8_MMA(0, 1, At, B1); PG8_BAR;
            PG8_LDA(At, 0, 1); PG8_STAGE(PG8_SA(0, 0), a2, voffA);
            PG8_BAR; PG8_WAIT_L(0); PG8_MMA(1, 0, At, B0); PG8_BAR; PG8_SCHED;
            PG8_STAGE(PG8_SB(0, 1), b2 + hstep, voffB);
            PG8_WAIT_V(6); PG8_BAR; PG8_MMA(1, 1, At, B1); PG8_BAR;
            PG8_LDB(B0, 1, 0); PG8_SCHED; PG8_LDA(At, 1, 0); PG8_STAGE(PG8_SA(0, 1), a2 + hstep, voffA);
            PG8_WAIT_L(8); PG8_BAR; PG8_WAIT_L(0); PG8_MMA(0, 0, At, B0); PG8_BAR; PG8_SCHED;
            PG8_LDB(B1, 1, 1); PG8_STAGE(PG8_SB(1, 0), b3, voffB);
            PG8_BAR; PG8_WAIT_L(0); PG8_MMA(0, 1, At, B1); PG8_BAR;
            PG8_LDA(At, 1, 1); PG8_STAGE(PG8_SA(1, 0), a3, voffA);
            PG8_BAR; PG8_WAIT_L(0); PG8_MMA(1, 0, At, B0); PG8_BAR; PG8_SCHED;
            PG8_STAGE(PG8_SB(1, 1), b3 + hstep, voffB);
            PG8_WAIT_V(6); PG8_BAR; PG8_MMA(1, 1, At, B1); PG8_BAR;
            }
        }
        if constexpr (ALIGN_EPI) { if (wr == 0) PG8_BAR; }
        if constexpr (!Epi::AFTER_DRAIN) { E(acc, cur, wr, wc, fr, fq); S.done(cur); }
        if (!has_next) break;
#pragma unroll
        for (int a = 0; a < 2; ++a)
#pragma unroll
            for (int b = 0; b < 2; ++b)
#pragma unroll
                for (int m = 0; m < 4; ++m)
#pragma unroll
                    for (int n = 0; n < 2; ++n) acc[a][b][m][n] = (f32x4){0.f, 0.f, 0.f, 0.f};
        cur = nxt; cA = nA; cB = nB; ++ui;
        if constexpr (ALIGN_EPI) { if (wr == 1) PG8_BAR; }
    }
    PG8_WAIT_V(0);
    if constexpr (!ALIGN_EPI) { if (wr == 0) PG8_BAR; }
    PG8_BAR;
    if constexpr (Epi::AFTER_DRAIN) { E.fused(acc, cur, wr, wc, fr, fq, lds, wid, lane); S.done(cur); }
#undef PG8_SA
#undef PG8_SB
#undef PG8_STAGE
#undef PG8_LDA
#undef PG8_LDB
#undef PG8_MMA
#undef PG8_WAIT_V
#undef PG8_WAIT_L
#undef PG8_BAR
#undef PG8_SCHED
}
}
namespace att {
typedef unsigned short bf16_t;
using bf16x8 = __attribute__((ext_vector_type(8))) short;
using s16x4  = __attribute__((ext_vector_type(4))) short;
using f32x16 = __attribute__((ext_vector_type(16))) float;
using u32x4  = __attribute__((ext_vector_type(4))) unsigned;
constexpr int NW = 8, QBLK = 32, KVBLK = 64, DV = 128;
constexpr float THR = 8.f;
#define SBAR() __builtin_amdgcn_sched_barrier(0)
__device__ __forceinline__ int crow(int r, int hi) { return (r & 3) + 8 * (r >> 2) + 4 * hi; }
__device__ __forceinline__ unsigned cvtpk(float lo, float hi) { unsigned r; asm volatile("v_cvt_pk_bf16_f32 %0, %1, %2" : "=v"(r) : "v"(lo), "v"(hi)); return r; }
template <int DQK> struct Cfg {
    static constexpr float SCALE = (DQK == 64) ? 0.125f : 0.07216878364870322f;
    static constexpr int KROWB = DQK * 2, SHM_K = KVBLK * DQK * 2, SHM_V = KVBLK * DV * 2, NP = DQK / 64, ND0 = DQK / 16;
    static constexpr int NQR = (DQK == 192) ? 4 : ND0;
    static constexpr int SHM_Q = (ND0 - NQR) * 16 * 2 * 256;
    static constexpr int SHM = 2 * SHM_V + 2 * SHM_K + NW * 64 * 4 + SHM_Q;
};
template <int DQK> __device__ __forceinline__ void partialSM(f32x16& p0, f32x16& p1, float& m_reg, float& mn, float& alpha) {
  constexpr float SCALE = Cfg<DQK>::SCALE; constexpr float C = SCALE * 1.4426950408889634f;
  float pmax = p0[0];
#pragma unroll
  for (int r = 1; r < 16; ++r) pmax = fmaxf(pmax, p0[r]);
#pragma unroll
  for (int r = 0; r < 16; ++r) pmax = fmaxf(pmax, p1[r]);
  { auto rr = __builtin_amdgcn_permlane32_swap(__float_as_uint(pmax), __float_as_uint(pmax), false, false);
    pmax = fmaxf(__uint_as_float(rr[0]), __uint_as_float(rr[1])); }
  if (__builtin_expect(__all(pmax - m_reg <= THR / SCALE), 1)) { mn = m_reg; alpha = 1.f; }
  else { mn = fmaxf(m_reg, pmax); alpha = __builtin_amdgcn_exp2f((m_reg - mn) * C); m_reg = mn; }
  float mnC = -mn * C;
#pragma unroll
  for (int r = 0; r < 16; ++r) p0[r] = fmaf(p0[r], C, mnC);
#pragma unroll
  for (int r = 0; r < 16; ++r) p1[r] = fmaf(p1[r], C, mnC);
#pragma unroll
  for (int r = 0; r < 16; ++r) p0[r] = __builtin_amdgcn_exp2f(p0[r]);
}
__device__ __forceinline__ void finishSM(f32x16& p0, f32x16& p1, float alpha, float& l_reg, bf16x8& pa0, bf16x8& pa1, bf16x8& pa2, bf16x8& pa3) {
#pragma unroll
  for (int r = 0; r < 16; ++r) p1[r] = __builtin_amdgcn_exp2f(p1[r]);
  float ps = 0;
#pragma unroll
  for (int r = 0; r < 16; ++r) ps += p0[r];
#pragma unroll
  for (int r = 0; r < 16; ++r) ps += p1[r];
  { auto rr = __builtin_amdgcn_permlane32_swap(__float_as_uint(ps), __float_as_uint(ps), false, false);
    ps = __uint_as_float(rr[0]) + __uint_as_float(rr[1]); }
  l_reg = l_reg * alpha + ps;
#define PK4(P, BASE, OUT) do { unsigned a0 = cvtpk(P[BASE + 0], P[BASE + 1]), a1 = cvtpk(P[BASE + 2], P[BASE + 3]);   \
    unsigned b0 = cvtpk(P[BASE + 4], P[BASE + 5]), b1 = cvtpk(P[BASE + 6], P[BASE + 7]);                              \
    auto r0 = __builtin_amdgcn_permlane32_swap(a0, b0, false, false); auto r1 = __builtin_amdgcn_permlane32_swap(a1, b1, false, false); \
    u32x4 w = {r0[0], r1[0], r0[1], r1[1]}; OUT = *reinterpret_cast<bf16x8*>(&w); } while (0)
  PK4(p0, 0, pa0); PK4(p0, 8, pa1); PK4(p1, 0, pa2); PK4(p1, 8, pa3);
#undef PK4
}
template <int DQK> __device__ __forceinline__ int kswz(int row, int colB) { return row * (DQK * 2) + (colB ^ ((row & 7) << 4)); }
template <int DQK> __device__ __forceinline__ void qkt(f32x16& p0, f32x16& p1, const char* Ks, const bf16x8* qr, const char* Qs, const int* kb, const int* qb, int r32, int hi) {
  constexpr int NQR = Cfg<DQK>::NQR; constexpr int KROWB = DQK * 2;
  p0 = f32x16{}; p1 = f32x16{};
#pragma unroll
  for (int g = 0; g < DQK / 64; ++g)
#pragma unroll
    for (int dd = 0; dd < 4; ++dd) { const int d0 = g * 4 + dd;
      bf16x8 b0 = *reinterpret_cast<const bf16x8*>(Ks + kb[dd] + g * 128);
      bf16x8 b1 = *reinterpret_cast<const bf16x8*>(Ks + kb[dd] + g * 128 + 32 * KROWB);
      bf16x8 q;
      if (d0 < NQR) q = qr[d0 < NQR ? d0 : 0]; else q = *reinterpret_cast<const bf16x8*>(Qs + qb[dd] + (g - NQR / 4) * 32768);
      p0 = __builtin_amdgcn_mfma_f32_32x32x16_bf16(b0, q, p0, 0, 0, 0);
      p1 = __builtin_amdgcn_mfma_f32_32x32x16_bf16(b1, q, p1, 0, 0, 0); }
}
__device__ __forceinline__ int v_st(int k, int c) { const int kk = (k & ~0xC) | ((k & 4) << 1) | ((k & 8) >> 1); return ((kk >> 3) * 4 + (c >> 5)) * 512 + ((kk & 7) * 32 + (c & 31)) * 2; }
__device__ __forceinline__ int v_rd_base(int lane) { return ((lane & 3) << 3) | (((lane >> 2) & 3) << 6) | (((lane >> 4) & 1) << 5) | (((lane >> 5) & 1) << 8); }
constexpr int v_rd_off(int d0, int ks, int half) { return d0 * 512 + ks * 4096 + half * 2048; }
template <int OFF> __device__ __forceinline__ s16x4 tr_read(int vb) {
  s16x4 r; asm volatile("ds_read_b64_tr_b16 %0, %1 offset:%2" : "=&v"(r) : "v"(vb), "i"(OFF) : "memory"); return r;
}
template <int D0> __device__ __forceinline__ void pv_one(f32x16& od, int vb, bf16x8 pa0, bf16x8 pa1, bf16x8 pa2, bf16x8 pa3) {
  const s16x4 l0 = tr_read<v_rd_off(D0, 0, 0)>(vb), h0 = tr_read<v_rd_off(D0, 0, 1)>(vb), l1 = tr_read<v_rd_off(D0, 1, 0)>(vb), h1 = tr_read<v_rd_off(D0, 1, 1)>(vb);
  const s16x4 l2 = tr_read<v_rd_off(D0, 2, 0)>(vb), h2 = tr_read<v_rd_off(D0, 2, 1)>(vb), l3 = tr_read<v_rd_off(D0, 3, 0)>(vb), h3 = tr_read<v_rd_off(D0, 3, 1)>(vb);
  asm volatile("s_waitcnt lgkmcnt(0)" ::: "memory"); SBAR();
#define PK(L, H) (bf16x8){L[0], L[1], L[2], L[3], H[0], H[1], H[2], H[3]}
  od = __builtin_amdgcn_mfma_f32_32x32x16_bf16(pa0, PK(l0, h0), od, 0, 0, 0);
  od = __builtin_amdgcn_mfma_f32_32x32x16_bf16(pa1, PK(l1, h1), od, 0, 0, 0);
  od = __builtin_amdgcn_mfma_f32_32x32x16_bf16(pa2, PK(l2, h2), od, 0, 0, 0);
  od = __builtin_amdgcn_mfma_f32_32x32x16_bf16(pa3, PK(l3, h3), od, 0, 0, 0);
#undef PK
}
__device__ __forceinline__ void pv_d0(f32x16* o, int vb, bf16x8 pa0, bf16x8 pa1, bf16x8 pa2, bf16x8 pa3) {
  pv_one<0>(o[0], vb, pa0, pa1, pa2, pa3); pv_one<1>(o[1], vb, pa0, pa1, pa2, pa3); pv_one<2>(o[2], vb, pa0, pa1, pa2, pa3); pv_one<3>(o[3], vb, pa0, pa1, pa2, pa3);
}
template <int DQK, bool OUT_BF16, int ldq, int ldk, int ldv, int ldo>
__device__ __forceinline__ void attn_dense_body(const bf16_t* __restrict__ Qb, const bf16_t* __restrict__ Kh, const bf16_t* __restrict__ Vh,
                                                float* __restrict__ Of, bf16_t* __restrict__ Ob, int seq, char* lds) {
  using C_ = Cfg<DQK>;
  constexpr int SHM_V = C_::SHM_V, SHM_K = C_::SHM_K, NP = C_::NP, ND0 = C_::ND0, NQR = C_::NQR;
  const int tid = ltid(), wid = tid >> 6, lane = tid & 63, r32 = lane & 31, hi = lane >> 5;
  char* V_lds = lds; char* K_lds = lds + 2 * SHM_V;
  float* ws = (float*)(lds + 2 * SHM_V + 2 * SHM_K) + wid * 64; float* li_l = ws; float* al_l = ws + 32;
  char* Q_lds = lds + 2 * SHM_V + 2 * SHM_K + NW * 64 * 4; const int qrow = wid * QBLK + r32;
  int kb[4], qb[4];
#pragma unroll
  for (int dd = 0; dd < 4; ++dd) { const int t = (dd * 32 + hi * 16) ^ ((r32 & 7) << 4); kb[dd] = r32 * (DQK * 2) + t; qb[dd] = qrow * 128 + t; }
  float m_reg = -1e30f, l_reg = 0; f32x16 o[4] = {}; bf16x8 qr[NQR];
  const bf16_t* Qw = Qb + (size_t)(wid * QBLK + r32) * ldq + hi * 8;
#pragma unroll
  for (int d0 = 0; d0 < NQR; ++d0) qr[d0] = *reinterpret_cast<const bf16x8*>(Qw + d0 * 16);
#pragma unroll
  for (int d0 = NQR; d0 < ND0; ++d0) *reinterpret_cast<bf16x8*>(Q_lds + qb[(d0 - NQR) & 3] + ((d0 - NQR) >> 2) * 32768) = *reinterpret_cast<const bf16x8*>(Qw + d0 * 16);
  const int sr = tid >> 4, sc = (tid & 15) * 8, vst0 = v_st(sr, sc), vst1 = v_st(32 + sr, sc);
  const int kr_ = tid >> 3, kc_ = (tid & 7) * 8;
  const int vb0 = (int)(uintptr_t)V_lds + v_rd_base(lane);
  bf16x8 vs0, vs1, ks[NP];
#define SLOAD(k0) do { vs0 = *reinterpret_cast<const bf16x8*>(&Vh[(size_t)((k0) + sr) * ldv + sc]); vs1 = *reinterpret_cast<const bf16x8*>(&Vh[(size_t)((k0) + 32 + sr) * ldv + sc]); \
    _Pragma("unroll") for (int i_ = 0; i_ < NP; ++i_) ks[i_] = *reinterpret_cast<const bf16x8*>(&Kh[(size_t)((k0) + kr_) * ldk + kc_ + 64 * i_]); } while (0)
#define SWRITE(b) do { *(bf16x8*)(V_lds + (b) * SHM_V + vst0) = vs0; *(bf16x8*)(V_lds + (b) * SHM_V + vst1) = vs1; \
    _Pragma("unroll") for (int i_ = 0; i_ < NP; ++i_) *(bf16x8*)(K_lds + (b) * SHM_K + kswz<DQK>(kr_, (kc_ + 64 * i_) * 2)) = ks[i_]; } while (0)
#define RESC(a) do { if (__any((a) < 1.f)) { if (hi == 0) al_l[r32] = (a); asm volatile("s_waitcnt lgkmcnt(0)" ::: "memory"); \
    _Pragma("unroll") for (int d = 0; d < 4; ++d) _Pragma("unroll") for (int r = 0; r < 16; ++r) o[d][r] *= al_l[crow(r, hi)]; } } while (0)
  const int NT = seq / KVBLK; bf16x8 pa0, pa1, pa2, pa3;
  if constexpr (DQK == 192) {
    f32x16 pA0, pA1; float mnA, alA;
    SLOAD(0); SWRITE(0); __syncthreads();
    for (int j = 0; j < NT; ++j) {
      const int buf = j & 1;
      if (j + 1 < NT) SLOAD((j + 1) * KVBLK);
      SBAR(); qkt<DQK>(pA0, pA1, K_lds + buf * SHM_K, qr, Q_lds, kb, qb, r32, hi);
      partialSM<DQK>(pA0, pA1, m_reg, mnA, alA);
      RESC(alA);
      finishSM(pA0, pA1, alA, l_reg, pa0, pa1, pa2, pa3); SBAR();
      pv_d0(o, vb0 + buf * (int)SHM_V, pa0, pa1, pa2, pa3);
      if (j + 1 < NT) SWRITE(buf ^ 1);
      __syncthreads();
    }
  } else {
  f32x16 pA0, pA1, pB0, pB1; float mnA, mnB, alA, alB;
  SLOAD(0); SWRITE(0); __syncthreads();
  qkt<DQK>(pA0, pA1, K_lds, qr, Q_lds, kb, qb, r32, hi); partialSM<DQK>(pA0, pA1, m_reg, mnA, alA);
  SLOAD(KVBLK);
  SWRITE(1); __syncthreads();
  for (int j = 1; j + 1 < NT; j += 2) {
    SBAR(); qkt<DQK>(pB0, pB1, K_lds + SHM_K, qr, Q_lds, kb, qb, r32, hi);
    finishSM(pA0, pA1, alA, l_reg, pa0, pa1, pa2, pa3); SBAR();
    SLOAD((j + 1) * KVBLK); SBAR();
    pv_d0(o, vb0, pa0, pa1, pa2, pa3); partialSM<DQK>(pB0, pB1, m_reg, mnB, alB);
    __syncthreads(); SWRITE(0);
    RESC(alB); __syncthreads();
    SBAR(); qkt<DQK>(pA0, pA1, K_lds, qr, Q_lds, kb, qb, r32, hi);
    finishSM(pB0, pB1, alB, l_reg, pa0, pa1, pa2, pa3); SBAR();
    SLOAD((j + 2) * KVBLK); SBAR();
    pv_d0(o, vb0 + (int)SHM_V, pa0, pa1, pa2, pa3); partialSM<DQK>(pA0, pA1, m_reg, mnA, alA);
    __syncthreads(); SWRITE(1);
    RESC(alA); __syncthreads();
  }
  SBAR(); qkt<DQK>(pB0, pB1, K_lds + SHM_K, qr, Q_lds, kb, qb, r32, hi);
  finishSM(pA0, pA1, alA, l_reg, pa0, pa1, pa2, pa3); SBAR();
  pv_d0(o, vb0, pa0, pa1, pa2, pa3); partialSM<DQK>(pB0, pB1, m_reg, mnB, alB);
  __syncthreads(); RESC(alB);
  finishSM(pB0, pB1, alB, l_reg, pa0, pa1, pa2, pa3); SBAR();
  pv_d0(o, vb0 + (int)SHM_V, pa0, pa1, pa2, pa3);
  }
  if (hi == 0) li_l[r32] = l_reg; asm volatile("s_waitcnt lgkmcnt(0)" ::: "memory");
  float rli[16];
#pragma unroll
  for (int r = 0; r < 16; ++r) rli[r] = __builtin_amdgcn_rcpf(li_l[crow(r, hi)]);
#pragma unroll
  for (int r = 0; r < 16; ++r) { const int orow = wid * QBLK + crow(r, hi);
#pragma unroll
    for (int d0 = 0; d0 < 4; ++d0) { const float v = o[d0][r] * rli[r];
      if (OUT_BF16) { const unsigned u = __float_as_uint(v); Ob[(size_t)orow * ldo + d0 * 32 + r32] = (bf16_t)((u + 0x7fffu + ((u >> 16) & 1u)) >> 16); }
      else Of[(size_t)orow * ldo + d0 * 32 + r32] = v; } }
  __syncthreads();
#undef SLOAD
#undef SWRITE
#undef RESC
}
#undef SBAR
}

#define LAS __attribute__((address_space(3)))
#ifndef PH_MASK
#define PH_MASK 0xffffffffu
#endif
#define PHON(id) ((PH_MASK >> (id)) & 1u)
typedef unsigned short bf16_t;
typedef unsigned v4u __attribute__((ext_vector_type(4)));
typedef unsigned v2u __attribute__((ext_vector_type(2)));
typedef float f32x4 __attribute__((ext_vector_type(4)));
typedef float f32x2 __attribute__((ext_vector_type(2)));
typedef short bf16x8 __attribute__((ext_vector_type(8)));
constexpr int NWAVES = 8, NTHR = 512;
constexpr int LDS_BYTES = 155648;
constexpr size_t MiB = 1u << 20;
constexpr size_t WS_CTL = 0, CTL_BYTES = 4096, WS_ROPE = 64 * 1024, WS_MOD = 128 * 1024, WS_MODP = 1 * MiB;
constexpr size_t WS_W0 = 4 * MiB, W_LAYER = 97 * MiB, WO_IN = 0, WO_Q = 21 * MiB, WO_KV = 22 * MiB, WO_OUT = 23 * MiB, WO_F1 = 31 * MiB, WO_F2 = 75 * MiB;
constexpr size_t WS_H = 198 * MiB, WS_P = 231 * MiB, WS_XBC = 318 * MiB, WS_ACT = 231 * MiB, WS_DT = 335 * MiB, WS_CQN = 336 * MiB, WS_CKVN = 343 * MiB;
constexpr size_t WS_QMLA = 348 * MiB, WS_KMLA = 361 * MiB, WS_VMLA = 374 * MiB, WS_ODIFF = 383 * MiB, WS_S = 416 * MiB, WS_R = 449 * MiB, WS_ATOT = 466 * MiB;
constexpr size_t WS_CAT = 467 * MiB, WS_PRE = 500 * MiB, WS_XA = 566 * MiB, WS_X1 = 632 * MiB, WS_END = 698 * MiB;

__device__ __forceinline__ float bf2f(bf16_t v) { return __uint_as_float((unsigned)v << 16); }
__device__ __forceinline__ unsigned f2bf(float f) { unsigned u = __float_as_uint(f); return (u + 0x7fffu + ((u >> 16) & 1u)) >> 16; }
__device__ __forceinline__ unsigned pk2(float lo, float hi) { return f2bf(lo) | (f2bf(hi) << 16); }
__device__ __forceinline__ void unpack8(v4u w, float* f) {
#pragma unroll
    for (int i = 0; i < 4; ++i) { f[2 * i] = __uint_as_float(w[i] << 16); f[2 * i + 1] = __uint_as_float(w[i] & 0xffff0000u); }
}
__device__ __forceinline__ v4u pack8(const float* f) { v4u w; w.x = pk2(f[0], f[1]); w.y = pk2(f[2], f[3]); w.z = pk2(f[4], f[5]); w.w = pk2(f[6], f[7]); return w; }
__device__ __forceinline__ v4u ld8(const bf16_t* p) { return *(const v4u*)p; }
__device__ __forceinline__ float wave_sum(float v) {
#pragma unroll
    for (int o = 1; o < 64; o <<= 1) v += __shfl_xor(v, o);
    return v;
}
__device__ __forceinline__ float siluf(float v) { return v / (1.0f + __expf(-v)); }

struct Args { const float* in[27]; float* out; unsigned char* ws; int ph_lo, ph_hi; };

struct Frame {
    LAS unsigned char* lds; char* ldsg;
    int tid, lane, wave, G, gw, NGW, bid;
    const float* in[27]; float* out; unsigned char* ws;
};
#define WSP(T, off) ((T*)(F.ws + (off)))

__device__ __forceinline__ int srccol(int mode, int n) {
    if (mode == 0) return n;
    if (mode == 1) { if (n < 4608) return n; if (n < 5312) return n + 16; if (n < 5328) return n - 5312 + 4608; return -1; }
    const int t = n >> 8, r = n & 255; return r < 128 ? t * 128 + r : 5632 + t * 128 + (r - 128);
}
__device__ __forceinline__ void transpose_item(const float* W, int K, int Nsrc, bf16_t* WT, int nblk, int mode, LAS float* scr, int item, int lane) {
    const int kb = item / nblk, nb = item % nblk, k0 = 64 * kb, n0 = 32 * nb;
    const int sc = srccol(mode, n0 + (lane & 31));
#pragma unroll 8
    for (int i = 0; i < 32; ++i) { const int kk = 2 * i + (lane >> 5); scr[kk * 33 + (lane & 31)] = (sc >= 0) ? W[(size_t)(k0 + kk) * Nsrc + sc] : 0.f; }
    asm volatile("s_waitcnt lgkmcnt(0)" ::: "memory");
    const int c = lane & 7;
#pragma unroll
    for (int j = 0; j < 4; ++j) { const int n = (lane >> 3) + 8 * j; const LAS float* s = scr + (8 * c) * 33 + n;
        v4u o; o.x = pk2(s[0 * 33], s[1 * 33]); o.y = pk2(s[2 * 33], s[3 * 33]); o.z = pk2(s[4 * 33], s[5 * 33]); o.w = pk2(s[6 * 33], s[7 * 33]);
        *(v4u*)(WT + (size_t)(n0 + n) * K + k0 + 8 * c) = o; }
    asm volatile("s_waitcnt lgkmcnt(0)" ::: "memory");
}
__device__ __forceinline__ void transpose_matrix(Frame& F, const float* W, int K, int Nsrc, bf16_t* WT, int Ndst, int mode) {
    LAS float* scr = (LAS float*)(F.lds + F.wave * 16384);
    const int nblk = Ndst / 32, nitems = (K / 64) * nblk;
    for (int it = F.gw; it < nitems; it += F.NGW) transpose_item(W, K, Nsrc, WT, nblk, mode, scr, it, F.lane);
}
__device__ __forceinline__ void phase_prologue(Frame& F) {
    {
        const float* c = F.in[1]; const float* cc = F.in[3]; const float* wada = F.in[4];
        float* modp = WSP(float, WS_MODP);
        const int NT = F.G * NTHR;
        for (int item = F.bid * NTHR + F.tid; item < 2 * 16 * 3072; item += NT) {
            const int n4 = item % 3072, kc = (item / 3072) % 16, l = item / (3072 * 16);
            f32x4 a0 = {0.f, 0.f, 0.f, 0.f}, a1 = {0.f, 0.f, 0.f, 0.f};
            const float* wp = wada + ((size_t)l * 2048 + kc * 128) * 12288 + n4 * 4;
#pragma unroll 8
            for (int k = 0; k < 128; ++k) { const f32x4 w = *(const f32x4*)(wp + (size_t)k * 12288); const float s0 = siluf(c[kc * 128 + k]), s1 = siluf(cc[kc * 128 + k]); a0 += w * s0; a1 += w * s1; }
            *(f32x4*)(modp + ((size_t)((kc * 2 + l) * 2 + 0)) * 12288 + n4 * 4) = a0;
            *(f32x4*)(modp + ((size_t)((kc * 2 + l) * 2 + 1)) * 12288 + n4 * 4) = a1;
        }
    }
    for (int l = 0; l < 2; ++l) {
        unsigned char* wb = F.ws + WS_W0 + (size_t)l * W_LAYER;
        transpose_matrix(F, F.in[6] + (size_t)l * 2048 * 5328, 2048, 5328, (bf16_t*)(wb + WO_IN), INW, 1);
        transpose_matrix(F, F.in[18] + (size_t)l * 384 * 768, 384, 768, (bf16_t*)(wb + WO_Q), 768, 0);
        transpose_matrix(F, F.in[19] + (size_t)l * 256 * 1024, 256, 1024, (bf16_t*)(wb + WO_KV), 1024, 0);
        transpose_matrix(F, F.in[20] + (size_t)l * 2048 * 2048, 2048, 2048, (bf16_t*)(wb + WO_OUT), 2048, 0);
        transpose_matrix(F, F.in[23] + (size_t)l * 2048 * 11264, 2048, 11264, (bf16_t*)(wb + WO_F1), 11264, 2);
        transpose_matrix(F, F.in[24] + (size_t)l * 5632 * 2048, 5632, 2048, (bf16_t*)(wb + WO_F2), 2048, 0);
    }
}
__device__ __forceinline__ void phase_modfinal(Frame& F) {
    const float* modp = WSP(float, WS_MODP); float* mod = WSP(float, WS_MOD); const float* bada = F.in[5];
    const int NT = F.G * NTHR;
    for (int i = F.bid * NTHR + F.tid; i < 2 * 2 * 12288; i += NT) {
        const int l = i / 24576, v = (i / 12288) & 1, n = i % 12288;
        float s = bada[l * 12288 + n];
        for (int kc = 0; kc < 16; ++kc) s += modp[((size_t)((kc * 2 + l) * 2 + v)) * 12288 + n];
        mod[i] = s;
    }
    f32x2* rope = WSP(f32x2, WS_ROPE);
    for (int i = F.bid * NTHR + F.tid; i < 128 * 16; i += NT) {
        const int pos = i >> 4, j = i & 15;
        const float inv = powf(10000.0f, -(float)j / 16.0f); const float ang = (float)pos * inv;
        f32x2 cs; cs.x = cosf(ang); cs.y = sinf(ang); rope[i] = cs;
    }
}
__device__ __forceinline__ const float* modvec(Frame& F, int l, int v, int chunk) { return WSP(float, WS_MOD) + ((size_t)(l * 2 + v) * 6 + chunk) * 2048; }
__device__ __forceinline__ void phase_copy_mod(Frame& F) {
    float* XA = WSP(float, WS_XA); bf16_t* H = WSP(bf16_t, WS_H);
    for (int r = F.gw; r < MROWS; r += F.NGW) {
        const int v = r >= SEQ; const float* src = v ? F.in[2] + (size_t)(r - SEQ) * DM : F.in[0] + (size_t)r * DM;
        const float* sh = modvec(F, 0, v, 0); const float* sc = modvec(F, 0, v, 1);
#pragma unroll
        for (int j = 0; j < 8; ++j) { const int c = 4 * F.lane + 256 * j; const f32x4 x = *(const f32x4*)(src + c); *(f32x4*)(XA + (size_t)r * DM + c) = x;
            const f32x4 s = *(const f32x4*)(sc + c), b = *(const f32x4*)(sh + c); const f32x4 h = x * (1.0f + s) + b;
            v2u w; w.x = pk2(h[0], h[1]); w.y = pk2(h[2], h[3]); *(v2u*)(H + (size_t)r * DM + c) = w; }
    }
}
__device__ __forceinline__ void phase_ln(Frame& F, int nrows, const float* PRE, const float* g, const float* b, float* xout, float* xout_lat_override, int l_mod, int ch_sh, int ch_sc, bool writeH) {
    bf16_t* H = WSP(bf16_t, WS_H);
    for (int r = F.gw; r < nrows; r += F.NGW) {
        const int v = r >= SEQ;
        f32x4 x[8]; float s = 0.f;
#pragma unroll
        for (int j = 0; j < 8; ++j) { x[j] = *(const f32x4*)(PRE + (size_t)r * DM + 4 * F.lane + 256 * j); s += (x[j][0] + x[j][1]) + (x[j][2] + x[j][3]); }
        const float mean = wave_sum(s) * (1.0f / DM); float q = 0.f;
#pragma unroll
        for (int j = 0; j < 8; ++j) { x[j] = x[j] - mean; q += (x[j][0] * x[j][0] + x[j][1] * x[j][1]) + (x[j][2] * x[j][2] + x[j][3] * x[j][3]); }
        const float rstd = rsqrtf(wave_sum(q) * (1.0f / DM) + 1e-5f);
        float* xo = (xout_lat_override && !v) ? xout_lat_override : xout;
        const float* sh = writeH ? modvec(F, l_mod, v, ch_sh) : nullptr; const float* sc = writeH ? modvec(F, l_mod, v, ch_sc) : nullptr;
#pragma unroll
        for (int j = 0; j < 8; ++j) { const int c = 4 * F.lane + 256 * j; const f32x4 gg = *(const f32x4*)(g + c), bb = *(const f32x4*)(b + c);
            const f32x4 y = x[j] * rstd * gg + bb; *(f32x4*)(xo + (size_t)r * DM + c) = y;
            if (writeH) { const f32x4 s2 = *(const f32x4*)(sc + c), b2 = *(const f32x4*)(sh + c); const f32x4 h = y * (1.0f + s2) + b2;
                v2u w; w.x = pk2(h[0], h[1]); w.y = pk2(h[2], h[3]); *(v2u*)(H + (size_t)r * DM + c) = w; } }
    }
}
__device__ __forceinline__ void phase_prep(Frame& F, int l) {
    const bf16_t* P = WSP(bf16_t, WS_P); bf16_t* CAT = WSP(bf16_t, WS_CAT); bf16_t* XBC = WSP(bf16_t, WS_XBC); float* DT = WSP(float, WS_DT);
    bf16_t* CQN = WSP(bf16_t, WS_CQN); bf16_t* CKVN = WSP(bf16_t, WS_CKVN); bf16_t* KMLA = WSP(bf16_t, WS_KMLA);
    const float* caw = F.in[7] + (size_t)l * 3 * 512; const float* scw = F.in[10] + (size_t)l * 3 * 1024; const float* scb = F.in[11] + (size_t)l * 1024;
    const float* dtb = F.in[12] + l * 16; const float* qnw = F.in[16] + l * 384; const float* kvnw = F.in[17] + l * 256;
    const int lane = F.lane;
    for (int r = F.gw; r < MROWS; r += F.NGW) {
        const bool hp = (r != 0 && r != SEQ), hn = (r != SEQ - 1 && r != MROWS - 1);
        const bf16_t* Pr = P + (size_t)r * INW; const bf16_t* Pp = Pr - INW; const bf16_t* Pn = Pr + INW;
        const v4u z4 = {0u, 0u, 0u, 0u};
        {
            const int ch = lane * 8; float bg[8], cg_[8], u_[8], cp[8], up[8], cn[8], un[8], y[8];
            unpack8(ld8(Pr + C_BG + ch), bg); unpack8(ld8(Pr + C_CG + ch), cg_); unpack8(ld8(Pr + C_U + ch), u_);
            unpack8(hp ? ld8(Pp + C_CG + ch) : z4, cp); unpack8(hp ? ld8(Pp + C_U + ch) : z4, up);
            unpack8(hn ? ld8(Pn + C_CG + ch) : z4, cn); unpack8(hn ? ld8(Pn + C_U + ch) : z4, un);
#pragma unroll
            for (int i = 0; i < 8; ++i) y[i] = bg[i] * (caw[ch + i] * cp[i] * up[i] + caw[512 + ch + i] * cg_[i] * u_[i] + caw[1024 + ch + i] * cn[i] * un[i]);
            *(v4u*)(CAT + (size_t)r * DM + ch) = pack8(y);
        }
#pragma unroll
        for (int q = 0; q < 2; ++q) {
            const int ch = lane * 8 + 512 * q; float x0[8], xp[8], xn[8], y[8];
            unpack8(ld8(Pr + C_XBC + ch), x0); unpack8(hp ? ld8(Pp + C_XBC + ch) : z4, xp); unpack8(hn ? ld8(Pn + C_XBC + ch) : z4, xn);
#pragma unroll
            for (int i = 0; i < 8; ++i) y[i] = siluf(scw[ch + i] * xp[i] + scw[1024 + ch + i] * x0[i] + scw[2048 + ch + i] * xn[i] + scb[ch + i]);
            *(v4u*)(XBC + (size_t)r * 1024 + ch) = pack8(y);
        }
        if (lane < 16) { const float v = bf2f(Pr[C_DT + lane]) + dtb[lane]; DT[(size_t)r * 16 + lane] = v > 20.f ? v : log1pf(__expf(v)); }
        {
            float x[8]; float ss = 0.f;
            if (lane < 48) { unpack8(ld8(Pr + C_CQ + lane * 8), x);
#pragma unroll
                for (int i = 0; i < 8; ++i) ss += x[i] * x[i]; }
            const float rs = rsqrtf(wave_sum(ss) * (1.0f / 384.f) + 1e-6f);
            if (lane < 48) {
#pragma unroll
                for (int i = 0; i < 8; ++i) x[i] = x[i] * rs * qnw[lane * 8 + i];
                *(v4u*)(CQN + (size_t)r * 384 + lane * 8) = pack8(x); }
        }
        {
            float x[8]; float ss = 0.f;
            if (lane < 32) { unpack8(ld8(Pr + C_CKV + lane * 8), x);
#pragma unroll
                for (int i = 0; i < 8; ++i) ss += x[i] * x[i]; }
            const float rs = rsqrtf(wave_sum(ss) * (1.0f / 256.f) + 1e-6f);
            if (lane < 32) {
#pragma unroll
                for (int i = 0; i < 8; ++i) x[i] = x[i] * rs * kvnw[lane * 8 + i];
                *(v4u*)(CKVN + (size_t)r * 256 + lane * 8) = pack8(x); }
        }
        if (lane < 32) { const int hh = lane >> 3, part = lane & 7; *(v4u*)(KMLA + (size_t)r * 768 + hh * 192 + 128 + part * 8) = ld8(Pr + C_KR + part * 8); }
    }
}
__device__ __forceinline__ int ssd_rowbase(int ci) { return ci < 2 ? SEQ + 128 * ci : 128 * (ci - 2); }
__device__ __forceinline__ void ssd_cum(const float* DT, const float* alog, int rb, int h, int d, int lane, float& a0, float& a1, float& ac0, float& ac1, float& total, float& dt0, float& dt1) {
    dt0 = DT[(size_t)(rb + 2 * lane) * 16 + d * 8 + h]; dt1 = DT[(size_t)(rb + 2 * lane + 1) * 16 + d * 8 + h];
    const float A = -__expf(alog[d * 8 + h]);
    a0 = dt0 * A; a1 = dt1 * A;
    const float pair = a0 + a1; float incl = pair;
#pragma unroll
    for (int o = 1; o < 64; o <<= 1) { const float t = __shfl_up(incl, o); if (lane >= o) incl += t; }
    const float excl = incl - pair;
    ac0 = excl + a0; ac1 = incl; total = __shfl(incl, 63);
}
constexpr int LP = 136;
__device__ __forceinline__ void phase_ssd1(Frame& F, int l) {
    const bf16_t* XBC = WSP(bf16_t, WS_XBC); const float* DT = WSP(float, WS_DT); float* S = WSP(float, WS_S); float* ATOT = WSP(float, WS_ATOT);
    const float* alog = F.in[13] + l * 16;
    char* lds = F.ldsg;
    bf16_t* BT = (bf16_t*)lds; bf16_t* XT = (bf16_t*)(lds + 34816); float* WG = (float*)(lds + 69632);
    const int tid = F.tid, lane = F.lane, w = F.wave;
    for (int u = (F.G - 1 - F.bid); u < 132; u += F.G) {
        const int ci = u >> 1, g = u & 1, rb = ssd_rowbase(ci);
        {
            const int ll = tid >> 2, n0 = (tid & 3) * 32;
#pragma unroll
            for (int q = 0; q < 4; ++q) { const v4u v = ld8(XBC + (size_t)(rb + ll) * 1024 + 512 + g * 128 + n0 + 8 * q);
#pragma unroll
                for (int i = 0; i < 4; ++i) { BT[(n0 + 8 * q + 2 * i) * LP + ll] = (bf16_t)(v[i] & 0xffffu); BT[(n0 + 8 * q + 2 * i + 1) * LP + ll] = (bf16_t)(v[i] >> 16); } }
        }
        {
            const int hh = w >> 1, d = w & 1, h = g * 4 + hh; float a0, a1, ac0, ac1, total, dt0, dt1;
            ssd_cum(DT, alog, rb, h, d, lane, a0, a1, ac0, ac1, total, dt0, dt1);
            float e0, e1;
            if (d == 0) { e0 = __expf(total - ac0); e1 = __expf(total - ac1); } else { e0 = __expf(ac0 - a0); e1 = __expf(ac1 - a1); }
            WG[w * 128 + 2 * lane] = e0 * dt0; WG[w * 128 + 2 * lane + 1] = e1 * dt1;
            if (lane == 0) ATOT[(ci * 8 + h) * 2 + d] = total;
        }
        __syncthreads();
        for (int hh = 0; hh < 4; ++hh) {
            const int h = g * 4 + hh;
            {
                const int ll = tid >> 2, p0 = (tid & 3) * 16; const float w0 = WG[(hh * 2) * 128 + ll], w1 = WG[(hh * 2 + 1) * 128 + ll];
#pragma unroll
                for (int q = 0; q < 2; ++q) { float x[8]; unpack8(ld8(XBC + (size_t)(rb + ll) * 1024 + h * 64 + p0 + 8 * q), x);
#pragma unroll
                    for (int i = 0; i < 8; ++i) { XT[(p0 + 8 * q + i) * LP + ll] = (bf16_t)f2bf(x[i] * w0); XT[(64 + p0 + 8 * q + i) * LP + ll] = (bf16_t)f2bf(x[i] * w1); } }
            }
            __syncthreads();
            const int pt = w & 3, nh = w >> 2;
#pragma unroll
            for (int d = 0; d < 2; ++d) {
                f32x4 acc[4];
#pragma unroll
                for (int nt = 0; nt < 4; ++nt) acc[nt] = (f32x4){0.f, 0.f, 0.f, 0.f};
#pragma unroll
                for (int ks = 0; ks < 4; ++ks) {
                    const bf16x8 a = *(const bf16x8*)(XT + (d * 64 + pt * 16 + (lane & 15)) * LP + ks * 32 + (lane >> 4) * 8);
#pragma unroll
                    for (int nt = 0; nt < 4; ++nt) { const bf16x8 b = *(const bf16x8*)(BT + ((nh * 4 + nt) * 16 + (lane & 15)) * LP + ks * 32 + (lane >> 4) * 8);
                        acc[nt] = __builtin_amdgcn_mfma_f32_16x16x32_bf16(a, b, acc[nt], 0, 0, 0); }
                }
                float* Sp = S + (size_t)((ci * 8 + h) * 2 + d) * 8192;
#pragma unroll
                for (int nt = 0; nt < 4; ++nt)
#pragma unroll
                    for (int j = 0; j < 4; ++j) Sp[(pt * 16 + (lane >> 4) * 4 + j) * 128 + (nh * 4 + nt) * 16 + (lane & 15)] = acc[nt][j];
            }
            __syncthreads();
        }
    }
}
__device__ __forceinline__ void ssd_scan_unit(Frame& F, int su) {
    const float* S = WSP(float, WS_S); const float* ATOT = WSP(float, WS_ATOT); bf16_t* Rb = WSP(bf16_t, WS_R);
    const int hd = su >> 2, h = hd >> 1, d = hd & 1, e = (su & 3) * 2048 + F.tid * 4;
    f32x4 R = {0.f, 0.f, 0.f, 0.f};
#pragma unroll 4
    for (int step = 0; step < 66; ++step) {
        const int ci = (d == 0) ? step : (step == 0 ? 1 : (step == 1 ? 0 : 67 - step));
        const size_t base = (size_t)((ci * 8 + h) * 2 + d);
        v2u wv; wv.x = pk2(R[0], R[1]); wv.y = pk2(R[2], R[3]); *(v2u*)(Rb + base * 8192 + e) = wv;
        const float dec = __expf(ATOT[base]); const f32x4 sv = *(const f32x4*)(S + base * 8192 + e);
        R = R * dec + sv;
    }
}
__device__ __forceinline__ void phase_ssd2(Frame& F, int l, int ci_first) {
    const bf16_t* XBC = WSP(bf16_t, WS_XBC); const bf16_t* P = WSP(bf16_t, WS_P); const float* DT = WSP(float, WS_DT); const bf16_t* Rb = WSP(bf16_t, WS_R); bf16_t* CAT = WSP(bf16_t, WS_CAT);
    const float* alog = F.in[13] + l * 16; const float* dskip = F.in[14] + l * 8; const float* normw = F.in[15] + l * 512;
    char* lds = F.ldsg;
    bf16_t* CL = (bf16_t*)lds; bf16_t* BL = (bf16_t*)(lds + 34816); bf16_t* XT = (bf16_t*)(lds + 34816); bf16_t* RL = (bf16_t*)(lds + 52224);
    const int tid = F.tid, lane = F.lane, w = F.wave;
    bf16_t* PW = (bf16_t*)(lds + 69632 + w * 4352); bf16_t* CW = (bf16_t*)(lds + 104448 + w * 4352); float* CUM = (float*)(lds + 139264); float* DTV = (float*)(lds + 143360);
    const int nunits = (66 - ci_first) * 2;
    for (int u = (F.G - 1 - F.bid); u < nunits; u += F.G) {
        const int ci = ci_first + (u >> 1), g = u & 1, rb = ssd_rowbase(ci);
        {
            const int row = tid >> 2, c0 = (tid & 3) * 32;
#pragma unroll
            for (int q = 0; q < 4; ++q) { *(v4u*)(CL + row * LP + c0 + 8 * q) = ld8(XBC + (size_t)(rb + row) * 1024 + 768 + g * 128 + c0 + 8 * q);
                *(v4u*)(BL + row * LP + c0 + 8 * q) = ld8(XBC + (size_t)(rb + row) * 1024 + 512 + g * 128 + c0 + 8 * q); }
        }
        {
            const int hh = w >> 1, d = w & 1, h = g * 4 + hh; float a0, a1, ac0, ac1, total, dt0, dt1;
            ssd_cum(DT, alog, rb, h, d, lane, a0, a1, ac0, ac1, total, dt0, dt1);
            float c0v, c1v;
            if (d == 0) { c0v = ac0; c1v = ac1; } else { c0v = total - (ac0 - a0); c1v = total - (ac1 - a1); }
            CUM[w * 128 + 2 * lane] = c0v; CUM[w * 128 + 2 * lane + 1] = c1v; DTV[w * 128 + 2 * lane] = dt0; DTV[w * 128 + 2 * lane + 1] = dt1;
        }
        __syncthreads();
        f32x4 gacc[8];
#pragma unroll
        for (int nt = 0; nt < 8; ++nt) gacc[nt] = (f32x4){0.f, 0.f, 0.f, 0.f};
#pragma unroll
        for (int ks = 0; ks < 4; ++ks) {
            const bf16x8 a = *(const bf16x8*)(CL + (16 * w + (lane & 15)) * LP + ks * 32 + (lane >> 4) * 8);
#pragma unroll
            for (int nt = 0; nt < 8; ++nt) { const bf16x8 b = *(const bf16x8*)(BL + (nt * 16 + (lane & 15)) * LP + ks * 32 + (lane >> 4) * 8);
                gacc[nt] = __builtin_amdgcn_mfma_f32_16x16x32_bf16(a, b, gacc[nt], 0, 0, 0); }
        }
        __syncthreads();
        f32x4 yacc[4][4];
#pragma unroll
        for (int a = 0; a < 4; ++a)
#pragma unroll
            for (int b = 0; b < 4; ++b) yacc[a][b] = (f32x4){0.f, 0.f, 0.f, 0.f};
#pragma unroll
        for (int hh = 0; hh < 4; ++hh) {
            const int h = g * 4 + hh;
#pragma unroll
            for (int d = 0; d < 2; ++d) {
                const int idx = hh * 2 + d;
                {
                    const int s = tid >> 2, p0 = (tid & 3) * 16; const float dtv = DTV[idx * 128 + s];
#pragma unroll
                    for (int q = 0; q < 2; ++q) { float x[8]; unpack8(ld8(XBC + (size_t)(rb + s) * 1024 + h * 64 + p0 + 8 * q), x);
#pragma unroll
                        for (int i = 0; i < 8; ++i) XT[(p0 + 8 * q + i) * LP + s] = (bf16_t)f2bf(x[i] * dtv); }
                }
                {
                    const int p = tid >> 3, n0 = (tid & 7) * 16; const bf16_t* src = Rb + (size_t)((ci * 8 + h) * 2 + d) * 8192 + p * 128 + n0;
                    *(v4u*)(RL + p * LP + n0) = ld8(src); *(v4u*)(RL + p * LP + n0 + 8) = ld8(src + 8);
                }
                {
#pragma unroll
                    for (int nt = 0; nt < 8; ++nt)
#pragma unroll
                        for (int j = 0; j < 4; ++j) { const int lrow = (lane >> 4) * 4 + j, lt = 16 * w + lrow, s = nt * 16 + (lane & 15);
                            const float e = CUM[idx * 128 + lt] - CUM[idx * 128 + s]; const bool ok = (d == 0) ? (s <= lt) : (s >= lt);
                            const float pv = ok ? gacc[nt][j] * __expf(e) : 0.f; PW[lrow * LP + s] = (bf16_t)f2bf(pv); }
                }
                {
                    const int rr = lane >> 2, c0 = (lane & 3) * 32; const float ex = __expf(CUM[idx * 128 + 16 * w + rr]);
#pragma unroll
                    for (int q = 0; q < 4; ++q) { float x[8]; unpack8(*(const v4u*)(CL + (16 * w + rr) * LP + c0 + 8 * q), x);
#pragma unroll
                        for (int i = 0; i < 8; ++i) x[i] *= ex;
                        *(v4u*)(CW + rr * LP + c0 + 8 * q) = pack8(x); }
                }
                __syncthreads();
#pragma unroll
                for (int ks = 0; ks < 4; ++ks) {
                    const bf16x8 ap = *(const bf16x8*)(PW + (lane & 15) * LP + ks * 32 + (lane >> 4) * 8);
                    const bf16x8 ac = *(const bf16x8*)(CW + (lane & 15) * LP + ks * 32 + (lane >> 4) * 8);
#pragma unroll
                    for (int pt = 0; pt < 4; ++pt) {
                        const bf16x8 bx = *(const bf16x8*)(XT + (pt * 16 + (lane & 15)) * LP + ks * 32 + (lane >> 4) * 8);
                        const bf16x8 br = *(const bf16x8*)(RL + (pt * 16 + (lane & 15)) * LP + ks * 32 + (lane >> 4) * 8);
                        yacc[hh][pt] = __builtin_amdgcn_mfma_f32_16x16x32_bf16(ap, bx, yacc[hh][pt], 0, 0, 0);
                        yacc[hh][pt] = __builtin_amdgcn_mfma_f32_16x16x32_bf16(ac, br, yacc[hh][pt], 0, 0, 0);
                    }
                }
                __syncthreads();
            }
        }
#pragma unroll
        for (int j = 0; j < 4; ++j) {
            const int row = rb + 16 * w + (lane >> 4) * 4 + j; float ssq = 0.f;
#pragma unroll
            for (int hh = 0; hh < 4; ++hh)
#pragma unroll
                for (int pt = 0; pt < 4; ++pt) { const int ch = hh * 64 + pt * 16 + (lane & 15);
                    const float xs = bf2f(XBC[(size_t)row * 1024 + g * 256 + ch]), z = bf2f(P[(size_t)row * INW + C_Z + g * 256 + ch]);
                    const float y = yacc[hh][pt][j] + xs * dskip[g * 4 + hh]; const float gv = y * siluf(z); yacc[hh][pt][j] = gv; ssq += gv * gv; }
            ssq += __shfl_xor(ssq, 1); ssq += __shfl_xor(ssq, 2); ssq += __shfl_xor(ssq, 4); ssq += __shfl_xor(ssq, 8);
            const float rs = rsqrtf(ssq * (1.0f / 256.f) + 1e-6f);
#pragma unroll
            for (int hh = 0; hh < 4; ++hh)
#pragma unroll
                for (int pt = 0; pt < 4; ++pt) { const int ch = hh * 64 + pt * 16 + (lane & 15);
                    CAT[(size_t)row * DM + 1024 + g * 256 + ch] = (bf16_t)f2bf(yacc[hh][pt][j] * rs * normw[g * 256 + ch]); }
        }
        __syncthreads();
    }
}
__device__ __forceinline__ void phase_diffcombine(Frame& F, int l, int nrows) {
    const float* OD = WSP(float, WS_ODIFF); bf16_t* CAT = WSP(bf16_t, WS_CAT);
    const float* lp = F.in[8] + l * 256; const float* sub = F.in[9] + l * 128;
    const int lane = F.lane;
    const float s1 = wave_sum(lp[lane] * lp[64 + lane]), s2 = wave_sum(lp[128 + lane] * lp[192 + lane]);
    const float lam_init = 0.8f - 0.6f * expf(-0.3f * (float)l);
    const float lam = expf(s1) - expf(s2) + lam_init;
    const int hh = lane >> 4, e0 = (lane & 15) * 8;
    float sw[8];
#pragma unroll
    for (int i = 0; i < 8; ++i) sw[i] = sub[e0 + i] * (1.0f - lam_init);
    for (int r = F.gw; r < nrows; r += F.NGW) {
        const float* o1 = OD + (size_t)r * 1024 + (hh * 2) * 128 + e0; const float* o2 = o1 + 128;
        const f32x4 a0 = *(const f32x4*)o1, a1 = *(const f32x4*)(o1 + 4), b0 = *(const f32x4*)o2, b1 = *(const f32x4*)(o2 + 4);
        float o[8]; float ss = 0.f;
#pragma unroll
        for (int i = 0; i < 4; ++i) { o[i] = a0[i] - lam * b0[i]; o[4 + i] = a1[i] - lam * b1[i]; }
#pragma unroll
        for (int i = 0; i < 8; ++i) ss += o[i] * o[i];
        ss += __shfl_xor(ss, 1); ss += __shfl_xor(ss, 2); ss += __shfl_xor(ss, 4); ss += __shfl_xor(ss, 8);
        const float rs = rsqrtf(ss * (1.0f / 128.f) + 1e-6f);
#pragma unroll
        for (int i = 0; i < 8; ++i) o[i] = o[i] * rs * sw[i];
        *(v4u*)(CAT + (size_t)r * DM + 512 + hh * 128 + e0) = pack8(o);
    }
}
__device__ __forceinline__ void phase_attn(Frame& F, int l) {
    unsigned* ctr = WSP(unsigned, WS_CTL) + 64 * (1 + l);
    LAS unsigned* bc = (LAS unsigned*)(F.lds + LDS_BYTES - 64);
    const bf16_t* P = WSP(bf16_t, WS_P); const bf16_t* QM = WSP(bf16_t, WS_QMLA); const bf16_t* KM = WSP(bf16_t, WS_KMLA); const bf16_t* VM = WSP(bf16_t, WS_VMLA);
    float* OD = WSP(float, WS_ODIFF); bf16_t* CAT = WSP(bf16_t, WS_CAT);
    const int n_scan = 64, n_mla = 128, n_diff = 256, n_cm = (l == 0) ? 4 : 0, n_cd = (l == 0) ? 8 : 0;
    const int total = n_scan + n_mla + n_diff + n_cm + n_cd;
    for (;;) {
        __syncthreads();
        if (F.tid == 0) bc[0] = atomicAdd(ctr, 1u);
        __syncthreads();
        int u = (int)bc[0];
        if (u >= total) break;
        if (u < n_scan) { if (PHON(9)) ssd_scan_unit(F, u); continue; }
        u -= n_scan;
        if (u < n_mla) { if (!PHON(7)) continue; const int h = u >> 5, qb = u & 31; const size_t q0 = (size_t)qb * 256;
            att::attn_dense_body<192, true, 768, 768, 512, DM>(QM + q0 * 768 + h * 192, KM + h * 192, VM + h * 128, nullptr, CAT + q0 * DM + 1536 + h * 128, MROWS, F.ldsg); continue; }
        u -= n_mla;
        if (u < n_diff) { if (!PHON(8)) continue; const int mi = u >> 5, qb = u & 31; const size_t q0 = (size_t)qb * 256;
            att::attn_dense_body<64, false, INW, INW, INW, 1024>(P + q0 * INW + C_DQ + mi * 64, P + C_DK + mi * 64, P + C_DV + (mi >> 1) * 128, OD + q0 * 1024 + mi * 128, nullptr, MROWS, F.ldsg); continue; }
        u -= n_diff;
        if (u < n_cm) { if (!PHON(7)) continue; const int h = u; const size_t q0 = SEQ;
            att::attn_dense_body<192, true, 768, 768, 512, DM>(QM + q0 * 768 + h * 192, KM + q0 * 768 + h * 192, VM + q0 * 512 + h * 128, nullptr, CAT + q0 * DM + 1536 + h * 128, NCTX, F.ldsg); continue; }
        u -= n_cm;
        if (PHON(8)) { const int mi = u; const size_t q0 = SEQ;
            att::attn_dense_body<64, false, INW, INW, INW, 1024>(P + q0 * INW + C_DQ + mi * 64, P + q0 * INW + C_DK + mi * 64, P + q0 * INW + C_DV + (mi >> 1) * 128, OD + q0 * 1024 + mi * 128, nullptr, NCTX, F.ldsg); }
    }
}

__global__ void __launch_bounds__(NTHR, 2) mk_fwd(Args args) {
    extern __shared__ __attribute__((aligned(16))) unsigned char lds_raw[];
    Frame F;
    F.lds = (LAS unsigned char*)lds_raw; F.ldsg = (char*)lds_raw;
    const int lo = args.ph_lo, hi = args.ph_hi;
    for (int ph = lo; ph < hi; ++ph) {
        if (ph > lo) cg::this_grid().sync();
        {
#pragma unroll
            for (int i = 0; i < 27; ++i) { const float* p = args.in[i]; asm volatile("" : "+s"(p)); F.in[i] = p; }
            float* op = args.out; unsigned char* wp = args.ws; asm volatile("" : "+s"(op), "+s"(wp)); F.out = op; F.ws = wp; }
        F.tid = ltid(); F.lane = F.tid & 63; F.wave = __builtin_amdgcn_readfirstlane(F.tid >> 6);
        F.bid = lbid(); F.G = gridDim.x; F.gw = F.bid * NWAVES + F.wave; F.NGW = F.G * NWAVES;
        if (ph == 0) { if (PHON(0)) phase_prologue(F); continue; }
        if (ph == 1) { if (PHON(1)) phase_modfinal(F); continue; }
        if (ph == 2) { if (PHON(2)) phase_copy_mod(F); continue; }
        const int l = (ph - 3) / 10, sp = (ph - 3) % 10;
        const bool last = (l == 1);
        int Kq = 384, Kkv = 256; asm volatile("" : "+s"(Kq), "+s"(Kkv));
        const int Mact = last ? SEQ : MROWS;
        unsigned char* wb = F.ws + WS_W0 + (size_t)l * W_LAYER;
        if (sp == 0) { if (PHON(3)) {
            pg8::Gemm g{WSP(const bf16_t, WS_H), (const bf16_t*)(wb + WO_IN), MROWS, INW, DM}; pg8::StaticOrder S; S.init(MROWS, INW, F.G, F.bid);
            pg8::EpiBf16R<0> E{WSP(bf16_t, WS_P), nullptr, WSP(const pg8::f32x2, WS_ROPE)};
            pg8::gemm_phase<pg8::EpiBf16R<0>, pg8::StaticOrder, true, true>(F.lds, g, S, E); }
        } else if (sp == 1) {
            if (PHON(4)) phase_prep(F, l);
        } else if (sp == 2) {
            if (PHON(5)) { pg8::Gemm g{WSP(const bf16_t, WS_CQN), (const bf16_t*)(wb + WO_Q), Mact, 768, Kq}; pg8::StaticOrder S; S.init(Mact, 768, F.G, F.bid);
              pg8::EpiBf16R<1> E{WSP(bf16_t, WS_QMLA), nullptr, WSP(const pg8::f32x2, WS_ROPE)};
              pg8::gemm_phase<pg8::EpiBf16R<1>, pg8::StaticOrder, true, true>(F.lds, g, S, E); }
            __syncthreads();
            if (PHON(16)) { pg8::Gemm g{WSP(const bf16_t, WS_CKVN), (const bf16_t*)(wb + WO_KV), MROWS, 1024, Kkv}; pg8::StaticOrder S; S.init(MROWS, 1024, F.G, F.bid);
              pg8::EpiBf16R<2> E{WSP(bf16_t, WS_KMLA), WSP(bf16_t, WS_VMLA), nullptr};
              pg8::gemm_phase<pg8::EpiBf16R<2>, pg8::StaticOrder, true, true>(F.lds, g, S, E); }
            __syncthreads();
            if (PHON(6)) phase_ssd1(F, l);
        } else if (sp == 3) {
            phase_attn(F, l);
        } else if (sp == 4) {
            if (PHON(10)) phase_ssd2(F, l, last ? 2 : 0);
            if (PHON(11)) phase_diffcombine(F, l, Mact);
        } else if (sp == 5) { if (PHON(12)) {
            pg8::Gemm g{WSP(const bf16_t, WS_CAT), (const bf16_t*)(wb + WO_OUT), Mact, DM, DM}; pg8::StaticOrder S; S.init(Mact, DM, F.G, F.bid);
            pg8::EpiResid E{WSP(const float, WS_XA), WSP(float, WS_PRE), modvec(F, l, 0, 2), modvec(F, l, 1, 2)};
            pg8::gemm_phase<pg8::EpiResid, pg8::StaticOrder, true, true>(F.lds, g, S, E); }
        } else if (sp == 6) {
            if (PHON(13)) phase_ln(F, Mact, WSP(const float, WS_PRE), F.in[21] + l * DM, F.in[22] + l * DM, WSP(float, WS_X1), nullptr, l, 3, 4, true);
        } else if (sp == 7) { if (PHON(14)) {
            pg8::Gemm g{WSP(const bf16_t, WS_H), (const bf16_t*)(wb + WO_F1), Mact, 2 * DFF, DM}; pg8::StaticOrder S; S.init(Mact, 2 * DFF, F.G, F.bid);
            pg8::EpiSwiglu E{WSP(bf16_t, WS_ACT)};
            pg8::gemm_phase<pg8::EpiSwiglu, pg8::StaticOrder, true, true>(F.lds, g, S, E); }
        } else if (sp == 8) { if (PHON(15)) {
            pg8::Gemm g{WSP(const bf16_t, WS_ACT), (const bf16_t*)(wb + WO_F2), Mact, DM, DFF}; pg8::StaticOrder S; S.init(Mact, DM, F.G, F.bid);
            pg8::EpiResid E{WSP(const float, WS_X1), WSP(float, WS_PRE), modvec(F, l, 0, 5), modvec(F, l, 1, 5)};
            pg8::gemm_phase<pg8::EpiResid, pg8::StaticOrder, true, true>(F.lds, g, S, E); }
        } else if (PHON(13)) {
            if (!last) phase_ln(F, Mact, WSP(const float, WS_PRE), F.in[25] + l * DM, F.in[26] + l * DM, WSP(float, WS_XA), nullptr, l + 1, 0, 1, true);
            else       phase_ln(F, Mact, WSP(const float, WS_PRE), F.in[25] + l * DM, F.in[26] + l * DM, F.out, nullptr, 0, 0, 1, false);
        }
    }
}

extern "C" void kernel_launch(void* const* d_in, const int* in_sizes, int n_in, void* d_out, int out_size, void* d_ws, size_t ws_size, hipStream_t stream) {
    static int grid = 0;
    if (grid == 0) {
        if (n_in != 27 || in_sizes[0] != SEQ * DM || out_size != SEQ * DM || ws_size < WS_END) {
            fprintf(stderr, "kernel_launch: unexpected shapes: n_in %d in0 %d out %d ws %zu (need >= %zu)\n", n_in, n_in > 0 ? in_sizes[0] : -1, out_size, ws_size, (size_t)WS_END); grid = -1; return; }
        int dev = 0, cus = 0, per_cu = 0;
        if (hipGetDevice(&dev) != hipSuccess || hipDeviceGetAttribute(&cus, hipDeviceAttributeMultiprocessorCount, dev) != hipSuccess) { grid = -1; return; }
        if (hipFuncSetAttribute((const void*)mk_fwd, hipFuncAttributeMaxDynamicSharedMemorySize, LDS_BYTES) != hipSuccess) { fprintf(stderr, "kernel_launch: hipFuncSetAttribute failed\n"); grid = -1; return; }
        if (hipOccupancyMaxActiveBlocksPerMultiprocessor(&per_cu, (const void*)mk_fwd, NTHR, LDS_BYTES) != hipSuccess || per_cu < 1) { fprintf(stderr, "kernel_launch: occupancy query gave %d\n", per_cu); per_cu = 1; }
        (void)hipGetLastError();
        grid = cus * 1;
    }
    if (grid < 0) return;
    (void)hipMemsetAsync((char*)d_ws + WS_CTL, 0, CTL_BYTES, stream);
    Args a{};
    for (int i = 0; i < 27; ++i) a.in[i] = (const float*)d_in[i];
    a.out = (float*)d_out; a.ws = (unsigned char*)d_ws;
#if MK_ONE_LAUNCH
    a.ph_lo = 0; a.ph_hi = NPH;
    void* kargs[] = {&a};
    hipError_t e = hipLaunchCooperativeKernel((const void*)mk_fwd, dim3(grid), dim3(NTHR), kargs, LDS_BYTES, stream);
    if (e != hipSuccess) fprintf(stderr, "kernel_launch: cooperative launch failed: %s (grid %d)\n", hipGetErrorString(e), grid);
#else
    for (int ph = 0; ph < NPH; ++ph) { a.ph_lo = ph; a.ph_hi = ph + 1; hipLaunchKernelGGL(mk_fwd, dim3(grid), dim3(NTHR), LDS_BYTES, stream, a); }
    const hipError_t le = hipPeekAtLastError();
    if (le != hipSuccess) fprintf(stderr, "kernel_launch: launch failed: %s\n", hipGetErrorName(le));
#endif
}
```

```cpp
#include <hip/hip_runtime.h>
#include <hip/hip_cooperative_groups.h>
#include <cstdio>
#include <cstdint>
namespace cg = cooperative_groups;

#ifndef MK_ONE_LAUNCH
#define MK_ONE_LAUNCH 1
#endif

constexpr int DM = 2048, SEQ = 8192, NCTX = 256, MROWS = SEQ + NCTX;
constexpr int INW = 5376;
constexpr int DFF = 5632;
constexpr int NPH = 23;
constexpr int C_BG = 0, C_CG = 512, C_U = 1024, C_DQ = 1536, C_DK = 2048, C_DV = 2560, C_Z = 3072, C_XBC = 3584, C_CQ = 4608, C_CKV = 4992, C_KR = 5248, C_DT = 5312;
constexpr float ALPHA_F = 1.4142135623730951f;

__device__ __forceinline__ int ltid() { int t = threadIdx.x; asm volatile("" : "+v"(t)); return t; }
__device__ __forceinline__ int lbid() { int b = blockIdx.x; asm volatile("" : "+s"(b)); return b; }

__device__ const float2 ROPE_TAB[2048] = {
  {1.000000000e+00f, 0.000000000e+00f}, {1.000000000e+00f, 0.000000000e+00f}, {1.000000000e+00f, 0.000000000e+00f}, {1.000000000e+00f, 0.000000000e+00f}, {1.000000000e+00f, 0.000000000e+00f}, {1.000000000e+00f, 0.000000000e+00f}, {1.000000000e+00f, 0.000000000e+00f}, {1.000000000e+00f, 0.000000000e+00f},
  {1.000000000e+00f, 0.000000000e+00f}, {1.000000000e+00f, 0.000000000e+00f}, {1.000000000e+00f, 0.000000000e+00f}, {1.000000000e+00f, 0.000000000e+00f}, {1.000000000e+00f, 0.000000000e+00f}, {1.000000000e+00f, 0.000000000e+00f}, {1.000000000e+00f, 0.000000000e+00f}, {1.000000000e+00f, 0.000000000e+00f},
  {5.403023059e-01f, 8.414709848e-01f}, {8.460091064e-01f, 5.331684460e-01f}, {9.504152809e-01f, 3.109835909e-01f}, {9.842302348e-01f, 1.768921847e-01f}, {9.950041651e-01f, 9.983341813e-02f}, {9.984192778e-01f, 5.620449919e-02f}, {9.995000417e-01f, 3.161750470e-02f}, {9.998418903e-01f, 1.778185709e-02f},
  {9.999500004e-01f, 9.999833111e-03f}, {9.999841887e-01f, 5.623383612e-03f}, {9.999950000e-01f, 3.162272359e-03f}, {9.999984189e-01f, 1.778278494e-03f}, {9.999995000e-01f, 9.999998808e-04f}, {9.999998419e-01f, 5.623412721e-04f}, {9.999999500e-01f, 3.162277519e-04f}, {9.999999842e-01f, 1.778279393e-04f},
  {-4.161468365e-01f, 9.092974268e-01f}, {4.314628163e-01f, 9.021307212e-01f}, {8.065784124e-01f, 5.911271138e-01f}, {9.374183100e-01f, 3.482052729e-01f}, {9.800665772e-01f, 1.986693337e-01f}, {9.936821085e-01f, 1.122313110e-01f}, {9.980006668e-01f, 6.320339453e-02f}, {9.993676111e-01f, 3.555809121e-02f},
  {9.998000067e-01f, 1.999866625e-02f}, {9.999367551e-01f, 1.124658940e-02f}, {9.999800001e-01f, 6.324513096e-03f}, {9.999936755e-01f, 3.556551364e-03f}, {9.999980000e-01f, 1.999998762e-03f}, {9.999993675e-01f, 1.124682366e-03f}, {9.999998000e-01f, 6.324554721e-04f}, {9.999999368e-01f, 3.556558729e-04f},
  {-9.899924966e-01f, 1.411200081e-01f}, {-1.159661631e-01f, 9.932531646e-01f}, {5.827536401e-01f, 8.126488756e-01f}, {8.610406595e-01f, 5.085361174e-01f}, {9.553364856e-01f, 2.955202180e-01f}, {9.858034692e-01f, 1.679033061e-01f}, {9.955033745e-01f, 9.472608625e-02f}, {9.985773124e-01f, 5.332308304e-02f},
  {9.995500338e-01f, 2.999549953e-02f}, {9.998577009e-01f, 1.686943954e-02f}, {9.999550003e-01f, 9.486690354e-03f}, {9.999857698e-01f, 5.334812988e-03f}, {9.999955000e-01f, 2.999995526e-03f}, {9.999985770e-01f, 1.687023105e-03f}, {9.999995500e-01f, 9.486831000e-04f}, {9.999998577e-01f, 5.334837808e-04f},
  {-6.536436209e-01f, -7.568024953e-01f}, {-6.276796763e-01f, 7.784717233e-01f}, {3.011374707e-01f, 9.535807379e-01f}, {7.575061759e-01f, 6.528279969e-01f}, {9.210609917e-01f, 3.894183478e-01f}, {9.748082657e-01f, 2.230444915e-01f}, {9.920106618e-01f, 1.261540598e-01f}, {9.974712443e-01f, 7.107120934e-02f},
  {9.992001067e-01f, 3.998933329e-02f}, {9.997470285e-01f, 2.249175622e-02f}, {9.999200011e-01f, 1.264877321e-02f}, {9.999747019e-01f, 7.113057742e-03f}, {9.999920000e-01f, 3.999989523e-03f}, {9.999974702e-01f, 2.249363310e-03f}, {9.999992000e-01f, 1.264910691e-03f}, {9.999997470e-01f, 7.113117008e-04f},
  {2.836621855e-01f, -9.589242747e-01f}, {-9.460792425e-01f, 3.239352821e-01f}, {-1.034233808e-02f, 9.999465166e-01f}, {6.300802992e-01f, 7.765299843e-01f}, {8.775825619e-01f, 4.794255386e-01f}, {9.607312596e-01f, 2.774805341e-01f}, {9.875260225e-01f, 1.574558824e-01f}, {9.960497565e-01f, 8.879686156e-02f},
  {9.987502605e-01f, 4.997916629e-02f}, {9.996047413e-01f, 2.811336165e-02f}, {9.998750026e-01f, 1.581072865e-02f}, {9.999604718e-01f, 8.891280002e-03f}, {9.999875000e-01f, 4.999979521e-03f}, {9.999960472e-01f, 2.811702920e-03f}, {9.999987500e-01f, 1.581138156e-03f}, {9.999996047e-01f, 8.891395984e-04f},
  {9.601702867e-01f, -2.794154982e-01f}, {-9.731036980e-01f, -2.303675170e-01f}, {-3.207963899e-01f, 9.471481807e-01f}, {4.827820346e-01f, 8.757405478e-01f}, {8.253356014e-01f, 5.646424931e-01f}, {9.436169596e-01f, 3.310393232e-01f}, {9.820539372e-01f, 1.886002770e-01f}, {9.943132976e-01f, 1.064944419e-01f},
  {9.982005400e-01f, 5.996400514e-02f}, {9.994308440e-01f, 3.373407806e-02f}, {9.998200054e-01f, 1.897252691e-02f}, {9.999430795e-01f, 1.066947415e-02f}, {9.999820001e-01f, 5.999964052e-03f}, {9.999943079e-01f, 3.374041408e-03f}, {9.999982000e-01f, 1.897365346e-03f}, {9.999994308e-01f, 1.066967410e-03f},
  {7.539022543e-01f, 6.569865987e-01f}, {-7.004298139e-01f, -7.137212872e-01f}, {-5.994374526e-01f, 8.004216016e-01f}, {3.202570024e-01f, 9.473306986e-01f}, {7.648421950e-01f, 6.442176781e-01f}, {9.235194568e-01f, 3.835515778e-01f}, {9.755998794e-01f, 2.195560870e-01f}, {9.922624183e-01f, 1.241583392e-01f},
  {9.975510002e-01f, 6.994284763e-02f}, {9.992253421e-01f, 3.935372584e-02f}, {9.997550100e-01f, 2.213413545e-02f}, {9.999225252e-01f, 1.244763455e-02f}, {9.999755001e-01f, 6.999943050e-03f}, {9.999922524e-01f, 3.936378830e-03f}, {9.999975500e-01f, 2.213592463e-03f}, {9.999992252e-01f, 1.244795304e-03f},
  {-1.455000338e-01f, 9.893582466e-01f}, {-2.120364479e-01f, -9.772617586e-01f}, {-8.186324475e-01f, 5.743177830e-01f}, {1.476312130e-01f, 9.890424788e-01f}, {6.967067008e-01f, 7.173560992e-01f}, {9.005023096e-01f, 4.348512278e-01f}, {9.681703064e-01f, 2.502923447e-01f}, {9.898977664e-01f, 1.417829752e-01f},
  {9.968017064e-01f, 7.991469219e-02f}, {9.989882418e-01f, 4.497213288e-02f}, {9.996800171e-01f, 2.529552265e-02f}, {9.998988088e-01f, 1.422575559e-02f}, {9.999680002e-01f, 7.999915047e-03f}, {9.999898807e-01f, 4.498715239e-03f}, {9.999968000e-01f, 2.529819359e-03f}, {9.999989881e-01f, 1.422623042e-03f},
  {-9.111302619e-01f, 4.121184852e-01f}, {3.416602554e-01f, -9.398235313e-01f}, {-9.566441680e-01f, 2.912592245e-01f}, {-2.965079623e-02f, 9.995603185e-01f}, {6.216099403e-01f, 7.833269319e-01f}, {8.746382611e-01f, 4.847761465e-01f}, {9.597726443e-01f, 2.807783310e-01f}, {9.872200896e-01f, 1.593627767e-01f},
  {9.959527334e-01f, 8.987854534e-02f}, {9.987195508e-01f, 5.058911778e-02f}, {9.995950273e-01f, 2.845665689e-02f}, {9.998719305e-01f, 1.600383071e-02f}, {9.999595003e-01f, 8.999879044e-03f}, {9.999871928e-01f, 5.061050226e-03f}, {9.999959500e-01f, 2.846046001e-03f}, {9.999987193e-01f, 1.600450735e-03f},
  {-8.390715291e-01f, -5.440211109e-01f}, {7.901318660e-01f, -6.129368926e-01f}, {-9.997860721e-01f, -2.068356987e-02f}, {-2.059976331e-01f, 9.785524897e-01f}, {5.403023059e-01f, 8.414709848e-01f}, {8.460091064e-01f, 5.331684460e-01f}, {9.504152902e-01f, 3.109835626e-01f}, {9.842302348e-01f, 1.768921847e-01f},
  {9.950041659e-01f, 9.983341072e-02f}, {9.984192778e-01f, 5.620449919e-02f}, {9.995000417e-01f, 3.161750470e-02f}, {9.998418903e-01f, 1.778185709e-02f}, {9.999500004e-01f, 9.999834042e-03f}, {9.999841887e-01f, 5.623383612e-03f}, {9.999950000e-01f, 3.162272359e-03f}, {9.999984189e-01f, 1.778278494e-03f},
  {4.425697988e-03f, -9.999902066e-01f}, {9.952573993e-01f, -9.727645772e-02f}, {-9.437797393e-01f, -3.305749593e-01f}, {-3.758474003e-01f, 9.266815697e-01f}, {4.535961002e-01f, 8.912073709e-01f}, {8.147053420e-01f, 5.798751639e-01f}, {9.401075903e-01f, 3.408778647e-01f}, {9.809291472e-01f, 1.943656558e-01f},
  {9.939560980e-01f, 1.097783002e-01f}, {9.980874321e-01f, 6.181810327e-02f}, {9.993950610e-01f, 3.477804006e-02f}, {9.998086883e-01f, 1.955982724e-02f}, {9.999395006e-01f, 1.099977904e-02f}, {9.999808683e-01f, 6.185714754e-03f}, {9.999939500e-01f, 3.478498401e-03f}, {9.999980868e-01f, 1.956106080e-03f},
  {8.438539587e-01f, -5.365729180e-01f}, {8.938616142e-01f, 4.483429653e-01f}, {-7.941793525e-01f, -6.076834341e-01f}, {-5.338430142e-01f, 8.455836068e-01f}, {3.623577100e-01f, 9.320391032e-01f}, {7.808259330e-01f, 6.247486393e-01f}, {9.288598710e-01f, 3.704312892e-01f}, {9.773178677e-01f, 2.117776794e-01f},
  {9.928086362e-01f, 1.197122046e-01f}, {9.977240240e-01f, 6.742975621e-02f}, {9.992800864e-01f, 3.793822392e-02f}, {9.997723246e-01f, 2.133773367e-02f}, {9.999280009e-01f, 1.199971211e-02f}, {9.999772317e-01f, 6.748044406e-03f}, {9.999928000e-01f, 3.794723862e-03f}, {9.999977232e-01f, 2.133933605e-03f},
  {9.074467815e-01f, 4.201670368e-01f}, {5.171728454e-01f, 8.558809777e-01f}, {-5.658204930e-01f, -8.245284529e-01f}, {-6.750016657e-01f, 7.378162043e-01f}, {2.674987597e-01f, 9.635582046e-01f}, {7.444779872e-01f, 6.676470075e-01f}, {9.166833698e-01f, 3.996143135e-01f}, {9.733975442e-01f, 2.291227201e-01f},
  {9.915618943e-01f, 1.296341379e-01f}, {9.973290651e-01f, 7.303927684e-02f}, {9.991551190e-01f, 4.109803212e-02f}, {9.997327995e-01f, 2.311557262e-02f}, {9.999155012e-01f, 1.299963410e-02f}, {9.999732789e-01f, 7.310371924e-03f}, {9.999915500e-01f, 4.110949176e-03f}, {9.999973279e-01f, 2.311761062e-03f},
  {1.367372182e-01f, 9.906073557e-01f}, {-1.879615160e-02f, 9.998233367e-01f}, {-2.813494808e-01f, -9.596053718e-01f}, {-7.948709048e-01f, 6.067785796e-01f}, {1.699671664e-01f, 9.854497259e-01f}, {7.057763743e-01f, 7.084346897e-01f}, {9.035902493e-01f, 4.283977840e-01f}, {9.691694136e-01f, 2.463953078e-01f},
  {9.902159961e-01f, 1.395431152e-01f}, {9.969025685e-01f, 7.864648034e-02f}, {9.990201601e-01f, 4.425742562e-02f}, {9.996901128e-01f, 2.489334034e-02f}, {9.999020016e-01f, 1.399954310e-02f}, {9.999690098e-01f, 7.872696665e-03f}, {9.999902000e-01f, 4.427174080e-03f}, {9.999969010e-01f, 2.489588678e-03f},
  {-7.596879129e-01f, 6.502878402e-01f}, {-5.489754720e-01f, 8.358384600e-01f}, {3.102235090e-02f, -9.995186910e-01f}, {-8.896704271e-01f, 4.566032536e-01f}, {7.073720167e-02f, 9.974949866e-01f}, {6.648435293e-01f, 7.469826514e-01f}, {8.895936264e-01f, 4.567528653e-01f}, {9.646348168e-01f, 2.635899662e-01f},
  {9.887710793e-01f, 1.494381236e-01f}, {9.964445467e-01f, 8.425120425e-02f}, {9.988752109e-01f, 4.741638026e-02f}, {9.996442648e-01f, 2.667102934e-02f}, {9.998875021e-01f, 1.499943810e-02f}, {9.999644246e-01f, 8.435019847e-03f}, {9.999887500e-01f, 4.743398540e-03f}, {9.999964424e-01f, 2.667415984e-03f},
  {-9.576594803e-01f, -2.879033167e-01f}, {-9.100810896e-01f, 4.144302238e-01f}, {3.403181682e-01f, -9.403103447e-01f}, {-9.564100499e-01f, 2.920270818e-01f}, {-2.919954613e-02f, 9.995736023e-01f}, {6.218088193e-01f, 7.831690700e-01f}, {8.747074844e-01f, 4.846512321e-01f}, {9.597951759e-01f, 2.807013010e-01f},
  {9.872272839e-01f, 1.593182031e-01f}, {9.959550145e-01f, 8.985326392e-02f}, {9.987202731e-01f, 5.057485702e-02f}, {9.995952558e-01f, 2.844863214e-02f}, {9.998720027e-01f, 1.599931810e-02f}, {9.999595231e-01f, 8.997339431e-03f}, {9.999872000e-01f, 5.059622526e-03f}, {9.999959523e-01f, 2.845243204e-03f},
  {-2.751633381e-01f, -9.613974919e-01f}, {-9.908979596e-01f, -1.346151313e-01f}, {6.158647923e-01f, -7.878518627e-01f}, {-9.929849841e-01f, 1.182405237e-01f}, {-1.288445416e-01f, 9.916648043e-01f}, {5.768082960e-01f, 8.168795441e-01f}, {8.589467084e-01f, 5.120649883e-01f}, {9.546520286e-01f, 2.977238725e-01f},
  {9.855847666e-01f, 1.691823508e-01f}, {9.954339876e-01f, 9.545248218e-02f}, {9.985553481e-01f, 5.373282803e-02f}, {9.995430857e-01f, 3.022614497e-02f}, {9.998555035e-01f, 1.699918210e-02f}, {9.999543054e-01f, 9.559656169e-03f}, {9.999855500e-01f, 5.375846007e-03f}, {9.999954305e-01f, 3.023070335e-03f},
  {6.603167082e-01f, -7.509872468e-01f}, {-7.665365398e-01f, -6.422006954e-01f}, {8.303361283e-01f, -5.572628770e-01f}, {-9.982416606e-01f, -5.927551864e-02f}, {-2.272021643e-01f, 9.738476146e-01f}, {5.299841756e-01f, 8.480075316e-01f}, {8.423270577e-01f, 5.389667224e-01f}, {9.492070108e-01f, 3.146522695e-01f},
  {9.838436942e-01f, 1.790295658e-01f}, {9.948814823e-01f, 1.010486820e-01f}, {9.983804374e-01f, 5.689026544e-02f}, {9.994877548e-01f, 3.200356222e-02f}, {9.998380044e-01f, 1.799902910e-02f}, {9.999487715e-01f, 1.012197082e-02f}, {9.999838000e-01f, 5.692068949e-03f}, {9.999948771e-01f, 3.200897370e-03f},
  {9.887046182e-01f, 1.498772097e-01f}, {-3.060954058e-01f, -9.520008417e-01f}, {9.624637956e-01f, -2.714100995e-01f}, {-9.720142724e-01f, -2.349218044e-01f}, {-3.232895443e-01f, 9.463000954e-01f}, {4.814845890e-01f, 8.764545570e-01f}, {8.248651506e-01f, 5.653295351e-01f}, {9.434618259e-01f, 3.314811956e-01f},
  {9.820042356e-01f, 1.888588926e-01f}, {9.942975170e-01f, 1.066416789e-01f}, {9.981955430e-01f, 6.004713022e-02f}, {9.994292631e-01f, 3.378088199e-02f}, {9.998195054e-01f, 1.899885811e-02f}, {9.999429214e-01f, 1.068428133e-02f}, {9.999819501e-01f, 6.008291323e-03f}, {9.999942921e-01f, 3.378724537e-03f},
  {4.080820618e-01f, 9.129452507e-01f}, {2.486167313e-01f, -9.686019414e-01f}, {9.991443799e-01f, 4.135829015e-02f}, {-9.151299503e-01f, -4.031589936e-01f}, {-4.161468365e-01f, 9.092974268e-01f}, {4.314628163e-01f, 9.021307212e-01f}, {8.065784476e-01f, 5.911270657e-01f}, {9.374183100e-01f, 3.482052729e-01f},
  {9.800665802e-01f, 1.986693191e-01f}, {9.936821085e-01f, 1.122313110e-01f}, {9.980006668e-01f, 6.320339453e-02f}, {9.993676111e-01f, 3.555809121e-02f}, {9.998000066e-01f, 1.999866811e-02f}, {9.999367551e-01f, 1.124658940e-02f}, {9.999800001e-01f, 6.324513096e-03f}, {9.999936755e-01f, 3.556551364e-03f},
  {-5.477292602e-01f, 8.366556385e-01f}, {7.267602563e-01f, -6.868912067e-01f}, {9.367404516e-01f, 3.500247509e-01f}, {-8.293829489e-01f, -5.586805205e-01f}, {-5.048462281e-01f, 8.632092944e-01f}, {3.800769984e-01f, 9.249548504e-01f}, {7.874851971e-01f, 6.163335658e-01f}, {9.310783539e-01f, 3.648192688e-01f},
  {9.780309161e-01f, 2.084598934e-01f}, {9.930352772e-01f, 1.178173940e-01f}, {9.977958103e-01f, 6.635903053e-02f}, {9.993027988e-01f, 3.733518799e-02f}, {9.997795081e-01f, 2.099845811e-02f}, {9.999302726e-01f, 1.180889298e-02f}, {9.999779501e-01f, 6.640734236e-03f}, {9.999930272e-01f, 3.734378079e-03f},
  {-9.999608264e-01f, -8.851309290e-03f}, {9.810745815e-01f, -1.936302286e-01f}, {7.814403926e-01f, 6.239798978e-01f}, {-7.174774633e-01f, -6.965817179e-01f}, {-5.885011558e-01f, 8.084963758e-01f}, {3.274895886e-01f, 9.448547874e-01f}, {7.676045628e-01f, 6.409237359e-01f}, {9.244439837e-01f, 3.813178741e-01f},
  {9.758974496e-01f, 2.182296219e-01f}, {9.923570442e-01f, 1.233997439e-01f}, {9.975809759e-01f, 6.951400294e-02f}, {9.992348263e-01f, 3.911217043e-02f}, {9.997580097e-01f, 2.199822712e-02f}, {9.999234739e-01f, 1.237119282e-02f}, {9.999758001e-01f, 6.956954712e-03f}, {9.999923473e-01f, 3.912204676e-03f},
  {-5.328330203e-01f, -8.462204042e-01f}, {9.332357723e-01f, 3.592645171e-01f}, {5.486452564e-01f, 8.360552510e-01f}, {-5.829432350e-01f, -8.125128828e-01f}, {-6.662759857e-01f, 7.457052439e-01f}, {2.738668392e-01f, 9.617676197e-01f}, {7.469563882e-01f, 6.648730361e-01f}, {9.175172750e-01f, 3.976959268e-01f},
  {9.736663975e-01f, 2.279775131e-01f}, {9.916474294e-01f, 1.289781990e-01f}, {9.973561656e-01f, 7.266828020e-02f}, {9.991636941e-01f, 4.088902546e-02f}, {9.997355116e-01f, 2.299797413e-02f}, {9.999163589e-01f, 1.293348969e-02f}, {9.999735501e-01f, 7.273174492e-03f}, {9.999916358e-01f, 4.090031381e-03f},
  {4.241790073e-01f, -9.055783620e-01f}, {5.979771709e-01f, 8.015131335e-01f}, {2.614416878e-01f, 9.652192724e-01f}, {-4.300232723e-01f, -9.028178029e-01f}, {-7.373937800e-01f, 6.754631102e-01f}, {2.193782753e-01f, 9.756398784e-01f}, {7.255613200e-01f, 6.881575190e-01f}, {9.103004290e-01f, 4.139482201e-01f},
  {9.713379761e-01f, 2.377026212e-01f}, {9.909064560e-01f, 1.345525754e-01f}, {9.971213823e-01f, 7.582182336e-02f}, {9.990894022e-01f, 4.266575118e-02f}, {9.997120138e-01f, 2.399769627e-02f}, {9.999089278e-01f, 1.349578153e-02f}, {9.999712001e-01f, 7.589393080e-03f}, {9.999908927e-01f, 4.267857492e-03f},
  {9.912028119e-01f, -1.323517501e-01f}, {7.855226359e-02f, 9.969099969e-01f}, {-5.168932904e-02f, 9.986632131e-01f}, {-2.635405934e-01f, -9.646483067e-01f}, {-8.011436155e-01f, 5.984721441e-01f}, {1.641961594e-01f, 9.864277070e-01f}, {7.034407513e-01f, 7.107539022e-01f}, {9.027957408e-01f, 4.300695879e-01f},
  {9.689124217e-01f, 2.474039593e-01f}, {9.901341474e-01f, 1.401226969e-01f}, {9.968766273e-01f, 7.897461572e-02f}, {9.990119510e-01f, 4.444234199e-02f}, {9.996875163e-01f, 2.499739629e-02f}, {9.999011805e-01f, 1.405806910e-02f}, {9.999687502e-01f, 7.905611374e-03f}, {9.999901179e-01f, 4.445683934e-03f},
  {6.469193223e-01f, 7.625584505e-01f}, {-4.650644959e-01f, 8.852768012e-01f}, {-3.596943393e-01f, 9.330701915e-01f}, {-8.874550263e-02f, -9.960543337e-01f}, {-8.568888271e-01f, 5.155012492e-01f}, {1.084949468e-01f, 9.940970006e-01f}, {6.806168009e-01f, 7.326395911e-01f}, {8.950055582e-01f, 4.460549862e-01f},
  {9.663899806e-01f, 2.570805427e-01f}, {9.893305281e-01f, 1.456883874e-01f}, {9.966219035e-01f, 8.212661834e-02f}, {9.989313406e-01f, 4.621879226e-02f}, {9.996620190e-01f, 2.599707130e-02f}, {9.998931169e-01f, 1.462035317e-02f}, {9.999662002e-01f, 8.221828878e-03f}, {9.999893115e-01f, 4.623509769e-03f},
  {-2.921388087e-01f, 9.563759284e-01f}, {-8.654506342e-01f, 5.009942114e-01f}, {-6.320286307e-01f, 7.749450367e-01f}, {8.884811635e-02f, -9.960451858e-01f}, {-9.040721624e-01f, 4.273798371e-01f}, {5.245061444e-02f, 9.986235192e-01f}, {6.571122908e-01f, 7.537927018e-01f}, {8.869323709e-01f, 4.618993066e-01f},
  {9.637709015e-01f, 2.667314183e-01f}, {9.884956235e-01f, 1.512494708e-01f}, {9.963572141e-01f, 8.527779227e-02f}, {9.988475711e-01f, 4.799510009e-02f}, {9.996355221e-01f, 2.699672032e-02f}, {9.998847372e-01f, 1.518263167e-02f}, {9.999635502e-01f, 8.538045559e-03f}, {9.999884735e-01f, 4.801335923e-03f},
  {-9.626058663e-01f, 2.709057883e-01f}, {-9.992934094e-01f, -3.758566202e-02f}, {-8.416849393e-01f, 5.399689462e-01f}, {2.636395107e-01f, -9.646212772e-01f}, {-9.422223247e-01f, 3.349881951e-01f}, {-3.759419011e-03f, 9.999929334e-01f}, {6.329506774e-01f, 7.741921209e-01f}, {8.785787046e-01f, 4.775975920e-01f},
  {9.610554380e-01f, 2.763556497e-01f}, {9.876294623e-01f, 1.568057565e-01f}, {9.960825606e-01f, 8.842812085e-02f}, {9.987606432e-01f, 4.977125243e-02f}, {9.996080256e-01f, 2.799634234e-02f}, {9.998760413e-01f, 1.574490538e-02f}, {9.999608003e-01f, 8.854261387e-03f}, {9.999876039e-01f, 4.979161926e-03f},
  {-7.480575297e-01f, -6.636338842e-01f}, {-8.253716334e-01f, -5.645898217e-01f}, {-9.678715076e-01f, 2.514453117e-01f}, {4.301158485e-01f, -9.027737019e-01f}, {-9.709581880e-01f, 2.392492366e-01f}, {-5.995756728e-02f, 9.982009267e-01f}, {6.081562113e-01f, 7.938173736e-01f}, {8.699472142e-01f, 4.931448515e-01f},
  {9.582438779e-01f, 2.859522171e-01f}, {9.867320673e-01f, 1.623570984e-01f}, {9.957979462e-01f, 9.157756515e-02f}, {9.986705569e-01f, 5.154724737e-02f}, {9.995795294e-01f, 2.899593637e-02f}, {9.998670292e-01f, 1.630717503e-02f}, {9.999579503e-01f, 9.170476329e-03f}, {9.999867027e-01f, 5.156987306e-03f},
  {1.542514499e-01f, -9.880316241e-01f}, {-3.972518623e-01f, -9.177096261e-01f}, {-9.980752275e-01f, -6.201483913e-02f}, {5.830269376e-01f, -8.124528233e-01f}, {-9.899924966e-01f, 1.411200081e-01f}, {-1.159661631e-01f, 9.932531646e-01f}, {5.827536401e-01f, 8.126488756e-01f}, {8.610406595e-01f, 5.085361174e-01f},
  {9.553364944e-01f, 2.955201896e-01f}, {9.858034692e-01f, 1.679033061e-01f}, {9.955033738e-01f, 9.472609366e-02f}, {9.985773124e-01f, 5.332308304e-02f}, {9.995500337e-01f, 2.999550139e-02f}, {9.998577009e-01f, 1.686943954e-02f}, {9.999550003e-01f, 9.486690354e-03f}, {9.999857698e-01f, 5.334812988e-03f},
  {9.147423578e-01f, -4.040376453e-01f}, {1.532154756e-01f, -9.881928041e-01f}, {-9.293002953e-01f, -3.693250075e-01f}, {7.175492218e-01f, -6.965077991e-01f}, {-9.991351562e-01f, 4.158051951e-02f}, {-1.716081385e-01f, 9.851652891e-01f}, {5.567683641e-01f, 8.306677968e-01f}, {8.518617972e-01f, 5.237666260e-01f},
  {9.523335692e-01f, 3.050586387e-01f}, {9.848436973e-01f, 1.734442042e-01f}, {9.951988471e-01f, 9.787366751e-02f}, {9.984809103e-01f, 5.509874635e-02f}, {9.995195384e-01f, 3.099503643e-02f}, {9.998480564e-01f, 1.743169684e-02f}, {9.999519504e-01f, 9.802903431e-03f}, {9.999848053e-01f, 5.512638036e-03f},
  {8.342233605e-01f, 5.514266812e-01f}, {6.564951791e-01f, -7.543302193e-01f}, {-7.683670888e-01f, -6.400093881e-01f}, {8.294403670e-01f, -5.585952717e-01f}, {-9.982947730e-01f, -5.837419103e-02f}, {-2.267075845e-01f, 9.739628695e-01f}, {5.302263665e-01f, 8.478561200e-01f}, {8.424135592e-01f, 5.388315091e-01f},
  {9.492354203e-01f, 3.145665538e-01f}, {9.838527819e-01f, 1.789796175e-01f}, {9.948843677e-01f, 1.010202700e-01f}, {9.983813507e-01f, 5.687423543e-02f}, {9.994880436e-01f, 3.199454047e-02f}, {9.998380958e-01f, 1.799395049e-02f}, {9.999488004e-01f, 1.011911553e-02f}, {9.999838092e-01f, 5.690463375e-03f},
  {-1.327674722e-02f, 9.999118601e-01f}, {9.575860738e-01f, -2.881473778e-01f}, {-5.312352786e-01f, -8.472243379e-01f}, {9.151713830e-01f, -4.030649323e-01f}, {-9.874797774e-01f, -1.577456471e-01f}, {-2.810903074e-01f, 9.596813216e-01f}, {5.031541870e-01f, 8.641966582e-01f}, {8.326989334e-01f, 5.537260030e-01f},
  {9.460423489e-01f, 3.240430126e-01f}, {9.828307545e-01f, 1.845093711e-01f}, {9.945599394e-01f, 1.041658623e-01f}, {9.982786339e-01f, 5.864954466e-02f}, {9.994555494e-01f, 3.299401065e-02f}, {9.998278189e-01f, 1.855619846e-02f}, {9.999455505e-01f, 1.043532661e-02f}, {9.999827814e-01f, 5.868288535e-03f},
  {-8.485702748e-01f, 5.290826861e-01f}, {9.637575328e-01f, 2.667797179e-01f}, {-2.414211151e-01f, -9.704204476e-01f}, {9.720383571e-01f, -2.348221291e-01f}, {-9.667981682e-01f, -2.555411942e-01f}, {-3.345843792e-01f, 9.423657958e-01f}, {4.755788956e-01f, 8.796730723e-01f}, {8.227209915e-01f, 5.684453977e-01f},
  {9.427546643e-01f, 3.334870955e-01f}, {9.817776473e-01f, 1.900332899e-01f}, {9.942255664e-01f, 1.073104056e-01f}, {9.981727603e-01f, 6.042466843e-02f}, {9.994220556e-01f, 3.399345156e-02f}, {9.998172259e-01f, 1.911843869e-02f}, {9.999422006e-01f, 1.075153665e-02f}, {9.999817221e-01f, 6.046113043e-03f},
  {-9.036922051e-01f, -4.281826695e-01f}, {6.731102676e-01f, 7.395421338e-01f}, {7.233466718e-02f, -9.973804169e-01f}, {9.982477619e-01f, -5.917267879e-02f}, {-9.364566873e-01f, -3.507832277e-01f}, {-3.870206816e-01f, 9.220710342e-01f}, {4.475280652e-01f, 8.942698871e-01f}, {8.124829236e-01f, 5.829849902e-01f},
  {9.393727149e-01f, 3.428978019e-01f}, {9.806934936e-01f, 1.955511994e-01f}, {9.938812503e-01f, 1.104538832e-01f}, {9.980637300e-01f, 6.219960483e-02f}, {9.993875625e-01f, 3.499285475e-02f}, {9.998063168e-01f, 1.968067474e-02f}, {9.999387506e-01f, 1.106774562e-02f}, {9.999806311e-01f, 6.223937825e-03f},
  {-1.279636896e-01f, -9.917788534e-01f}, {1.751565337e-01f, 9.845405978e-01f}, {3.789161719e-01f, -9.254309994e-01f}, {9.929728258e-01f, 1.183425843e-01f}, {-8.967583530e-01f, -4.425205716e-01f}, {-4.382335472e-01f, 8.988611451e-01f}, {4.190297442e-01f, 9.079725070e-01f}, {8.019878986e-01f, 5.973402803e-01f},
  {9.358968291e-01f, 3.522742188e-01f}, {9.795783277e-01f, 2.010629250e-01f}, {9.935269954e-01f, 1.135962562e-01f}, {9.979515440e-01f, 6.397433710e-02f}, {9.993520699e-01f, 3.599222668e-02f}, {9.997950914e-01f, 2.024290457e-02f}, {9.999352007e-01f, 1.138395348e-02f}, {9.999795085e-01f, 6.401761945e-03f},
  {7.654140519e-01f, -6.435381334e-01f}, {-3.767422893e-01f, 9.263181135e-01f}, {6.479216888e-01f, -7.617069550e-01f}, {9.563800296e-01f, 2.921253822e-01f}, {-8.481000064e-01f, -5.298361813e-01f}, {-4.880608524e-01f, 8.728096037e-01f}, {3.901124287e-01f, 9.207672306e-01f}, {7.912392691e-01f, 6.115066795e-01f},
  {9.323273439e-01f, 3.616154364e-01f}, {9.784321880e-01f, 2.065682779e-01f}, {9.931628052e-01f, 1.167374932e-01f}, {9.978362017e-01f, 6.574887451e-02f}, {9.993155781e-01f, 3.699155889e-02f}, {9.997835499e-01f, 2.080512613e-02f}, {9.999315508e-01f, 1.170016020e-02f}, {9.999783543e-01f, 6.579586328e-03f},
  {9.550736440e-01f, 2.963685787e-01f}, {-8.126112051e-01f, 5.828061679e-01f}, {8.526731157e-01f, -5.224447891e-01f}, {8.896234916e-01f, 4.566946935e-01f}, {-7.909677411e-01f, -6.118578532e-01f}, {-5.363451811e-01f, 8.439987244e-01f}, {3.608050334e-01f, 9.326412643e-01f}, {7.802404339e-01f, 6.254797082e-01f},
  {9.286646373e-01f, 3.709204650e-01f}, {9.772551046e-01f, 2.120671131e-01f}, {9.927886843e-01f, 1.198775555e-01f}, {9.977177040e-01f, 6.752320399e-02f}, {9.992780868e-01f, 3.799085783e-02f}, {9.997716923e-01f, 2.136734297e-02f}, {9.999278009e-01f, 1.201636575e-02f}, {9.999771684e-01f, 6.757410504e-03f},
  {2.666429324e-01f, 9.637953863e-01f}, {-9.982103598e-01f, 5.980031485e-02f}, {9.728653499e-01f, -2.313720187e-01f}, {7.948083899e-01f, 6.068604645e-01f}, {-7.259322386e-01f, -6.877662284e-01f}, {-5.829338849e-01f, 8.125195911e-01f}, {3.311368634e-01f, 9.435827349e-01f}, {7.689949093e-01f, 6.392549018e-01f},
  {9.249090653e-01f, 3.801884019e-01f}, {9.760471178e-01f, 2.175592422e-01f}, {9.924046346e-01f, 1.230164264e-01f}, {9.975960518e-01f, 6.929731252e-02f}, {9.992395964e-01f, 3.899011506e-02f}, {9.997595184e-01f, 2.192955306e-02f}, {9.999239510e-01f, 1.233257010e-02f}, {9.999759510e-01f, 6.935234000e-03f},
  {-6.669380617e-01f, 7.451131605e-01f}, {-8.763794418e-01f, -4.816212973e-01f}, {9.965789837e-01f, 8.264580634e-02f}, {6.749256518e-01f, 7.378857395e-01f}, {-6.536436209e-01f, -7.568024953e-01f}, {-6.276796763e-01f, 7.784717233e-01f}, {3.011375844e-01f, 9.535807020e-01f}, {7.575061759e-01f, 6.528279969e-01f},
  {9.210610033e-01f, 3.894183203e-01f}, {9.748082657e-01f, 2.230444915e-01f}, {9.920106618e-01f, 1.261540598e-01f}, {9.974712443e-01f, 7.107120934e-02f}, {9.992001065e-01f, 3.998933702e-02f}, {9.997470285e-01f, 2.249175622e-02f}, {9.999200011e-01f, 1.264877321e-02f}, {9.999747019e-01f, 7.113057742e-03f},
  {-9.873392775e-01f, -1.586226688e-01f}, {-4.846393970e-01f, -8.747140418e-01f}, {9.214623472e-01f, 3.884676855e-01f}, {5.337561004e-01f, 8.456384720e-01f}, {-5.748240246e-01f, -8.182770562e-01f}, {-6.704410942e-01f, 7.419627614e-01f}, {2.708370782e-01f, 9.626252007e-01f}, {7.457779040e-01f, 6.661946547e-01f},
  {9.171208242e-01f, 3.986093247e-01f}, {9.735385875e-01f, 2.285226875e-01f}, {9.916067680e-01f, 1.292904390e-01f}, {9.973432826e-01f, 7.284488142e-02f}, {9.991596177e-01f, 4.098851526e-02f}, {9.997342224e-01f, 2.305395040e-02f}, {9.999159512e-01f, 1.296497506e-02f}, {9.999734212e-01f, 7.290880793e-03f},
  {-3.999853150e-01f, -9.165215479e-01f}, {5.636094028e-02f, -9.984104589e-01f}, {7.549653475e-01f, 6.557646866e-01f}, {3.757521519e-01f, 9.267201953e-01f}, {-4.902605720e-01f, -8.715759127e-01f}, {-7.110829506e-01f, 7.031081264e-01f}, {2.402658714e-01f, 9.707071191e-01f}, {7.338138022e-01f, 6.793506485e-01f},
  {9.130889457e-01f, 4.077604411e-01f}, {9.722381233e-01f, 2.339936570e-01f}, {9.911929581e-01f, 1.324255253e-01f}, {9.972121675e-01f, 7.461831571e-02f}, {9.991181295e-01f, 4.198765625e-02f}, {9.997211001e-01f, 2.361613915e-02f}, {9.999118013e-01f, 1.328117562e-02f}, {9.999721088e-01f, 7.468704080e-03f},
  {5.551133015e-01f, -8.317747426e-01f}, {5.800031129e-01f, -8.146142578e-01f}, {5.135984179e-01f, 8.580306901e-01f}, {2.058971709e-01f, 9.785736329e-01f}, {-4.007989973e-01f, -9.161660132e-01f}, {-7.494767587e-01f, 6.620306550e-01f}, {2.094544189e-01f, 9.778184118e-01f}, {7.216176540e-01f, 6.922918182e-01f},
  {9.089657591e-01f, 4.168707818e-01f}, {9.709069144e-01f, 2.394572270e-01f}, {9.907692363e-01f, 1.355592873e-01f}, {9.970778984e-01f, 7.639152146e-02f}, {9.990756424e-01f, 4.298675152e-02f}, {9.997076617e-01f, 2.417832043e-02f}, {9.999075514e-01f, 1.359737484e-02f}, {9.999707649e-01f, 7.646527131e-03f},
  {9.998433086e-01f, 1.770192511e-02f}, {9.250146691e-01f, -3.799313911e-01f}, {2.212981743e-01f, 9.752061926e-01f}, {2.954782069e-02f, 9.995633678e-01f}, {-3.073327792e-01f, -9.516021032e-01f}, {-7.855011387e-01f, 6.188602113e-01f}, {1.784335295e-01f, 9.839519681e-01f}, {7.091933579e-01f, 7.050140291e-01f},
  {9.047516642e-01f, 4.259394629e-01f}, {9.695450064e-01f, 2.449132102e-01f}, {9.903356068e-01f, 1.386916938e-01f}, {9.969404762e-01f, 7.816448565e-02f}, {9.990321560e-01f, 4.398580752e-02f}, {9.996939072e-01f, 2.474049220e-02f}, {9.999032016e-01f, 1.391357271e-02f}, {9.999693893e-01f, 7.824349474e-03f},
  {5.253219888e-01f, 8.509035245e-01f}, {9.851382016e-01f, 1.717635693e-01f}, {-9.294810554e-02f, 9.956709545e-01f}, {-1.477329862e-01f, 9.890272821e-01f}, {-2.107957994e-01f, -9.775301177e-01f}, {-8.190422014e-01f, 5.737332763e-01f}, {1.472342216e-01f, 9.891016550e-01f}, {6.965447594e-01f, 7.175133435e-01f},
  {9.004471075e-01f, 4.349655234e-01f}, {9.681524315e-01f, 2.503614776e-01f}, {9.898920739e-01f, 1.418227133e-01f}, {9.967999021e-01f, 7.993719522e-02f}, {9.989876708e-01f, 4.498481582e-02f}, {9.996798365e-01f, 2.530265802e-02f}, {9.998987517e-01f, 1.422976918e-02f}, {9.999679821e-01f, 8.002171569e-03f},
  {-4.321779449e-01f, 9.017883476e-01f}, {7.418580135e-01f, 6.705569982e-01f}, {-3.979767653e-01f, 9.173954950e-01f}, {-3.203543695e-01f, 9.472977768e-01f}, {-1.121526217e-01f, -9.936909929e-01f}, {-8.499939088e-01f, 5.267925161e-01f}, {1.158876918e-01f, 9.932623233e-01f}, {6.836758997e-01f, 7.297857660e-01f},
  {8.960525071e-01f, 4.439480877e-01f}, {9.667292484e-01f, 2.558017989e-01f}, {9.894386421e-01f, 1.449523146e-01f}, {9.966561752e-01f, 8.170965944e-02f}, {9.989421864e-01f, 4.598378286e-02f}, {9.996654497e-01f, 2.586481583e-02f}, {9.998942019e-01f, 1.454596424e-02f}, {9.999665433e-01f, 8.179994343e-03f},
  {-9.923354692e-01f, 1.235731227e-01f}, {2.700984580e-01f, 9.628327077e-01f}, {-6.635382560e-01f, 7.481423547e-01f}, {-4.828719382e-01f, 8.756909793e-01f}, {-1.238837738e-02f, -9.999232611e-01f}, {-8.782584087e-01f, 4.781863313e-01f}, {8.442528403e-02f, 9.964298126e-01f}, {6.705908480e-01f, 7.418274156e-01f},
  {8.915682887e-01f, 4.528862843e-01f}, {9.652754871e-01f, 2.612340599e-01f}, {9.889753181e-01f, 1.480804517e-01f}, {9.965092972e-01f, 8.348185785e-02f}, {9.988957032e-01f, 4.698270019e-02f}, {9.996507468e-01f, 2.642696360e-02f}, {9.998895520e-01f, 1.486215783e-02f}, {9.999650728e-01f, 8.357815927e-03f},
  {-6.401443395e-01f, -7.682546613e-01f}, {-2.848466063e-01f, 9.585731119e-01f}, {-8.632964878e-01f, 5.046971113e-01f}, {-6.301599705e-01f, 7.764653318e-01f}, {8.749917344e-02f, -9.961645921e-01f}, {-9.037463447e-01f, 4.280683876e-01f}, {5.287845807e-02f, 9.986009557e-01f}, {6.572937422e-01f, 7.536344847e-01f},
  {8.869949277e-01f, 4.617791660e-01f}, {9.637912089e-01f, 2.666580313e-01f}, {9.885021022e-01f, 1.512071226e-01f}, {9.963592674e-01f, 8.525379969e-02f}, {9.988482211e-01f, 4.798157054e-02f}, {9.996357278e-01f, 2.698910488e-02f}, {9.998848022e-01f, 1.517834901e-02f}, {9.999635708e-01f, 8.535637247e-03f},
  {3.005925437e-01f, -9.537526528e-01f}, {-7.520639951e-01f, 6.590900905e-01f}, {-9.774427254e-01f, 2.112006594e-01f}, {-7.575730765e-01f, 6.527503610e-01f}, {1.865124631e-01f, -9.824525948e-01f}, {-9.263771379e-01f, 3.765971301e-01f}, {2.127875808e-02f, 9.997735816e-01f}, {6.437888326e-01f, 7.652032012e-01f},
  {8.823328681e-01f, 4.706258703e-01f}, {9.622764532e-01f, 2.720735702e-01f}, {9.880190013e-01f, 1.543322815e-01f}, {9.962060867e-01f, 8.702547193e-02f}, {9.987997401e-01f, 4.898039663e-02f}, {9.996203926e-01f, 2.755123762e-02f}, {9.998799524e-01f, 1.549453961e-02f}, {9.999620371e-01f, 8.713459228e-03f},
  {9.649660285e-01f, -2.623748537e-01f}, {-9.876590838e-01f, 1.566190737e-01f}, {-9.946564265e-01f, -1.032404628e-01f}, {-8.610927113e-01f, 5.084479743e-01f}, {2.836621855e-01f, -9.589242747e-01f}, {-9.460792425e-01f, 3.239352821e-01f}, {-1.034221888e-02f, 9.999465178e-01f}, {6.300802992e-01f, 7.765299843e-01f},
  {8.775825619e-01f, 4.794255386e-01f}, {9.607312596e-01f, 2.774805341e-01f}, {9.875260201e-01f, 1.574558971e-01f}, {9.960497565e-01f, 8.879686156e-02f}, {9.987502604e-01f, 4.997917001e-02f}, {9.996047414e-01f, 2.811335979e-02f}, {9.998750026e-01f, 1.581072865e-02f}, {9.999604718e-01f, 8.891280002e-03f},
  {7.421541968e-01f, 6.702291758e-01f}, {-9.190735378e-01f, -3.940860720e-01f}, {-9.132301279e-01f, -4.074441477e-01f}, {-9.374542500e-01f, 3.481085020e-01f}, {3.779776544e-01f, -9.258147184e-01f}, {-9.627903713e-01f, 2.702493312e-01f}, {-4.195285448e-02f, 9.991195914e-01f}, {6.161725219e-01f, 7.876112133e-01f},
  {8.727445123e-01f, 4.881772386e-01f}, {9.591556934e-01f, 2.828786946e-01f}, {9.870231637e-01f, 1.605779382e-01f}, {9.958902758e-01f, 9.056797780e-02f}, {9.986997817e-01f, 5.097789714e-02f}, {9.995887740e-01f, 2.867547492e-02f}, {9.998699528e-01f, 1.612691704e-02f}, {9.999588749e-01f, 9.069100495e-03f},
  {-1.629907808e-01f, 9.866275920e-01f}, {-5.674300293e-01f, -8.234216185e-01f}, {-7.412399645e-01f, -6.712401321e-01f}, {-9.842484715e-01f, 1.767906850e-01f}, {4.685169241e-01f, -8.834545217e-01f}, {-9.764576931e-01f, 2.157090023e-01f}, {-7.352154075e-02f, 9.972936293e-01f}, {6.020698986e-01f, 7.984433839e-01f},
  {8.678191892e-01f, 4.968801213e-01f}, {9.575497876e-01f, 2.882679384e-01f}, {9.865104371e-01f, 1.636983734e-01f}, {9.957276465e-01f, 9.233880022e-02f}, {9.986483046e-01f, 5.197656957e-02f}, {9.995724905e-01f, 2.923758099e-02f}, {9.998648031e-01f, 1.644310196e-02f}, {9.999572463e-01f, 9.246920701e-03f},
  {-9.182827862e-01f, 3.959251502e-01f}, {-4.102818995e-02f, -9.991579893e-01f}, {-4.957418213e-01f, -8.684699457e-01f}, {-9.999999947e-01f, -1.030206758e-04f}, {5.543744949e-01f, -8.322673365e-01f}, {-9.870379993e-01f, 1.604867217e-01f}, {-1.050167117e-01f, 9.944704572e-01f}, {5.877769370e-01f, 8.090230357e-01f},
  {8.628070850e-01f, 5.055333165e-01f}, {9.559136100e-01f, 2.936480378e-01f}, {9.859878454e-01f, 1.668171717e-01f}, {9.955618677e-01f, 9.410933806e-02f}, {9.985958286e-01f, 5.297519375e-02f}, {9.995558910e-01f, 2.979967596e-02f}, {9.998595533e-01f, 1.675928710e-02f}, {9.999555861e-01f, 9.424741546e-03f},
  {-8.293098329e-01f, -5.587890489e-01f}, {4.980096003e-01f, -8.671715159e-01f}, {-2.010796199e-01f, -9.795749009e-01f}, {-9.842120244e-01f, -1.769934771e-01f}, {6.346929496e-01f, -7.727644270e-01f}, {-9.944978661e-01f, 1.047568344e-01f}, {-1.364068747e-01f, 9.906528981e-01f}, {5.732980611e-01f, 8.193468943e-01f},
  {8.577087010e-01f, 5.141359589e-01f}, {9.542471952e-01f, 2.990188798e-01f}, {9.854553963e-01f, 1.699342871e-01f}, {9.953929407e-01f, 9.587957830e-02f}, {9.985423542e-01f, 5.397376122e-02f}, {9.995389754e-01f, 3.036176336e-02f}, {9.998542036e-01f, 1.707546870e-02f}, {9.999538943e-01f, 9.602561162e-03f},
  {2.212675626e-02f, -9.997551734e-01f}, {8.836693140e-01f, -4.681116785e-01f}, {1.135217773e-01f, -9.935355082e-01f}, {-9.373825054e-01f, -3.483016489e-01f}, {7.086697743e-01f, -7.055403256e-01f}, {-9.988136461e-01f, 4.869599955e-02f}, {-1.676606422e-01f, 9.858447692e-01f}, {5.586378969e-01f, 8.294116591e-01f},
  {8.525245158e-01f, 5.226872391e-01f}, {9.525506134e-01f, 3.043802375e-01f}, {9.849130902e-01f, 1.730497178e-01f}, {9.952208667e-01f, 9.764950793e-02f}, {9.984878810e-01f, 5.497227845e-02f}, {9.995217437e-01f, 3.092384116e-02f}, {9.998487538e-01f, 1.739165045e-02f}, {9.999521709e-01f, 9.780380474e-03f},
  {8.532201077e-01f, -5.215510021e-01f}, {9.971746360e-01f, 7.511820869e-02f}, {4.168670742e-01f, -9.089674595e-01f}, {-8.609884168e-01f, -5.086245631e-01f}, {7.755658183e-01f, -6.312667118e-01f}, {-9.999717335e-01f, -7.518784889e-03f}, {-1.987468801e-01f, 9.800508546e-01f}, {5.438010803e-01f, 8.392141473e-01f},
  {8.472551097e-01f, 5.311861999e-01f}, {9.508239095e-01f, 3.097319700e-01f}, {9.843609349e-01f, 1.761634181e-01f}, {9.950456449e-01f, 9.941913618e-02f}, {9.984324096e-01f, 5.597073698e-02f}, {9.995041959e-01f, 3.148590732e-02f}, {9.998432041e-01f, 1.770782860e-02f}, {9.999504159e-01f, 9.958200408e-03f},
  {8.998668270e-01f, 4.361647552e-01f}, {8.035690866e-01f, 5.952114944e-01f}, {6.788702112e-01f, -7.342582900e-01f}, {-7.574391895e-01f, -6.529057162e-01f}, {8.347129424e-01f, -5.506853038e-01f}, {-9.979684672e-01f, -6.370979912e-02f}, {-2.296342702e-01f, 9.732769914e-01f}, {5.287923029e-01f, 8.487512594e-01f},
  {8.419009790e-01f, 5.396320427e-01f}, {9.490671287e-01f, 3.150739362e-01f}, {9.837989360e-01f, 1.792753567e-01f}, {9.948672764e-01f, 1.011884500e-01f}, {9.983759396e-01f, 5.696914326e-02f}, {9.994863320e-01f, 3.204796724e-02f}, {9.998375544e-01f, 1.802400685e-02f}, {9.999486292e-01f, 1.013601910e-02f},
  {1.191801354e-01f, 9.928726481e-01f}, {3.624766664e-01f, 9.319928467e-01f}, {8.735505105e-01f, -4.867335058e-01f}, {-6.300007138e-01f, -7.765945536e-01f}, {8.855196056e-01f, -4.646020105e-01f}, {-9.928101803e-01f, -1.196993984e-01f}, {-2.602920453e-01f, 9.655299328e-01f}, {5.136163109e-01f, 8.580199795e-01f},
  {8.364626591e-01f, 5.480239228e-01f}, {9.472803452e-01f, 3.204059106e-01f}, {9.832270991e-01f, 1.823855026e-01f}, {9.946857626e-01f, 1.029574365e-01f}, {9.983184713e-01f, 5.796748886e-02f}, {9.994681521e-01f, 3.261001331e-02f}, {9.998318047e-01f, 1.834018143e-02f}, {9.999468110e-01f, 1.031383746e-02f},
  {-7.710802230e-01f, 6.367380071e-01f}, {-1.902490958e-01f, 9.817358512e-01f}, {9.816020978e-01f, -1.909380047e-01f}, {-4.826923346e-01f, -8.757899920e-01f}, {9.274784664e-01f, -3.738765764e-01f}, {-9.845131804e-01f, -1.753105749e-01f}, {-2.906895502e-01f, 9.568174253e-01f}, {4.982779032e-01f, 8.670173765e-01f},
  {8.309406937e-01f, 5.563610011e-01f}, {9.454635966e-01f, 3.257277812e-01f}, {9.826454300e-01f, 1.854938246e-01f}, {9.945011026e-01f, 1.047261048e-01f}, {9.982600046e-01f, 5.896578020e-02f}, {9.994496561e-01f, 3.317204907e-02f}, {9.998259550e-01f, 1.865635603e-02f}, {9.999449611e-01f, 1.049165644e-02f},
  {-9.524129804e-01f, -3.048106211e-01f}, {-6.843819158e-01f, 7.291237161e-01f}, {9.923083195e-01f, 1.237909494e-01f}, {-3.201591802e-01f, -9.473637630e-01f}, {9.601702867e-01f, -2.794154982e-01f}, {-9.731036980e-01f, -2.303675170e-01f}, {-3.207963899e-01f, 9.471481807e-01f}, {4.827820346e-01f, 8.757405478e-01f},
  {8.253356351e-01f, 5.646424439e-01f}, {9.436169596e-01f, 3.310393232e-01f}, {9.820539344e-01f, 1.886002917e-01f}, {9.943132976e-01f, 1.064944419e-01f}, {9.982005398e-01f, 5.996400886e-02f}, {9.994308440e-01f, 3.373407806e-02f}, {9.998200054e-01f, 1.897252691e-02f}, {9.999430795e-01f, 1.066947415e-02f},
  {-2.581016359e-01f, -9.661177700e-01f}, {-9.677396624e-01f, 2.519522691e-01f}, {9.046075662e-01f, 4.262454119e-01f}, {-1.475292025e-01f, -9.890577002e-01f}, {9.832684211e-01f, -1.821625980e-01f}, {-9.586178037e-01f, -2.846961652e-01f}, {-3.505824602e-01f, 9.365318674e-01f}, {4.671333972e-01f, 8.841868520e-01f},
  {8.196480097e-01f, 5.728674718e-01f}, {9.417404730e-01f, 3.363404250e-01f}, {9.814526211e-01f, 1.917048581e-01f}, {9.941223492e-01f, 1.082624348e-01f}, {9.981400766e-01f, 6.096218127e-02f}, {9.994117160e-01f, 3.429609266e-02f}, {9.998139558e-01f, 1.928869776e-02f}, {9.999411664e-01f, 1.084729152e-02f},
  {6.735071623e-01f, -7.391806966e-01f}, {-9.530500361e-01f, -3.028128610e-01f}, {7.271980777e-01f, 6.864276770e-01f}, {2.975377145e-02f, -9.995572585e-01f}, {9.965421208e-01f, -8.308911770e-02f}, {-9.411012936e-01f, -3.381247627e-01f}, {-3.800179774e-01f, 9.249791008e-01f}, {4.513370430e-01f, 8.923535586e-01f},
  {8.138784539e-01f, 5.810351644e-01f}, {9.398342161e-01f, 3.416308626e-01f}, {9.808414904e-01f, 1.948075221e-01f}, {9.939282563e-01f, 1.100300928e-01f}, {9.980786154e-01f, 6.196028901e-02f}, {9.993922719e-01f, 3.485809641e-02f}, {9.998078062e-01f, 1.960486481e-02f}, {9.999392216e-01f, 1.102510855e-02f},
  {9.858965816e-01f, 1.673557003e-01f}, {-6.448370157e-01f, -7.643201052e-01f}, {4.776714527e-01f, 8.785385497e-01f}, {2.060983265e-01f, -9.785312871e-01f}, {9.998586332e-01f, 1.681409119e-02f}, {-9.206095453e-01f, -3.904843980e-01f}, {-4.090735085e-01f, 9.125014327e-01f}, {4.353979670e-01f, 9.002380853e-01f},
  {8.080275111e-01f, 5.891447541e-01f}, {9.378982288e-01f, 3.469105251e-01f}, {9.802205514e-01f, 1.979082381e-01f}, {9.937310211e-01f, 1.117973955e-01f}, {9.980161562e-01f, 6.295833478e-02f}, {9.993725116e-01f, 3.542009286e-02f}, {9.998015566e-01f, 1.992103176e-02f}, {9.999372453e-01f, 1.120292616e-02f},
  {3.918572304e-01f, 9.200260382e-01f}, {-1.380281595e-01f, -9.904283049e-01f}, {1.807759664e-01f, 9.835243006e-01f}, {3.759426448e-01f, -9.266429344e-01f}, {9.931849076e-01f, 1.165492996e-01f}, {-8.972073423e-01f, -4.416095391e-01f}, {-4.377200005e-01f, 8.991113397e-01f}, {4.193212096e-01f, 9.078379388e-01f},
  {8.020957664e-01f, 5.971954299e-01f}, {9.359325930e-01f, 3.521791893e-01f}, {9.795898101e-01f, 2.010069749e-01f}, {9.935306427e-01f, 1.135643520e-01f}, {9.979526988e-01f, 6.395632131e-02f}, {9.993524355e-01f, 3.598207439e-02f}, {9.997952070e-01f, 2.023719487e-02f}, {9.999352373e-01f, 1.138074248e-02f},
  {-5.624538512e-01f, 8.268286795e-01f}, {4.112906278e-01f, -9.115042619e-01f}, {-1.340468804e-01f, 9.909749915e-01f}, {5.339299224e-01f, -8.455287328e-01f}, {9.765876257e-01f, 2.151199881e-01f}, {-8.709686692e-01f, -4.913385567e-01f}, {-4.659289146e-01f, 8.848221553e-01f}, {4.031118544e-01f, 9.151507159e-01f},
  {7.960838130e-01f, 6.051863868e-01f}, {9.339373606e-01f, 3.574367167e-01f}, {9.789492729e-01f, 2.041037017e-01f}, {9.933271224e-01f, 1.153309494e-01f}, {9.978882433e-01f, 6.495424389e-02f}, {9.993320433e-01f, 3.654404454e-02f}, {9.997887575e-01f, 2.055335594e-02f}, {9.999331976e-01f, 1.155855845e-02f},
  {-9.996474560e-01f, -2.655115402e-02f}, {8.339421773e-01f, -5.518518324e-01f}, {-4.355781575e-01f, 9.001509144e-01f}, {6.750773206e-01f, -7.377469832e-01f}, {9.502326217e-01f, 3.115412729e-01f}, {-8.419764782e-01f, -5.395142354e-01f}, {-4.936717281e-01f, 8.696483340e-01f}, {3.867750272e-01f, 9.221741041e-01f},
  {7.899922520e-01f, 6.131168256e-01f}, {9.319125840e-01f, 3.626829688e-01f}, {9.782989462e-01f, 2.071983875e-01f}, {9.931204618e-01f, 1.170971747e-01f}, {9.978227905e-01f, 6.595209408e-02f}, {9.993113350e-01f, 3.710600686e-02f}, {9.997822079e-01f, 2.086951683e-02f}, {9.999311264e-01f, 1.173637498e-02f},
  {-5.177697998e-01f, -8.555199790e-01f}, {9.997526257e-01f, -2.224157018e-02f}, {-6.939117212e-01f, 7.200600830e-01f}, {7.949331221e-01f, -6.066970673e-01f}, {9.143830324e-01f, 4.048501822e-01f}, {-8.103224264e-01f, -5.859842705e-01f}, {-5.209211185e-01f, 8.536048197e-01f}, {3.703158941e-01f, 9.289058825e-01f},
  {7.838216925e-01f, 6.209859534e-01f}, {9.298583485e-01f, 3.679177241e-01f}, {9.776388366e-01f, 2.102910013e-01f}, {9.929106598e-01f, 1.188630370e-01f}, {9.977563394e-01f, 6.694988575e-02f}, {9.992903108e-01f, 3.766795372e-02f}, {9.997755584e-01f, 2.118567376e-02f}, {9.999290235e-01f, 1.191419021e-02f},
  {4.401430225e-01f, -8.979276807e-01f}, {8.576571642e-01f, 5.142219255e-01f}, {-8.834316904e-01f, 4.685599731e-01f}, {8.897171354e-01f, -4.565122331e-01f}, {8.693973961e-01f, 4.941135170e-01f}, {-7.761065864e-01f, -6.306017496e-01f}, {-5.476494281e-01f, 8.367078964e-01f}, {3.537396597e-01f, 9.353439224e-01f},
  {7.775727143e-01f, 6.287930296e-01f}, {9.277746974e-01f, 3.731408726e-01f}, {9.769689537e-01f, 2.133814976e-01f}, {9.926977189e-01f, 1.206285161e-01f}, {9.976888905e-01f, 6.794761047e-02f}, {9.992689706e-01f, 3.822988867e-02f}, {9.997688089e-01f, 2.150183044e-02f}, {9.999268890e-01f, 1.209200506e-02f},
  {9.933903797e-01f, -1.147848138e-01f}, {4.514202490e-01f, 8.923114696e-01f}, {-9.853413039e-01f, 1.705945920e-01f}, {9.564401992e-01f, -2.919283222e-01f}, {8.157250450e-01f, 5.784398422e-01f}, {-7.394371294e-01f, -6.732256172e-01f}, {-5.738303336e-01f, 8.189742048e-01f}, {3.370516780e-01f, 9.414861477e-01f},
  {7.712460165e-01f, 6.365371804e-01f}, {9.256617187e-01f, 3.783521937e-01f}, {9.762892980e-01f, 2.164698746e-01f}, {9.924816379e-01f, 1.223936212e-01f}, {9.976204439e-01f, 6.894526724e-02f}, {9.992473143e-01f, 3.879181525e-02f}, {9.997619595e-01f, 2.181798310e-02f}, {9.999247229e-01f, 1.226981954e-02f},
  {6.333192031e-01f, 7.738906816e-01f}, {-9.384513530e-02f, 9.955868072e-01f}, {-9.895353918e-01f, -1.442903610e-01f}, {9.929971882e-01f, -1.181379883e-01f}, {7.539022543e-01f, 6.569865987e-01f}, {-7.004299841e-01f, -7.137211202e-01f}, {-5.994372618e-01f, 8.004217446e-01f}, {3.202570024e-01f, 9.473306986e-01f},
  {7.648421950e-01f, 6.442176781e-01f}, {9.235194568e-01f, 3.835515778e-01f}, {9.755998794e-01f, 2.195560870e-01f}, {9.922624183e-01f, 1.241583392e-01f}, {9.975510002e-01f, 6.994284763e-02f}, {9.992253421e-01f, 3.935372584e-02f}, {9.997550100e-01f, 2.213413545e-02f}, {9.999225252e-01f, 1.244763455e-02f},
  {-3.090227282e-01f, 9.510546533e-01f}, {-6.102111043e-01f, 7.922388580e-01f}, {-8.955979808e-01f, -4.448643128e-01f}, {9.982355487e-01f, 5.937835785e-02f}, {6.845467360e-01f, 7.289689748e-01f}, {-6.592084691e-01f, -7.519602345e-01f}, {-6.244449937e-01f, 7.810687869e-01f}, {3.033610551e-01f, 9.528756846e-01f},
  {7.583618900e-01f, 6.518337547e-01f}, {9.213480022e-01f, 3.887388055e-01f}, {9.749007048e-01f, 2.226401038e-01f}, {9.920400619e-01f, 1.259226572e-01f}, {9.974805585e-01f, 7.094036552e-02f}, {9.992030539e-01f, 3.991562399e-02f}, {9.997479606e-01f, 2.245028372e-02f}, {9.999202959e-01f, 1.262544824e-02f},
  {-9.672505883e-01f, 2.538233628e-01f}, {-9.386403774e-01f, 3.448974367e-01f}, {-7.128450694e-01f, -7.013215433e-01f}, {9.719900655e-01f, 2.350219407e-01f}, {6.083510875e-01f, 7.936680379e-01f}, {-6.159027162e-01f, -7.878222161e-01f}, {-6.488281469e-01f, 7.609349747e-01f}, {2.863691790e-01f, 9.581193523e-01f},
  {7.518057496e-01f, 6.593846487e-01f}, {9.191474004e-01f, 3.939137677e-01f}, {9.741917812e-01f, 2.257218942e-01f}, {9.918145684e-01f, 1.276865770e-01f}, {9.974091192e-01f, 7.193781246e-02f}, {9.991804496e-01f, 4.047751324e-02f}, {9.997408112e-01f, 2.276643161e-02f}, {9.999180349e-01f, 1.280326153e-02f},
  {-7.361927182e-01f, -6.767719569e-01f}, {-9.779862647e-01f, -2.086692743e-01f}, {-4.593983755e-01f, -8.882303376e-01f}, {9.150885079e-01f, 4.032530506e-01f}, {5.260773552e-01f, 8.504367210e-01f}, {-5.706501970e-01f, -8.211932493e-01f}, {-6.725627078e-01f, 7.400401368e-01f}, {2.692867473e-01f, 9.630600437e-01f},
  {7.451744294e-01f, 6.668696048e-01f}, {9.169177444e-01f, 3.990762459e-01f}, {9.734731156e-01f, 2.288014274e-01f}, {9.915859366e-01f, 1.294501078e-01f}, {9.973366826e-01f, 7.293518747e-02f}, {9.991575295e-01f, 4.103938597e-02f}, {9.997335619e-01f, 2.308257536e-02f}, {9.999157423e-01f, 1.298107534e-02f},
  {1.717173418e-01f, -9.851462605e-01f}, {-7.161304948e-01f, -6.979664135e-01f}, {-1.603949705e-01f, -9.870529132e-01f}, {8.293255221e-01f, 5.587657634e-01f}, {4.385472419e-01f, 8.987081376e-01f}, {-5.235932086e-01f, -8.519683984e-01f}, {-6.956245860e-01f, 7.184054811e-01f}, {2.521191618e-01f, 9.676961963e-01f},
  {7.384685523e-01f, 6.742879187e-01f}, {9.146590931e-01f, 4.042261042e-01f}, {9.727447153e-01f, 2.318786725e-01f}, {9.913541710e-01f, 1.312132144e-01f}, {9.972632491e-01f, 7.393248211e-02f}, {9.991342935e-01f, 4.160124571e-02f}, {9.997262125e-01f, 2.339871866e-02f}, {9.999134181e-01f, 1.315888782e-02f},
  {9.217512697e-01f, -3.877816354e-01f}, {-2.337207587e-01f, -9.723037627e-01f}, {1.545165179e-01f, -9.879902053e-01f}, {7.174060294e-01f, 6.966552871e-01f}, {3.466353178e-01f, 9.379999768e-01f}, {-4.748813157e-01f, -8.800498486e-01f}, {-7.179910692e-01f, 6.960523145e-01f}, {2.348718512e-01f, 9.720263441e-01f},
  {7.316888689e-01f, 6.816387600e-01f}, {9.123715058e-01f, 4.093632071e-01f}, {9.720065911e-01f, 2.349535844e-01f}, {9.911192705e-01f, 1.329759061e-01f}, {9.971888179e-01f, 7.492971024e-02f}, {9.991107413e-01f, 4.216309603e-02f}, {9.997187632e-01f, 2.371485776e-02f}, {9.999110623e-01f, 1.333669988e-02f},
  {8.243313311e-01f, 5.661076369e-01f}, {3.206739413e-01f, -9.471896449e-01f}, {4.541028846e-01f, -8.909492523e-01f}, {5.828599138e-01f, 8.125726558e-01f}, {2.512599349e-01f, 9.679196481e-01f}, {-4.246676935e-01f, -9.053492973e-01f}, {-7.396394557e-01f, 6.730033251e-01f}, {2.175502694e-01f, 9.760491178e-01f},
  {7.248360173e-01f, 6.889214382e-01f}, {9.100550791e-01f, 4.144873377e-01f}, {9.712587434e-01f, 2.380261612e-01f}, {9.908812338e-01f, 1.347381921e-01f}, {9.971133894e-01f, 7.592686345e-02f}, {9.990868733e-01f, 4.272492929e-02f}, {9.997112139e-01f, 2.403099635e-02f}, {9.999086748e-01f, 1.351451244e-02f},
  {-3.097503173e-02f, 9.995201586e-01f}, {7.763037288e-01f, -6.303590411e-01f}, {7.086563507e-01f, -7.055538084e-01f}, {4.299306917e-01f, 9.028618944e-01f}, {1.533735793e-01f, 9.881682778e-01f}, {-3.731119396e-01f, -9.277863334e-01f}, {-7.605484252e-01f, 6.492812125e-01f}, {2.001598939e-01f, 9.797632453e-01f},
  {7.179106829e-01f, 6.961352249e-01f}, {9.077098615e-01f, 4.195983881e-01f}, {9.705011830e-01f, 2.410963578e-01f}, {9.906400657e-01f, 1.365000372e-01f}, {9.970369639e-01f, 7.692394073e-02f}, {9.990626894e-01f, 4.328674904e-02f}, {9.997035647e-01f, 2.434713068e-02f}, {9.999062557e-01f, 1.369232365e-02f},
  {-8.578030932e-01f, 5.139784560e-01f}, {9.928478447e-01f, -1.193865876e-01f}, {8.929339780e-01f, -4.501876398e-01f}, {2.634407533e-01f, 9.646755773e-01f}, {5.395523011e-02f, 9.985433557e-01f}, {-3.203761718e-01f, -9.472904035e-01f}, {-7.806967553e-01f, 6.249100545e-01f}, {1.827063410e-01f, 9.831675305e-01f},
  {7.109135581e-01f, 7.032793989e-01f}, {9.053359523e-01f, 4.246961426e-01f}, {9.697339177e-01f, 2.441641434e-01f}, {9.903957650e-01f, 1.382614507e-01f}, {9.969595419e-01f, 7.792093366e-02f}, {9.990381894e-01f, 4.384855882e-02f}, {9.996958154e-01f, 2.466326443e-02f}, {9.999038051e-01f, 1.387013443e-02f},
  {-8.959709468e-01f, -4.441126687e-01f}, {9.036121431e-01f, 4.283516019e-01f}, {9.886589454e-01f, -1.501781928e-01f}, {8.864288797e-02f, 9.960634711e-01f}, {-4.600222091e-02f, 9.989413375e-01f}, {-2.666280039e-01f, -9.637995163e-01f}, {-8.000646032e-01f, 5.999138528e-01f}, {1.651948960e-01f, 9.862609423e-01f},
  {7.038453428e-01f, 7.103532456e-01f}, {9.029334011e-01f, 4.297804941e-01f}, {9.689569550e-01f, 2.472294874e-01f}, {9.901483302e-01f, 1.400224418e-01f}, {9.968811223e-01f, 7.891785610e-02f}, {9.990133736e-01f, 4.441035101e-02f}, {9.996879663e-01f, 2.497939386e-02f}, {9.999013228e-01f, 1.404794477e-02f},
  {-1.103872438e-01f, -9.938886539e-01f}, {5.360818520e-01f, 8.441660073e-01f}, {9.863393414e-01f, 1.647261474e-01f}, {-8.895072913e-02f, 9.960360274e-01f}, {-1.455000338e-01f, 9.893582466e-01f}, {-2.120364479e-01f, -9.772617586e-01f}, {-8.186323106e-01f, 5.743179782e-01f}, {1.476312130e-01f, 9.890424788e-01f},
  {6.967067436e-01f, 7.173560577e-01f}, {9.005023096e-01f, 4.348512278e-01f}, {9.681703064e-01f, 2.502923447e-01f}, {9.898977664e-01f, 1.417829752e-01f}, {9.968017059e-01f, 7.991469961e-02f}, {9.989882418e-01f, 4.497213288e-02f}, {9.996800171e-01f, 2.529552265e-02f}, {9.998988088e-01f, 1.422575559e-02f},
  {7.766859820e-01f, -6.298879943e-01f}, {3.445185325e-03f, 9.999940653e-01f}, {8.862052262e-01f, 4.632928847e-01f}, {-2.637388853e-01f, 9.645941117e-01f}, {-2.435445237e-01f, 9.698897179e-01f}, {-1.567750159e-01f, -9.876343424e-01f}, {-8.363815912e-01f, 5.481476388e-01f}, {1.300208462e-01f, 9.915112604e-01f},
  {6.894984312e-01f, 7.242871760e-01f}, {8.980427419e-01f, 4.399082105e-01f}, {9.673739687e-01f, 2.533527278e-01f}, {9.896440723e-01f, 1.435430604e-01f}, {9.967212932e-01f, 8.091145579e-02f}, {9.989627942e-01f, 4.553389681e-02f}, {9.996719680e-01f, 2.561164704e-02f}, {9.998962633e-01f, 1.440356503e-02f},
  {9.496776979e-01f, 3.132287824e-01f}, {-5.302493098e-01f, 8.478417715e-01f}, {6.981857146e-01f, 7.159166906e-01f}, {-4.302088505e-01f, 9.027293863e-01f}, {-3.391546816e-01f, 9.407306214e-01f}, {-1.010174785e-01f, -9.948846511e-01f}, {-8.532945541e-01f, 5.214291936e-01f}, {1.123693641e-01f, 9.936665064e-01f},
  {6.822212125e-01f, 7.311458248e-01f}, {8.955547626e-01f, 4.449513088e-01f}, {9.665679648e-01f, 2.564105487e-01f}, {9.893872465e-01f, 1.453027063e-01f}, {9.966398832e-01f, 8.190813848e-02f}, {9.989370307e-01f, 4.609564634e-02f}, {9.996638188e-01f, 2.592777074e-02f}, {9.998936861e-01f, 1.458137402e-02f},
  {2.495401180e-01f, 9.683644611e-01f}, {-9.006392088e-01f, 4.345676190e-01f}, {4.409287511e-01f, 8.975421084e-01f}, {-5.831102465e-01f, 8.123930332e-01f}, {-4.313770170e-01f, 9.021717515e-01f}, {-4.494105369e-02f, -9.989896404e-01f}, {-8.693541698e-01f, 4.941895663e-01f}, {9.468234863e-02f, 9.955075353e-01f},
  {6.748757724e-01f, 7.379313598e-01f}, {8.930384766e-01f, 4.499803098e-01f}, {9.657522875e-01f, 2.594658342e-01f}, {9.891272942e-01f, 1.470618780e-01f}, {9.965574766e-01f, 8.290473926e-02f}, {9.989109512e-01f, 4.665738502e-02f}, {9.996555698e-01f, 2.624388999e-02f}, {9.998910773e-01f, 1.475918348e-02f},
  {-6.800234956e-01f, 7.331903201e-01f}, {-9.936468888e-01f, -1.125427045e-01f}, {1.399453517e-01f, 9.901592289e-01f}, {-7.176206406e-01f, 6.964342152e-01f}, {-5.192891431e-01f, 8.545986109e-01f}, {1.127792530e-02f, -9.999364022e-01f}, {-8.845446221e-01f, 4.664555837e-01f}, {7.696539271e-02f, 9.970337649e-01f},
  {6.674628454e-01f, 7.446431025e-01f}, {8.904939370e-01f, 4.549951079e-01f}, {9.649269605e-01f, 2.625184963e-01f}, {9.888642139e-01f, 1.488205847e-01f}, {9.964740734e-01f, 8.390125714e-02f}, {9.988845559e-01f, 4.721910521e-02f}, {9.996472207e-01f, 2.656000847e-02f}, {9.998884369e-01f, 1.493699154e-02f},
  {-9.843766434e-01f, -1.760756199e-01f}, {-7.806286820e-01f, -6.249950886e-01f}, {-1.749181574e-01f, 9.845829768e-01f}, {-8.294976431e-01f, 5.585102148e-01f}, {-6.020119027e-01f, 7.984871126e-01f}, {6.746077372e-02f, -9.977219272e-01f}, {-8.988504928e-01f, 4.382553955e-01f}, {5.922409879e-02f, 9.982447125e-01f},
  {6.599831728e-01f, 7.512803815e-01f}, {8.879212510e-01f, 4.599954913e-01f}, {9.640919764e-01f, 2.655685619e-01f}, {9.885980044e-01f, 1.505788355e-01f}, {9.963896744e-01f, 8.489768369e-02f}, {9.988578448e-01f, 4.778081048e-02f}, {9.996387718e-01f, 2.687612243e-02f}, {9.998857649e-01f, 1.511479913e-02f},
  {-3.836984449e-01f, -9.234584470e-01f}, {-3.271927780e-01f, -9.449576107e-01f}, {-4.724333302e-01f, 8.813664099e-01f}, {-9.152127100e-01f, 4.029710850e-01f}, {-6.787203275e-01f, 7.343968390e-01f}, {1.234308237e-01f, -9.923531789e-01f}, {-9.122576928e-01f, 4.096167744e-01f}, {4.146407704e-02f, 9.991399954e-01f},
  {6.524375025e-01f, 7.578425333e-01f}, {8.853204729e-01f, 4.649813548e-01f}, {9.632473592e-01f, 2.686159432e-01f}, {9.883286709e-01f, 1.523365953e-01f}, {9.963042784e-01f, 8.589403277e-02f}, {9.988308176e-01f, 4.834250436e-02f}, {9.996302228e-01f, 2.719223557e-02f}, {9.998830612e-01f, 1.529260717e-02f},
  {5.697503343e-01f, -8.218178366e-01f}, {2.270120019e-01f, -9.738919606e-01f}, {-7.230991089e-01f, 6.907442932e-01f}, {-9.720626554e-01f, 2.347215243e-01f}, {-7.486465191e-01f, 6.629693729e-01f}, {1.790106509e-01f, -9.838471359e-01f}, {-9.247526141e-01f, 3.805687884e-01f}, {2.369106270e-02f, 9.997193274e-01f},
  {6.448265436e-01f, 7.643289401e-01f}, {8.826917124e-01f, 4.699524879e-01f}, {9.623931097e-01f, 2.716606383e-01f}, {9.880562120e-01f, 1.540938735e-01f}, {9.962178860e-01f, 8.689029596e-02f}, {9.988034748e-01f, 4.890417923e-02f}, {9.996215739e-01f, 2.750834413e-02f}, {9.998803260e-01f, 1.547041379e-02f},
  {9.993732837e-01f, 3.539830273e-02f}, {7.113042761e-01f, -7.028842200e-01f}, {-9.020542361e-01f, 4.316226999e-01f}, {-9.982538526e-01f, 5.906983832e-02f}, {-8.110931256e-01f, 5.849170382e-01f}, {2.340240777e-01f, -9.722308013e-01f}, {-9.363229511e-01f, 3.511400451e-01f}, {5.910437661e-03f, 9.999825332e-01f},
  {6.371511479e-01f, 7.707388759e-01f}, {8.800350389e-01f, 4.749087600e-01f}, {9.615292282e-01f, 2.747026454e-01f}, {9.877806264e-01f, 1.558506791e-01f}, {9.961304975e-01f, 8.788647225e-02f}, {9.987758161e-01f, 4.946583863e-02f}, {9.996128250e-01f, 2.782445179e-02f}, {9.998775591e-01f, 1.564821993e-02f},
  {5.101770449e-01f, 8.600694058e-01f}, {9.765252486e-01f, -2.154029687e-01f}, {-9.915538504e-01f, 1.296956507e-01f}, {-9.929606288e-01f, -1.184448804e-01f}, {-8.654354959e-01f, 5.010203613e-01f}, {2.882981135e-01f, -9.575407029e-01f}, {-9.469569600e-01f, 3.213604143e-01f}, {-1.187205637e-02f, 9.999295247e-01f},
  {6.294120377e-01f, 7.770717385e-01f}, {8.773505365e-01f, 4.798500142e-01f}, {9.606557395e-01f, 2.777418769e-01f}, {9.875019194e-01f, 1.576069771e-01f}, {9.960421134e-01f, 8.888255324e-02f}, {9.987478414e-01f, 5.002748612e-02f}, {9.996039762e-01f, 2.814055482e-02f}, {9.998747606e-01f, 1.582602650e-02f},
  {-4.480736161e-01f, 8.939966636e-01f}, {9.409945525e-01f, 3.384217076e-01f}, {-9.827212994e-01f, -1.850914579e-01f}, {-9.563499296e-01f, -2.922239076e-01f}, {-9.111302619e-01f, 4.121184852e-01f}, {3.416602554e-01f, -9.398235313e-01f}, {-9.566441680e-01f, 2.912592245e-01f}, {-2.965079623e-02f, 9.995603185e-01f},
  {6.216099869e-01f, 7.833268948e-01f}, {8.746382611e-01f, 4.847761465e-01f}, {9.597726360e-01f, 2.807783596e-01f}, {9.872200896e-01f, 1.593627767e-01f}, {9.959527327e-01f, 8.987855276e-02f}, {9.987195510e-01f, 5.058911406e-02f}, {9.995950273e-01f, 2.845665689e-02f}, {9.998719305e-01f, 1.600383071e-02f},
  {-9.943674609e-01f, 1.059875118e-01f}, {6.156554058e-01f, 7.880154956e-01f}, {-8.764333210e-01f, -4.815232433e-01f}, {-8.895764379e-01f, -4.567863407e-01f}, {-9.477217239e-01f, 3.190980008e-01f}, {3.939427052e-01f, -9.191349983e-01f}, {-9.653747427e-01f, 2.608670278e-01f}, {-4.742015991e-02f, 9.988750314e-01f},
  {6.137457758e-01f, 7.895037192e-01f}, {8.718983561e-01f, 4.896868966e-01f}, {9.588799431e-01f, 2.838120059e-01f}, {9.869351381e-01f, 1.611180724e-01f}, {9.958623560e-01f, 9.087446241e-02f}, {9.986909448e-01f, 5.115072601e-02f}, {9.995859786e-01f, 2.877275425e-02f}, {9.998690688e-01f, 1.618163628e-02f},
  {-6.264444479e-01f, -7.794660696e-01f}, {1.007066243e-01f, 9.949161652e-01f}, {-6.832289885e-01f, -7.302041832e-01f}, {-7.947461559e-01f, -6.069419640e-01f}, {-9.748435789e-01f, 2.228901000e-01f}, {4.449792900e-01f, -8.955408598e-01f}, {-9.731400858e-01f, 2.302137560e-01f}, {-6.517452839e-02f, 9.978738802e-01f},
  {6.058201908e-01f, 7.956015940e-01f}, {8.691308793e-01f, 4.945821616e-01f}, {9.579776530e-01f, 2.868428427e-01f}, {9.866470631e-01f, 1.628728733e-01f}, {9.957709834e-01f, 9.187028118e-02f}, {9.986620226e-01f, 5.171232550e-02f}, {9.995768298e-01f, 2.908885060e-02f}, {9.998661754e-01f, 1.635944133e-02f},
  {3.174287015e-01f, -9.482821413e-01f}, {-4.452612126e-01f, 8.954007218e-01f}, {-4.222704815e-01f, -9.064698784e-01f}, {-6.748499826e-01f, -7.379549451e-01f}, {-9.922253492e-01f, 1.244542343e-01f}, {4.946095243e-01f, -8.691153079e-01f}, {-9.799323156e-01f, 1.993305216e-01f}, {-8.290828739e-02f, 9.965571814e-01f},
  {5.978339766e-01f, 8.016199452e-01f}, {8.663359185e-01f, 4.994617866e-01f}, {9.570657916e-01f, 2.898707825e-01f}, {9.863558705e-01f, 1.646271445e-01f}, {9.956786158e-01f, 9.286600066e-02f}, {9.986327848e-01f, 5.227390491e-02f}, {9.995675812e-01f, 2.940494218e-02f}, {9.998632504e-01f, 1.653724401e-02f},
  {9.694593667e-01f, -2.452519855e-01f}, {-8.540936460e-01f, 5.201192593e-01f}, {-1.194339657e-01f, -9.928421465e-01f}, {-5.336693826e-01f, -8.456932009e-01f}, {-9.996930562e-01f, 2.477485342e-02f}, {5.426756651e-01f, -8.399423329e-01f}, {-9.857447428e-01f, 1.682477399e-01f}, {-1.006158291e-01f, 9.949253514e-01f},
  {5.897880270e-01f, 8.075580990e-01f}, {8.635135319e-01f, 5.043256689e-01f}, {9.561443597e-01f, 2.928958236e-01f}, {9.860615588e-01f, 1.663808950e-01f}, {9.955852518e-01f, 9.386163469e-02f}, {9.986032312e-01f, 5.283546780e-02f}, {9.995582325e-01f, 2.972103268e-02f}, {9.998602938e-01f, 1.671504802e-02f},
  {7.301735610e-01f, 6.832617147e-01f}, {-9.998821447e-01f, -1.535241693e-02f}, {1.952449607e-01f, -9.807545082e-01f}, {-3.756571205e-01f, -9.267587215e-01f}, {-9.971721562e-01f, -7.515112046e-02f}, {5.890265674e-01f, -8.081136695e-01f}, {-9.905714679e-01f, 1.369969595e-01f}, {-1.182915542e-01f, 9.929789062e-01f},
  {5.816830992e-01f, 8.134154979e-01f}, {8.606638685e-01f, 5.091735514e-01f}, {9.552133576e-01f, 2.959179642e-01f}, {9.857641264e-01f, 1.681341341e-01f}, {9.954908922e-01f, 9.485717486e-02f}, {9.985733616e-01f, 5.339701770e-02f}, {9.995487840e-01f, 3.003711834e-02f}, {9.998573056e-01f, 1.689285151e-02f},
  {-1.804304493e-01f, 9.835877454e-01f}, {-8.377248218e-01f, -5.460925956e-01f}, {4.905616517e-01f, -8.714064872e-01f}, {-2.057968231e-01f, -9.785947412e-01f}, {-9.846877893e-01f, -1.743271569e-01f}, {6.335149110e-01f, -7.737304812e-01f}, {-9.944077373e-01f, 1.056089575e-01f}, {-1.359298730e-01f, 9.907184613e-01f},
  {5.735200037e-01f, 8.191915560e-01f}, {8.577869887e-01f, 5.140053326e-01f}, {9.542728121e-01f, 2.989371172e-01f}, {9.854635793e-01f, 1.698868268e-01f}, {9.953955378e-01f, 9.585261276e-02f}, {9.985431764e-01f, 5.395854699e-02f}, {9.995392354e-01f, 3.035320100e-02f}, {9.998542858e-01f, 1.707065260e-02f},
  {-9.251475366e-01f, 3.796077390e-01f}, {-4.175648955e-01f, -9.086471032e-01f}, {7.372311535e-01f, -6.756406044e-01f}, {-2.944579810e-02f, -9.995663785e-01f}, {-9.623649317e-01f, -2.717604429e-01f}, {6.760008016e-01f, -7.369008863e-01f}, {-9.972496750e-01f, 7.411535468e-02f}, {-1.535250904e-01f, 9.881447498e-01f},
  {5.652995567e-01f, 8.248856958e-01f}, {8.548829836e-01f, 5.188208597e-01f}, {9.533227151e-01f, 3.019533092e-01f}, {9.851599158e-01f, 1.716389823e-01f}, {9.952991873e-01f, 9.684796223e-02f}, {9.985126755e-01f, 5.452005922e-02f}, {9.995295869e-01f, 3.066928249e-02f}, {9.998512343e-01f, 1.724845501e-02f},
  {-8.192882453e-01f, -5.733818720e-01f}, {1.312005053e-01f, -9.913558531e-01f}, {9.107885630e-01f, -4.128730962e-01f}, {1.478339325e-01f, -9.890121983e-01f}, {-9.304262022e-01f, -3.664793067e-01f}, {7.163492032e-01f, -6.977419430e-01f}, {-9.990944289e-01f, 4.254788036e-02f}, {-1.710718782e-01f, 9.852585511e-01f},
  {5.570225804e-01f, 8.304973479e-01f}, {8.519519448e-01f, 5.236199803e-01f}, {9.523630937e-01f, 3.049664534e-01f}, {9.848531345e-01f, 1.733906097e-01f}, {9.952018415e-01f, 9.784321484e-02f}, {9.984818586e-01f, 5.508155793e-02f}, {9.995198385e-01f, 3.098535905e-02f}, {9.998481513e-01f, 1.742625688e-02f},
  {3.982088039e-02f, -9.992068342e-01f}, {6.395552906e-01f, -7.687451010e-01f}, {9.940242463e-01f, -1.091595058e-01f}, {3.204510557e-01f, -9.472650743e-01f}, {-8.891908908e-01f, -4.575364026e-01f}, {7.544332398e-01f, -6.563767872e-01f}, {-9.999401824e-01f, 1.093762364e-02f}, {-1.885645696e-01f, 9.820607940e-01f},
  {5.486899024e-01f, 8.360259511e-01f}, {8.489939337e-01f, 5.284025933e-01f}, {9.513939397e-01f, 3.079765762e-01f}, {9.845432413e-01f, 1.751416741e-01f}, {9.951035005e-01f, 9.883836961e-02f}, {9.984507262e-01f, 5.564303550e-02f}, {9.995099901e-01f, 3.130143251e-02f}, {9.998450366e-01f, 1.760405633e-02f},
  {8.623188723e-01f, -5.063656411e-01f}, {9.509409315e-01f, -3.093725017e-01f}, {9.786828137e-01f, 2.053775797e-01f}, {4.829613148e-01f, -8.756416895e-01f}, {-8.390715291e-01f, -5.440211109e-01f}, {7.901318660e-01f, -6.129368926e-01f}, {-9.997860770e-01f, -2.068333150e-02f}, {-2.059976331e-01f, 9.785524897e-01f},
  {5.403023059e-01f, 8.414709848e-01f}, {8.460091064e-01f, 5.331684460e-01f}, {9.504152809e-01f, 3.109835909e-01f}, {9.842302348e-01f, 1.768921847e-01f}, {9.950041651e-01f, 9.983341813e-02f}, {9.984192780e-01f, 5.620449547e-02f}, {9.995000417e-01f, 3.161750470e-02f}, {9.998418903e-01f, 1.778185709e-02f},
  {8.920048698e-01f, 4.520257872e-01f}, {9.694527238e-01f, 2.452782427e-01f}, {8.662854932e-01f, 4.995492411e-01f}, {6.302406996e-01f, -7.763998072e-01f}, {-7.805679417e-01f, -6.250709467e-01f}, {8.233328271e-01f, -5.675588567e-01f}, {-9.986322645e-01f, -5.228384329e-02f}, {-2.233655562e-01f, 9.747347477e-01f},
  {5.318607295e-01f, 8.468318395e-01f}, {8.429975262e-01f, 5.379174387e-01f}, {9.494271181e-01f, 3.139874958e-01f}, {9.839141132e-01f, 1.786421505e-01f}, {9.949038340e-01f, 1.008283742e-01f}, {9.983875139e-01f, 5.676594140e-02f}, {9.994899934e-01f, 3.193357373e-02f}, {9.998387124e-01f, 1.795965543e-02f},
  {1.015857037e-01f, 9.948267914e-01f}, {6.893923357e-01f, 7.243881608e-01f}, {6.679785330e-01f, 7.441805423e-01f}, {7.576409417e-01f, -6.526715893e-01f}, {-7.142657855e-01f, -6.998745514e-01f}, {8.539305980e-01f, -5.203869078e-01f}, {-9.964799160e-01f, -8.383183766e-02f}, {-2.406628465e-01f, 9.706087751e-01f},
  {5.233659675e-01f, 8.521080120e-01f}, {8.399592882e-01f, 5.426494210e-01f}, {9.484294516e-01f, 3.169882891e-01f}, {9.835948828e-01f, 1.803915368e-01f}, {9.948025080e-01f, 1.018232295e-01f}, {9.983554343e-01f, 5.732736565e-02f}, {9.994798451e-01f, 3.224963957e-02f}, {9.998355028e-01f, 1.813745505e-02f},
  {-7.822308899e-01f, 6.229886314e-01f}, {1.970090633e-01f, 9.804016672e-01f}, {4.034298040e-01f, 9.150105973e-01f}, {8.611455722e-01f, -5.083584400e-01f}, {-6.408262712e-01f, -7.676859320e-01f}, {8.818289637e-01f, -4.715693786e-01f}, {-9.933311512e-01f, -1.152962447e-01f}, {-2.578840345e-01f, 9.661758767e-01f},
  {5.148188695e-01f, 8.572989745e-01f}, {8.368944560e-01f, 5.473642933e-01f}, {9.474223102e-01f, 3.199858843e-01f}, {9.832725421e-01f, 1.821403526e-01f}, {9.947001872e-01f, 1.028179829e-01f}, {9.983230390e-01f, 5.788877177e-02f}, {9.994695970e-01f, 3.256569846e-02f}, {9.998322617e-01f, 1.831525411e-02f},
  {-9.468680108e-01f, -3.216224032e-01f}, {-3.560463237e-01f, 9.344683063e-01f}, {9.887337000e-02f, 9.951000235e-01f}, {9.374901074e-01f, -3.480119230e-01f}, {-5.609837837e-01f, -8.278267901e-01f}, {9.069392526e-01f, -4.212614295e-01f}, {-9.891891661e-01f, -1.466451284e-01f}, {-2.750236744e-01f, 9.614374543e-01f},
  {5.062202901e-01f, 8.624042079e-01f}, {8.338031914e-01f, 5.520618064e-01f}, {9.464056851e-01f, 3.229803078e-01f}, {9.829470919e-01f, 1.838885924e-01f}, {9.945968724e-01f, 1.038126262e-01f}, {9.982903277e-01f, 5.845016330e-02f}, {9.994592488e-01f, 3.288175781e-02f}, {9.998289889e-01f, 1.849305072e-02f},
  {-2.409590492e-01f, -9.705352835e-01f}, {-7.994488075e-01f, 6.007342209e-01f}, {-2.154882311e-01f, 9.765064374e-01f}, {9.842666794e-01f, -1.766892861e-01f}, {-4.755369280e-01f, -8.796957600e-01f}, {9.291825053e-01f, -3.696212546e-01f}, {-9.840580399e-01f, -1.778476151e-01f}, {-2.920763464e-01f, 9.563950062e-01f},
  {4.975710893e-01f, 8.674232019e-01f}, {8.306855598e-01f, 5.567418619e-01f}, {9.453796055e-01f, 3.259714733e-01f}, {9.826185307e-01f, 1.856362654e-01f}, {9.944925623e-01f, 1.048071730e-01f}, {9.982573010e-01f, 5.901153264e-02f}, {9.994488007e-01f, 3.319781388e-02f}, {9.998256845e-01f, 1.867084861e-02f},
  {6.864865509e-01f, -7.271425001e-01f}, {-9.966333753e-01f, 8.198728756e-02f}, {-5.084800933e-01f, 8.610737453e-01f}, {9.999999788e-01f, 2.060413504e-04f}, {-3.853378388e-01f, -9.227755686e-01f}, {9.484880243e-01f, -3.168129854e-01f}, {-9.779429805e-01f, -2.088720345e-01f}, {-3.090365447e-01f, 9.510501638e-01f},
  {4.888721318e-01f, 8.723554544e-01f}, {8.275416598e-01f, 5.614043119e-01f}, {9.443440625e-01f, 3.289594073e-01f}, {9.822868650e-01f, 1.873833367e-01f}, {9.943872577e-01f, 1.058016150e-01f}, {9.982239586e-01f, 5.957288331e-02f}, {9.994382526e-01f, 3.351386663e-02f}, {9.998223485e-01f, 1.884864591e-02f},
  {9.827795820e-01f, 1.847817446e-01f}, {-8.868746619e-01f, -4.620101017e-01f}, {-7.510490434e-01f, 6.602464195e-01f}, {9.841937852e-01f, 1.770948704e-01f}, {-2.912894642e-01f, -9.566349607e-01f}, {9.647951032e-01f, -2.630026785e-01f}, {-9.708500105e-01f, -2.396878325e-01f}, {-3.258991334e-01f, 9.454045456e-01f},
  {4.801242876e-01f, 8.772004722e-01f}, {8.243715908e-01f, 5.660490088e-01f}, {9.432990858e-01f, 3.319440236e-01f}, {9.819520930e-01f, 1.891298155e-01f}, {9.942809587e-01f, 1.067959512e-01f}, {9.981903004e-01f, 6.013421886e-02f}, {9.994276047e-01f, 3.382991230e-02f}, {9.998189809e-01f, 1.902644076e-02f},
  {3.755095978e-01f, 9.268185054e-01f}, {-5.039728760e-01f, -8.637194801e-01f}, {-9.191339729e-01f, 3.939450974e-01f}, {9.373466181e-01f, 3.483982169e-01f}, {-1.943297194e-01f, -9.809362671e-01f}, {9.780520113e-01f, -2.083608964e-01f}, {-9.627863291e-01f, -2.702637314e-01f}, {-3.426586664e-01f, 9.394599717e-01f},
  {4.713284315e-01f, 8.819577709e-01f}, {8.211754191e-01f, 5.706758547e-01f}, {9.422446762e-01f, 3.349253204e-01f}, {9.816142129e-01f, 1.908757108e-01f}, {9.941736662e-01f, 1.077901732e-01f}, {9.981563267e-01f, 6.069553168e-02f}, {9.994168567e-01f, 3.414595831e-02f}, {9.998155816e-01f, 1.920423686e-02f},
  {-5.770021789e-01f, 8.167426066e-01f}, {3.414078174e-02f, -9.994170336e-01f}, {-9.960693628e-01f, 8.857665853e-02f}, {8.609360133e-01f, 5.087132600e-01f}, {-9.542828141e-02f, -9.954363079e-01f}, {9.882167644e-01f, -1.530608589e-01f}, {-9.537598777e-01f, -3.005696187e-01f}, {-3.593098438e-01f, 9.332183218e-01f},
  {4.624853373e-01f, 8.866269299e-01f}, {8.179533134e-01f, 5.752846053e-01f}, {9.411808341e-01f, 3.379032961e-01f}, {9.812732316e-01f, 1.926209879e-01f}, {9.940653787e-01f, 1.087842948e-01f}, {9.981220373e-01f, 6.125682530e-02f}, {9.994060088e-01f, 3.446200091e-02f}, {9.998121508e-01f, 1.938203235e-02f},
  {-9.990208133e-01f, -4.424267809e-02f}, {5.617429128e-01f, -8.273118516e-01f}, {-9.742256121e-01f, -2.255758335e-01f}, {7.573719227e-01f, 6.529837446e-01f}, {4.425697988e-03f, -9.999902066e-01f}, {9.952573993e-01f, -9.727645772e-02f}, {-9.437798181e-01f, -3.305747343e-01f}, {-3.758474003e-01f, 9.266815697e-01f},
  {4.535961002e-01f, 8.912073709e-01f}, {8.147053420e-01f, 5.798751639e-01f}, {9.401075903e-01f, 3.408778647e-01f}, {9.809291472e-01f, 1.943656558e-01f}, {9.939560972e-01f, 1.097783077e-01f}, {9.980874321e-01f, 6.181810327e-02f}, {9.993950610e-01f, 3.477804006e-02f}, {9.998086883e-01f, 1.955982537e-02f},
  {-5.025443191e-01f, -8.645514486e-01f}, {9.163355735e-01f, -4.004111845e-01f}, {-8.557689424e-01f, -5.173582098e-01f}, {6.299207052e-01f, 7.766594525e-01f}, {1.042364063e-01f, -9.945525484e-01f}, {9.991515381e-01f, -4.118499635e-02f}, {-9.328559791e-01f, -3.602495278e-01f}, {-3.922661065e-01f, 9.198517825e-01f},
  {4.446615039e-01f, 8.956986920e-01f}, {8.114316076e-01f, 5.844473854e-01f}, {9.390249353e-01f, 3.438490525e-01f}, {9.805819579e-01f, 1.961097238e-01f}, {9.938458217e-01f, 1.107722107e-01f}, {9.980525115e-01f, 6.237935797e-02f}, {9.993840133e-01f, 3.509407201e-02f}, {9.998051942e-01f, 1.973761964e-02f},
  {4.559691044e-01f, -8.899956044e-01f}, {9.887145094e-01f, 1.498119448e-01f}, {-6.524436848e-01f, -7.578372108e-01f}, {4.826021076e-01f, 8.758397147e-01f}, {2.030046771e-01f, -9.791777679e-01f}, {9.998869357e-01f, 1.503714472e-02f}, {-9.209993553e-01f, -3.895640993e-01f}, {-4.085607702e-01f, 9.127311198e-01f},
  {4.356824420e-01f, 9.001004443e-01f}, {8.081322136e-01f, 5.890011251e-01f}, {9.379329003e-01f, 3.468167738e-01f}, {9.802316707e-01f, 1.978531569e-01f}, {9.937345532e-01f, 1.117659956e-01f}, {9.980172753e-01f, 6.294059295e-02f}, {9.993728656e-01f, 3.541010418e-02f}, {9.998016685e-01f, 1.991541328e-02f},
  {9.952666362e-01f, -9.718190589e-02f}, {7.565874902e-01f, 6.538924757e-01f}, {-3.844182537e-01f, -9.231590362e-01f}, {3.200624839e-01f, 9.473964357e-01f}, {2.997455252e-01f, -9.540191927e-01f}, {9.974612549e-01f, 7.121127068e-02f}, {-9.082219023e-01f, -4.184889199e-01f}, {-4.247261310e-01f, 9.053218840e-01f},
  {4.266598122e-01f, 9.044121873e-01f}, {8.048072290e-01f, 5.935362871e-01f}, {9.368314756e-01f, 3.497810550e-01f}, {9.798782838e-01f, 1.995959644e-01f}, {9.936222901e-01f, 1.127596761e-01f}, {9.979817235e-01f, 6.350180803e-02f}, {9.993616180e-01f, 3.572613280e-02f}, {9.997981112e-01f, 2.009320443e-02f},
  {6.195206126e-01f, 7.849803887e-01f}, {2.914465538e-01f, 9.565871138e-01f}, {-7.827047274e-02f, -9.969321607e-01f}, {1.474282516e-01f, 9.890727530e-01f}, {3.934913924e-01f, -9.193283005e-01f}, {9.918821230e-01f, 1.271607411e-01f}, {-8.945362039e-01f, -4.469955032e-01f}, {-4.407574007e-01f, 8.976262662e-01f},
  {4.175945170e-01f, 9.086334901e-01f}, {8.014568295e-01f, 5.980526319e-01f}, {9.357206930e-01f, 3.527418104e-01f}, {9.795217952e-01f, 2.013381554e-01f}, {9.935090334e-01f, 1.137532439e-01f}, {9.979458556e-01f, 6.406301046e-02f}, {9.993502704e-01f, 3.604215785e-02f}, {9.997945222e-01f, 2.027099680e-02f},
  {-3.258098052e-01f, 9.454353340e-01f}, {-2.634541314e-01f, 9.646719238e-01f}, {2.356393079e-01f, -9.718405819e-01f}, {-2.985579311e-02f, 9.995542164e-01f}, {4.833047588e-01f, -8.754521747e-01f}, {9.831672727e-01f, 1.827077279e-01f}, {-8.799561509e-01f, -4.750549152e-01f}, {-4.566490802e-01f, 8.896469061e-01f},
  {4.084874626e-01f, 9.127639305e-01f}, {7.980810859e-01f, 6.025500646e-01f}, {9.346005532e-01f, 3.556990384e-01f}, {9.791622120e-01f, 2.030796950e-01f}, {9.933947841e-01f, 1.147466905e-01f}, {9.979096726e-01f, 6.462418519e-02f}, {9.993388230e-01f, 3.635817558e-02f}, {9.997909017e-01f, 2.044878854e-02f},
  {-9.715921906e-01f, 2.366613934e-01f}, {-7.372213326e-01f, 6.756513203e-01f}, {5.261809886e-01f, -8.503726049e-01f}, {-2.061982012e-01f, 9.785102461e-01f}, {5.682899437e-01f, -8.228283782e-01f}, {9.713441080e-01f, 2.376775627e-01f}, {-8.644961024e-01f, -5.026395219e-01f}, {-4.723965703e-01f, 8.813861131e-01f},
  {3.993395600e-01f, 9.168030954e-01f}, {7.946801049e-01f, 6.070284433e-01f}, {9.334710569e-01f, 3.586527372e-01f}, {9.787995325e-01f, 2.048205925e-01f}, {9.932795405e-01f, 1.157400297e-01f}, {9.978731741e-01f, 6.518533949e-02f}, {9.993272755e-01f, 3.667419339e-02f}, {9.997872495e-01f, 2.062657776e-02f},
  {-7.240971967e-01f, -6.896979409e-01f}, {-9.839316487e-01f, 1.785455423e-01f}, {7.645443186e-01f, -6.445711636e-01f}, {-3.760372225e-01f, 9.266045582e-01f}, {6.475961933e-01f, -7.619837074e-01f}, {9.564502073e-01f, 2.918955309e-01f}, {-8.481717500e-01f, -5.297213253e-01f}, {-4.879944690e-01f, 8.728467209e-01f},
  {3.901517238e-01f, 9.207505810e-01f}, {7.912539576e-01f, 6.114876732e-01f}, {9.323322365e-01f, 3.616028218e-01f}, {9.784337548e-01f, 2.065608568e-01f}, {9.931633036e-01f, 1.167332532e-01f}, {9.978363600e-01f, 6.574647317e-02f}, {9.993156281e-01f, 3.699020753e-02f}, {9.997835657e-01f, 2.080436820e-02f},
  {1.891294205e-01f, -9.819521690e-01f}, {-9.276105631e-01f, -3.735487159e-01f}, {9.270853567e-01f, -3.748502919e-01f}, {-5.340162202e-01f, 8.454742318e-01f}, {7.204326113e-01f, -6.935249474e-01f}, {9.385324046e-01f, 3.451911433e-01f}, {-8.309991709e-01f, -5.562736539e-01f}, {-5.034382623e-01f, 8.640312009e-01f},
  {3.809248729e-01f, 9.246059924e-01f}, {7.878028251e-01f, 6.159275191e-01f}, {9.311840821e-01f, 3.645493180e-01f}, {9.780648860e-01f, 2.083004533e-01f}, {9.930460735e-01f, 1.177263600e-01f}, {9.977992303e-01f, 6.630758607e-02f}, {9.993038808e-01f, 3.730621798e-02f}, {9.997798503e-01f, 2.098215797e-02f},
  {9.284713207e-01f, -3.714041014e-01f}, {-5.856038514e-01f, -8.105973903e-01f}, {9.976883249e-01f, -6.795591499e-02f}, {-6.751540238e-01f, 7.376767884e-01f}, {7.860706498e-01f, -6.181366624e-01f}, {9.176476495e-01f, 3.973950068e-01f}, {-8.129957948e-01f, -5.822695575e-01f}, {-5.187226524e-01f, 8.549425770e-01f},
  {3.716599298e-01f, 9.283689442e-01f}, {7.843267803e-01f, 6.203478877e-01f}, {9.300266266e-01f, 3.674921411e-01f}, {9.776929243e-01f, 2.100393912e-01f}, {9.929278513e-01f, 1.187193417e-01f}, {9.977617851e-01f, 6.686867800e-02f}, {9.992920336e-01f, 3.762222097e-02f}, {9.997761033e-01f, 2.115994522e-02f},
  {8.141809705e-01f, 5.806111842e-01f}, {-6.324278670e-02f, -9.979981713e-01f}, {9.693516017e-01f, 2.456775778e-01f}, {-7.949961987e-01f, 6.066144113e-01f}, {8.438539587e-01f, -5.365729180e-01f}, {8.938616142e-01f, 4.483429653e-01f}, {-7.941793525e-01f, -6.076834341e-01f}, {-5.338430142e-01f, 8.455836068e-01f},
  {3.623578211e-01f, 9.320390600e-01f}, {7.808259330e-01f, 6.247486393e-01f}, {9.288598600e-01f, 3.704313169e-01f}, {9.773178677e-01f, 2.117776794e-01f}, {9.928086353e-01f, 1.197122120e-01f}, {9.977240240e-01f, 6.742975621e-02f}, {9.992800864e-01f, 3.793822392e-02f}, {9.997723246e-01f, 2.133773367e-02f},
  {-4.866360920e-02f, 9.988152247e-01f}, {4.786024988e-01f, -8.780316897e-01f}, {8.448832693e-01f, 5.349507092e-01f}, {-8.897645961e-01f, 4.564197229e-01f}, {8.932062830e-01f, -4.496471238e-01f}, {8.672498998e-01f, 4.978730876e-01f}, {-7.745689422e-01f, -6.324894891e-01f}, {-5.487947659e-01f, 8.359571191e-01f},
  {3.530194771e-01f, 9.356159729e-01f}, {7.773003940e-01f, 6.291296348e-01f}, {9.276838157e-01f, 3.733667607e-01f}, {9.769397237e-01f, 2.135152833e-01f}, {9.926884264e-01f, 1.207049626e-01f}, {9.976859478e-01f, 6.799080567e-02f}, {9.992680393e-01f, 3.825422308e-02f}, {9.997685144e-01f, 2.151551958e-02f},
  {-8.667670911e-01f, 4.987131539e-01f}, {8.730401082e-01f, -4.876484076e-01f}, {6.366296978e-01f, 7.711696493e-01f}, {-9.564702688e-01f, 2.918297875e-01f}, {9.336335757e-01f, -3.582294603e-01f}, {8.378961870e-01f, 5.458296252e-01f}, {-7.541838773e-01f, -6.566632922e-01f}, {-5.635727784e-01f, 8.260664159e-01f},
  {3.436457194e-01f, 9.390993662e-01f}, {7.737502371e-01f, 6.334907818e-01f}, {9.264984948e-01f, 3.762984709e-01f}, {9.765584904e-01f, 2.152522121e-01f}, {9.925672249e-01f, 1.216975926e-01f}, {9.976475561e-01f, 6.855183363e-02f}, {9.992558923e-01f, 3.857021841e-02f}, {9.997646725e-01f, 2.169330666e-02f},
  {-8.879689067e-01f, -4.599034907e-01f}, {9.985987075e-01f, 5.292089673e-02f}, {3.652422354e-01f, 9.309125144e-01f}, {-9.930093536e-01f, 1.180356885e-01f}, {9.647326681e-01f, -2.632316074e-01f}, {8.058937730e-01f, 5.920601546e-01f}, {-7.330448482e-01f, -6.801803074e-01f}, {-5.781727749e-01f, 8.159143597e-01f},
  {3.342377091e-01f, 9.424888083e-01f}, {7.701756497e-01f, 6.378318498e-01f}, {9.253038976e-01f, 3.792264457e-01f}, {9.761741690e-01f, 2.169884602e-01f}, {9.924450317e-01f, 1.226900934e-01f}, {9.976088489e-01f, 6.911283990e-02f}, {9.992436454e-01f, 3.888620616e-02f}, {9.997607990e-01f, 2.187109307e-02f},
  {-9.277620460e-02f, -9.956869869e-01f}, {8.166087424e-01f, 5.771916162e-01f}, {5.763408854e-02f, 9.983377744e-01f}, {-9.982294262e-01f, -5.948119644e-02f}, {9.861923970e-01f, -1.656036111e-01f}, {7.713432897e-01f, 6.364193032e-01f}, {-7.111726737e-01f, -7.030173740e-01f}, {-5.925897472e-01f, 8.055044329e-01f},
  {3.247962754e-01f, 9.457840025e-01f}, {7.665767074e-01f, 6.421527480e-01f}, {9.241000586e-01f, 3.821506007e-01f}, {9.757867573e-01f, 2.187240366e-01f}, {9.923218452e-01f, 1.236824789e-01f}, {9.975698262e-01f, 6.967382433e-02f}, {9.992312986e-01f, 3.920219375e-02f}, {9.997568940e-01f, 2.204887692e-02f},
  {7.877145121e-01f, -6.160404592e-01f}, {3.831195069e-01f, 9.236987839e-01f}, {-2.556895696e-01f, 9.667589379e-01f}, {-9.719658482e-01f, -2.351220745e-01f}, {9.977982792e-01f, -6.632189735e-02f}, {7.343545514e-01f, 6.787660811e-01f}, {-6.885895538e-01f, -7.251513128e-01f}, {-6.068195228e-01f, 7.948396484e-01f},
  {3.153223624e-01f, 9.489846194e-01f}, {7.629535240e-01f, 6.464533396e-01f}, {9.228869673e-01f, 3.850709617e-01f}, {9.753962633e-01f, 2.204589068e-01f}, {9.921976672e-01f, 1.246747334e-01f}, {9.975304881e-01f, 7.023478672e-02f}, {9.992188517e-01f, 3.951817742e-02f}, {9.997529572e-01f, 2.222666193e-02f},
  {9.439841392e-01f, 3.299908257e-01f}, {-1.683704464e-01f, 9.857237913e-01f}, {-5.436599665e-01f, 8.393055706e-01f}, {-9.150469596e-01f, -4.033473215e-01f}, {9.994345727e-01f, 3.362342848e-02f}, {6.950438698e-01f, 7.189673282e-01f}, {-6.653177293e-01f, -7.465603252e-01f}, {-6.208572206e-01f, 7.839236644e-01f},
  {3.058169175e-01f, 9.520903387e-01f}, {7.593061752e-01f, 6.507335340e-01f}, {9.216646586e-01f, 3.879874445e-01f}, {9.750026847e-01f, 2.221930799e-01f}, {9.920724962e-01f, 1.256668706e-01f}, {9.974908340e-01f, 7.079573433e-02f}, {9.992063050e-01f, 3.983415713e-02f}, {9.997489889e-01f, 2.240444624e-02f},
  {2.323591020e-01f, 9.726300672e-01f}, {-6.679985997e-01f, 7.441625298e-01f}, {-7.777124942e-01f, 6.286201368e-01f}, {-8.292679533e-01f, -5.588511981e-01f}, {9.910848972e-01f, 1.332318524e-01f}, {6.535361888e-01f, 7.568952701e-01f}, {-6.413808207e-01f, -7.672226814e-01f}, {-6.346987778e-01f, 7.727596402e-01f},
  {2.962808911e-01f, 9.551008499e-01f}, {7.556348538e-01f, 6.549931051e-01f}, {9.204331217e-01f, 3.909000749e-01f}, {9.746060196e-01f, 2.239265649e-01f}, {9.919463330e-01f, 1.266588821e-01f}, {9.974508651e-01f, 7.135665213e-02f}, {9.991936585e-01f, 4.015012914e-02f}, {9.997449890e-01f, 2.258222798e-02f},
};

namespace pg8 {
#define PG8_LAS __attribute__((address_space(3)))
typedef unsigned short bf16_t;
typedef short bf16x8 __attribute__((ext_vector_type(8)));
typedef float f32x4 __attribute__((ext_vector_type(4)));
typedef unsigned u32x4 __attribute__((ext_vector_type(4)));
constexpr int BM = 256, BK = 64, HALF = 128, HTB = HALF * BK * 2  , STAGE_BYTES = 8 * HTB, NXCD = 8, WGM = 8;

__host__ __device__ __forceinline__ int lds_byte(int r, int c) { const int st = (r >> 4) * 2 + (c >> 5), rr = r & 15, cc = c & 31, ob = rr * 64 + cc * 2; return st * 1024 + (ob ^ (((ob >> 9) & 1) << 5)); }
__host__ __device__ __forceinline__ void stage_rc(int b, int& R, int& C) { const int st = b / 1024, sb = b % 1024, swz = sb ^ (((sb >> 9) & 1) << 5); R = (st >> 1) * 16 + swz / 64; C = (st & 1) * 32 + (swz % 64) / 2; }
__host__ __device__ __forceinline__ int perm32(int rho) { const int n = rho >> 4, i = rho & 15; return 8 * (i >> 2) + 4 * n + (i & 3); }

struct Unit { int pm, pn, ko, ks; };
struct Gemm { const bf16_t* A; const bf16_t* Bt; int M, N, K, ld; };

struct StaticOrder {
    int nM, nN, nwg, G, c;
    __host__ __device__ void init(int M, int N, int G_, int c_) { nM = M / BM; nN = N / BM; nwg = nM * nN; G = G_; c = c_; }
    __host__ __device__ bool next(int i, Unit& u) const {
        const int L = i * G + c; if (L >= nwg) return false;
        int wgid = L; { const int q = nwg / NXCD, r = nwg % NXCD, xcd = wgid % NXCD, off = wgid / NXCD; wgid = (xcd < r ? xcd * (q + 1) : r * (q + 1) + (xcd - r) * q) + off; }
        const int nig = WGM * nN, gid = wgid / nig, fm = gid * WGM, gsz = (nM - fm) < WGM ? (nM - fm) : WGM;
        u.pm = fm + ((wgid % nig) % gsz); u.pn = (wgid % nig) / gsz; u.ko = 0; u.ks = 0; return true;
    }
    __device__ __forceinline__ void a_ready(const Unit&) const {}
    __device__ __forceinline__ void done(const Unit&) const {}
};

struct SplitKOrder {
    int nN, nS, kchunk, G, c;
    __host__ __device__ void init(int N, int nS_, int kchunk_, int G_, int c_) { nN = N / BM; nS = nS_; kchunk = kchunk_; G = G_; c = c_; }
    __host__ __device__ bool next(int i, Unit& u) const { const int L = i * G + c; if (L >= nN * nS) return false; u.pm = 0; u.pn = L % nN; u.ks = L / nN; u.ko = u.ks * kchunk; return true; }
    __device__ __forceinline__ void a_ready(const Unit&) const {}
    __device__ __forceinline__ void done(const Unit&) const {}
};
__device__ __forceinline__ unsigned cvt_pk_bf16(float lo, float hi) { unsigned r; asm volatile("v_cvt_pk_bf16_f32 %0, %1, %2" : "=v"(r) : "v"(lo), "v"(hi)); return r; }
typedef float f32x2 __attribute__((ext_vector_type(2)));
typedef unsigned u32x2 __attribute__((ext_vector_type(2)));
typedef float f32x2 __attribute__((ext_vector_type(2)));
template <int MODE> struct EpiBf16R {
    static constexpr bool PERM = false, AFTER_DRAIN = false;
    bf16_t* O; bf16_t* O2; const f32x2* rope;
    __device__ __forceinline__ void operator()(const f32x4 (&acc)[2][2][4][2], const Unit& u, int wr, int wc, int fr, int fq) const {
        asm volatile("" : "+v"(fr), "+v"(fq));
#pragma unroll
        for (int bj = 0; bj < 2; ++bj) {
            const int cg0 = u.pn * BM + bj * HALF + wc * 32;
            bool dorope = false; int axis = 0; bf16_t* base = O; int ldc = 0, dcol = 0;
            if (MODE == 0) { dorope = (cg0 >= 1536 && cg0 < 2560) || (cg0 >= 5248 && cg0 < 5312); axis = (cg0 >> 5) & 1; ldc = 5376; dcol = cg0; }
            else if (MODE == 1) { const int w = cg0 % 192; dorope = w >= 128; axis = ((w - 128) >> 5) & 1; ldc = 768; dcol = cg0; }
            else { if (bj == 0) { base = O; ldc = 768; dcol = u.pn * 192 + wc * 32; } else { base = O2; ldc = 512; dcol = u.pn * 128 + wc * 32; } }
            dorope = dorope && (u.pm < 32);
#pragma unroll
            for (int ai = 0; ai < 2; ++ai)
#pragma unroll
                for (int m = 0; m < 4; ++m) {
                    const int row = u.pm * BM + ai * HALF + wr * 64 + m * 16 + fr;
                    f32x4 v0 = acc[ai][bj][m][0], v1 = acc[ai][bj][m][1];
                    if (dorope) {
                        const int pos = axis ? (row & 63) : (row >> 6);
                        const f32x2* rp = rope + pos * 16 + 4 * fq;
                        f32x4 o0, o1;
#pragma unroll
                        for (int i = 0; i < 4; ++i) { const f32x2 cs = rp[i]; o0[i] = v0[i] * cs.x - v1[i] * cs.y; o1[i] = v1[i] * cs.x + v0[i] * cs.y; }
                        v0 = o0; v1 = o1;
                    }
                    bf16_t* p = base + (size_t)row * ldc + dcol + 4 * fq;
                    u32x2 w0, w1; w0.x = cvt_pk_bf16(v0[0], v0[1]); w0.y = cvt_pk_bf16(v0[2], v0[3]); w1.x = cvt_pk_bf16(v1[0], v1[1]); w1.y = cvt_pk_bf16(v1[2], v1[3]);
                    *(u32x2*)p = w0; *(u32x2*)(p + 16) = w1;
                }
        }
    }
};
struct EpiResid {
    static constexpr bool PERM = false, AFTER_DRAIN = false;
    const float* xres; float* out; const float* gate_lat; const float* gate_ctx;
    __device__ __forceinline__ void operator()(const f32x4 (&acc)[2][2][4][2], const Unit& u, int wr, int wc, int fr, int fq) const {
        asm volatile("" : "+v"(fr), "+v"(fq));
        const int col0 = u.pn * BM + wc * 32 + 4 * fq;
        const float* gate = (u.pm >= 32) ? gate_ctx : gate_lat;
#pragma unroll
        for (int bj = 0; bj < 2; ++bj)
#pragma unroll
            for (int n = 0; n < 2; ++n) {
                const f32x4 gv = *(const f32x4*)(gate + col0 + bj * HALF + n * 16);
#pragma unroll
                for (int ai = 0; ai < 2; ++ai)
#pragma unroll
                    for (int m = 0; m < 4; ++m) {
                        const size_t off = (size_t)(u.pm * BM + ai * HALF + wr * 64 + m * 16 + fr) * 2048 + col0 + bj * HALF + n * 16;
                        const f32x4 xr = *(const f32x4*)(xres + off);
                        *(f32x4*)(out + off) = xr * 1.4142135623730951f + gv * acc[ai][bj][m][n];
                    }
            }
    }
};
struct EpiSwiglu {
    static constexpr bool PERM = true, AFTER_DRAIN = false;
    bf16_t* O;
    __device__ __forceinline__ void operator()(const f32x4 (&acc)[2][2][4][2], const Unit& u, int wr, int wc, int fr, int fq) const {
        asm volatile("" : "+v"(fr), "+v"(fq));
        const int col0 = u.pn * HALF + wc * 32 + 8 * fq;
#pragma unroll
        for (int ai = 0; ai < 2; ++ai)
#pragma unroll
            for (int m = 0; m < 4; ++m) {
                const int row = u.pm * BM + ai * HALF + wr * 64 + m * 16 + fr;
                float a[8];
#pragma unroll
                for (int n = 0; n < 2; ++n)
#pragma unroll
                    for (int i = 0; i < 4; ++i) { const float g = acc[ai][0][m][n][i], up = acc[ai][1][m][n][i]; a[n * 4 + i] = g / (1.0f + __expf(-g)) * up; }
                u32x4 w; w.x = cvt_pk_bf16(a[0], a[1]); w.y = cvt_pk_bf16(a[2], a[3]); w.z = cvt_pk_bf16(a[4], a[5]); w.w = cvt_pk_bf16(a[6], a[7]);
                *(u32x4*)(O + (size_t)row * 5632 + col0) = w;
            }
    }
};

struct EpiPart {
    static constexpr bool PERM = false, AFTER_DRAIN = false;
    float* part;
    __device__ __forceinline__ void operator()(const f32x4 (&acc)[2][2][4][2], const Unit& u, int wr, int wc, int fr, int fq) const {
        asm volatile("" : "+v"(fr), "+v"(fq));
        const int col0 = u.pn * BM + wc * 32 + 4 * fq;
        float* base = part + (size_t)u.ks * 256 * 2048;
#pragma unroll
        for (int bj = 0; bj < 2; ++bj)
#pragma unroll
            for (int n = 0; n < 2; ++n)
#pragma unroll
                for (int ai = 0; ai < 2; ++ai)
#pragma unroll
                    for (int m = 0; m < 4; ++m) {
                        const size_t off = (size_t)(ai * HALF + wr * 64 + m * 16 + fr) * 2048 + col0 + bj * HALF + n * 16;
                        *(f32x4*)(base + off) = acc[ai][bj][m][n];
                    }
    }
};

template <class Epi, class Sched, bool ALIGN_EPI = false, bool SP2 = false>
__device__ __forceinline__ void gemm_phase(PG8_LAS unsigned char* lds, const Gemm g, const Sched& S, const Epi& E) {
    const int tid = ltid(), wid = __builtin_amdgcn_readfirstlane(tid >> 6), lane = tid & 63, wr = wid >> 2, wc = wid & 3, fr = lane & 15, fq = lane >> 4;
    const int K = g.K, LD = g.ld, nt = K / BK;
    unsigned voffA[2], voffB[2];
#pragma unroll
    for (int i = 0; i < 2; ++i) { int R, C; stage_rc(tid * 16 + i * 8192, R, C); const int Rb = Epi::PERM ? ((R & ~31) + perm32(R & 31)) : R;
        voffA[i] = (unsigned)(R * LD + C) * 2u; voffB[i] = (unsigned)(Rb * LD + C) * 2u; }
    const size_t kstep = (size_t)(BK * 2);
    const size_t hstep = (size_t)HALF * LD * 2;
    const size_t tstep = 2 * hstep;
    const unsigned ldsw = (unsigned)wid * 1024u;
    const int aoff = lds_byte(wr * 64 + fr, fq * 8), boff = lds_byte(wc * 32 + fr, fq * 8);
#define PG8_SA(b, h) (((b) * 2 + (h)) * HTB)
#define PG8_SB(b, h) ((4 + (b) * 2 + (h)) * HTB)
#define PG8_STAGE(bufoff, gbase, voff) do { _Pragma("unroll") for (int _i = 0; _i < 2; ++_i) \
        __builtin_amdgcn_global_load_lds((const unsigned*)((const char*)(gbase) + (voff)[_i]), (PG8_LAS unsigned*)(lds + (bufoff) + ldsw + _i * 8192), 16, 0, 0); } while (0)
#define PG8_LDA(dst, b, h) do { _Pragma("unroll") for (int m = 0; m < 4; ++m) _Pragma("unroll") for (int k = 0; k < 2; ++k) dst[m][k] = *(const PG8_LAS bf16x8*)(lds + PG8_SA(b, h) + aoff + m * 2048 + k * 1024); } while (0)
#define PG8_LDB(dst, b, h) do { _Pragma("unroll") for (int n = 0; n < 2; ++n) _Pragma("unroll") for (int k = 0; k < 2; ++k) dst[n][k] = *(const PG8_LAS bf16x8*)(lds + PG8_SB(b, h) + boff + n * 2048 + k * 1024); } while (0)
#define PG8_MMA(ai, bj, At, Bt) do { __builtin_amdgcn_s_setprio(1); _Pragma("unroll") for (int m = 0; m < 4; ++m) _Pragma("unroll") for (int n = 0; n < 2; ++n) _Pragma("unroll") for (int k = 0; k < 2; ++k) \
        acc[ai][bj][m][n] = __builtin_amdgcn_mfma_f32_16x16x32_bf16(Bt[n][k], At[m][k], acc[ai][bj][m][n], 0, 0, 0); __builtin_amdgcn_s_setprio(0); } while (0)
#define PG8_WAIT_V(n) asm volatile("s_waitcnt vmcnt(" #n ")" ::: "memory")
#define PG8_WAIT_L(n) asm volatile("s_waitcnt lgkmcnt(" #n ")" ::: "memory")
#define PG8_BAR __builtin_amdgcn_s_barrier()
#define PG8_SCHED __builtin_amdgcn_sched_barrier(0)
    Unit cur, nxt; int ui = 0;
    if (!S.next(0, cur)) return;
    f32x4 acc[2][2][4][2];
#pragma unroll
    for (int a = 0; a < 2; ++a)
#pragma unroll
        for (int b = 0; b < 2; ++b)
#pragma unroll
            for (int m = 0; m < 4; ++m)
#pragma unroll
                for (int n = 0; n < 2; ++n) acc[a][b][m][n] = (f32x4){0.f, 0.f, 0.f, 0.f};
    bf16x8 At[4][2], B0[2][2], B1[2][2];
    const char* cA = (const char*)g.A + (size_t)cur.pm * tstep + (size_t)cur.ko * 2; const char* cB = (const char*)g.Bt + (size_t)cur.pn * tstep + (size_t)cur.ko * 2;
    S.a_ready(cur);
    if constexpr (SP2) {
        PG8_STAGE(PG8_SB(0, 0), cB, voffB); PG8_STAGE(PG8_SB(0, 1), cB + hstep, voffB); PG8_STAGE(PG8_SA(0, 0), cA, voffA); PG8_STAGE(PG8_SA(0, 1), cA + hstep, voffA);
        if (wr == 1) PG8_BAR;
        PG8_WAIT_V(2); PG8_BAR;
        PG8_STAGE(PG8_SB(1, 0), cB + kstep, voffB); PG8_STAGE(PG8_SA(1, 0), cA + kstep, voffA); PG8_STAGE(PG8_SB(1, 1), cB + hstep + kstep, voffB);
        PG8_WAIT_V(6); PG8_BAR;
    } else {
        PG8_STAGE(PG8_SB(0, 0), cB, voffB); PG8_STAGE(PG8_SA(0, 0), cA, voffA); PG8_STAGE(PG8_SB(0, 1), cB + hstep, voffB); PG8_STAGE(PG8_SA(0, 1), cA + hstep, voffA);
        if (wr == 1) PG8_BAR;
        PG8_WAIT_V(4); PG8_BAR;
        PG8_STAGE(PG8_SB(1, 0), cB + kstep, voffB); PG8_STAGE(PG8_SA(1, 0), cA + kstep, voffA); PG8_STAGE(PG8_SB(1, 1), cB + hstep + kstep, voffB);
        PG8_WAIT_V(6); PG8_BAR;
    }
    for (;;) {
        const bool has_next = S.next(ui + 1, nxt);
        const char* nA = has_next ? (const char*)g.A + (size_t)nxt.pm * tstep + (size_t)nxt.ko * 2 : cA; const char* nB = has_next ? (const char*)g.Bt + (size_t)nxt.pn * tstep + (size_t)nxt.ko * 2 : cB;
        for (int t = 0; t < nt; t += 2) {
            const bool last = (t == nt - 2);
            const char* a1 = cA + (size_t)(t + 1) * kstep;
            const char* a2 = last ? nA : cA + (size_t)(t + 2) * kstep; const char* b2 = last ? nB : cB + (size_t)(t + 2) * kstep;
            const char* a3 = a2 + kstep; const char* b3 = b2 + kstep;
            if (last && has_next) S.a_ready(nxt);
            if constexpr (SP2) {
            PG8_LDB(B0, 0, 0); PG8_LDB(B1, 0, 1); PG8_SCHED; PG8_LDA(At, 0, 0); PG8_STAGE(PG8_SA(1, 1), a1 + hstep, voffA);
            PG8_WAIT_V(8); PG8_WAIT_L(0); PG8_BAR; PG8_MMA(0, 0, At, B0); PG8_MMA(0, 1, At, B1); PG8_BAR; PG8_SCHED;
            PG8_LDA(At, 0, 1); PG8_STAGE(PG8_SB(0, 0), b2, voffB); PG8_STAGE(PG8_SB(0, 1), b2 + hstep, voffB); PG8_STAGE(PG8_SA(0, 0), a2, voffA);
            PG8_WAIT_V(8); PG8_WAIT_L(0); PG8_BAR; PG8_MMA(1, 0, At, B0); PG8_MMA(1, 1, At, B1); PG8_BAR; PG8_SCHED;
            PG8_LDB(B0, 1, 0); PG8_LDB(B1, 1, 1); PG8_SCHED; PG8_LDA(At, 1, 0); PG8_STAGE(PG8_SA(0, 1), a2 + hstep, voffA);
            PG8_WAIT_V(8); PG8_WAIT_L(0); PG8_BAR; PG8_MMA(0, 0, At, B0); PG8_MMA(0, 1, At, B1); PG8_BAR; PG8_SCHED;
            PG8_LDA(At, 1, 1); PG8_STAGE(PG8_SB(1, 0), b3, voffB); PG8_STAGE(PG8_SB(1, 1), b3 + hstep, voffB); PG8_STAGE(PG8_SA(1, 0), a3, voffA);
            PG8_WAIT_V(8); PG8_WAIT_L(0); PG8_BAR; PG8_MMA(1, 0, At, B0); PG8_MMA(1, 1, At, B1); PG8_BAR; PG8_SCHED;
            } else {
            PG8_LDB(B0, 0, 0); PG8_SCHED; PG8_LDA(At, 0, 0); PG8_STAGE(PG8_SA(1, 1), a1 + hstep, voffA);
            PG8_WAIT_L(8); PG8_BAR; PG8_WAIT_L(0); PG8_MMA(0, 0, At, B0); PG8_BAR; PG8_SCHED;
            PG8_LDB(B1, 0, 1); PG8_STAGE(PG8_SB(0, 0), b2, voffB);
            PG8_BAR; PG8_WAIT_L(0); PG8_MMA(0, 1, At, B1); PG8_BAR;
            PG8_LDA(At, 0, 1); PG8_STAGE(PG8_SA(0, 0), a2, voffA);
            PG8_BAR; PG8_WAIT_L(0); PG8_MMA(1, 0, At, B0); PG8_BAR; PG8_SCHED;
            PG8_STAGE(PG8_SB(0, 1), b2 + hstep, voffB);
            PG8_WAIT_V(6); PG8_BAR; PG8_MMA(1, 1, At, B1); PG8_BAR;
            PG8_LDB(B0, 1, 0); PG8_SCHED; PG8_LDA(At, 1, 0); PG8_STAGE(PG8_SA(0, 1), a2 + hstep, voffA);
            PG8_WAIT_L(8); PG8_BAR; PG8_WAIT_L(0); PG8_MMA(0, 0, At, B0); PG8_BAR; PG8_SCHED;
            PG8_LDB(B1, 1, 1); PG8_STAGE(PG8_SB(1, 0), b3, voffB);
            PG8_BAR; PG8_WAIT_L(0); PG8_MMA(0, 1, At, B1); PG8_BAR;
            PG8_LDA(At, 1, 1); PG8_STAGE(PG8_SA(1, 0), a3, voffA);
            PG8_BAR; PG8_WAIT_L(0); PG8_MMA(1, 0, At, B0); PG8_BAR; PG8_SCHED;
            PG8_STAGE(PG8_SB(1, 1), b3 + hstep, voffB);
            PG8_WAIT_V(6); PG8_BAR; PG8_MMA(1, 1, At, B1); PG8_BAR;
            }
        }
        if constexpr (ALIGN_EPI) { if (wr == 0) PG8_BAR; }
        if constexpr (!Epi::AFTER_DRAIN) { E(acc, cur, wr, wc, fr, fq); S.done(cur); }
        if (!has_next) break;
#pragma unroll
        for (int a = 0; a < 2; ++a)
#pragma unroll
            for (int b = 0; b < 2; ++b)
#pragma unroll
                for (int m = 0; m < 4; ++m)
#pragma unroll
                    for (int n = 0; n < 2; ++n) acc[a][b][m][n] = (f32x4){0.f, 0.f, 0.f, 0.f};
        cur = nxt; cA = nA; cB = nB; ++ui;
        if constexpr (ALIGN_EPI) { if (wr == 1) PG8_BAR; }
    }
    PG8_WAIT_V(0);
    if constexpr (!ALIGN_EPI) { if (wr == 0) PG8_BAR; }
    PG8_BAR;
    if constexpr (Epi::AFTER_DRAIN) { E.fused(acc, cur, wr, wc, fr, fq, lds, wid, lane); S.done(cur); }
#undef PG8_SA
#undef PG8_SB
#undef PG8_STAGE
#undef PG8_LDA
#undef PG8_LDB
#undef PG8_MMA
#undef PG8_WAIT_V
#undef PG8_WAIT_L
#undef PG8_BAR
#undef PG8_SCHED
}
}
namespace att {
typedef unsigned short bf16_t;
using bf16x8 = __attribute__((ext_vector_type(8))) short;
using s16x4  = __attribute__((ext_vector_type(4))) short;
using f32x16 = __attribute__((ext_vector_type(16))) float;
using u32x4  = __attribute__((ext_vector_type(4))) unsigned;
constexpr int NW = 8, QBLK = 32, KVBLK = 64, DV = 128;
constexpr float THR = 8.f;
#define SBAR() __builtin_amdgcn_sched_barrier(0)
__device__ __forceinline__ int crow(int r, int hi) { return (r & 3) + 8 * (r >> 2) + 4 * hi; }
__device__ __forceinline__ unsigned cvtpk(float lo, float hi) { unsigned r; asm volatile("v_cvt_pk_bf16_f32 %0, %1, %2" : "=v"(r) : "v"(lo), "v"(hi)); return r; }
template <int DQK> struct Cfg {
    static constexpr float SCALE = (DQK == 64) ? 0.125f : 0.07216878364870322f;
    static constexpr int KROWB = DQK * 2, SHM_K = KVBLK * DQK * 2, SHM_V = KVBLK * DV * 2, NP = DQK / 64, ND0 = DQK / 16;
    static constexpr int NQR = (DQK == 192) ? 12 : ND0;
    static constexpr int SHM_Q = (ND0 - NQR) * 16 * 2 * 256;
    static constexpr int SHM = 2 * SHM_V + 2 * SHM_K + NW * 64 * 4 + SHM_Q;
};
template <int DQK> __device__ __forceinline__ void partialSM(f32x16& p0, f32x16& p1, float& m_reg, float& mn, float& alpha) {
  constexpr float SCALE = Cfg<DQK>::SCALE; constexpr float C = SCALE * 1.4426950408889634f;
  float pmax = p0[0];
#pragma unroll
  for (int r = 1; r < 16; ++r) pmax = fmaxf(pmax, p0[r]);
#pragma unroll
  for (int r = 0; r < 16; ++r) pmax = fmaxf(pmax, p1[r]);
  { auto rr = __builtin_amdgcn_permlane32_swap(__float_as_uint(pmax), __float_as_uint(pmax), false, false);
    pmax = fmaxf(__uint_as_float(rr[0]), __uint_as_float(rr[1])); }
  if (__builtin_expect(__all(pmax - m_reg <= THR / SCALE), 1)) { mn = m_reg; alpha = 1.f; }
  else { mn = fmaxf(m_reg, pmax); alpha = __builtin_amdgcn_exp2f((m_reg - mn) * C); m_reg = mn; }
  float mnC = -mn * C;
#pragma unroll
  for (int r = 0; r < 16; ++r) p0[r] = fmaf(p0[r], C, mnC);
#pragma unroll
  for (int r = 0; r < 16; ++r) p1[r] = fmaf(p1[r], C, mnC);
#pragma unroll
  for (int r = 0; r < 16; ++r) p0[r] = __builtin_amdgcn_exp2f(p0[r]);
}
__device__ __forceinline__ void finishSM(f32x16& p0, f32x16& p1, float alpha, float& l_reg, bf16x8& pa0, bf16x8& pa1, bf16x8& pa2, bf16x8& pa3) {
#pragma unroll
  for (int r = 0; r < 16; ++r) p1[r] = __builtin_amdgcn_exp2f(p1[r]);
  float ps = 0;
#pragma unroll
  for (int r = 0; r < 16; ++r) ps += p0[r];
#pragma unroll
  for (int r = 0; r < 16; ++r) ps += p1[r];
  { auto rr = __builtin_amdgcn_permlane32_swap(__float_as_uint(ps), __float_as_uint(ps), false, false);
    ps = __uint_as_float(rr[0]) + __uint_as_float(rr[1]); }
  l_reg = l_reg * alpha + ps;
#define PK4(P, BASE, OUT) do { unsigned a0 = cvtpk(P[BASE + 0], P[BASE + 1]), a1 = cvtpk(P[BASE + 2], P[BASE + 3]);   \
    unsigned b0 = cvtpk(P[BASE + 4], P[BASE + 5]), b1 = cvtpk(P[BASE + 6], P[BASE + 7]);                              \
    auto r0 = __builtin_amdgcn_permlane32_swap(a0, b0, false, false); auto r1 = __builtin_amdgcn_permlane32_swap(a1, b1, false, false); \
    u32x4 w = {r0[0], r1[0], r0[1], r1[1]}; OUT = *reinterpret_cast<bf16x8*>(&w); } while (0)
  PK4(p0, 0, pa0); PK4(p0, 8, pa1); PK4(p1, 0, pa2); PK4(p1, 8, pa3);
#undef PK4
}
template <int DQK> __device__ __forceinline__ int kswz(int row, int colB) { return row * (DQK * 2) + (colB ^ ((row & 7) << 4)); }
template <int DQK> __device__ __forceinline__ void qkt(f32x16& p0, f32x16& p1, const char* Ks, const bf16x8* qr, const char* Qs, const int* kb, const int* qb, int r32, int hi) {
  constexpr int NQR = Cfg<DQK>::NQR; constexpr int KROWB = DQK * 2;
  p0 = f32x16{}; p1 = f32x16{};
#pragma unroll
  for (int g = 0; g < DQK / 64; ++g)
#pragma unroll
    for (int dd = 0; dd < 4; ++dd) { const int d0 = g * 4 + dd;
      bf16x8 b0 = *reinterpret_cast<const bf16x8*>(Ks + kb[dd] + g * 128);
      bf16x8 b1 = *reinterpret_cast<const bf16x8*>(Ks + kb[dd] + g * 128 + 32 * KROWB);
      bf16x8 q;
      if (d0 < NQR) q = qr[d0 < NQR ? d0 : 0]; else q = *reinterpret_cast<const bf16x8*>(Qs + qb[dd] + (g - NQR / 4) * 32768);
      p0 = __builtin_amdgcn_mfma_f32_32x32x16_bf16(b0, q, p0, 0, 0, 0);
      p1 = __builtin_amdgcn_mfma_f32_32x32x16_bf16(b1, q, p1, 0, 0, 0); }
}
__device__ __forceinline__ int v_st(int k, int c) { const int kk = (k & ~0xC) | ((k & 4) << 1) | ((k & 8) >> 1); return ((kk >> 3) * 4 + (c >> 5)) * 512 + ((kk & 7) * 32 + (c & 31)) * 2; }
__device__ __forceinline__ int v_rd_base(int lane) { return ((lane & 3) << 3) | (((lane >> 2) & 3) << 6) | (((lane >> 4) & 1) << 5) | (((lane >> 5) & 1) << 8); }
constexpr int v_rd_off(int d0, int ks, int half) { return d0 * 512 + ks * 4096 + half * 2048; }
template <int OFF> __device__ __forceinline__ s16x4 tr_read(int vb) {
  s16x4 r; asm volatile("ds_read_b64_tr_b16 %0, %1 offset:%2" : "=&v"(r) : "v"(vb), "i"(OFF) : "memory"); return r;
}
template <int D0> __device__ __forceinline__ void pv_one(f32x16& od, int vb, bf16x8 pa0, bf16x8 pa1, bf16x8 pa2, bf16x8 pa3) {
  const s16x4 l0 = tr_read<v_rd_off(D0, 0, 0)>(vb), h0 = tr_read<v_rd_off(D0, 0, 1)>(vb), l1 = tr_read<v_rd_off(D0, 1, 0)>(vb), h1 = tr_read<v_rd_off(D0, 1, 1)>(vb);
  const s16x4 l2 = tr_read<v_rd_off(D0, 2, 0)>(vb), h2 = tr_read<v_rd_off(D0, 2, 1)>(vb), l3 = tr_read<v_rd_off(D0, 3, 0)>(vb), h3 = tr_read<v_rd_off(D0, 3, 1)>(vb);
  asm volatile("s_waitcnt lgkmcnt(0)" ::: "memory"); SBAR();
#define PK(L, H) (bf16x8){L[0], L[1], L[2], L[3], H[0], H[1], H[2], H[3]}
  od = __builtin_amdgcn_mfma_f32_32x32x16_bf16(pa0, PK(l0, h0), od, 0, 0, 0);
  od = __builtin_amdgcn_mfma_f32_32x32x16_bf16(pa1, PK(l1, h1), od, 0, 0, 0);
  od = __builtin_amdgcn_mfma_f32_32x32x16_bf16(pa2, PK(l2, h2), od, 0, 0, 0);
  od = __builtin_amdgcn_mfma_f32_32x32x16_bf16(pa3, PK(l3, h3), od, 0, 0, 0);
#undef PK
}
__device__ __forceinline__ void pv_d0(f32x16* o, int vb, bf16x8 pa0, bf16x8 pa1, bf16x8 pa2, bf16x8 pa3) {
  pv_one<0>(o[0], vb, pa0, pa1, pa2, pa3); pv_one<1>(o[1], vb, pa0, pa1, pa2, pa3); pv_one<2>(o[2], vb, pa0, pa1, pa2, pa3); pv_one<3>(o[3], vb, pa0, pa1, pa2, pa3);
}
template <int DQK, bool OUT_BF16, int ldq, int ldk, int ldv, int ldo>
__device__ __forceinline__ void attn_dense_body(const bf16_t* __restrict__ Qb, const bf16_t* __restrict__ Kh, const bf16_t* __restrict__ Vh,
                                                float* __restrict__ Of, bf16_t* __restrict__ Ob, int seq, char* lds) {
  using C_ = Cfg<DQK>;
  constexpr int SHM_V = C_::SHM_V, SHM_K = C_::SHM_K, NP = C_::NP, ND0 = C_::ND0, NQR = C_::NQR;
  const int tid = ltid(), wid = tid >> 6, lane = tid & 63, r32 = lane & 31, hi = lane >> 5;
  char* V_lds = lds; char* K_lds = lds + 2 * SHM_V;
  float* ws = (float*)(lds + 2 * SHM_V + 2 * SHM_K) + wid * 64; float* li_l = ws; float* al_l = ws + 32;
  char* Q_lds = lds + 2 * SHM_V + 2 * SHM_K + NW * 64 * 4; const int qrow = wid * QBLK + r32;
  int kb[4], qb[4];
#pragma unroll
  for (int dd = 0; dd < 4; ++dd) { const int t = (dd * 32 + hi * 16) ^ ((r32 & 7) << 4); kb[dd] = r32 * (DQK * 2) + t; qb[dd] = qrow * 128 + t; }
  float m_reg = -1e30f, l_reg = 0; f32x16 o[4] = {}; bf16x8 qr[NQR];
  const bf16_t* Qw = Qb + (size_t)(wid * QBLK + r32) * ldq + hi * 8;
#pragma unroll
  for (int d0 = 0; d0 < NQR; ++d0) qr[d0] = *reinterpret_cast<const bf16x8*>(Qw + d0 * 16);
#pragma unroll
  for (int d0 = NQR; d0 < ND0; ++d0) *reinterpret_cast<bf16x8*>(Q_lds + qb[(d0 - NQR) & 3] + ((d0 - NQR) >> 2) * 32768) = *reinterpret_cast<const bf16x8*>(Qw + d0 * 16);
  const int sr = tid >> 4, sc = (tid & 15) * 8, vst0 = v_st(sr, sc), vst1 = v_st(32 + sr, sc);
  const int kr_ = tid >> 3, kc_ = (tid & 7) * 8;
  const int vb0 = (int)(uintptr_t)V_lds + v_rd_base(lane);
  bf16x8 vs0, vs1, ks[NP];
#define SLOAD(k0) do { vs0 = *reinterpret_cast<const bf16x8*>(&Vh[(size_t)((k0) + sr) * ldv + sc]); vs1 = *reinterpret_cast<const bf16x8*>(&Vh[(size_t)((k0) + 32 + sr) * ldv + sc]); \
    _Pragma("unroll") for (int i_ = 0; i_ < NP; ++i_) ks[i_] = *reinterpret_cast<const bf16x8*>(&Kh[(size_t)((k0) + kr_) * ldk + kc_ + 64 * i_]); } while (0)
#define SWRITE(b) do { *(bf16x8*)(V_lds + (b) * SHM_V + vst0) = vs0; *(bf16x8*)(V_lds + (b) * SHM_V + vst1) = vs1; \
    _Pragma("unroll") for (int i_ = 0; i_ < NP; ++i_) *(bf16x8*)(K_lds + (b) * SHM_K + kswz<DQK>(kr_, (kc_ + 64 * i_) * 2)) = ks[i_]; } while (0)
#define RESC(a) do { if (__any((a) < 1.f)) { if (hi == 0) al_l[r32] = (a); asm volatile("s_waitcnt lgkmcnt(0)" ::: "memory"); \
    _Pragma("unroll") for (int d = 0; d < 4; ++d) _Pragma("unroll") for (int r = 0; r < 16; ++r) o[d][r] *= al_l[crow(r, hi)]; } } while (0)
  const int NT = seq / KVBLK; bf16x8 pa0, pa1, pa2, pa3;
  if constexpr (DQK == 192) {
    f32x16 pA0, pA1; float mnA, alA;
    SLOAD(0); SWRITE(0); __syncthreads();
    for (int j = 0; j < NT; ++j) {
      const int buf = j & 1;
      if (j + 1 < NT) SLOAD((j + 1) * KVBLK);
      SBAR(); qkt<DQK>(pA0, pA1, K_lds + buf * SHM_K, qr, Q_lds, kb, qb, r32, hi);
      partialSM<DQK>(pA0, pA1, m_reg, mnA, alA);
      RESC(alA);
      finishSM(pA0, pA1, alA, l_reg, pa0, pa1, pa2, pa3); SBAR();
      pv_d0(o, vb0 + buf * (int)SHM_V, pa0, pa1, pa2, pa3);
      if (j + 1 < NT) SWRITE(buf ^ 1);
      __syncthreads();
    }
  } else {
  f32x16 pA0, pA1, pB0, pB1; float mnA, mnB, alA, alB;
  SLOAD(0); SWRITE(0); __syncthreads();
  qkt<DQK>(pA0, pA1, K_lds, qr, Q_lds, kb, qb, r32, hi); partialSM<DQK>(pA0, pA1, m_reg, mnA, alA);
  SLOAD(KVBLK);
  SWRITE(1); __syncthreads();
  for (int j = 1; j + 1 < NT; j += 2) {
    SBAR(); qkt<DQK>(pB0, pB1, K_lds + SHM_K, qr, Q_lds, kb, qb, r32, hi);
    finishSM(pA0, pA1, alA, l_reg, pa0, pa1, pa2, pa3); SBAR();
    SLOAD((j + 1) * KVBLK); SBAR();
    pv_d0(o, vb0, pa0, pa1, pa2, pa3); partialSM<DQK>(pB0, pB1, m_reg, mnB, alB);
    __syncthreads(); SWRITE(0);
    RESC(alB); __syncthreads();
    SBAR(); qkt<DQK>(pA0, pA1, K_lds, qr, Q_lds, kb, qb, r32, hi);
    finishSM(pB0, pB1, alB, l_reg, pa0, pa1, pa2, pa3); SBAR();
    SLOAD((j + 2) * KVBLK); SBAR();
    pv_d0(o, vb0 + (int)SHM_V, pa0, pa1, pa2, pa3); partialSM<DQK>(pA0, pA1, m_reg, mnA, alA);
    __syncthreads(); SWRITE(1);
    RESC(alA); __syncthreads();
  }
  SBAR(); qkt<DQK>(pB0, pB1, K_lds + SHM_K, qr, Q_lds, kb, qb, r32, hi);
  finishSM(pA0, pA1, alA, l_reg, pa0, pa1, pa2, pa3); SBAR();
  pv_d0(o, vb0, pa0, pa1, pa2, pa3); partialSM<DQK>(pB0, pB1, m_reg, mnB, alB);
  __syncthreads(); RESC(alB);
  finishSM(pB0, pB1, alB, l_reg, pa0, pa1, pa2, pa3); SBAR();
  pv_d0(o, vb0 + (int)SHM_V, pa0, pa1, pa2, pa3);
  }
  if (hi == 0) li_l[r32] = l_reg; asm volatile("s_waitcnt lgkmcnt(0)" ::: "memory");
  float rli[16];
#pragma unroll
  for (int r = 0; r < 16; ++r) rli[r] = __builtin_amdgcn_rcpf(li_l[crow(r, hi)]);
#pragma unroll
  for (int r = 0; r < 16; ++r) { const int orow = wid * QBLK + crow(r, hi);
#pragma unroll
    for (int d0 = 0; d0 < 4; ++d0) { const float v = o[d0][r] * rli[r];
      if (OUT_BF16) { const unsigned u = __float_as_uint(v); Ob[(size_t)orow * ldo + d0 * 32 + r32] = (bf16_t)((u + 0x7fffu + ((u >> 16) & 1u)) >> 16); }
      else Of[(size_t)orow * ldo + d0 * 32 + r32] = v; } }
  __syncthreads();
#undef SLOAD
#undef SWRITE
#undef RESC
}
#undef SBAR
}

#define LAS __attribute__((address_space(3)))
#ifndef PH_MASK
#define PH_MASK 0xffffffffu
#endif
#define PHON(id) ((PH_MASK >> (id)) & 1u)
#ifndef PROBE_MASK
#define PROBE_MASK 0u
#endif
#define PRB(id) ((PROBE_MASK >> (id)) & 1u)
typedef unsigned short bf16_t;
typedef unsigned v4u __attribute__((ext_vector_type(4)));
typedef unsigned v2u __attribute__((ext_vector_type(2)));
typedef float f32x4 __attribute__((ext_vector_type(4)));
typedef float f32x2 __attribute__((ext_vector_type(2)));
typedef short bf16x8 __attribute__((ext_vector_type(8)));
constexpr int NWAVES = 8, NTHR = 512;
constexpr int LDS_BYTES = 155648;
constexpr size_t MiB = 1u << 20;
constexpr size_t WS_CTL = 0, CTL_BYTES = 32768, WS_ROPE = 64 * 1024, WS_MOD = 128 * 1024, WS_MODP = 1 * MiB;
constexpr size_t WS_W0 = 4 * MiB, W_LAYER = 97 * MiB, WO_IN = 0, WO_Q = 21 * MiB, WO_KV = 22 * MiB, WO_OUT = 23 * MiB, WO_F1 = 31 * MiB, WO_F2 = 75 * MiB;
constexpr size_t WS_H = 198 * MiB, WS_P = 231 * MiB, WS_XBC = 318 * MiB, WS_ACT = 231 * MiB, WS_DT = 335 * MiB, WS_CQN = 336 * MiB, WS_CKVN = 343 * MiB;
constexpr size_t WS_QMLA = 348 * MiB, WS_KMLA = 361 * MiB, WS_VMLA = 374 * MiB, WS_ODIFF = 383 * MiB, WS_S = 416 * MiB, WS_R = 449 * MiB, WS_ATOT = 466 * MiB;
constexpr size_t WS_CAT = 467 * MiB, WS_PRE = 500 * MiB, WS_XA = 566 * MiB, WS_X1 = 632 * MiB, WS_PART = 698 * MiB, WS_END = 720 * MiB;

__device__ __forceinline__ float bf2f(bf16_t v) { return __uint_as_float((unsigned)v << 16); }
__device__ __forceinline__ unsigned f2bf(float f) { unsigned u = __float_as_uint(f); return (u + 0x7fffu + ((u >> 16) & 1u)) >> 16; }
__device__ __forceinline__ unsigned pk2(float lo, float hi) { return f2bf(lo) | (f2bf(hi) << 16); }
__device__ __forceinline__ void unpack8(v4u w, float* f) {
#pragma unroll
    for (int i = 0; i < 4; ++i) { f[2 * i] = __uint_as_float(w[i] << 16); f[2 * i + 1] = __uint_as_float(w[i] & 0xffff0000u); }
}
__device__ __forceinline__ v4u pack8(const float* f) { v4u w; w.x = pk2(f[0], f[1]); w.y = pk2(f[2], f[3]); w.z = pk2(f[4], f[5]); w.w = pk2(f[6], f[7]); return w; }
__device__ __forceinline__ v4u ld8(const bf16_t* p) { return *(const v4u*)p; }
__device__ __forceinline__ float wave_sum(float v) {
#pragma unroll
    for (int o = 1; o < 64; o <<= 1) v += __shfl_xor(v, o);
    return v;
}
__device__ __forceinline__ float siluf(float v) { return v / (1.0f + __expf(-v)); }

struct Args { const float* in[27]; float* out; unsigned char* ws; int ph_lo, ph_hi; };

struct Frame {
    LAS unsigned char* lds; char* ldsg;
    int tid, lane, wave, G, gw, NGW, bid;
    const __attribute__((address_space(4))) char* ka; float* out; unsigned char* ws;
};
#define INP(i) (*(const float* const __attribute__((address_space(4)))*)(F.ka + 8 * (i)))
#define WSP(T, off) ((T*)(F.ws + (off)))

__device__ __forceinline__ int srccol(int mode, int n) {
    if (mode == 0) return n;
    if (mode == 1) { if (n < 4608) return n; if (n < 5312) return n + 16; if (n < 5328) return n - 5312 + 4608; return -1; }
    const int t = n >> 8, r = n & 255; return r < 128 ? t * 128 + r : 5632 + t * 128 + (r - 128);
}
__device__ __forceinline__ void transpose_item(const float* W, int K, int Nsrc, bf16_t* WT, int nblk, int mode, LAS float* scr, int item, int lane) {
    const int kb = item / nblk, nb = item % nblk, k0 = 64 * kb, n0 = 64 * nb;
    const int kk = lane >> 4, c4 = (lane & 15) * 4;
    const int sc = srccol(mode, n0 + c4);
    f32x4 v[16];
#pragma unroll
    for (int i = 0; i < 16; ++i) v[i] = (sc >= 0) ? *(const f32x4*)(W + (size_t)(k0 + 4 * i + kk) * Nsrc + sc) : (f32x4){0.f, 0.f, 0.f, 0.f};
#pragma unroll
    for (int i = 0; i < 16; ++i) { LAS float* s = scr + (4 * i + kk) * 65 + c4; s[0] = v[i][0]; s[1] = v[i][1]; s[2] = v[i][2]; s[3] = v[i][3]; }
    asm volatile("s_waitcnt lgkmcnt(0)" ::: "memory");
    const int c = lane & 7;
#pragma unroll
    for (int j = 0; j < 8; ++j) { const int n = (lane >> 3) + 8 * j; const LAS float* s = scr + (8 * c) * 65 + n;
        v4u o; o.x = pk2(s[0 * 65], s[1 * 65]); o.y = pk2(s[2 * 65], s[3 * 65]); o.z = pk2(s[4 * 65], s[5 * 65]); o.w = pk2(s[6 * 65], s[7 * 65]);
        *(v4u*)(WT + (size_t)(n0 + n) * K + k0 + 8 * c) = o; }
    asm volatile("s_waitcnt lgkmcnt(0)" ::: "memory");
}
__device__ __forceinline__ void transpose_matrix(Frame& F, const float* W, int K, int Nsrc, bf16_t* WT, int Ndst, int mode) {
    LAS float* scr = (LAS float*)(F.lds + F.wave * 16896);
    const int nblk = Ndst / 64, nitems = (K / 64) * nblk;
    for (int it = F.gw; it < nitems; it += F.NGW) transpose_item(W, K, Nsrc, WT, nblk, mode, scr, it, F.lane);
}
__device__ __forceinline__ void phase_prologue(Frame& F) {
    {
        const float* c = INP(1); const float* cc = INP(3); const float* wada = INP(4);
        float* modp = WSP(float, WS_MODP);
        const int NT = F.G * NTHR;
        for (int item = F.bid * NTHR + F.tid; item < 2 * 16 * 3072; item += NT) {
            const int n4 = item % 3072, kc = (item / 3072) % 16, l = item / (3072 * 16);
            f32x4 a0 = {0.f, 0.f, 0.f, 0.f}, a1 = {0.f, 0.f, 0.f, 0.f};
            const float* wp = wada + ((size_t)l * 2048 + kc * 128) * 12288 + n4 * 4;
#pragma unroll 8
            for (int k = 0; k < 128; ++k) { const f32x4 w = *(const f32x4*)(wp + (size_t)k * 12288); const float s0 = siluf(c[kc * 128 + k]), s1 = siluf(cc[kc * 128 + k]); a0 += w * s0; a1 += w * s1; }
            *(f32x4*)(modp + ((size_t)((kc * 2 + l) * 2 + 0)) * 12288 + n4 * 4) = a0;
            *(f32x4*)(modp + ((size_t)((kc * 2 + l) * 2 + 1)) * 12288 + n4 * 4) = a1;
        }
    }
    {
        unsigned char* wb = F.ws + WS_W0;
        transpose_matrix(F, INP(6), 2048, 5328, (bf16_t*)(wb + WO_IN), INW, 1);
        transpose_matrix(F, INP(18), 384, 768, (bf16_t*)(wb + WO_Q), 768, 0);
        transpose_matrix(F, INP(19), 256, 1024, (bf16_t*)(wb + WO_KV), 1024, 0);
    }
}
constexpr int DT_N0 = 1024, DT_N1 = DT_N0 + 5632, DT_N2 = DT_N1 + 2816, DT_N3 = DT_N2 + 2688, DT_N4 = DT_N3 + 72, DT_N5 = DT_N4 + 64, DT_N6 = DT_N5 + 1024, DT_N7 = DT_N6 + 5632, DT_N8 = DT_N7 + 2816;
constexpr int DT_UNITS = (DT_N8 + 63) / 64;
__device__ __forceinline__ void deferred_transpose_unit(Frame& F, int tu) {
    LAS float* scr = (LAS float*)(F.lds + F.wave * 16896);
    unsigned char* w0 = F.ws + WS_W0; unsigned char* w1 = w0 + W_LAYER;
    for (int q = 0; q < 8; ++q) {
        int it = tu * 64 + q * 8 + F.wave;
        if (it >= DT_N8) break;
        const float* W; int K, Nsrc, Nd, mode; bf16_t* WT;
        if (it < DT_N0)      { W = INP(20); K = 2048; Nsrc = 2048; Nd = 2048; mode = 0; WT = (bf16_t*)(w0 + WO_OUT); }
        else if (it < DT_N1) { it -= DT_N0; W = INP(23); K = 2048; Nsrc = 11264; Nd = 11264; mode = 2; WT = (bf16_t*)(w0 + WO_F1); }
        else if (it < DT_N2) { it -= DT_N1; W = INP(24); K = 5632; Nsrc = 2048; Nd = 2048; mode = 0; WT = (bf16_t*)(w0 + WO_F2); }
        else if (it < DT_N3) { it -= DT_N2; W = INP(6) + (size_t)2048 * 5328; K = 2048; Nsrc = 5328; Nd = INW; mode = 1; WT = (bf16_t*)(w1 + WO_IN); }
        else if (it < DT_N4) { it -= DT_N3; W = INP(18) + (size_t)384 * 768; K = 384; Nsrc = 768; Nd = 768; mode = 0; WT = (bf16_t*)(w1 + WO_Q); }
        else if (it < DT_N5) { it -= DT_N4; W = INP(19) + (size_t)256 * 1024; K = 256; Nsrc = 1024; Nd = 1024; mode = 0; WT = (bf16_t*)(w1 + WO_KV); }
        else if (it < DT_N6) { it -= DT_N5; W = INP(20) + (size_t)2048 * 2048; K = 2048; Nsrc = 2048; Nd = 2048; mode = 0; WT = (bf16_t*)(w1 + WO_OUT); }
        else if (it < DT_N7) { it -= DT_N6; W = INP(23) + (size_t)2048 * 11264; K = 2048; Nsrc = 11264; Nd = 11264; mode = 2; WT = (bf16_t*)(w1 + WO_F1); }
        else                 { it -= DT_N7; W = INP(24) + (size_t)5632 * 2048; K = 5632; Nsrc = 2048; Nd = 2048; mode = 0; WT = (bf16_t*)(w1 + WO_F2); }
        transpose_item(W, K, Nsrc, WT, Nd / 64, mode, scr, it, F.lane);
    }
}
__device__ __forceinline__ void phase_modfinal(Frame& F) {
    const float* modp = WSP(float, WS_MODP); float* mod = WSP(float, WS_MOD); const float* bada = INP(5);
    const int NT = F.G * NTHR;
    for (int i = F.bid * NTHR + F.tid; i < 2 * 2 * 12288; i += NT) {
        const int l = i / 24576, v = (i / 12288) & 1, n = i % 12288;
        float s = bada[l * 12288 + n];
        for (int kc = 0; kc < 16; ++kc) s += modp[((size_t)((kc * 2 + l) * 2 + v)) * 12288 + n];
        mod[i] = s;
    }
    f32x2* rope = WSP(f32x2, WS_ROPE);
    for (int i = F.bid * NTHR + F.tid; i < 128 * 16; i += NT) { f32x2 cs; cs.x = ROPE_TAB[i].x; cs.y = ROPE_TAB[i].y; rope[i] = cs; }
}
__device__ __forceinline__ const float* modvec(Frame& F, int l, int v, int chunk) { return WSP(float, WS_MOD) + ((size_t)(l * 2 + v) * 6 + chunk) * 2048; }
__device__ __forceinline__ void phase_copy_mod(Frame& F) {
    float* XA = WSP(float, WS_XA); bf16_t* H = WSP(bf16_t, WS_H);
    for (int r = F.gw; r < MROWS; r += F.NGW) {
        const int v = r >= SEQ; const float* src = v ? INP(2) + (size_t)(r - SEQ) * DM : INP(0) + (size_t)r * DM;
        const float* sh = modvec(F, 0, v, 0); const float* sc = modvec(F, 0, v, 1);
#pragma unroll
        for (int j = 0; j < 8; ++j) { const int c = 4 * F.lane + 256 * j; const f32x4 x = *(const f32x4*)(src + c); *(f32x4*)(XA + (size_t)r * DM + c) = x;
            const f32x4 s = *(const f32x4*)(sc + c), b = *(const f32x4*)(sh + c); const f32x4 h = x * (1.0f + s) + b;
            v2u w; w.x = pk2(h[0], h[1]); w.y = pk2(h[2], h[3]); *(v2u*)(H + (size_t)r * DM + c) = w; }
    }
}
__device__ __forceinline__ float half_sum(float v) {
#pragma unroll
    for (int o = 1; o < 32; o <<= 1) v += __shfl_xor(v, o);
    return v;
}
template <int NPARTS>
__device__ __forceinline__ void ln_row(Frame& F, int r, int l32, const float* PRE, const float* g, const float* b, float* xo, const float* sh, const float* sc, bool writeH, const float* xres, const float* gate_ctx) {
    bf16_t* H = WSP(bf16_t, WS_H);
    f32x4 x[16]; float s = 0.f;
    if (NPARTS > 0) {
        float* PREw = const_cast<float*>(PRE);
#pragma unroll 1
        for (int j = 0; j < 16; ++j) { const int c = 4 * l32 + 128 * j; const float* pp = WSP(const float, WS_PART) + (size_t)(r - SEQ) * DM + c; f32x4 a = *(const f32x4*)pp;
#pragma unroll
            for (int t = 1; t < NPARTS; ++t) a += *(const f32x4*)(pp + (size_t)t * 256 * 2048);
            *(f32x4*)(PREw + (size_t)r * DM + c) = *(const f32x4*)(xres + (size_t)r * DM + c) * 1.4142135623730951f + *(const f32x4*)(gate_ctx + c) * a; }
        asm volatile("s_waitcnt vmcnt(0)" ::: "memory");
    }
#pragma unroll
    for (int j = 0; j < 16; ++j) { x[j] = *(const f32x4*)(PRE + (size_t)r * DM + 4 * l32 + 128 * j); s += (x[j][0] + x[j][1]) + (x[j][2] + x[j][3]); }
    const float mean = half_sum(s) * (1.0f / DM); float q = 0.f;
#pragma unroll
    for (int j = 0; j < 16; ++j) { x[j] = x[j] - mean; q += (x[j][0] * x[j][0] + x[j][1] * x[j][1]) + (x[j][2] * x[j][2] + x[j][3] * x[j][3]); }
    const float rstd = rsqrtf(half_sum(q) * (1.0f / DM) + 1e-5f);
#pragma unroll
    for (int j = 0; j < 16; ++j) { const int c = 4 * l32 + 128 * j; const f32x4 gg = *(const f32x4*)(g + c), bb = *(const f32x4*)(b + c);
        const f32x4 y = x[j] * rstd * gg + bb; *(f32x4*)(xo + (size_t)r * DM + c) = y;
        if (writeH) { const f32x4 s2 = *(const f32x4*)(sc + c), b2 = *(const f32x4*)(sh + c); const f32x4 h = y * (1.0f + s2) + b2;
            v2u w; w.x = pk2(h[0], h[1]); w.y = pk2(h[2], h[3]); *(v2u*)(H + (size_t)r * DM + c) = w; }
        if ((j & 3) == 3) asm volatile("" ::: "memory"); }
}
template <int NPARTS>
__device__ __forceinline__ void phase_ln(Frame& F, bool ctx_rows, const float* PRE, const float* g, const float* b, float* xout, int l_mod, int ch_sh, int ch_sc, bool writeH, const float* xres, const float* gate_ctx) {
    const int l32 = F.lane & 31, sub = F.lane >> 5;
    for (int r = 2 * F.gw + sub; r < SEQ; r += 2 * F.NGW)
        ln_row<0>(F, r, l32, PRE, g, b, xout, writeH ? modvec(F, l_mod, 0, ch_sh) : nullptr, writeH ? modvec(F, l_mod, 0, ch_sc) : nullptr, writeH, nullptr, nullptr);
    if (ctx_rows && F.wave == 0 && sub == 0)
        for (int r = SEQ + F.bid; r < MROWS; r += F.G)
            ln_row<NPARTS>(F, r, l32, PRE, g, b, xout, writeH ? modvec(F, l_mod, 1, ch_sh) : nullptr, writeH ? modvec(F, l_mod, 1, ch_sc) : nullptr, writeH, xres, gate_ctx);
}
__device__ __forceinline__ void phase_prep(Frame& F, int l) {
    const bf16_t* P = WSP(bf16_t, WS_P); bf16_t* CAT = WSP(bf16_t, WS_CAT); bf16_t* XBC = WSP(bf16_t, WS_XBC); float* DT = WSP(float, WS_DT);
    bf16_t* CQN = WSP(bf16_t, WS_CQN); bf16_t* CKVN = WSP(bf16_t, WS_CKVN); bf16_t* KMLA = WSP(bf16_t, WS_KMLA);
    const float* caw = INP(7) + (size_t)l * 3 * 512; const float* scw = INP(10) + (size_t)l * 3 * 1024; const float* scb = INP(11) + (size_t)l * 1024;
    const float* dtb = INP(12) + l * 16; const float* qnw = INP(16) + l * 384; const float* kvnw = INP(17) + l * 256;
    const int lane = F.lane;
    for (int r = F.gw; r < MROWS; r += F.NGW) {
        const bool hp = (r != 0 && r != SEQ), hn = (r != SEQ - 1 && r != MROWS - 1);
        const bf16_t* Pr = P + (size_t)r * INW; const bf16_t* Pp = Pr - INW; const bf16_t* Pn = Pr + INW;
        const v4u z4 = {0u, 0u, 0u, 0u};
        {
            const int ch = lane * 8; float bg[8], cg_[8], u_[8], cp[8], up[8], cn[8], un[8], y[8];
            unpack8(ld8(Pr + C_BG + ch), bg); unpack8(ld8(Pr + C_CG + ch), cg_); unpack8(ld8(Pr + C_U + ch), u_);
            unpack8(hp ? ld8(Pp + C_CG + ch) : z4, cp); unpack8(hp ? ld8(Pp + C_U + ch) : z4, up);
            unpack8(hn ? ld8(Pn + C_CG + ch) : z4, cn); unpack8(hn ? ld8(Pn + C_U + ch) : z4, un);
#pragma unroll
            for (int i = 0; i < 8; ++i) y[i] = bg[i] * (caw[ch + i] * cp[i] * up[i] + caw[512 + ch + i] * cg_[i] * u_[i] + caw[1024 + ch + i] * cn[i] * un[i]);
            *(v4u*)(CAT + (size_t)r * DM + ch) = pack8(y);
        }
#pragma unroll
        for (int q = 0; q < 2; ++q) {
            const int ch = lane * 8 + 512 * q; float x0[8], xp[8], xn[8], y[8];
            unpack8(ld8(Pr + C_XBC + ch), x0); unpack8(hp ? ld8(Pp + C_XBC + ch) : z4, xp); unpack8(hn ? ld8(Pn + C_XBC + ch) : z4, xn);
#pragma unroll
            for (int i = 0; i < 8; ++i) y[i] = siluf(scw[ch + i] * xp[i] + scw[1024 + ch + i] * x0[i] + scw[2048 + ch + i] * xn[i] + scb[ch + i]);
            *(v4u*)(XBC + (size_t)r * 1024 + ch) = pack8(y);
        }
        if (lane < 16) { const float v = bf2f(Pr[C_DT + lane]) + dtb[lane]; DT[(size_t)r * 16 + lane] = v > 20.f ? v : __logf(1.0f + __expf(v)); }
        {
            float x[8]; float ss = 0.f;
            if (lane < 48) { unpack8(ld8(Pr + C_CQ + lane * 8), x);
#pragma unroll
                for (int i = 0; i < 8; ++i) ss += x[i] * x[i]; }
            const float rs = rsqrtf(wave_sum(ss) * (1.0f / 384.f) + 1e-6f);
            if (lane < 48) {
#pragma unroll
                for (int i = 0; i < 8; ++i) x[i] = x[i] * rs * qnw[lane * 8 + i];
                *(v4u*)(CQN + (size_t)r * 384 + lane * 8) = pack8(x); }
        }
        {
            float x[8]; float ss = 0.f;
            if (lane < 32) { unpack8(ld8(Pr + C_CKV + lane * 8), x);
#pragma unroll
                for (int i = 0; i < 8; ++i) ss += x[i] * x[i]; }
            const float rs = rsqrtf(wave_sum(ss) * (1.0f / 256.f) + 1e-6f);
            if (lane < 32) {
#pragma unroll
                for (int i = 0; i < 8; ++i) x[i] = x[i] * rs * kvnw[lane * 8 + i];
                *(v4u*)(CKVN + (size_t)r * 256 + lane * 8) = pack8(x); }
        }
        if (lane < 32) { const int hh = lane >> 3, part = lane & 7; *(v4u*)(KMLA + (size_t)r * 768 + hh * 192 + 128 + part * 8) = ld8(Pr + C_KR + part * 8); }
    }
}
__device__ __forceinline__ int ssd_rowbase(int ci) { return ci < 2 ? SEQ + 128 * ci : 128 * (ci - 2); }
__device__ __forceinline__ void ssd_cum(const float* DT, const float* alog, int rb, int h, int d, int lane, float& a0, float& a1, float& ac0, float& ac1, float& total, float& dt0, float& dt1) {
    dt0 = DT[(size_t)(rb + 2 * lane) * 16 + d * 8 + h]; dt1 = DT[(size_t)(rb + 2 * lane + 1) * 16 + d * 8 + h];
    const float A = -__expf(alog[d * 8 + h]);
    a0 = dt0 * A; a1 = dt1 * A;
    const float pair = a0 + a1; float incl = pair;
#pragma unroll
    for (int o = 1; o < 64; o <<= 1) { const float t = __shfl_up(incl, o); if (lane >= o) incl += t; }
    const float excl = incl - pair;
    ac0 = excl + a0; ac1 = incl; total = __shfl(incl, 63);
}
constexpr int LP = 136;
__device__ __forceinline__ void phase_ssd1(Frame& F, int l) {
    const bf16_t* XBC = WSP(bf16_t, WS_XBC); const float* DT = WSP(float, WS_DT); float* S = WSP(float, WS_S); float* ATOT = WSP(float, WS_ATOT);
    const float* alog = INP(13) + l * 16;
    char* lds = F.ldsg;
    bf16_t* BT = (bf16_t*)lds; bf16_t* XT = (bf16_t*)(lds + 34816); float* WG = (float*)(lds + 69632);
    const int tid = F.tid, lane = F.lane, w = F.wave;
    for (int u = (F.G - 1 - F.bid); u < 132; u += F.G) {
        const int ci = u >> 1, g = u & 1, rb = ssd_rowbase(ci);
        {
            const int ll = tid >> 2, n0 = (tid & 3) * 32;
#pragma unroll
            for (int q = 0; q < 4; ++q) { const v4u v = ld8(XBC + (size_t)(rb + ll) * 1024 + 512 + g * 128 + n0 + 8 * q);
#pragma unroll
                for (int i = 0; i < 4; ++i) { BT[(n0 + 8 * q + 2 * i) * LP + ll] = (bf16_t)(v[i] & 0xffffu); BT[(n0 + 8 * q + 2 * i + 1) * LP + ll] = (bf16_t)(v[i] >> 16); } }
        }
        {
            const int hh = w >> 1, d = w & 1, h = g * 4 + hh; float a0, a1, ac0, ac1, total, dt0, dt1;
            ssd_cum(DT, alog, rb, h, d, lane, a0, a1, ac0, ac1, total, dt0, dt1);
            float e0, e1;
            if (d == 0) { e0 = __expf(total - ac0); e1 = __expf(total - ac1); } else { e0 = __expf(ac0 - a0); e1 = __expf(ac1 - a1); }
            WG[w * 128 + 2 * lane] = e0 * dt0; WG[w * 128 + 2 * lane + 1] = e1 * dt1;
            if (lane == 0) ATOT[(ci * 8 + h) * 2 + d] = total;
        }
        __syncthreads();
        for (int hh = 0; hh < 4; ++hh) {
            const int h = g * 4 + hh;
            {
                const int ll = tid >> 2, p0 = (tid & 3) * 16; const float w0 = WG[(hh * 2) * 128 + ll], w1 = WG[(hh * 2 + 1) * 128 + ll];
#pragma unroll
                for (int q = 0; q < 2; ++q) { float x[8]; unpack8(ld8(XBC + (size_t)(rb + ll) * 1024 + h * 64 + p0 + 8 * q), x);
#pragma unroll
                    for (int i = 0; i < 8; ++i) { XT[(p0 + 8 * q + i) * LP + ll] = (bf16_t)f2bf(x[i] * w0); XT[(64 + p0 + 8 * q + i) * LP + ll] = (bf16_t)f2bf(x[i] * w1); } }
            }
            __syncthreads();
            const int pt = w & 3, nh = w >> 2;
#pragma unroll
            for (int d = 0; d < 2; ++d) {
                f32x4 acc[4];
#pragma unroll
                for (int nt = 0; nt < 4; ++nt) acc[nt] = (f32x4){0.f, 0.f, 0.f, 0.f};
#pragma unroll
                for (int ks = 0; ks < 4; ++ks) {
                    const bf16x8 a = *(const bf16x8*)(XT + (d * 64 + pt * 16 + (lane & 15)) * LP + ks * 32 + (lane >> 4) * 8);
#pragma unroll
                    for (int nt = 0; nt < 4; ++nt) { const bf16x8 b = *(const bf16x8*)(BT + ((nh * 4 + nt) * 16 + (lane & 15)) * LP + ks * 32 + (lane >> 4) * 8);
                        acc[nt] = __builtin_amdgcn_mfma_f32_16x16x32_bf16(a, b, acc[nt], 0, 0, 0); }
                }
                float* Sp = S + (size_t)((ci * 8 + h) * 2 + d) * 8192;
#pragma unroll
                for (int nt = 0; nt < 4; ++nt)
#pragma unroll
                    for (int j = 0; j < 4; ++j) Sp[(pt * 16 + (lane >> 4) * 4 + j) * 128 + (nh * 4 + nt) * 16 + (lane & 15)] = acc[nt][j];
            }
            __syncthreads();
        }
    }
}
__device__ __forceinline__ void ssd_scan_unit(Frame& F, int su) {
    const float* S = WSP(float, WS_S); const float* ATOT = WSP(float, WS_ATOT); bf16_t* Rb = WSP(bf16_t, WS_R);
    const int hd = su >> 2, h = hd >> 1, d = hd & 1, e = (su & 3) * 2048 + F.tid * 4;
    f32x4 R = {0.f, 0.f, 0.f, 0.f};
#pragma unroll 4
    for (int step = 0; step < 66; ++step) {
        const int ci = (d == 0) ? step : (step == 0 ? 1 : (step == 1 ? 0 : 67 - step));
        const size_t base = (size_t)((ci * 8 + h) * 2 + d);
        v2u wv; wv.x = pk2(R[0], R[1]); wv.y = pk2(R[2], R[3]); *(v2u*)(Rb + base * 8192 + e) = wv;
        const float dec = __expf(ATOT[base]); const f32x4 sv = *(const f32x4*)(S + base * 8192 + e);
        R = R * dec + sv;
    }
}
__device__ __forceinline__ void phase_ssd2(Frame& F, int l, int ci_first) {
    const bf16_t* XBC = WSP(bf16_t, WS_XBC); const bf16_t* P = WSP(bf16_t, WS_P); const float* DT = WSP(float, WS_DT); const bf16_t* Rb = WSP(bf16_t, WS_R); bf16_t* CAT = WSP(bf16_t, WS_CAT);
    const float* alog = INP(13) + l * 16; const float* dskip = INP(14) + l * 8; const float* normw = INP(15) + l * 512;
    char* lds = F.ldsg;
    bf16_t* CL = (bf16_t*)lds; bf16_t* BL = (bf16_t*)(lds + 34816); bf16_t* XT = (bf16_t*)(lds + 34816); bf16_t* RL = (bf16_t*)(lds + 52224);
    const int tid = F.tid, lane = F.lane, w = F.wave;
    bf16_t* PW = (bf16_t*)(lds + 69632 + w * 4352); bf16_t* CW = (bf16_t*)(lds + 104448 + w * 4352); float* CUM = (float*)(lds + 139264); float* DTV = (float*)(lds + 143360);
    const int nunits = (66 - ci_first) * 2;
    for (int u = (F.G - 1 - F.bid); u < nunits; u += F.G) {
        const int ci = ci_first + (u >> 1), g = u & 1, rb = ssd_rowbase(ci);
        {
            const int row = tid >> 2, c0 = (tid & 3) * 32;
#pragma unroll
            for (int q = 0; q < 4; ++q) { *(v4u*)(CL + row * LP + c0 + 8 * q) = ld8(XBC + (size_t)(rb + row) * 1024 + 768 + g * 128 + c0 + 8 * q);
                *(v4u*)(BL + row * LP + c0 + 8 * q) = ld8(XBC + (size_t)(rb + row) * 1024 + 512 + g * 128 + c0 + 8 * q); }
        }
        {
            const int hh = w >> 1, d = w & 1, h = g * 4 + hh; float a0, a1, ac0, ac1, total, dt0, dt1;
            ssd_cum(DT, alog, rb, h, d, lane, a0, a1, ac0, ac1, total, dt0, dt1);
            float c0v, c1v;
            if (d == 0) { c0v = ac0; c1v = ac1; } else { c0v = total - (ac0 - a0); c1v = total - (ac1 - a1); }
            CUM[w * 128 + 2 * lane] = c0v; CUM[w * 128 + 2 * lane + 1] = c1v; DTV[w * 128 + 2 * lane] = dt0; DTV[w * 128 + 2 * lane + 1] = dt1;
        }
        __syncthreads();
        f32x4 gacc[8];
#pragma unroll
        for (int nt = 0; nt < 8; ++nt) gacc[nt] = (f32x4){0.f, 0.f, 0.f, 0.f};
#pragma unroll
        for (int ks = 0; ks < 4; ++ks) {
            const bf16x8 a = *(const bf16x8*)(CL + (16 * w + (lane & 15)) * LP + ks * 32 + (lane >> 4) * 8);
#pragma unroll
            for (int nt = 0; nt < 8; ++nt) { const bf16x8 b = *(const bf16x8*)(BL + (nt * 16 + (lane & 15)) * LP + ks * 32 + (lane >> 4) * 8);
                gacc[nt] = __builtin_amdgcn_mfma_f32_16x16x32_bf16(a, b, gacc[nt], 0, 0, 0); }
        }
        __syncthreads();
        f32x4 yacc[4][4];
#pragma unroll
        for (int a = 0; a < 4; ++a)
#pragma unroll
            for (int b = 0; b < 4; ++b) yacc[a][b] = (f32x4){0.f, 0.f, 0.f, 0.f};
#pragma unroll
        for (int hh = 0; hh < 4; ++hh) {
            const int h = g * 4 + hh;
#pragma unroll
            for (int d = 0; d < 2; ++d) {
                const int idx = hh * 2 + d;
                {
                    const int s = tid >> 2, p0 = (tid & 3) * 16; const float dtv = DTV[idx * 128 + s];
#pragma unroll
                    for (int q = 0; q < 2; ++q) { float x[8]; unpack8(ld8(XBC + (size_t)(rb + s) * 1024 + h * 64 + p0 + 8 * q), x);
#pragma unroll
                        for (int i = 0; i < 8; ++i) XT[(p0 + 8 * q + i) * LP + s] = (bf16_t)f2bf(x[i] * dtv); }
                }
                {
                    const int p = tid >> 3, n0 = (tid & 7) * 16; const bf16_t* src = Rb + (size_t)((ci * 8 + h) * 2 + d) * 8192 + p * 128 + n0;
                    *(v4u*)(RL + p * LP + n0) = ld8(src); *(v4u*)(RL + p * LP + n0 + 8) = ld8(src + 8);
                }
                {
#pragma unroll
                    for (int nt = 0; nt < 8; ++nt)
#pragma unroll
                        for (int j = 0; j < 4; ++j) { const int lrow = (lane >> 4) * 4 + j, lt = 16 * w + lrow, s = nt * 16 + (lane & 15);
                            const float e = CUM[idx * 128 + lt] - CUM[idx * 128 + s]; const bool ok = (d == 0) ? (s <= lt) : (s >= lt);
                            const float pv = ok ? gacc[nt][j] * __expf(e) : 0.f; PW[lrow * LP + s] = (bf16_t)f2bf(pv); }
                }
                {
                    const int rr = lane >> 2, c0 = (lane & 3) * 32; const float ex = __expf(CUM[idx * 128 + 16 * w + rr]);
#pragma unroll
                    for (int q = 0; q < 4; ++q) { float x[8]; unpack8(*(const v4u*)(CL + (16 * w + rr) * LP + c0 + 8 * q), x);
#pragma unroll
                        for (int i = 0; i < 8; ++i) x[i] *= ex;
                        *(v4u*)(CW + rr * LP + c0 + 8 * q) = pack8(x); }
                }
                __syncthreads();
#pragma unroll
                for (int ks = 0; ks < 4; ++ks) {
                    const bf16x8 ap = *(const bf16x8*)(PW + (lane & 15) * LP + ks * 32 + (lane >> 4) * 8);
                    const bf16x8 ac = *(const bf16x8*)(CW + (lane & 15) * LP + ks * 32 + (lane >> 4) * 8);
#pragma unroll
                    for (int pt = 0; pt < 4; ++pt) {
                        const bf16x8 bx = *(const bf16x8*)(XT + (pt * 16 + (lane & 15)) * LP + ks * 32 + (lane >> 4) * 8);
                        const bf16x8 br = *(const bf16x8*)(RL + (pt * 16 + (lane & 15)) * LP + ks * 32 + (lane >> 4) * 8);
                        yacc[hh][pt] = __builtin_amdgcn_mfma_f32_16x16x32_bf16(ap, bx, yacc[hh][pt], 0, 0, 0);
                        yacc[hh][pt] = __builtin_amdgcn_mfma_f32_16x16x32_bf16(ac, br, yacc[hh][pt], 0, 0, 0);
                    }
                }
                __syncthreads();
            }
        }
#pragma unroll
        for (int j = 0; j < 4; ++j) {
            const int row = rb + 16 * w + (lane >> 4) * 4 + j; float ssq = 0.f;
#pragma unroll
            for (int hh = 0; hh < 4; ++hh)
#pragma unroll
                for (int pt = 0; pt < 4; ++pt) { const int ch = hh * 64 + pt * 16 + (lane & 15);
                    const float xs = bf2f(XBC[(size_t)row * 1024 + g * 256 + ch]), z = bf2f(P[(size_t)row * INW + C_Z + g * 256 + ch]);
                    const float y = yacc[hh][pt][j] + xs * dskip[g * 4 + hh]; const float gv = y * siluf(z); yacc[hh][pt][j] = gv; ssq += gv * gv; }
            ssq += __shfl_xor(ssq, 1); ssq += __shfl_xor(ssq, 2); ssq += __shfl_xor(ssq, 4); ssq += __shfl_xor(ssq, 8);
            const float rs = rsqrtf(ssq * (1.0f / 256.f) + 1e-6f);
#pragma unroll
            for (int hh = 0; hh < 4; ++hh)
#pragma unroll
                for (int pt = 0; pt < 4; ++pt) { const int ch = hh * 64 + pt * 16 + (lane & 15);
                    CAT[(size_t)row * DM + 1024 + g * 256 + ch] = (bf16_t)f2bf(yacc[hh][pt][j] * rs * normw[g * 256 + ch]); }
        }
        __syncthreads();
    }
}
__device__ __forceinline__ void phase_diffcombine(Frame& F, int l, int nrows) {
    const float* OD = WSP(float, WS_ODIFF); bf16_t* CAT = WSP(bf16_t, WS_CAT);
    const float* lp = INP(8) + l * 256; const float* sub = INP(9) + l * 128;
    const int lane = F.lane;
    const float s1 = wave_sum(lp[lane] * lp[64 + lane]), s2 = wave_sum(lp[128 + lane] * lp[192 + lane]);
    int ll = l; asm volatile("" : "+s"(ll));
    const float lam_init = (ll == 0) ? 0.2f : 0.35550906759f;
    const float lam = __expf(s1) - __expf(s2) + lam_init;
    const int hh = lane >> 4, e0 = (lane & 15) * 8;
    float sw[8];
#pragma unroll
    for (int i = 0; i < 8; ++i) sw[i] = sub[e0 + i] * (1.0f - lam_init);
    for (int r = F.gw; r < nrows; r += F.NGW) {
        const float* o1 = OD + (size_t)r * 1024 + (hh * 2) * 128 + e0; const float* o2 = o1 + 128;
        const f32x4 a0 = *(const f32x4*)o1, a1 = *(const f32x4*)(o1 + 4), b0 = *(const f32x4*)o2, b1 = *(const f32x4*)(o2 + 4);
        float o[8]; float ss = 0.f;
#pragma unroll
        for (int i = 0; i < 4; ++i) { o[i] = a0[i] - lam * b0[i]; o[4 + i] = a1[i] - lam * b1[i]; }
#pragma unroll
        for (int i = 0; i < 8; ++i) ss += o[i] * o[i];
        ss += __shfl_xor(ss, 1); ss += __shfl_xor(ss, 2); ss += __shfl_xor(ss, 4); ss += __shfl_xor(ss, 8);
        const float rs = rsqrtf(ss * (1.0f / 128.f) + 1e-6f);
#pragma unroll
        for (int i = 0; i < 8; ++i) o[i] = o[i] * rs * sw[i];
        *(v4u*)(CAT + (size_t)r * DM + 512 + hh * 128 + e0) = pack8(o);
    }
}
__device__ __forceinline__ void phase_attn(Frame& F, int l, int rep) {
    unsigned* ctr = WSP(unsigned, WS_CTL) + 64 * (1 + l + 2 * rep);
    LAS unsigned* bc = (LAS unsigned*)(F.lds + LDS_BYTES - 64);
    const bf16_t* P = WSP(bf16_t, WS_P); const bf16_t* QM = WSP(bf16_t, WS_QMLA); const bf16_t* KM = WSP(bf16_t, WS_KMLA); const bf16_t* VM = WSP(bf16_t, WS_VMLA);
    float* OD = WSP(float, WS_ODIFF); bf16_t* CAT = WSP(bf16_t, WS_CAT);
    const int n_scan = 64, n_mla = 128, n_diff = 256, n_cm = (l == 0) ? 4 : 0, n_cd = (l == 0) ? 8 : 0;
    const int n_tr = (l == 0) ? DT_UNITS : 0;
    const int total = n_scan + n_mla + n_diff + n_cm + n_cd + n_tr;
#ifndef PROBE_FILT
#define PROBE_FILT 7
#endif
    const int filt = rep ? PROBE_FILT : 7;
    for (;;) {
        __syncthreads();
        if (F.tid == 0) bc[0] = atomicAdd(ctr, 1u);
        __syncthreads();
        int u = (int)bc[0];
        if (u >= total) break;
        if (u < n_mla) { if (!(filt & 2)) continue; const int h = u >> 5, qb = u & 31; const size_t q0 = (size_t)qb * 256;
            att::attn_dense_body<192, true, 768, 768, 512, DM>(QM + q0 * 768 + h * 192, KM + h * 192, VM + h * 128, nullptr, CAT + q0 * DM + 1536 + h * 128, MROWS, F.ldsg); continue; }
        u -= n_mla;
        if (u < n_diff) { if (!(filt & 4)) continue; const int mi = u >> 5, qb = u & 31; const size_t q0 = (size_t)qb * 256;
            att::attn_dense_body<64, false, INW, INW, INW, 1024>(P + q0 * INW + C_DQ + mi * 64, P + C_DK + mi * 64, P + C_DV + (mi >> 1) * 128, OD + q0 * 1024 + mi * 128, nullptr, MROWS, F.ldsg); continue; }
        u -= n_diff;
        if (u < n_scan) { if (filt & 1) ssd_scan_unit(F, u); continue; }
        u -= n_scan;
        if (u < n_cm) { if (!(filt & 2)) continue; const int h = u; const size_t q0 = SEQ;
            att::attn_dense_body<192, true, 768, 768, 512, DM>(QM + q0 * 768 + h * 192, KM + q0 * 768 + h * 192, VM + q0 * 512 + h * 128, nullptr, CAT + q0 * DM + 1536 + h * 128, NCTX, F.ldsg); continue; }
        u -= n_cm;
        if (u >= n_cd) { if (rep == 0) deferred_transpose_unit(F, u - n_cd); continue; }
        if (filt & 4) { const int mi = u; const size_t q0 = SEQ;
            att::attn_dense_body<64, false, INW, INW, INW, 1024>(P + q0 * INW + C_DQ + mi * 64, P + q0 * INW + C_DK + mi * 64, P + q0 * INW + C_DV + (mi >> 1) * 128, OD + q0 * 1024 + mi * 128, nullptr, NCTX, F.ldsg); }
    }
}

typedef __attribute__((address_space(1))) unsigned gu32;
#define XB_TMO      128
#define XB_XCNT(j)  (256  + 64 * (j))
#define XB_XSUB(j)  (1280 + 64 * (j))
#define XB_XGEN(j)  (2304 + 64 * (j))
#define XB_TOP      3328
#define XB_TOPGEN   3392
#define XCD_BAR_WORDS 3456
#define XB_SPIN_CAP (1u << 18)

__device__ __forceinline__ unsigned xb_ld(unsigned* p)              { return __hip_atomic_load(p, __ATOMIC_RELAXED, __HIP_MEMORY_SCOPE_AGENT); }
__device__ __forceinline__ unsigned xb_add(unsigned* p, unsigned v) { return __hip_atomic_fetch_add(p, v, __ATOMIC_RELAXED, __HIP_MEMORY_SCOPE_AGENT); }
__device__ __forceinline__ unsigned xb_xcc_id() { return (unsigned)__builtin_amdgcn_s_getreg((3 << 11) | 20) & 0xFu; }
#define XB_SPIN(cond, bar) do { unsigned _sp = 0; while (cond) { __builtin_amdgcn_s_sleep(1); \
    if ((++_sp & 255u) == 0u) { if (xb_ld(&(bar)[XB_TMO])) break; if (_sp > XB_SPIN_CAP) { atomicAdd(&(bar)[XB_TMO], 1u); break; } } } } while (0)

struct XcdBarrier {
    unsigned* bar; unsigned x;
    volatile LAS unsigned* st;
};

__device__ __forceinline__ XcdBarrier xcd_barrier_post(unsigned* bar, volatile LAS unsigned* st) {
    XcdBarrier b; b.bar = bar; b.x = xb_xcc_id(); b.st = st;
    if (threadIdx.x == 0) (void)xb_add(&bar[XB_XCNT(b.x)], 1u);
    return b;
}
__device__ __forceinline__ void xcd_barrier_complete(unsigned* bar, unsigned x, unsigned& nloc, unsigned& nx) {
    const unsigned G = gridDim.x * gridDim.y * gridDim.z;
    unsigned sum, cnt, mine, sp = 0u;
    for (;;) {
        sum = 0u; cnt = 0u; mine = 0u;
#pragma unroll
        for (unsigned j = 0; j < 16; ++j) { const unsigned c = xb_ld(&bar[XB_XCNT(j)]); sum += c; cnt += (c > 0u) ? 1u : 0u; mine = (j == x) ? c : mine; }
        if (sum == G) break;
        __builtin_amdgcn_s_sleep(1);
        if ((++sp & 255u) == 0u) { if (xb_ld(&bar[XB_TMO])) break; if (sp > XB_SPIN_CAP) { atomicAdd(&bar[XB_TMO], 1u); break; } }
    }
    nloc = mine > 0u ? mine : 1u; nx = cnt > 0u ? cnt : 1u;
}

__device__ __forceinline__ void xcd_barrier(const XcdBarrier& b) {
    asm volatile("s_waitcnt vmcnt(0)" ::: "memory");
    __syncthreads();
    if (threadIdx.x == 0) {
        unsigned* bar = b.bar;
        __builtin_amdgcn_s_waitcnt(0);
        unsigned bx_ = b.x; asm volatile("" : "+s"(bx_));
        unsigned nloc = b.st[0], nx = b.st[1];
        if (nloc == 0u) { xcd_barrier_complete(bar, bx_, nloc, nx); b.st[0] = nloc; b.st[1] = nx; }
        const unsigned old = xb_add(&bar[XB_XSUB(bx_)], 1u);
        const unsigned gen = old / nloc;
        if (old + 1u == (gen + 1u) * nloc) {
            __builtin_amdgcn_fence(__ATOMIC_RELEASE, "agent");
            asm volatile("s_waitcnt vmcnt(0)" ::: "memory");
            const unsigned og = xb_add(&bar[XB_TOP], 1u);
            const unsigned tg = og / nx;
            if (og + 1u == (tg + 1u) * nx) xb_add(&bar[XB_TOPGEN], 1u);
            else XB_SPIN(xb_ld(&bar[XB_TOPGEN]) == tg, bar);
            __builtin_amdgcn_fence(__ATOMIC_ACQUIRE, "agent");
            xb_add(&bar[XB_XGEN(bx_)], 1u);
            asm volatile("s_waitcnt vmcnt(0)" ::: "memory");
        } else {
            XB_SPIN(xb_ld(&bar[XB_XGEN(bx_)]) == gen, bar);
            __builtin_amdgcn_fence(__ATOMIC_ACQUIRE, "agent");
            asm volatile("s_waitcnt vmcnt(0)" ::: "memory");
        }
    }
    __syncthreads();
}


__global__ void __launch_bounds__(NTHR, 2) mk_fwd(Args args) {
    extern __shared__ __attribute__((aligned(16))) unsigned char lds_raw[];
    Frame F;
    F.lds = (LAS unsigned char*)lds_raw; F.ldsg = (char*)lds_raw;
    const int lo = args.ph_lo, hi = args.ph_hi;
    volatile LAS unsigned* bst = (volatile LAS unsigned*)((LAS unsigned char*)lds_raw + (LDS_BYTES - 32));
    if (threadIdx.x == 0) { bst[0] = 0u; bst[1] = 0u; }
    __syncthreads();
    XcdBarrier xbar = xcd_barrier_post((unsigned*)args.ws + 1024, bst);
    int nseam = 0;
    for (int ph = lo; ph < hi; ++ph) {
      int nrep = 1;
      if (PROBE_MASK) { const int sp_ = ph < 3 ? -1 : (ph - 3) % 10;
          const int ty = ph < 3 ? ph : (sp_ == 0 ? 3 : sp_ == 1 ? 4 : sp_ == 2 ? 5 : sp_ == 3 ? 7 : sp_ == 4 ? 10 : sp_ == 5 ? 12 : sp_ == 6 ? 13 : sp_ == 7 ? 14 : sp_ == 8 ? 15 : 13);
          if (PRB(ty)) nrep = 2; }
      for (int rep = 0; rep < nrep; ++rep) {
        if (ph > lo || rep > 0) { if (nseam == 0) cg::this_grid().sync(); else xcd_barrier(xbar); ++nseam; }
        { const __attribute__((address_space(4))) char* ka = (const __attribute__((address_space(4))) char*)__builtin_amdgcn_kernarg_segment_ptr(); asm volatile("" : "+s"(ka)); F.ka = ka;
          F.out = *(float* const __attribute__((address_space(4)))*)(ka + 216); F.ws = *(unsigned char* const __attribute__((address_space(4)))*)(ka + 224); }
        F.tid = ltid(); F.lane = F.tid & 63; F.wave = __builtin_amdgcn_readfirstlane(F.tid >> 6);
        F.bid = lbid(); F.G = gridDim.x; F.gw = F.bid * NWAVES + F.wave; F.NGW = F.G * NWAVES;
        if (ph == 0) { if (PHON(0)) phase_prologue(F); continue; }
        if (ph == 1) { if (PHON(1)) phase_modfinal(F); continue; }
        if (ph == 2) { if (PHON(2)) phase_copy_mod(F); continue; }
        const int l = (ph - 3) / 10, sp = (ph - 3) % 10;
        const bool last = (l == 1);
        int Kq = 384, Kkv = 256; asm volatile("" : "+s"(Kq), "+s"(Kkv));
        const int Mact = last ? SEQ : MROWS;
        unsigned char* wb = F.ws + WS_W0 + (size_t)l * W_LAYER;
        if (sp == 0) { if (PHON(3)) {
            pg8::Gemm g{WSP(const bf16_t, WS_H), (const bf16_t*)(wb + WO_IN), MROWS, INW, DM, DM}; pg8::StaticOrder S; S.init(MROWS, INW, F.G, F.bid);
            pg8::EpiBf16R<0> E{WSP(bf16_t, WS_P), nullptr, WSP(const pg8::f32x2, WS_ROPE)};
            pg8::gemm_phase<pg8::EpiBf16R<0>, pg8::StaticOrder, true, true>(F.lds, g, S, E); }
        } else if (sp == 1) {
            if (PHON(4)) phase_prep(F, l);
        } else if (sp == 2) {
            if (PHON(5)) { pg8::Gemm g{WSP(const bf16_t, WS_CQN), (const bf16_t*)(wb + WO_Q), Mact, 768, Kq, Kq}; pg8::StaticOrder S; S.init(Mact, 768, F.G, F.bid);
              pg8::EpiBf16R<1> E{WSP(bf16_t, WS_QMLA), nullptr, WSP(const pg8::f32x2, WS_ROPE)};
              pg8::gemm_phase<pg8::EpiBf16R<1>, pg8::StaticOrder, true, true>(F.lds, g, S, E); }
            __syncthreads();
            if (PHON(16)) { pg8::Gemm g{WSP(const bf16_t, WS_CKVN), (const bf16_t*)(wb + WO_KV), MROWS, 1024, Kkv, Kkv}; pg8::StaticOrder S; S.init(MROWS, 1024, F.G, F.bid);
              pg8::EpiBf16R<2> E{WSP(bf16_t, WS_KMLA), WSP(bf16_t, WS_VMLA), nullptr};
              pg8::gemm_phase<pg8::EpiBf16R<2>, pg8::StaticOrder, true, true>(F.lds, g, S, E); }
            __syncthreads();
            if (PHON(6)) phase_ssd1(F, l);
        } else if (sp == 3) {
            phase_attn(F, l, rep);
        } else if (sp == 4) {
            if (PHON(10)) phase_ssd2(F, l, last ? 2 : 0);
            if (PHON(11)) phase_diffcombine(F, l, Mact);
        } else if (sp == 5) { if (PHON(12)) {
            pg8::Gemm g{WSP(const bf16_t, WS_CAT), (const bf16_t*)(wb + WO_OUT), SEQ, DM, DM, DM}; pg8::StaticOrder S; S.init(SEQ, DM, F.G, F.bid);
            pg8::EpiResid E{WSP(const float, WS_XA), WSP(float, WS_PRE), modvec(F, l, 0, 2), modvec(F, l, 1, 2)};
            pg8::gemm_phase<pg8::EpiResid, pg8::StaticOrder, true, true>(F.lds, g, S, E);
            if (!last) {
                __syncthreads();
                int kc = 256; asm volatile("" : "+s"(kc));
                pg8::Gemm g2{WSP(const bf16_t, WS_CAT) + (size_t)SEQ * DM, (const bf16_t*)(wb + WO_OUT), 256, DM, kc, DM}; pg8::SplitKOrder S2; S2.init(DM, 8, 256, F.G, (F.bid + 128) % F.G);
                pg8::EpiPart E2{WSP(float, WS_PART)};
                pg8::gemm_phase<pg8::EpiPart, pg8::SplitKOrder, true, true>(F.lds, g2, S2, E2);
            } }
        } else if (sp == 6) {
            if (PHON(13)) phase_ln<8>(F, !last, WSP(const float, WS_PRE), INP(21) + l * DM, INP(22) + l * DM, WSP(float, WS_X1), l, 3, 4, true, WSP(const float, WS_XA), modvec(F, l, 1, 2));
        } else if (sp == 7) { if (PHON(14)) {
            pg8::Gemm g{WSP(const bf16_t, WS_H), (const bf16_t*)(wb + WO_F1), Mact, 2 * DFF, DM, DM}; pg8::StaticOrder S; S.init(Mact, 2 * DFF, F.G, F.bid);
            pg8::EpiSwiglu E{WSP(bf16_t, WS_ACT)};
            pg8::gemm_phase<pg8::EpiSwiglu, pg8::StaticOrder, true, true>(F.lds, g, S, E); }
        } else if (sp == 8) { if (PHON(15)) {
            pg8::Gemm g{WSP(const bf16_t, WS_ACT), (const bf16_t*)(wb + WO_F2), SEQ, DM, DFF, DFF}; pg8::StaticOrder S; S.init(SEQ, DM, F.G, F.bid);
            pg8::EpiResid E{WSP(const float, WS_X1), WSP(float, WS_PRE), modvec(F, l, 0, 5), modvec(F, l, 1, 5)};
            pg8::gemm_phase<pg8::EpiResid, pg8::StaticOrder, true, true>(F.lds, g, S, E);
            if (!last) {
                __syncthreads();
                int kc = 512; asm volatile("" : "+s"(kc));
                pg8::Gemm g2{WSP(const bf16_t, WS_ACT) + (size_t)SEQ * DFF, (const bf16_t*)(wb + WO_F2), 256, DM, kc, DFF}; pg8::SplitKOrder S2; S2.init(DM, 11, 512, F.G, (F.bid + 128) % F.G);
                pg8::EpiPart E2{WSP(float, WS_PART)};
                pg8::gemm_phase<pg8::EpiPart, pg8::SplitKOrder, true, true>(F.lds, g2, S2, E2);
            } }
        } else if (PHON(13)) {
            if (!last) phase_ln<11>(F, true, WSP(const float, WS_PRE), INP(25) + l * DM, INP(26) + l * DM, WSP(float, WS_XA), l + 1, 0, 1, true, WSP(const float, WS_X1), modvec(F, l, 1, 5));
            else       phase_ln<1>(F, false, WSP(const float, WS_PRE), INP(25) + l * DM, INP(26) + l * DM, F.out, 0, 0, 1, false, nullptr, nullptr);
        }
      }
    }
}

extern "C" void kernel_launch(void* const* d_in, const int* in_sizes, int n_in, void* d_out, int out_size, void* d_ws, size_t ws_size, hipStream_t stream) {
    static int grid = 0;
    if (grid == 0) {
        if (n_in != 27 || in_sizes[0] != SEQ * DM || out_size != SEQ * DM || ws_size < WS_END) {
            fprintf(stderr, "kernel_launch: unexpected shapes: n_in %d in0 %d out %d ws %zu (need >= %zu)\n", n_in, n_in > 0 ? in_sizes[0] : -1, out_size, ws_size, (size_t)WS_END); grid = -1; return; }
        int dev = 0, cus = 0, per_cu = 0;
        if (hipGetDevice(&dev) != hipSuccess || hipDeviceGetAttribute(&cus, hipDeviceAttributeMultiprocessorCount, dev) != hipSuccess) { grid = -1; return; }
        if (hipFuncSetAttribute((const void*)mk_fwd, hipFuncAttributeMaxDynamicSharedMemorySize, LDS_BYTES) != hipSuccess) { fprintf(stderr, "kernel_launch: hipFuncSetAttribute failed\n"); grid = -1; return; }
        if (hipOccupancyMaxActiveBlocksPerMultiprocessor(&per_cu, (const void*)mk_fwd, NTHR, LDS_BYTES) != hipSuccess || per_cu < 1) { fprintf(stderr, "kernel_launch: occupancy query gave %d\n", per_cu); per_cu = 1; }
        (void)hipGetLastError();
        grid = cus * 1;
    }
    if (grid < 0) return;
    (void)hipMemsetAsync((char*)d_ws + WS_CTL, 0, CTL_BYTES, stream);
    Args a{};
    for (int i = 0; i < 27; ++i) a.in[i] = (const float*)d_in[i];
    a.out = (float*)d_out; a.ws = (unsigned char*)d_ws;
#if MK_ONE_LAUNCH
    a.ph_lo = 0; a.ph_hi = NPH;
    void* kargs[] = {&a};
    hipError_t e = hipLaunchCooperativeKernel((const void*)mk_fwd, dim3(grid), dim3(NTHR), kargs, LDS_BYTES, stream);
    if (e != hipSuccess) fprintf(stderr, "kernel_launch: cooperative launch failed: %s (grid %d)\n", hipGetErrorString(e), grid);
#else
    for (int ph = 0; ph < NPH; ++ph) { a.ph_lo = ph; a.ph_hi = ph + 1; hipLaunchKernelGGL(mk_fwd, dim3(grid), dim3(NTHR), LDS_BYTES, stream, a); }
    const hipError_t le = hipPeekAtLastError();
    if (le != hipSuccess) fprintf(stderr, "kernel_launch: launch failed: %s\n", hipGetErrorName(le));
#endif
}
```

```cpp
#include <hip/hip_runtime.h>
#include <hip/hip_cooperative_groups.h>
#include <cstdio>
#include <cstdint>
namespace cg = cooperative_groups;

#ifndef MK_ONE_LAUNCH
#define MK_ONE_LAUNCH 1
#endif

constexpr int DM = 2048, SEQ = 8192, NCTX = 256, MROWS = SEQ + NCTX;
constexpr int INW = 5376;
constexpr int DFF = 5632;
constexpr int NPH = 23;
constexpr int C_BG = 0, C_CG = 512, C_U = 1024, C_DQ = 1536, C_DK = 2048, C_DV = 2560, C_Z = 3072, C_XBC = 3584, C_CQ = 4608, C_CKV = 4992, C_KR = 5248, C_DT = 5312;
constexpr float ALPHA_F = 1.4142135623730951f;

__device__ __forceinline__ int ltid() { int t = threadIdx.x; asm volatile("" : "+v"(t)); return t; }
__device__ __forceinline__ int lbid() { int b = blockIdx.x; asm volatile("" : "+s"(b)); return b; }

__device__ const float2 ROPE_TAB[2048] = {
  {1.000000000e+00f, 0.000000000e+00f}, {1.000000000e+00f, 0.000000000e+00f}, {1.000000000e+00f, 0.000000000e+00f}, {1.000000000e+00f, 0.000000000e+00f}, {1.000000000e+00f, 0.000000000e+00f}, {1.000000000e+00f, 0.000000000e+00f}, {1.000000000e+00f, 0.000000000e+00f}, {1.000000000e+00f, 0.000000000e+00f},
  {1.000000000e+00f, 0.000000000e+00f}, {1.000000000e+00f, 0.000000000e+00f}, {1.000000000e+00f, 0.000000000e+00f}, {1.000000000e+00f, 0.000000000e+00f}, {1.000000000e+00f, 0.000000000e+00f}, {1.000000000e+00f, 0.000000000e+00f}, {1.000000000e+00f, 0.000000000e+00f}, {1.000000000e+00f, 0.000000000e+00f},
  {5.403023059e-01f, 8.414709848e-01f}, {8.460091064e-01f, 5.331684460e-01f}, {9.504152809e-01f, 3.109835909e-01f}, {9.842302348e-01f, 1.768921847e-01f}, {9.950041651e-01f, 9.983341813e-02f}, {9.984192778e-01f, 5.620449919e-02f}, {9.995000417e-01f, 3.161750470e-02f}, {9.998418903e-01f, 1.778185709e-02f},
  {9.999500004e-01f, 9.999833111e-03f}, {9.999841887e-01f, 5.623383612e-03f}, {9.999950000e-01f, 3.162272359e-03f}, {9.999984189e-01f, 1.778278494e-03f}, {9.999995000e-01f, 9.999998808e-04f}, {9.999998419e-01f, 5.623412721e-04f}, {9.999999500e-01f, 3.162277519e-04f}, {9.999999842e-01f, 1.778279393e-04f},
  {-4.161468365e-01f, 9.092974268e-01f}, {4.314628163e-01f, 9.021307212e-01f}, {8.065784124e-01f, 5.911271138e-01f}, {9.374183100e-01f, 3.482052729e-01f}, {9.800665772e-01f, 1.986693337e-01f}, {9.936821085e-01f, 1.122313110e-01f}, {9.980006668e-01f, 6.320339453e-02f}, {9.993676111e-01f, 3.555809121e-02f},
  {9.998000067e-01f, 1.999866625e-02f}, {9.999367551e-01f, 1.124658940e-02f}, {9.999800001e-01f, 6.324513096e-03f}, {9.999936755e-01f, 3.556551364e-03f}, {9.999980000e-01f, 1.999998762e-03f}, {9.999993675e-01f, 1.124682366e-03f}, {9.999998000e-01f, 6.324554721e-04f}, {9.999999368e-01f, 3.556558729e-04f},
  {-9.899924966e-01f, 1.411200081e-01f}, {-1.159661631e-01f, 9.932531646e-01f}, {5.827536401e-01f, 8.126488756e-01f}, {8.610406595e-01f, 5.085361174e-01f}, {9.553364856e-01f, 2.955202180e-01f}, {9.858034692e-01f, 1.679033061e-01f}, {9.955033745e-01f, 9.472608625e-02f}, {9.985773124e-01f, 5.332308304e-02f},
  {9.995500338e-01f, 2.999549953e-02f}, {9.998577009e-01f, 1.686943954e-02f}, {9.999550003e-01f, 9.486690354e-03f}, {9.999857698e-01f, 5.334812988e-03f}, {9.999955000e-01f, 2.999995526e-03f}, {9.999985770e-01f, 1.687023105e-03f}, {9.999995500e-01f, 9.486831000e-04f}, {9.999998577e-01f, 5.334837808e-04f},
  {-6.536436209e-01f, -7.568024953e-01f}, {-6.276796763e-01f, 7.784717233e-01f}, {3.011374707e-01f, 9.535807379e-01f}, {7.575061759e-01f, 6.528279969e-01f}, {9.210609917e-01f, 3.894183478e-01f}, {9.748082657e-01f, 2.230444915e-01f}, {9.920106618e-01f, 1.261540598e-01f}, {9.974712443e-01f, 7.107120934e-02f},
  {9.992001067e-01f, 3.998933329e-02f}, {9.997470285e-01f, 2.249175622e-02f}, {9.999200011e-01f, 1.264877321e-02f}, {9.999747019e-01f, 7.113057742e-03f}, {9.999920000e-01f, 3.999989523e-03f}, {9.999974702e-01f, 2.249363310e-03f}, {9.999992000e-01f, 1.264910691e-03f}, {9.999997470e-01f, 7.113117008e-04f},
  {2.836621855e-01f, -9.589242747e-01f}, {-9.460792425e-01f, 3.239352821e-01f}, {-1.034233808e-02f, 9.999465166e-01f}, {6.300802992e-01f, 7.765299843e-01f}, {8.775825619e-01f, 4.794255386e-01f}, {9.607312596e-01f, 2.774805341e-01f}, {9.875260225e-01f, 1.574558824e-01f}, {9.960497565e-01f, 8.879686156e-02f},
  {9.987502605e-01f, 4.997916629e-02f}, {9.996047413e-01f, 2.811336165e-02f}, {9.998750026e-01f, 1.581072865e-02f}, {9.999604718e-01f, 8.891280002e-03f}, {9.999875000e-01f, 4.999979521e-03f}, {9.999960472e-01f, 2.811702920e-03f}, {9.999987500e-01f, 1.581138156e-03f}, {9.999996047e-01f, 8.891395984e-04f},
  {9.601702867e-01f, -2.794154982e-01f}, {-9.731036980e-01f, -2.303675170e-01f}, {-3.207963899e-01f, 9.471481807e-01f}, {4.827820346e-01f, 8.757405478e-01f}, {8.253356014e-01f, 5.646424931e-01f}, {9.436169596e-01f, 3.310393232e-01f}, {9.820539372e-01f, 1.886002770e-01f}, {9.943132976e-01f, 1.064944419e-01f},
  {9.982005400e-01f, 5.996400514e-02f}, {9.994308440e-01f, 3.373407806e-02f}, {9.998200054e-01f, 1.897252691e-02f}, {9.999430795e-01f, 1.066947415e-02f}, {9.999820001e-01f, 5.999964052e-03f}, {9.999943079e-01f, 3.374041408e-03f}, {9.999982000e-01f, 1.897365346e-03f}, {9.999994308e-01f, 1.066967410e-03f},
  {7.539022543e-01f, 6.569865987e-01f}, {-7.004298139e-01f, -7.137212872e-01f}, {-5.994374526e-01f, 8.004216016e-01f}, {3.202570024e-01f, 9.473306986e-01f}, {7.648421950e-01f, 6.442176781e-01f}, {9.235194568e-01f, 3.835515778e-01f}, {9.755998794e-01f, 2.195560870e-01f}, {9.922624183e-01f, 1.241583392e-01f},
  {9.975510002e-01f, 6.994284763e-02f}, {9.992253421e-01f, 3.935372584e-02f}, {9.997550100e-01f, 2.213413545e-02f}, {9.999225252e-01f, 1.244763455e-02f}, {9.999755001e-01f, 6.999943050e-03f}, {9.999922524e-01f, 3.936378830e-03f}, {9.999975500e-01f, 2.213592463e-03f}, {9.999992252e-01f, 1.244795304e-03f},
  {-1.455000338e-01f, 9.893582466e-01f}, {-2.120364479e-01f, -9.772617586e-01f}, {-8.186324475e-01f, 5.743177830e-01f}, {1.476312130e-01f, 9.890424788e-01f}, {6.967067008e-01f, 7.173560992e-01f}, {9.005023096e-01f, 4.348512278e-01f}, {9.681703064e-01f, 2.502923447e-01f}, {9.898977664e-01f, 1.417829752e-01f},
  {9.968017064e-01f, 7.991469219e-02f}, {9.989882418e-01f, 4.497213288e-02f}, {9.996800171e-01f, 2.529552265e-02f}, {9.998988088e-01f, 1.422575559e-02f}, {9.999680002e-01f, 7.999915047e-03f}, {9.999898807e-01f, 4.498715239e-03f}, {9.999968000e-01f, 2.529819359e-03f}, {9.999989881e-01f, 1.422623042e-03f},
  {-9.111302619e-01f, 4.121184852e-01f}, {3.416602554e-01f, -9.398235313e-01f}, {-9.566441680e-01f, 2.912592245e-01f}, {-2.965079623e-02f, 9.995603185e-01f}, {6.216099403e-01f, 7.833269319e-01f}, {8.746382611e-01f, 4.847761465e-01f}, {9.597726443e-01f, 2.807783310e-01f}, {9.872200896e-01f, 1.593627767e-01f},
  {9.959527334e-01f, 8.987854534e-02f}, {9.987195508e-01f, 5.058911778e-02f}, {9.995950273e-01f, 2.845665689e-02f}, {9.998719305e-01f, 1.600383071e-02f}, {9.999595003e-01f, 8.999879044e-03f}, {9.999871928e-01f, 5.061050226e-03f}, {9.999959500e-01f, 2.846046001e-03f}, {9.999987193e-01f, 1.600450735e-03f},
  {-8.390715291e-01f, -5.440211109e-01f}, {7.901318660e-01f, -6.129368926e-01f}, {-9.997860721e-01f, -2.068356987e-02f}, {-2.059976331e-01f, 9.785524897e-01f}, {5.403023059e-01f, 8.414709848e-01f}, {8.460091064e-01f, 5.331684460e-01f}, {9.504152902e-01f, 3.109835626e-01f}, {9.842302348e-01f, 1.768921847e-01f},
  {9.950041659e-01f, 9.983341072e-02f}, {9.984192778e-01f, 5.620449919e-02f}, {9.995000417e-01f, 3.161750470e-02f}, {9.998418903e-01f, 1.778185709e-02f}, {9.999500004e-01f, 9.999834042e-03f}, {9.999841887e-01f, 5.623383612e-03f}, {9.999950000e-01f, 3.162272359e-03f}, {9.999984189e-01f, 1.778278494e-03f},
  {4.425697988e-03f, -9.999902066e-01f}, {9.952573993e-01f, -9.727645772e-02f}, {-9.437797393e-01f, -3.305749593e-01f}, {-3.758474003e-01f, 9.266815697e-01f}, {4.535961002e-01f, 8.912073709e-01f}, {8.147053420e-01f, 5.798751639e-01f}, {9.401075903e-01f, 3.408778647e-01f}, {9.809291472e-01f, 1.943656558e-01f},
  {9.939560980e-01f, 1.097783002e-01f}, {9.980874321e-01f, 6.181810327e-02f}, {9.993950610e-01f, 3.477804006e-02f}, {9.998086883e-01f, 1.955982724e-02f}, {9.999395006e-01f, 1.099977904e-02f}, {9.999808683e-01f, 6.185714754e-03f}, {9.999939500e-01f, 3.478498401e-03f}, {9.999980868e-01f, 1.956106080e-03f},
  {8.438539587e-01f, -5.365729180e-01f}, {8.938616142e-01f, 4.483429653e-01f}, {-7.941793525e-01f, -6.076834341e-01f}, {-5.338430142e-01f, 8.455836068e-01f}, {3.623577100e-01f, 9.320391032e-01f}, {7.808259330e-01f, 6.247486393e-01f}, {9.288598710e-01f, 3.704312892e-01f}, {9.773178677e-01f, 2.117776794e-01f},
  {9.928086362e-01f, 1.197122046e-01f}, {9.977240240e-01f, 6.742975621e-02f}, {9.992800864e-01f, 3.793822392e-02f}, {9.997723246e-01f, 2.133773367e-02f}, {9.999280009e-01f, 1.199971211e-02f}, {9.999772317e-01f, 6.748044406e-03f}, {9.999928000e-01f, 3.794723862e-03f}, {9.999977232e-01f, 2.133933605e-03f},
  {9.074467815e-01f, 4.201670368e-01f}, {5.171728454e-01f, 8.558809777e-01f}, {-5.658204930e-01f, -8.245284529e-01f}, {-6.750016657e-01f, 7.378162043e-01f}, {2.674987597e-01f, 9.635582046e-01f}, {7.444779872e-01f, 6.676470075e-01f}, {9.166833698e-01f, 3.996143135e-01f}, {9.733975442e-01f, 2.291227201e-01f},
  {9.915618943e-01f, 1.296341379e-01f}, {9.973290651e-01f, 7.303927684e-02f}, {9.991551190e-01f, 4.109803212e-02f}, {9.997327995e-01f, 2.311557262e-02f}, {9.999155012e-01f, 1.299963410e-02f}, {9.999732789e-01f, 7.310371924e-03f}, {9.999915500e-01f, 4.110949176e-03f}, {9.999973279e-01f, 2.311761062e-03f},
  {1.367372182e-01f, 9.906073557e-01f}, {-1.879615160e-02f, 9.998233367e-01f}, {-2.813494808e-01f, -9.596053718e-01f}, {-7.948709048e-01f, 6.067785796e-01f}, {1.699671664e-01f, 9.854497259e-01f}, {7.057763743e-01f, 7.084346897e-01f}, {9.035902493e-01f, 4.283977840e-01f}, {9.691694136e-01f, 2.463953078e-01f},
  {9.902159961e-01f, 1.395431152e-01f}, {9.969025685e-01f, 7.864648034e-02f}, {9.990201601e-01f, 4.425742562e-02f}, {9.996901128e-01f, 2.489334034e-02f}, {9.999020016e-01f, 1.399954310e-02f}, {9.999690098e-01f, 7.872696665e-03f}, {9.999902000e-01f, 4.427174080e-03f}, {9.999969010e-01f, 2.489588678e-03f},
  {-7.596879129e-01f, 6.502878402e-01f}, {-5.489754720e-01f, 8.358384600e-01f}, {3.102235090e-02f, -9.995186910e-01f}, {-8.896704271e-01f, 4.566032536e-01f}, {7.073720167e-02f, 9.974949866e-01f}, {6.648435293e-01f, 7.469826514e-01f}, {8.895936264e-01f, 4.567528653e-01f}, {9.646348168e-01f, 2.635899662e-01f},
  {9.887710793e-01f, 1.494381236e-01f}, {9.964445467e-01f, 8.425120425e-02f}, {9.988752109e-01f, 4.741638026e-02f}, {9.996442648e-01f, 2.667102934e-02f}, {9.998875021e-01f, 1.499943810e-02f}, {9.999644246e-01f, 8.435019847e-03f}, {9.999887500e-01f, 4.743398540e-03f}, {9.999964424e-01f, 2.667415984e-03f},
  {-9.576594803e-01f, -2.879033167e-01f}, {-9.100810896e-01f, 4.144302238e-01f}, {3.403181682e-01f, -9.403103447e-01f}, {-9.564100499e-01f, 2.920270818e-01f}, {-2.919954613e-02f, 9.995736023e-01f}, {6.218088193e-01f, 7.831690700e-01f}, {8.747074844e-01f, 4.846512321e-01f}, {9.597951759e-01f, 2.807013010e-01f},
  {9.872272839e-01f, 1.593182031e-01f}, {9.959550145e-01f, 8.985326392e-02f}, {9.987202731e-01f, 5.057485702e-02f}, {9.995952558e-01f, 2.844863214e-02f}, {9.998720027e-01f, 1.599931810e-02f}, {9.999595231e-01f, 8.997339431e-03f}, {9.999872000e-01f, 5.059622526e-03f}, {9.999959523e-01f, 2.845243204e-03f},
  {-2.751633381e-01f, -9.613974919e-01f}, {-9.908979596e-01f, -1.346151313e-01f}, {6.158647923e-01f, -7.878518627e-01f}, {-9.929849841e-01f, 1.182405237e-01f}, {-1.288445416e-01f, 9.916648043e-01f}, {5.768082960e-01f, 8.168795441e-01f}, {8.589467084e-01f, 5.120649883e-01f}, {9.546520286e-01f, 2.977238725e-01f},
  {9.855847666e-01f, 1.691823508e-01f}, {9.954339876e-01f, 9.545248218e-02f}, {9.985553481e-01f, 5.373282803e-02f}, {9.995430857e-01f, 3.022614497e-02f}, {9.998555035e-01f, 1.699918210e-02f}, {9.999543054e-01f, 9.559656169e-03f}, {9.999855500e-01f, 5.375846007e-03f}, {9.999954305e-01f, 3.023070335e-03f},
  {6.603167082e-01f, -7.509872468e-01f}, {-7.665365398e-01f, -6.422006954e-01f}, {8.303361283e-01f, -5.572628770e-01f}, {-9.982416606e-01f, -5.927551864e-02f}, {-2.272021643e-01f, 9.738476146e-01f}, {5.299841756e-01f, 8.480075316e-01f}, {8.423270577e-01f, 5.389667224e-01f}, {9.492070108e-01f, 3.146522695e-01f},
  {9.838436942e-01f, 1.790295658e-01f}, {9.948814823e-01f, 1.010486820e-01f}, {9.983804374e-01f, 5.689026544e-02f}, {9.994877548e-01f, 3.200356222e-02f}, {9.998380044e-01f, 1.799902910e-02f}, {9.999487715e-01f, 1.012197082e-02f}, {9.999838000e-01f, 5.692068949e-03f}, {9.999948771e-01f, 3.200897370e-03f},
  {9.887046182e-01f, 1.498772097e-01f}, {-3.060954058e-01f, -9.520008417e-01f}, {9.624637956e-01f, -2.714100995e-01f}, {-9.720142724e-01f, -2.349218044e-01f}, {-3.232895443e-01f, 9.463000954e-01f}, {4.814845890e-01f, 8.764545570e-01f}, {8.248651506e-01f, 5.653295351e-01f}, {9.434618259e-01f, 3.314811956e-01f},
  {9.820042356e-01f, 1.888588926e-01f}, {9.942975170e-01f, 1.066416789e-01f}, {9.981955430e-01f, 6.004713022e-02f}, {9.994292631e-01f, 3.378088199e-02f}, {9.998195054e-01f, 1.899885811e-02f}, {9.999429214e-01f, 1.068428133e-02f}, {9.999819501e-01f, 6.008291323e-03f}, {9.999942921e-01f, 3.378724537e-03f},
  {4.080820618e-01f, 9.129452507e-01f}, {2.486167313e-01f, -9.686019414e-01f}, {9.991443799e-01f, 4.135829015e-02f}, {-9.151299503e-01f, -4.031589936e-01f}, {-4.161468365e-01f, 9.092974268e-01f}, {4.314628163e-01f, 9.021307212e-01f}, {8.065784476e-01f, 5.911270657e-01f}, {9.374183100e-01f, 3.482052729e-01f},
  {9.800665802e-01f, 1.986693191e-01f}, {9.936821085e-01f, 1.122313110e-01f}, {9.980006668e-01f, 6.320339453e-02f}, {9.993676111e-01f, 3.555809121e-02f}, {9.998000066e-01f, 1.999866811e-02f}, {9.999367551e-01f, 1.124658940e-02f}, {9.999800001e-01f, 6.324513096e-03f}, {9.999936755e-01f, 3.556551364e-03f},
  {-5.477292602e-01f, 8.366556385e-01f}, {7.267602563e-01f, -6.868912067e-01f}, {9.367404516e-01f, 3.500247509e-01f}, {-8.293829489e-01f, -5.586805205e-01f}, {-5.048462281e-01f, 8.632092944e-01f}, {3.800769984e-01f, 9.249548504e-01f}, {7.874851971e-01f, 6.163335658e-01f}, {9.310783539e-01f, 3.648192688e-01f},
  {9.780309161e-01f, 2.084598934e-01f}, {9.930352772e-01f, 1.178173940e-01f}, {9.977958103e-01f, 6.635903053e-02f}, {9.993027988e-01f, 3.733518799e-02f}, {9.997795081e-01f, 2.099845811e-02f}, {9.999302726e-01f, 1.180889298e-02f}, {9.999779501e-01f, 6.640734236e-03f}, {9.999930272e-01f, 3.734378079e-03f},
  {-9.999608264e-01f, -8.851309290e-03f}, {9.810745815e-01f, -1.936302286e-01f}, {7.814403926e-01f, 6.239798978e-01f}, {-7.174774633e-01f, -6.965817179e-01f}, {-5.885011558e-01f, 8.084963758e-01f}, {3.274895886e-01f, 9.448547874e-01f}, {7.676045628e-01f, 6.409237359e-01f}, {9.244439837e-01f, 3.813178741e-01f},
  {9.758974496e-01f, 2.182296219e-01f}, {9.923570442e-01f, 1.233997439e-01f}, {9.975809759e-01f, 6.951400294e-02f}, {9.992348263e-01f, 3.911217043e-02f}, {9.997580097e-01f, 2.199822712e-02f}, {9.999234739e-01f, 1.237119282e-02f}, {9.999758001e-01f, 6.956954712e-03f}, {9.999923473e-01f, 3.912204676e-03f},
  {-5.328330203e-01f, -8.462204042e-01f}, {9.332357723e-01f, 3.592645171e-01f}, {5.486452564e-01f, 8.360552510e-01f}, {-5.829432350e-01f, -8.125128828e-01f}, {-6.662759857e-01f, 7.457052439e-01f}, {2.738668392e-01f, 9.617676197e-01f}, {7.469563882e-01f, 6.648730361e-01f}, {9.175172750e-01f, 3.976959268e-01f},
  {9.736663975e-01f, 2.279775131e-01f}, {9.916474294e-01f, 1.289781990e-01f}, {9.973561656e-01f, 7.266828020e-02f}, {9.991636941e-01f, 4.088902546e-02f}, {9.997355116e-01f, 2.299797413e-02f}, {9.999163589e-01f, 1.293348969e-02f}, {9.999735501e-01f, 7.273174492e-03f}, {9.999916358e-01f, 4.090031381e-03f},
  {4.241790073e-01f, -9.055783620e-01f}, {5.979771709e-01f, 8.015131335e-01f}, {2.614416878e-01f, 9.652192724e-01f}, {-4.300232723e-01f, -9.028178029e-01f}, {-7.373937800e-01f, 6.754631102e-01f}, {2.193782753e-01f, 9.756398784e-01f}, {7.255613200e-01f, 6.881575190e-01f}, {9.103004290e-01f, 4.139482201e-01f},
  {9.713379761e-01f, 2.377026212e-01f}, {9.909064560e-01f, 1.345525754e-01f}, {9.971213823e-01f, 7.582182336e-02f}, {9.990894022e-01f, 4.266575118e-02f}, {9.997120138e-01f, 2.399769627e-02f}, {9.999089278e-01f, 1.349578153e-02f}, {9.999712001e-01f, 7.589393080e-03f}, {9.999908927e-01f, 4.267857492e-03f},
  {9.912028119e-01f, -1.323517501e-01f}, {7.855226359e-02f, 9.969099969e-01f}, {-5.168932904e-02f, 9.986632131e-01f}, {-2.635405934e-01f, -9.646483067e-01f}, {-8.011436155e-01f, 5.984721441e-01f}, {1.641961594e-01f, 9.864277070e-01f}, {7.034407513e-01f, 7.107539022e-01f}, {9.027957408e-01f, 4.300695879e-01f},
  {9.689124217e-01f, 2.474039593e-01f}, {9.901341474e-01f, 1.401226969e-01f}, {9.968766273e-01f, 7.897461572e-02f}, {9.990119510e-01f, 4.444234199e-02f}, {9.996875163e-01f, 2.499739629e-02f}, {9.999011805e-01f, 1.405806910e-02f}, {9.999687502e-01f, 7.905611374e-03f}, {9.999901179e-01f, 4.445683934e-03f},
  {6.469193223e-01f, 7.625584505e-01f}, {-4.650644959e-01f, 8.852768012e-01f}, {-3.596943393e-01f, 9.330701915e-01f}, {-8.874550263e-02f, -9.960543337e-01f}, {-8.568888271e-01f, 5.155012492e-01f}, {1.084949468e-01f, 9.940970006e-01f}, {6.806168009e-01f, 7.326395911e-01f}, {8.950055582e-01f, 4.460549862e-01f},
  {9.663899806e-01f, 2.570805427e-01f}, {9.893305281e-01f, 1.456883874e-01f}, {9.966219035e-01f, 8.212661834e-02f}, {9.989313406e-01f, 4.621879226e-02f}, {9.996620190e-01f, 2.599707130e-02f}, {9.998931169e-01f, 1.462035317e-02f}, {9.999662002e-01f, 8.221828878e-03f}, {9.999893115e-01f, 4.623509769e-03f},
  {-2.921388087e-01f, 9.563759284e-01f}, {-8.654506342e-01f, 5.009942114e-01f}, {-6.320286307e-01f, 7.749450367e-01f}, {8.884811635e-02f, -9.960451858e-01f}, {-9.040721624e-01f, 4.273798371e-01f}, {5.245061444e-02f, 9.986235192e-01f}, {6.571122908e-01f, 7.537927018e-01f}, {8.869323709e-01f, 4.618993066e-01f},
  {9.637709015e-01f, 2.667314183e-01f}, {9.884956235e-01f, 1.512494708e-01f}, {9.963572141e-01f, 8.527779227e-02f}, {9.988475711e-01f, 4.799510009e-02f}, {9.996355221e-01f, 2.699672032e-02f}, {9.998847372e-01f, 1.518263167e-02f}, {9.999635502e-01f, 8.538045559e-03f}, {9.999884735e-01f, 4.801335923e-03f},
  {-9.626058663e-01f, 2.709057883e-01f}, {-9.992934094e-01f, -3.758566202e-02f}, {-8.416849393e-01f, 5.399689462e-01f}, {2.636395107e-01f, -9.646212772e-01f}, {-9.422223247e-01f, 3.349881951e-01f}, {-3.759419011e-03f, 9.999929334e-01f}, {6.329506774e-01f, 7.741921209e-01f}, {8.785787046e-01f, 4.775975920e-01f},
  {9.610554380e-01f, 2.763556497e-01f}, {9.876294623e-01f, 1.568057565e-01f}, {9.960825606e-01f, 8.842812085e-02f}, {9.987606432e-01f, 4.977125243e-02f}, {9.996080256e-01f, 2.799634234e-02f}, {9.998760413e-01f, 1.574490538e-02f}, {9.999608003e-01f, 8.854261387e-03f}, {9.999876039e-01f, 4.979161926e-03f},
  {-7.480575297e-01f, -6.636338842e-01f}, {-8.253716334e-01f, -5.645898217e-01f}, {-9.678715076e-01f, 2.514453117e-01f}, {4.301158485e-01f, -9.027737019e-01f}, {-9.709581880e-01f, 2.392492366e-01f}, {-5.995756728e-02f, 9.982009267e-01f}, {6.081562113e-01f, 7.938173736e-01f}, {8.699472142e-01f, 4.931448515e-01f},
  {9.582438779e-01f, 2.859522171e-01f}, {9.867320673e-01f, 1.623570984e-01f}, {9.957979462e-01f, 9.157756515e-02f}, {9.986705569e-01f, 5.154724737e-02f}, {9.995795294e-01f, 2.899593637e-02f}, {9.998670292e-01f, 1.630717503e-02f}, {9.999579503e-01f, 9.170476329e-03f}, {9.999867027e-01f, 5.156987306e-03f},
  {1.542514499e-01f, -9.880316241e-01f}, {-3.972518623e-01f, -9.177096261e-01f}, {-9.980752275e-01f, -6.201483913e-02f}, {5.830269376e-01f, -8.124528233e-01f}, {-9.899924966e-01f, 1.411200081e-01f}, {-1.159661631e-01f, 9.932531646e-01f}, {5.827536401e-01f, 8.126488756e-01f}, {8.610406595e-01f, 5.085361174e-01f},
  {9.553364944e-01f, 2.955201896e-01f}, {9.858034692e-01f, 1.679033061e-01f}, {9.955033738e-01f, 9.472609366e-02f}, {9.985773124e-01f, 5.332308304e-02f}, {9.995500337e-01f, 2.999550139e-02f}, {9.998577009e-01f, 1.686943954e-02f}, {9.999550003e-01f, 9.486690354e-03f}, {9.999857698e-01f, 5.334812988e-03f},
  {9.147423578e-01f, -4.040376453e-01f}, {1.532154756e-01f, -9.881928041e-01f}, {-9.293002953e-01f, -3.693250075e-01f}, {7.175492218e-01f, -6.965077991e-01f}, {-9.991351562e-01f, 4.158051951e-02f}, {-1.716081385e-01f, 9.851652891e-01f}, {5.567683641e-01f, 8.306677968e-01f}, {8.518617972e-01f, 5.237666260e-01f},
  {9.523335692e-01f, 3.050586387e-01f}, {9.848436973e-01f, 1.734442042e-01f}, {9.951988471e-01f, 9.787366751e-02f}, {9.984809103e-01f, 5.509874635e-02f}, {9.995195384e-01f, 3.099503643e-02f}, {9.998480564e-01f, 1.743169684e-02f}, {9.999519504e-01f, 9.802903431e-03f}, {9.999848053e-01f, 5.512638036e-03f},
  {8.342233605e-01f, 5.514266812e-01f}, {6.564951791e-01f, -7.543302193e-01f}, {-7.683670888e-01f, -6.400093881e-01f}, {8.294403670e-01f, -5.585952717e-01f}, {-9.982947730e-01f, -5.837419103e-02f}, {-2.267075845e-01f, 9.739628695e-01f}, {5.302263665e-01f, 8.478561200e-01f}, {8.424135592e-01f, 5.388315091e-01f},
  {9.492354203e-01f, 3.145665538e-01f}, {9.838527819e-01f, 1.789796175e-01f}, {9.948843677e-01f, 1.010202700e-01f}, {9.983813507e-01f, 5.687423543e-02f}, {9.994880436e-01f, 3.199454047e-02f}, {9.998380958e-01f, 1.799395049e-02f}, {9.999488004e-01f, 1.011911553e-02f}, {9.999838092e-01f, 5.690463375e-03f},
  {-1.327674722e-02f, 9.999118601e-01f}, {9.575860738e-01f, -2.881473778e-01f}, {-5.312352786e-01f, -8.472243379e-01f}, {9.151713830e-01f, -4.030649323e-01f}, {-9.874797774e-01f, -1.577456471e-01f}, {-2.810903074e-01f, 9.596813216e-01f}, {5.031541870e-01f, 8.641966582e-01f}, {8.326989334e-01f, 5.537260030e-01f},
  {9.460423489e-01f, 3.240430126e-01f}, {9.828307545e-01f, 1.845093711e-01f}, {9.945599394e-01f, 1.041658623e-01f}, {9.982786339e-01f, 5.864954466e-02f}, {9.994555494e-01f, 3.299401065e-02f}, {9.998278189e-01f, 1.855619846e-02f}, {9.999455505e-01f, 1.043532661e-02f}, {9.999827814e-01f, 5.868288535e-03f},
  {-8.485702748e-01f, 5.290826861e-01f}, {9.637575328e-01f, 2.667797179e-01f}, {-2.414211151e-01f, -9.704204476e-01f}, {9.720383571e-01f, -2.348221291e-01f}, {-9.667981682e-01f, -2.555411942e-01f}, {-3.345843792e-01f, 9.423657958e-01f}, {4.755788956e-01f, 8.796730723e-01f}, {8.227209915e-01f, 5.684453977e-01f},
  {9.427546643e-01f, 3.334870955e-01f}, {9.817776473e-01f, 1.900332899e-01f}, {9.942255664e-01f, 1.073104056e-01f}, {9.981727603e-01f, 6.042466843e-02f}, {9.994220556e-01f, 3.399345156e-02f}, {9.998172259e-01f, 1.911843869e-02f}, {9.999422006e-01f, 1.075153665e-02f}, {9.999817221e-01f, 6.046113043e-03f},
  {-9.036922051e-01f, -4.281826695e-01f}, {6.731102676e-01f, 7.395421338e-01f}, {7.233466718e-02f, -9.973804169e-01f}, {9.982477619e-01f, -5.917267879e-02f}, {-9.364566873e-01f, -3.507832277e-01f}, {-3.870206816e-01f, 9.220710342e-01f}, {4.475280652e-01f, 8.942698871e-01f}, {8.124829236e-01f, 5.829849902e-01f},
  {9.393727149e-01f, 3.428978019e-01f}, {9.806934936e-01f, 1.955511994e-01f}, {9.938812503e-01f, 1.104538832e-01f}, {9.980637300e-01f, 6.219960483e-02f}, {9.993875625e-01f, 3.499285475e-02f}, {9.998063168e-01f, 1.968067474e-02f}, {9.999387506e-01f, 1.106774562e-02f}, {9.999806311e-01f, 6.223937825e-03f},
  {-1.279636896e-01f, -9.917788534e-01f}, {1.751565337e-01f, 9.845405978e-01f}, {3.789161719e-01f, -9.254309994e-01f}, {9.929728258e-01f, 1.183425843e-01f}, {-8.967583530e-01f, -4.425205716e-01f}, {-4.382335472e-01f, 8.988611451e-01f}, {4.190297442e-01f, 9.079725070e-01f}, {8.019878986e-01f, 5.973402803e-01f},
  {9.358968291e-01f, 3.522742188e-01f}, {9.795783277e-01f, 2.010629250e-01f}, {9.935269954e-01f, 1.135962562e-01f}, {9.979515440e-01f, 6.397433710e-02f}, {9.993520699e-01f, 3.599222668e-02f}, {9.997950914e-01f, 2.024290457e-02f}, {9.999352007e-01f, 1.138395348e-02f}, {9.999795085e-01f, 6.401761945e-03f},
  {7.654140519e-01f, -6.435381334e-01f}, {-3.767422893e-01f, 9.263181135e-01f}, {6.479216888e-01f, -7.617069550e-01f}, {9.563800296e-01f, 2.921253822e-01f}, {-8.481000064e-01f, -5.298361813e-01f}, {-4.880608524e-01f, 8.728096037e-01f}, {3.901124287e-01f, 9.207672306e-01f}, {7.912392691e-01f, 6.115066795e-01f},
  {9.323273439e-01f, 3.616154364e-01f}, {9.784321880e-01f, 2.065682779e-01f}, {9.931628052e-01f, 1.167374932e-01f}, {9.978362017e-01f, 6.574887451e-02f}, {9.993155781e-01f, 3.699155889e-02f}, {9.997835499e-01f, 2.080512613e-02f}, {9.999315508e-01f, 1.170016020e-02f}, {9.999783543e-01f, 6.579586328e-03f},
  {9.550736440e-01f, 2.963685787e-01f}, {-8.126112051e-01f, 5.828061679e-01f}, {8.526731157e-01f, -5.224447891e-01f}, {8.896234916e-01f, 4.566946935e-01f}, {-7.909677411e-01f, -6.118578532e-01f}, {-5.363451811e-01f, 8.439987244e-01f}, {3.608050334e-01f, 9.326412643e-01f}, {7.802404339e-01f, 6.254797082e-01f},
  {9.286646373e-01f, 3.709204650e-01f}, {9.772551046e-01f, 2.120671131e-01f}, {9.927886843e-01f, 1.198775555e-01f}, {9.977177040e-01f, 6.752320399e-02f}, {9.992780868e-01f, 3.799085783e-02f}, {9.997716923e-01f, 2.136734297e-02f}, {9.999278009e-01f, 1.201636575e-02f}, {9.999771684e-01f, 6.757410504e-03f},
  {2.666429324e-01f, 9.637953863e-01f}, {-9.982103598e-01f, 5.980031485e-02f}, {9.728653499e-01f, -2.313720187e-01f}, {7.948083899e-01f, 6.068604645e-01f}, {-7.259322386e-01f, -6.877662284e-01f}, {-5.829338849e-01f, 8.125195911e-01f}, {3.311368634e-01f, 9.435827349e-01f}, {7.689949093e-01f, 6.392549018e-01f},
  {9.249090653e-01f, 3.801884019e-01f}, {9.760471178e-01f, 2.175592422e-01f}, {9.924046346e-01f, 1.230164264e-01f}, {9.975960518e-01f, 6.929731252e-02f}, {9.992395964e-01f, 3.899011506e-02f}, {9.997595184e-01f, 2.192955306e-02f}, {9.999239510e-01f, 1.233257010e-02f}, {9.999759510e-01f, 6.935234000e-03f},
  {-6.669380617e-01f, 7.451131605e-01f}, {-8.763794418e-01f, -4.816212973e-01f}, {9.965789837e-01f, 8.264580634e-02f}, {6.749256518e-01f, 7.378857395e-01f}, {-6.536436209e-01f, -7.568024953e-01f}, {-6.276796763e-01f, 7.784717233e-01f}, {3.011375844e-01f, 9.535807020e-01f}, {7.575061759e-01f, 6.528279969e-01f},
  {9.210610033e-01f, 3.894183203e-01f}, {9.748082657e-01f, 2.230444915e-01f}, {9.920106618e-01f, 1.261540598e-01f}, {9.974712443e-01f, 7.107120934e-02f}, {9.992001065e-01f, 3.998933702e-02f}, {9.997470285e-01f, 2.249175622e-02f}, {9.999200011e-01f, 1.264877321e-02f}, {9.999747019e-01f, 7.113057742e-03f},
  {-9.873392775e-01f, -1.586226688e-01f}, {-4.846393970e-01f, -8.747140418e-01f}, {9.214623472e-01f, 3.884676855e-01f}, {5.337561004e-01f, 8.456384720e-01f}, {-5.748240246e-01f, -8.182770562e-01f}, {-6.704410942e-01f, 7.419627614e-01f}, {2.708370782e-01f, 9.626252007e-01f}, {7.457779040e-01f, 6.661946547e-01f},
  {9.171208242e-01f, 3.986093247e-01f}, {9.735385875e-01f, 2.285226875e-01f}, {9.916067680e-01f, 1.292904390e-01f}, {9.973432826e-01f, 7.284488142e-02f}, {9.991596177e-01f, 4.098851526e-02f}, {9.997342224e-01f, 2.305395040e-02f}, {9.999159512e-01f, 1.296497506e-02f}, {9.999734212e-01f, 7.290880793e-03f},
  {-3.999853150e-01f, -9.165215479e-01f}, {5.636094028e-02f, -9.984104589e-01f}, {7.549653475e-01f, 6.557646866e-01f}, {3.757521519e-01f, 9.267201953e-01f}, {-4.902605720e-01f, -8.715759127e-01f}, {-7.110829506e-01f, 7.031081264e-01f}, {2.402658714e-01f, 9.707071191e-01f}, {7.338138022e-01f, 6.793506485e-01f},
  {9.130889457e-01f, 4.077604411e-01f}, {9.722381233e-01f, 2.339936570e-01f}, {9.911929581e-01f, 1.324255253e-01f}, {9.972121675e-01f, 7.461831571e-02f}, {9.991181295e-01f, 4.198765625e-02f}, {9.997211001e-01f, 2.361613915e-02f}, {9.999118013e-01f, 1.328117562e-02f}, {9.999721088e-01f, 7.468704080e-03f},
  {5.551133015e-01f, -8.317747426e-01f}, {5.800031129e-01f, -8.146142578e-01f}, {5.135984179e-01f, 8.580306901e-01f}, {2.058971709e-01f, 9.785736329e-01f}, {-4.007989973e-01f, -9.161660132e-01f}, {-7.494767587e-01f, 6.620306550e-01f}, {2.094544189e-01f, 9.778184118e-01f}, {7.216176540e-01f, 6.922918182e-01f},
  {9.089657591e-01f, 4.168707818e-01f}, {9.709069144e-01f, 2.394572270e-01f}, {9.907692363e-01f, 1.355592873e-01f}, {9.970778984e-01f, 7.639152146e-02f}, {9.990756424e-01f, 4.298675152e-02f}, {9.997076617e-01f, 2.417832043e-02f}, {9.999075514e-01f, 1.359737484e-02f}, {9.999707649e-01f, 7.646527131e-03f},
  {9.998433086e-01f, 1.770192511e-02f}, {9.250146691e-01f, -3.799313911e-01f}, {2.212981743e-01f, 9.752061926e-01f}, {2.954782069e-02f, 9.995633678e-01f}, {-3.073327792e-01f, -9.516021032e-01f}, {-7.855011387e-01f, 6.188602113e-01f}, {1.784335295e-01f, 9.839519681e-01f}, {7.091933579e-01f, 7.050140291e-01f},
  {9.047516642e-01f, 4.259394629e-01f}, {9.695450064e-01f, 2.449132102e-01f}, {9.903356068e-01f, 1.386916938e-01f}, {9.969404762e-01f, 7.816448565e-02f}, {9.990321560e-01f, 4.398580752e-02f}, {9.996939072e-01f, 2.474049220e-02f}, {9.999032016e-01f, 1.391357271e-02f}, {9.999693893e-01f, 7.824349474e-03f},
  {5.253219888e-01f, 8.509035245e-01f}, {9.851382016e-01f, 1.717635693e-01f}, {-9.294810554e-02f, 9.956709545e-01f}, {-1.477329862e-01f, 9.890272821e-01f}, {-2.107957994e-01f, -9.775301177e-01f}, {-8.190422014e-01f, 5.737332763e-01f}, {1.472342216e-01f, 9.891016550e-01f}, {6.965447594e-01f, 7.175133435e-01f},
  {9.004471075e-01f, 4.349655234e-01f}, {9.681524315e-01f, 2.503614776e-01f}, {9.898920739e-01f, 1.418227133e-01f}, {9.967999021e-01f, 7.993719522e-02f}, {9.989876708e-01f, 4.498481582e-02f}, {9.996798365e-01f, 2.530265802e-02f}, {9.998987517e-01f, 1.422976918e-02f}, {9.999679821e-01f, 8.002171569e-03f},
  {-4.321779449e-01f, 9.017883476e-01f}, {7.418580135e-01f, 6.705569982e-01f}, {-3.979767653e-01f, 9.173954950e-01f}, {-3.203543695e-01f, 9.472977768e-01f}, {-1.121526217e-01f, -9.936909929e-01f}, {-8.499939088e-01f, 5.267925161e-01f}, {1.158876918e-01f, 9.932623233e-01f}, {6.836758997e-01f, 7.297857660e-01f},
  {8.960525071e-01f, 4.439480877e-01f}, {9.667292484e-01f, 2.558017989e-01f}, {9.894386421e-01f, 1.449523146e-01f}, {9.966561752e-01f, 8.170965944e-02f}, {9.989421864e-01f, 4.598378286e-02f}, {9.996654497e-01f, 2.586481583e-02f}, {9.998942019e-01f, 1.454596424e-02f}, {9.999665433e-01f, 8.179994343e-03f},
  {-9.923354692e-01f, 1.235731227e-01f}, {2.700984580e-01f, 9.628327077e-01f}, {-6.635382560e-01f, 7.481423547e-01f}, {-4.828719382e-01f, 8.756909793e-01f}, {-1.238837738e-02f, -9.999232611e-01f}, {-8.782584087e-01f, 4.781863313e-01f}, {8.442528403e-02f, 9.964298126e-01f}, {6.705908480e-01f, 7.418274156e-01f},
  {8.915682887e-01f, 4.528862843e-01f}, {9.652754871e-01f, 2.612340599e-01f}, {9.889753181e-01f, 1.480804517e-01f}, {9.965092972e-01f, 8.348185785e-02f}, {9.988957032e-01f, 4.698270019e-02f}, {9.996507468e-01f, 2.642696360e-02f}, {9.998895520e-01f, 1.486215783e-02f}, {9.999650728e-01f, 8.357815927e-03f},
  {-6.401443395e-01f, -7.682546613e-01f}, {-2.848466063e-01f, 9.585731119e-01f}, {-8.632964878e-01f, 5.046971113e-01f}, {-6.301599705e-01f, 7.764653318e-01f}, {8.749917344e-02f, -9.961645921e-01f}, {-9.037463447e-01f, 4.280683876e-01f}, {5.287845807e-02f, 9.986009557e-01f}, {6.572937422e-01f, 7.536344847e-01f},
  {8.869949277e-01f, 4.617791660e-01f}, {9.637912089e-01f, 2.666580313e-01f}, {9.885021022e-01f, 1.512071226e-01f}, {9.963592674e-01f, 8.525379969e-02f}, {9.988482211e-01f, 4.798157054e-02f}, {9.996357278e-01f, 2.698910488e-02f}, {9.998848022e-01f, 1.517834901e-02f}, {9.999635708e-01f, 8.535637247e-03f},
  {3.005925437e-01f, -9.537526528e-01f}, {-7.520639951e-01f, 6.590900905e-01f}, {-9.774427254e-01f, 2.112006594e-01f}, {-7.575730765e-01f, 6.527503610e-01f}, {1.865124631e-01f, -9.824525948e-01f}, {-9.263771379e-01f, 3.765971301e-01f}, {2.127875808e-02f, 9.997735816e-01f}, {6.437888326e-01f, 7.652032012e-01f},
  {8.823328681e-01f, 4.706258703e-01f}, {9.622764532e-01f, 2.720735702e-01f}, {9.880190013e-01f, 1.543322815e-01f}, {9.962060867e-01f, 8.702547193e-02f}, {9.987997401e-01f, 4.898039663e-02f}, {9.996203926e-01f, 2.755123762e-02f}, {9.998799524e-01f, 1.549453961e-02f}, {9.999620371e-01f, 8.713459228e-03f},
  {9.649660285e-01f, -2.623748537e-01f}, {-9.876590838e-01f, 1.566190737e-01f}, {-9.946564265e-01f, -1.032404628e-01f}, {-8.610927113e-01f, 5.084479743e-01f}, {2.836621855e-01f, -9.589242747e-01f}, {-9.460792425e-01f, 3.239352821e-01f}, {-1.034221888e-02f, 9.999465178e-01f}, {6.300802992e-01f, 7.765299843e-01f},
  {8.775825619e-01f, 4.794255386e-01f}, {9.607312596e-01f, 2.774805341e-01f}, {9.875260201e-01f, 1.574558971e-01f}, {9.960497565e-01f, 8.879686156e-02f}, {9.987502604e-01f, 4.997917001e-02f}, {9.996047414e-01f, 2.811335979e-02f}, {9.998750026e-01f, 1.581072865e-02f}, {9.999604718e-01f, 8.891280002e-03f},
  {7.421541968e-01f, 6.702291758e-01f}, {-9.190735378e-01f, -3.940860720e-01f}, {-9.132301279e-01f, -4.074441477e-01f}, {-9.374542500e-01f, 3.481085020e-01f}, {3.779776544e-01f, -9.258147184e-01f}, {-9.627903713e-01f, 2.702493312e-01f}, {-4.195285448e-02f, 9.991195914e-01f}, {6.161725219e-01f, 7.876112133e-01f},
  {8.727445123e-01f, 4.881772386e-01f}, {9.591556934e-01f, 2.828786946e-01f}, {9.870231637e-01f, 1.605779382e-01f}, {9.958902758e-01f, 9.056797780e-02f}, {9.986997817e-01f, 5.097789714e-02f}, {9.995887740e-01f, 2.867547492e-02f}, {9.998699528e-01f, 1.612691704e-02f}, {9.999588749e-01f, 9.069100495e-03f},
  {-1.629907808e-01f, 9.866275920e-01f}, {-5.674300293e-01f, -8.234216185e-01f}, {-7.412399645e-01f, -6.712401321e-01f}, {-9.842484715e-01f, 1.767906850e-01f}, {4.685169241e-01f, -8.834545217e-01f}, {-9.764576931e-01f, 2.157090023e-01f}, {-7.352154075e-02f, 9.972936293e-01f}, {6.020698986e-01f, 7.984433839e-01f},
  {8.678191892e-01f, 4.968801213e-01f}, {9.575497876e-01f, 2.882679384e-01f}, {9.865104371e-01f, 1.636983734e-01f}, {9.957276465e-01f, 9.233880022e-02f}, {9.986483046e-01f, 5.197656957e-02f}, {9.995724905e-01f, 2.923758099e-02f}, {9.998648031e-01f, 1.644310196e-02f}, {9.999572463e-01f, 9.246920701e-03f},
  {-9.182827862e-01f, 3.959251502e-01f}, {-4.102818995e-02f, -9.991579893e-01f}, {-4.957418213e-01f, -8.684699457e-01f}, {-9.999999947e-01f, -1.030206758e-04f}, {5.543744949e-01f, -8.322673365e-01f}, {-9.870379993e-01f, 1.604867217e-01f}, {-1.050167117e-01f, 9.944704572e-01f}, {5.877769370e-01f, 8.090230357e-01f},
  {8.628070850e-01f, 5.055333165e-01f}, {9.559136100e-01f, 2.936480378e-01f}, {9.859878454e-01f, 1.668171717e-01f}, {9.955618677e-01f, 9.410933806e-02f}, {9.985958286e-01f, 5.297519375e-02f}, {9.995558910e-01f, 2.979967596e-02f}, {9.998595533e-01f, 1.675928710e-02f}, {9.999555861e-01f, 9.424741546e-03f},
  {-8.293098329e-01f, -5.587890489e-01f}, {4.980096003e-01f, -8.671715159e-01f}, {-2.010796199e-01f, -9.795749009e-01f}, {-9.842120244e-01f, -1.769934771e-01f}, {6.346929496e-01f, -7.727644270e-01f}, {-9.944978661e-01f, 1.047568344e-01f}, {-1.364068747e-01f, 9.906528981e-01f}, {5.732980611e-01f, 8.193468943e-01f},
  {8.577087010e-01f, 5.141359589e-01f}, {9.542471952e-01f, 2.990188798e-01f}, {9.854553963e-01f, 1.699342871e-01f}, {9.953929407e-01f, 9.587957830e-02f}, {9.985423542e-01f, 5.397376122e-02f}, {9.995389754e-01f, 3.036176336e-02f}, {9.998542036e-01f, 1.707546870e-02f}, {9.999538943e-01f, 9.602561162e-03f},
  {2.212675626e-02f, -9.997551734e-01f}, {8.836693140e-01f, -4.681116785e-01f}, {1.135217773e-01f, -9.935355082e-01f}, {-9.373825054e-01f, -3.483016489e-01f}, {7.086697743e-01f, -7.055403256e-01f}, {-9.988136461e-01f, 4.869599955e-02f}, {-1.676606422e-01f, 9.858447692e-01f}, {5.586378969e-01f, 8.294116591e-01f},
  {8.525245158e-01f, 5.226872391e-01f}, {9.525506134e-01f, 3.043802375e-01f}, {9.849130902e-01f, 1.730497178e-01f}, {9.952208667e-01f, 9.764950793e-02f}, {9.984878810e-01f, 5.497227845e-02f}, {9.995217437e-01f, 3.092384116e-02f}, {9.998487538e-01f, 1.739165045e-02f}, {9.999521709e-01f, 9.780380474e-03f},
  {8.532201077e-01f, -5.215510021e-01f}, {9.971746360e-01f, 7.511820869e-02f}, {4.168670742e-01f, -9.089674595e-01f}, {-8.609884168e-01f, -5.086245631e-01f}, {7.755658183e-01f, -6.312667118e-01f}, {-9.999717335e-01f, -7.518784889e-03f}, {-1.987468801e-01f, 9.800508546e-01f}, {5.438010803e-01f, 8.392141473e-01f},
  {8.472551097e-01f, 5.311861999e-01f}, {9.508239095e-01f, 3.097319700e-01f}, {9.843609349e-01f, 1.761634181e-01f}, {9.950456449e-01f, 9.941913618e-02f}, {9.984324096e-01f, 5.597073698e-02f}, {9.995041959e-01f, 3.148590732e-02f}, {9.998432041e-01f, 1.770782860e-02f}, {9.999504159e-01f, 9.958200408e-03f},
  {8.998668270e-01f, 4.361647552e-01f}, {8.035690866e-01f, 5.952114944e-01f}, {6.788702112e-01f, -7.342582900e-01f}, {-7.574391895e-01f, -6.529057162e-01f}, {8.347129424e-01f, -5.506853038e-01f}, {-9.979684672e-01f, -6.370979912e-02f}, {-2.296342702e-01f, 9.732769914e-01f}, {5.287923029e-01f, 8.487512594e-01f},
  {8.419009790e-01f, 5.396320427e-01f}, {9.490671287e-01f, 3.150739362e-01f}, {9.837989360e-01f, 1.792753567e-01f}, {9.948672764e-01f, 1.011884500e-01f}, {9.983759396e-01f, 5.696914326e-02f}, {9.994863320e-01f, 3.204796724e-02f}, {9.998375544e-01f, 1.802400685e-02f}, {9.999486292e-01f, 1.013601910e-02f},
  {1.191801354e-01f, 9.928726481e-01f}, {3.624766664e-01f, 9.319928467e-01f}, {8.735505105e-01f, -4.867335058e-01f}, {-6.300007138e-01f, -7.765945536e-01f}, {8.855196056e-01f, -4.646020105e-01f}, {-9.928101803e-01f, -1.196993984e-01f}, {-2.602920453e-01f, 9.655299328e-01f}, {5.136163109e-01f, 8.580199795e-01f},
  {8.364626591e-01f, 5.480239228e-01f}, {9.472803452e-01f, 3.204059106e-01f}, {9.832270991e-01f, 1.823855026e-01f}, {9.946857626e-01f, 1.029574365e-01f}, {9.983184713e-01f, 5.796748886e-02f}, {9.994681521e-01f, 3.261001331e-02f}, {9.998318047e-01f, 1.834018143e-02f}, {9.999468110e-01f, 1.031383746e-02f},
  {-7.710802230e-01f, 6.367380071e-01f}, {-1.902490958e-01f, 9.817358512e-01f}, {9.816020978e-01f, -1.909380047e-01f}, {-4.826923346e-01f, -8.757899920e-01f}, {9.274784664e-01f, -3.738765764e-01f}, {-9.845131804e-01f, -1.753105749e-01f}, {-2.906895502e-01f, 9.568174253e-01f}, {4.982779032e-01f, 8.670173765e-01f},
  {8.309406937e-01f, 5.563610011e-01f}, {9.454635966e-01f, 3.257277812e-01f}, {9.826454300e-01f, 1.854938246e-01f}, {9.945011026e-01f, 1.047261048e-01f}, {9.982600046e-01f, 5.896578020e-02f}, {9.994496561e-01f, 3.317204907e-02f}, {9.998259550e-01f, 1.865635603e-02f}, {9.999449611e-01f, 1.049165644e-02f},
  {-9.524129804e-01f, -3.048106211e-01f}, {-6.843819158e-01f, 7.291237161e-01f}, {9.923083195e-01f, 1.237909494e-01f}, {-3.201591802e-01f, -9.473637630e-01f}, {9.601702867e-01f, -2.794154982e-01f}, {-9.731036980e-01f, -2.303675170e-01f}, {-3.207963899e-01f, 9.471481807e-01f}, {4.827820346e-01f, 8.757405478e-01f},
  {8.253356351e-01f, 5.646424439e-01f}, {9.436169596e-01f, 3.310393232e-01f}, {9.820539344e-01f, 1.886002917e-01f}, {9.943132976e-01f, 1.064944419e-01f}, {9.982005398e-01f, 5.996400886e-02f}, {9.994308440e-01f, 3.373407806e-02f}, {9.998200054e-01f, 1.897252691e-02f}, {9.999430795e-01f, 1.066947415e-02f},
  {-2.581016359e-01f, -9.661177700e-01f}, {-9.677396624e-01f, 2.519522691e-01f}, {9.046075662e-01f, 4.262454119e-01f}, {-1.475292025e-01f, -9.890577002e-01f}, {9.832684211e-01f, -1.821625980e-01f}, {-9.586178037e-01f, -2.846961652e-01f}, {-3.505824602e-01f, 9.365318674e-01f}, {4.671333972e-01f, 8.841868520e-01f},
  {8.196480097e-01f, 5.728674718e-01f}, {9.417404730e-01f, 3.363404250e-01f}, {9.814526211e-01f, 1.917048581e-01f}, {9.941223492e-01f, 1.082624348e-01f}, {9.981400766e-01f, 6.096218127e-02f}, {9.994117160e-01f, 3.429609266e-02f}, {9.998139558e-01f, 1.928869776e-02f}, {9.999411664e-01f, 1.084729152e-02f},
  {6.735071623e-01f, -7.391806966e-01f}, {-9.530500361e-01f, -3.028128610e-01f}, {7.271980777e-01f, 6.864276770e-01f}, {2.975377145e-02f, -9.995572585e-01f}, {9.965421208e-01f, -8.308911770e-02f}, {-9.411012936e-01f, -3.381247627e-01f}, {-3.800179774e-01f, 9.249791008e-01f}, {4.513370430e-01f, 8.923535586e-01f},
  {8.138784539e-01f, 5.810351644e-01f}, {9.398342161e-01f, 3.416308626e-01f}, {9.808414904e-01f, 1.948075221e-01f}, {9.939282563e-01f, 1.100300928e-01f}, {9.980786154e-01f, 6.196028901e-02f}, {9.993922719e-01f, 3.485809641e-02f}, {9.998078062e-01f, 1.960486481e-02f}, {9.999392216e-01f, 1.102510855e-02f},
  {9.858965816e-01f, 1.673557003e-01f}, {-6.448370157e-01f, -7.643201052e-01f}, {4.776714527e-01f, 8.785385497e-01f}, {2.060983265e-01f, -9.785312871e-01f}, {9.998586332e-01f, 1.681409119e-02f}, {-9.206095453e-01f, -3.904843980e-01f}, {-4.090735085e-01f, 9.125014327e-01f}, {4.353979670e-01f, 9.002380853e-01f},
  {8.080275111e-01f, 5.891447541e-01f}, {9.378982288e-01f, 3.469105251e-01f}, {9.802205514e-01f, 1.979082381e-01f}, {9.937310211e-01f, 1.117973955e-01f}, {9.980161562e-01f, 6.295833478e-02f}, {9.993725116e-01f, 3.542009286e-02f}, {9.998015566e-01f, 1.992103176e-02f}, {9.999372453e-01f, 1.120292616e-02f},
  {3.918572304e-01f, 9.200260382e-01f}, {-1.380281595e-01f, -9.904283049e-01f}, {1.807759664e-01f, 9.835243006e-01f}, {3.759426448e-01f, -9.266429344e-01f}, {9.931849076e-01f, 1.165492996e-01f}, {-8.972073423e-01f, -4.416095391e-01f}, {-4.377200005e-01f, 8.991113397e-01f}, {4.193212096e-01f, 9.078379388e-01f},
  {8.020957664e-01f, 5.971954299e-01f}, {9.359325930e-01f, 3.521791893e-01f}, {9.795898101e-01f, 2.010069749e-01f}, {9.935306427e-01f, 1.135643520e-01f}, {9.979526988e-01f, 6.395632131e-02f}, {9.993524355e-01f, 3.598207439e-02f}, {9.997952070e-01f, 2.023719487e-02f}, {9.999352373e-01f, 1.138074248e-02f},
  {-5.624538512e-01f, 8.268286795e-01f}, {4.112906278e-01f, -9.115042619e-01f}, {-1.340468804e-01f, 9.909749915e-01f}, {5.339299224e-01f, -8.455287328e-01f}, {9.765876257e-01f, 2.151199881e-01f}, {-8.709686692e-01f, -4.913385567e-01f}, {-4.659289146e-01f, 8.848221553e-01f}, {4.031118544e-01f, 9.151507159e-01f},
  {7.960838130e-01f, 6.051863868e-01f}, {9.339373606e-01f, 3.574367167e-01f}, {9.789492729e-01f, 2.041037017e-01f}, {9.933271224e-01f, 1.153309494e-01f}, {9.978882433e-01f, 6.495424389e-02f}, {9.993320433e-01f, 3.654404454e-02f}, {9.997887575e-01f, 2.055335594e-02f}, {9.999331976e-01f, 1.155855845e-02f},
  {-9.996474560e-01f, -2.655115402e-02f}, {8.339421773e-01f, -5.518518324e-01f}, {-4.355781575e-01f, 9.001509144e-01f}, {6.750773206e-01f, -7.377469832e-01f}, {9.502326217e-01f, 3.115412729e-01f}, {-8.419764782e-01f, -5.395142354e-01f}, {-4.936717281e-01f, 8.696483340e-01f}, {3.867750272e-01f, 9.221741041e-01f},
  {7.899922520e-01f, 6.131168256e-01f}, {9.319125840e-01f, 3.626829688e-01f}, {9.782989462e-01f, 2.071983875e-01f}, {9.931204618e-01f, 1.170971747e-01f}, {9.978227905e-01f, 6.595209408e-02f}, {9.993113350e-01f, 3.710600686e-02f}, {9.997822079e-01f, 2.086951683e-02f}, {9.999311264e-01f, 1.173637498e-02f},
  {-5.177697998e-01f, -8.555199790e-01f}, {9.997526257e-01f, -2.224157018e-02f}, {-6.939117212e-01f, 7.200600830e-01f}, {7.949331221e-01f, -6.066970673e-01f}, {9.143830324e-01f, 4.048501822e-01f}, {-8.103224264e-01f, -5.859842705e-01f}, {-5.209211185e-01f, 8.536048197e-01f}, {3.703158941e-01f, 9.289058825e-01f},
  {7.838216925e-01f, 6.209859534e-01f}, {9.298583485e-01f, 3.679177241e-01f}, {9.776388366e-01f, 2.102910013e-01f}, {9.929106598e-01f, 1.188630370e-01f}, {9.977563394e-01f, 6.694988575e-02f}, {9.992903108e-01f, 3.766795372e-02f}, {9.997755584e-01f, 2.118567376e-02f}, {9.999290235e-01f, 1.191419021e-02f},
  {4.401430225e-01f, -8.979276807e-01f}, {8.576571642e-01f, 5.142219255e-01f}, {-8.834316904e-01f, 4.685599731e-01f}, {8.897171354e-01f, -4.565122331e-01f}, {8.693973961e-01f, 4.941135170e-01f}, {-7.761065864e-01f, -6.306017496e-01f}, {-5.476494281e-01f, 8.367078964e-01f}, {3.537396597e-01f, 9.353439224e-01f},
  {7.775727143e-01f, 6.287930296e-01f}, {9.277746974e-01f, 3.731408726e-01f}, {9.769689537e-01f, 2.133814976e-01f}, {9.926977189e-01f, 1.206285161e-01f}, {9.976888905e-01f, 6.794761047e-02f}, {9.992689706e-01f, 3.822988867e-02f}, {9.997688089e-01f, 2.150183044e-02f}, {9.999268890e-01f, 1.209200506e-02f},
  {9.933903797e-01f, -1.147848138e-01f}, {4.514202490e-01f, 8.923114696e-01f}, {-9.853413039e-01f, 1.705945920e-01f}, {9.564401992e-01f, -2.919283222e-01f}, {8.157250450e-01f, 5.784398422e-01f}, {-7.394371294e-01f, -6.732256172e-01f}, {-5.738303336e-01f, 8.189742048e-01f}, {3.370516780e-01f, 9.414861477e-01f},
  {7.712460165e-01f, 6.365371804e-01f}, {9.256617187e-01f, 3.783521937e-01f}, {9.762892980e-01f, 2.164698746e-01f}, {9.924816379e-01f, 1.223936212e-01f}, {9.976204439e-01f, 6.894526724e-02f}, {9.992473143e-01f, 3.879181525e-02f}, {9.997619595e-01f, 2.181798310e-02f}, {9.999247229e-01f, 1.226981954e-02f},
  {6.333192031e-01f, 7.738906816e-01f}, {-9.384513530e-02f, 9.955868072e-01f}, {-9.895353918e-01f, -1.442903610e-01f}, {9.929971882e-01f, -1.181379883e-01f}, {7.539022543e-01f, 6.569865987e-01f}, {-7.004299841e-01f, -7.137211202e-01f}, {-5.994372618e-01f, 8.004217446e-01f}, {3.202570024e-01f, 9.473306986e-01f},
  {7.648421950e-01f, 6.442176781e-01f}, {9.235194568e-01f, 3.835515778e-01f}, {9.755998794e-01f, 2.195560870e-01f}, {9.922624183e-01f, 1.241583392e-01f}, {9.975510002e-01f, 6.994284763e-02f}, {9.992253421e-01f, 3.935372584e-02f}, {9.997550100e-01f, 2.213413545e-02f}, {9.999225252e-01f, 1.244763455e-02f},
  {-3.090227282e-01f, 9.510546533e-01f}, {-6.102111043e-01f, 7.922388580e-01f}, {-8.955979808e-01f, -4.448643128e-01f}, {9.982355487e-01f, 5.937835785e-02f}, {6.845467360e-01f, 7.289689748e-01f}, {-6.592084691e-01f, -7.519602345e-01f}, {-6.244449937e-01f, 7.810687869e-01f}, {3.033610551e-01f, 9.528756846e-01f},
  {7.583618900e-01f, 6.518337547e-01f}, {9.213480022e-01f, 3.887388055e-01f}, {9.749007048e-01f, 2.226401038e-01f}, {9.920400619e-01f, 1.259226572e-01f}, {9.974805585e-01f, 7.094036552e-02f}, {9.992030539e-01f, 3.991562399e-02f}, {9.997479606e-01f, 2.245028372e-02f}, {9.999202959e-01f, 1.262544824e-02f},
  {-9.672505883e-01f, 2.538233628e-01f}, {-9.386403774e-01f, 3.448974367e-01f}, {-7.128450694e-01f, -7.013215433e-01f}, {9.719900655e-01f, 2.350219407e-01f}, {6.083510875e-01f, 7.936680379e-01f}, {-6.159027162e-01f, -7.878222161e-01f}, {-6.488281469e-01f, 7.609349747e-01f}, {2.863691790e-01f, 9.581193523e-01f},
  {7.518057496e-01f, 6.593846487e-01f}, {9.191474004e-01f, 3.939137677e-01f}, {9.741917812e-01f, 2.257218942e-01f}, {9.918145684e-01f, 1.276865770e-01f}, {9.974091192e-01f, 7.193781246e-02f}, {9.991804496e-01f, 4.047751324e-02f}, {9.997408112e-01f, 2.276643161e-02f}, {9.999180349e-01f, 1.280326153e-02f},
  {-7.361927182e-01f, -6.767719569e-01f}, {-9.779862647e-01f, -2.086692743e-01f}, {-4.593983755e-01f, -8.882303376e-01f}, {9.150885079e-01f, 4.032530506e-01f}, {5.260773552e-01f, 8.504367210e-01f}, {-5.706501970e-01f, -8.211932493e-01f}, {-6.725627078e-01f, 7.400401368e-01f}, {2.692867473e-01f, 9.630600437e-01f},
  {7.451744294e-01f, 6.668696048e-01f}, {9.169177444e-01f, 3.990762459e-01f}, {9.734731156e-01f, 2.288014274e-01f}, {9.915859366e-01f, 1.294501078e-01f}, {9.973366826e-01f, 7.293518747e-02f}, {9.991575295e-01f, 4.103938597e-02f}, {9.997335619e-01f, 2.308257536e-02f}, {9.999157423e-01f, 1.298107534e-02f},
  {1.717173418e-01f, -9.851462605e-01f}, {-7.161304948e-01f, -6.979664135e-01f}, {-1.603949705e-01f, -9.870529132e-01f}, {8.293255221e-01f, 5.587657634e-01f}, {4.385472419e-01f, 8.987081376e-01f}, {-5.235932086e-01f, -8.519683984e-01f}, {-6.956245860e-01f, 7.184054811e-01f}, {2.521191618e-01f, 9.676961963e-01f},
  {7.384685523e-01f, 6.742879187e-01f}, {9.146590931e-01f, 4.042261042e-01f}, {9.727447153e-01f, 2.318786725e-01f}, {9.913541710e-01f, 1.312132144e-01f}, {9.972632491e-01f, 7.393248211e-02f}, {9.991342935e-01f, 4.160124571e-02f}, {9.997262125e-01f, 2.339871866e-02f}, {9.999134181e-01f, 1.315888782e-02f},
  {9.217512697e-01f, -3.877816354e-01f}, {-2.337207587e-01f, -9.723037627e-01f}, {1.545165179e-01f, -9.879902053e-01f}, {7.174060294e-01f, 6.966552871e-01f}, {3.466353178e-01f, 9.379999768e-01f}, {-4.748813157e-01f, -8.800498486e-01f}, {-7.179910692e-01f, 6.960523145e-01f}, {2.348718512e-01f, 9.720263441e-01f},
  {7.316888689e-01f, 6.816387600e-01f}, {9.123715058e-01f, 4.093632071e-01f}, {9.720065911e-01f, 2.349535844e-01f}, {9.911192705e-01f, 1.329759061e-01f}, {9.971888179e-01f, 7.492971024e-02f}, {9.991107413e-01f, 4.216309603e-02f}, {9.997187632e-01f, 2.371485776e-02f}, {9.999110623e-01f, 1.333669988e-02f},
  {8.243313311e-01f, 5.661076369e-01f}, {3.206739413e-01f, -9.471896449e-01f}, {4.541028846e-01f, -8.909492523e-01f}, {5.828599138e-01f, 8.125726558e-01f}, {2.512599349e-01f, 9.679196481e-01f}, {-4.246676935e-01f, -9.053492973e-01f}, {-7.396394557e-01f, 6.730033251e-01f}, {2.175502694e-01f, 9.760491178e-01f},
  {7.248360173e-01f, 6.889214382e-01f}, {9.100550791e-01f, 4.144873377e-01f}, {9.712587434e-01f, 2.380261612e-01f}, {9.908812338e-01f, 1.347381921e-01f}, {9.971133894e-01f, 7.592686345e-02f}, {9.990868733e-01f, 4.272492929e-02f}, {9.997112139e-01f, 2.403099635e-02f}, {9.999086748e-01f, 1.351451244e-02f},
  {-3.097503173e-02f, 9.995201586e-01f}, {7.763037288e-01f, -6.303590411e-01f}, {7.086563507e-01f, -7.055538084e-01f}, {4.299306917e-01f, 9.028618944e-01f}, {1.533735793e-01f, 9.881682778e-01f}, {-3.731119396e-01f, -9.277863334e-01f}, {-7.605484252e-01f, 6.492812125e-01f}, {2.001598939e-01f, 9.797632453e-01f},
  {7.179106829e-01f, 6.961352249e-01f}, {9.077098615e-01f, 4.195983881e-01f}, {9.705011830e-01f, 2.410963578e-01f}, {9.906400657e-01f, 1.365000372e-01f}, {9.970369639e-01f, 7.692394073e-02f}, {9.990626894e-01f, 4.328674904e-02f}, {9.997035647e-01f, 2.434713068e-02f}, {9.999062557e-01f, 1.369232365e-02f},
  {-8.578030932e-01f, 5.139784560e-01f}, {9.928478447e-01f, -1.193865876e-01f}, {8.929339780e-01f, -4.501876398e-01f}, {2.634407533e-01f, 9.646755773e-01f}, {5.395523011e-02f, 9.985433557e-01f}, {-3.203761718e-01f, -9.472904035e-01f}, {-7.806967553e-01f, 6.249100545e-01f}, {1.827063410e-01f, 9.831675305e-01f},
  {7.109135581e-01f, 7.032793989e-01f}, {9.053359523e-01f, 4.246961426e-01f}, {9.697339177e-01f, 2.441641434e-01f}, {9.903957650e-01f, 1.382614507e-01f}, {9.969595419e-01f, 7.792093366e-02f}, {9.990381894e-01f, 4.384855882e-02f}, {9.996958154e-01f, 2.466326443e-02f}, {9.999038051e-01f, 1.387013443e-02f},
  {-8.959709468e-01f, -4.441126687e-01f}, {9.036121431e-01f, 4.283516019e-01f}, {9.886589454e-01f, -1.501781928e-01f}, {8.864288797e-02f, 9.960634711e-01f}, {-4.600222091e-02f, 9.989413375e-01f}, {-2.666280039e-01f, -9.637995163e-01f}, {-8.000646032e-01f, 5.999138528e-01f}, {1.651948960e-01f, 9.862609423e-01f},
  {7.038453428e-01f, 7.103532456e-01f}, {9.029334011e-01f, 4.297804941e-01f}, {9.689569550e-01f, 2.472294874e-01f}, {9.901483302e-01f, 1.400224418e-01f}, {9.968811223e-01f, 7.891785610e-02f}, {9.990133736e-01f, 4.441035101e-02f}, {9.996879663e-01f, 2.497939386e-02f}, {9.999013228e-01f, 1.404794477e-02f},
  {-1.103872438e-01f, -9.938886539e-01f}, {5.360818520e-01f, 8.441660073e-01f}, {9.863393414e-01f, 1.647261474e-01f}, {-8.895072913e-02f, 9.960360274e-01f}, {-1.455000338e-01f, 9.893582466e-01f}, {-2.120364479e-01f, -9.772617586e-01f}, {-8.186323106e-01f, 5.743179782e-01f}, {1.476312130e-01f, 9.890424788e-01f},
  {6.967067436e-01f, 7.173560577e-01f}, {9.005023096e-01f, 4.348512278e-01f}, {9.681703064e-01f, 2.502923447e-01f}, {9.898977664e-01f, 1.417829752e-01f}, {9.968017059e-01f, 7.991469961e-02f}, {9.989882418e-01f, 4.497213288e-02f}, {9.996800171e-01f, 2.529552265e-02f}, {9.998988088e-01f, 1.422575559e-02f},
  {7.766859820e-01f, -6.298879943e-01f}, {3.445185325e-03f, 9.999940653e-01f}, {8.862052262e-01f, 4.632928847e-01f}, {-2.637388853e-01f, 9.645941117e-01f}, {-2.435445237e-01f, 9.698897179e-01f}, {-1.567750159e-01f, -9.876343424e-01f}, {-8.363815912e-01f, 5.481476388e-01f}, {1.300208462e-01f, 9.915112604e-01f},
  {6.894984312e-01f, 7.242871760e-01f}, {8.980427419e-01f, 4.399082105e-01f}, {9.673739687e-01f, 2.533527278e-01f}, {9.896440723e-01f, 1.435430604e-01f}, {9.967212932e-01f, 8.091145579e-02f}, {9.989627942e-01f, 4.553389681e-02f}, {9.996719680e-01f, 2.561164704e-02f}, {9.998962633e-01f, 1.440356503e-02f},
  {9.496776979e-01f, 3.132287824e-01f}, {-5.302493098e-01f, 8.478417715e-01f}, {6.981857146e-01f, 7.159166906e-01f}, {-4.302088505e-01f, 9.027293863e-01f}, {-3.391546816e-01f, 9.407306214e-01f}, {-1.010174785e-01f, -9.948846511e-01f}, {-8.532945541e-01f, 5.214291936e-01f}, {1.123693641e-01f, 9.936665064e-01f},
  {6.822212125e-01f, 7.311458248e-01f}, {8.955547626e-01f, 4.449513088e-01f}, {9.665679648e-01f, 2.564105487e-01f}, {9.893872465e-01f, 1.453027063e-01f}, {9.966398832e-01f, 8.190813848e-02f}, {9.989370307e-01f, 4.609564634e-02f}, {9.996638188e-01f, 2.592777074e-02f}, {9.998936861e-01f, 1.458137402e-02f},
  {2.495401180e-01f, 9.683644611e-01f}, {-9.006392088e-01f, 4.345676190e-01f}, {4.409287511e-01f, 8.975421084e-01f}, {-5.831102465e-01f, 8.123930332e-01f}, {-4.313770170e-01f, 9.021717515e-01f}, {-4.494105369e-02f, -9.989896404e-01f}, {-8.693541698e-01f, 4.941895663e-01f}, {9.468234863e-02f, 9.955075353e-01f},
  {6.748757724e-01f, 7.379313598e-01f}, {8.930384766e-01f, 4.499803098e-01f}, {9.657522875e-01f, 2.594658342e-01f}, {9.891272942e-01f, 1.470618780e-01f}, {9.965574766e-01f, 8.290473926e-02f}, {9.989109512e-01f, 4.665738502e-02f}, {9.996555698e-01f, 2.624388999e-02f}, {9.998910773e-01f, 1.475918348e-02f},
  {-6.800234956e-01f, 7.331903201e-01f}, {-9.936468888e-01f, -1.125427045e-01f}, {1.399453517e-01f, 9.901592289e-01f}, {-7.176206406e-01f, 6.964342152e-01f}, {-5.192891431e-01f, 8.545986109e-01f}, {1.127792530e-02f, -9.999364022e-01f}, {-8.845446221e-01f, 4.664555837e-01f}, {7.696539271e-02f, 9.970337649e-01f},
  {6.674628454e-01f, 7.446431025e-01f}, {8.904939370e-01f, 4.549951079e-01f}, {9.649269605e-01f, 2.625184963e-01f}, {9.888642139e-01f, 1.488205847e-01f}, {9.964740734e-01f, 8.390125714e-02f}, {9.988845559e-01f, 4.721910521e-02f}, {9.996472207e-01f, 2.656000847e-02f}, {9.998884369e-01f, 1.493699154e-02f},
  {-9.843766434e-01f, -1.760756199e-01f}, {-7.806286820e-01f, -6.249950886e-01f}, {-1.749181574e-01f, 9.845829768e-01f}, {-8.294976431e-01f, 5.585102148e-01f}, {-6.020119027e-01f, 7.984871126e-01f}, {6.746077372e-02f, -9.977219272e-01f}, {-8.988504928e-01f, 4.382553955e-01f}, {5.922409879e-02f, 9.982447125e-01f},
  {6.599831728e-01f, 7.512803815e-01f}, {8.879212510e-01f, 4.599954913e-01f}, {9.640919764e-01f, 2.655685619e-01f}, {9.885980044e-01f, 1.505788355e-01f}, {9.963896744e-01f, 8.489768369e-02f}, {9.988578448e-01f, 4.778081048e-02f}, {9.996387718e-01f, 2.687612243e-02f}, {9.998857649e-01f, 1.511479913e-02f},
  {-3.836984449e-01f, -9.234584470e-01f}, {-3.271927780e-01f, -9.449576107e-01f}, {-4.724333302e-01f, 8.813664099e-01f}, {-9.152127100e-01f, 4.029710850e-01f}, {-6.787203275e-01f, 7.343968390e-01f}, {1.234308237e-01f, -9.923531789e-01f}, {-9.122576928e-01f, 4.096167744e-01f}, {4.146407704e-02f, 9.991399954e-01f},
  {6.524375025e-01f, 7.578425333e-01f}, {8.853204729e-01f, 4.649813548e-01f}, {9.632473592e-01f, 2.686159432e-01f}, {9.883286709e-01f, 1.523365953e-01f}, {9.963042784e-01f, 8.589403277e-02f}, {9.988308176e-01f, 4.834250436e-02f}, {9.996302228e-01f, 2.719223557e-02f}, {9.998830612e-01f, 1.529260717e-02f},
  {5.697503343e-01f, -8.218178366e-01f}, {2.270120019e-01f, -9.738919606e-01f}, {-7.230991089e-01f, 6.907442932e-01f}, {-9.720626554e-01f, 2.347215243e-01f}, {-7.486465191e-01f, 6.629693729e-01f}, {1.790106509e-01f, -9.838471359e-01f}, {-9.247526141e-01f, 3.805687884e-01f}, {2.369106270e-02f, 9.997193274e-01f},
  {6.448265436e-01f, 7.643289401e-01f}, {8.826917124e-01f, 4.699524879e-01f}, {9.623931097e-01f, 2.716606383e-01f}, {9.880562120e-01f, 1.540938735e-01f}, {9.962178860e-01f, 8.689029596e-02f}, {9.988034748e-01f, 4.890417923e-02f}, {9.996215739e-01f, 2.750834413e-02f}, {9.998803260e-01f, 1.547041379e-02f},
  {9.993732837e-01f, 3.539830273e-02f}, {7.113042761e-01f, -7.028842200e-01f}, {-9.020542361e-01f, 4.316226999e-01f}, {-9.982538526e-01f, 5.906983832e-02f}, {-8.110931256e-01f, 5.849170382e-01f}, {2.340240777e-01f, -9.722308013e-01f}, {-9.363229511e-01f, 3.511400451e-01f}, {5.910437661e-03f, 9.999825332e-01f},
  {6.371511479e-01f, 7.707388759e-01f}, {8.800350389e-01f, 4.749087600e-01f}, {9.615292282e-01f, 2.747026454e-01f}, {9.877806264e-01f, 1.558506791e-01f}, {9.961304975e-01f, 8.788647225e-02f}, {9.987758161e-01f, 4.946583863e-02f}, {9.996128250e-01f, 2.782445179e-02f}, {9.998775591e-01f, 1.564821993e-02f},
  {5.101770449e-01f, 8.600694058e-01f}, {9.765252486e-01f, -2.154029687e-01f}, {-9.915538504e-01f, 1.296956507e-01f}, {-9.929606288e-01f, -1.184448804e-01f}, {-8.654354959e-01f, 5.010203613e-01f}, {2.882981135e-01f, -9.575407029e-01f}, {-9.469569600e-01f, 3.213604143e-01f}, {-1.187205637e-02f, 9.999295247e-01f},
  {6.294120377e-01f, 7.770717385e-01f}, {8.773505365e-01f, 4.798500142e-01f}, {9.606557395e-01f, 2.777418769e-01f}, {9.875019194e-01f, 1.576069771e-01f}, {9.960421134e-01f, 8.888255324e-02f}, {9.987478414e-01f, 5.002748612e-02f}, {9.996039762e-01f, 2.814055482e-02f}, {9.998747606e-01f, 1.582602650e-02f},
  {-4.480736161e-01f, 8.939966636e-01f}, {9.409945525e-01f, 3.384217076e-01f}, {-9.827212994e-01f, -1.850914579e-01f}, {-9.563499296e-01f, -2.922239076e-01f}, {-9.111302619e-01f, 4.121184852e-01f}, {3.416602554e-01f, -9.398235313e-01f}, {-9.566441680e-01f, 2.912592245e-01f}, {-2.965079623e-02f, 9.995603185e-01f},
  {6.216099869e-01f, 7.833268948e-01f}, {8.746382611e-01f, 4.847761465e-01f}, {9.597726360e-01f, 2.807783596e-01f}, {9.872200896e-01f, 1.593627767e-01f}, {9.959527327e-01f, 8.987855276e-02f}, {9.987195510e-01f, 5.058911406e-02f}, {9.995950273e-01f, 2.845665689e-02f}, {9.998719305e-01f, 1.600383071e-02f},
  {-9.943674609e-01f, 1.059875118e-01f}, {6.156554058e-01f, 7.880154956e-01f}, {-8.764333210e-01f, -4.815232433e-01f}, {-8.895764379e-01f, -4.567863407e-01f}, {-9.477217239e-01f, 3.190980008e-01f}, {3.939427052e-01f, -9.191349983e-01f}, {-9.653747427e-01f, 2.608670278e-01f}, {-4.742015991e-02f, 9.988750314e-01f},
  {6.137457758e-01f, 7.895037192e-01f}, {8.718983561e-01f, 4.896868966e-01f}, {9.588799431e-01f, 2.838120059e-01f}, {9.869351381e-01f, 1.611180724e-01f}, {9.958623560e-01f, 9.087446241e-02f}, {9.986909448e-01f, 5.115072601e-02f}, {9.995859786e-01f, 2.877275425e-02f}, {9.998690688e-01f, 1.618163628e-02f},
  {-6.264444479e-01f, -7.794660696e-01f}, {1.007066243e-01f, 9.949161652e-01f}, {-6.832289885e-01f, -7.302041832e-01f}, {-7.947461559e-01f, -6.069419640e-01f}, {-9.748435789e-01f, 2.228901000e-01f}, {4.449792900e-01f, -8.955408598e-01f}, {-9.731400858e-01f, 2.302137560e-01f}, {-6.517452839e-02f, 9.978738802e-01f},
  {6.058201908e-01f, 7.956015940e-01f}, {8.691308793e-01f, 4.945821616e-01f}, {9.579776530e-01f, 2.868428427e-01f}, {9.866470631e-01f, 1.628728733e-01f}, {9.957709834e-01f, 9.187028118e-02f}, {9.986620226e-01f, 5.171232550e-02f}, {9.995768298e-01f, 2.908885060e-02f}, {9.998661754e-01f, 1.635944133e-02f},
  {3.174287015e-01f, -9.482821413e-01f}, {-4.452612126e-01f, 8.954007218e-01f}, {-4.222704815e-01f, -9.064698784e-01f}, {-6.748499826e-01f, -7.379549451e-01f}, {-9.922253492e-01f, 1.244542343e-01f}, {4.946095243e-01f, -8.691153079e-01f}, {-9.799323156e-01f, 1.993305216e-01f}, {-8.290828739e-02f, 9.965571814e-01f},
  {5.978339766e-01f, 8.016199452e-01f}, {8.663359185e-01f, 4.994617866e-01f}, {9.570657916e-01f, 2.898707825e-01f}, {9.863558705e-01f, 1.646271445e-01f}, {9.956786158e-01f, 9.286600066e-02f}, {9.986327848e-01f, 5.227390491e-02f}, {9.995675812e-01f, 2.940494218e-02f}, {9.998632504e-01f, 1.653724401e-02f},
  {9.694593667e-01f, -2.452519855e-01f}, {-8.540936460e-01f, 5.201192593e-01f}, {-1.194339657e-01f, -9.928421465e-01f}, {-5.336693826e-01f, -8.456932009e-01f}, {-9.996930562e-01f, 2.477485342e-02f}, {5.426756651e-01f, -8.399423329e-01f}, {-9.857447428e-01f, 1.682477399e-01f}, {-1.006158291e-01f, 9.949253514e-01f},
  {5.897880270e-01f, 8.075580990e-01f}, {8.635135319e-01f, 5.043256689e-01f}, {9.561443597e-01f, 2.928958236e-01f}, {9.860615588e-01f, 1.663808950e-01f}, {9.955852518e-01f, 9.386163469e-02f}, {9.986032312e-01f, 5.283546780e-02f}, {9.995582325e-01f, 2.972103268e-02f}, {9.998602938e-01f, 1.671504802e-02f},
  {7.301735610e-01f, 6.832617147e-01f}, {-9.998821447e-01f, -1.535241693e-02f}, {1.952449607e-01f, -9.807545082e-01f}, {-3.756571205e-01f, -9.267587215e-01f}, {-9.971721562e-01f, -7.515112046e-02f}, {5.890265674e-01f, -8.081136695e-01f}, {-9.905714679e-01f, 1.369969595e-01f}, {-1.182915542e-01f, 9.929789062e-01f},
  {5.816830992e-01f, 8.134154979e-01f}, {8.606638685e-01f, 5.091735514e-01f}, {9.552133576e-01f, 2.959179642e-01f}, {9.857641264e-01f, 1.681341341e-01f}, {9.954908922e-01f, 9.485717486e-02f}, {9.985733616e-01f, 5.339701770e-02f}, {9.995487840e-01f, 3.003711834e-02f}, {9.998573056e-01f, 1.689285151e-02f},
  {-1.804304493e-01f, 9.835877454e-01f}, {-8.377248218e-01f, -5.460925956e-01f}, {4.905616517e-01f, -8.714064872e-01f}, {-2.057968231e-01f, -9.785947412e-01f}, {-9.846877893e-01f, -1.743271569e-01f}, {6.335149110e-01f, -7.737304812e-01f}, {-9.944077373e-01f, 1.056089575e-01f}, {-1.359298730e-01f, 9.907184613e-01f},
  {5.735200037e-01f, 8.191915560e-01f}, {8.577869887e-01f, 5.140053326e-01f}, {9.542728121e-01f, 2.989371172e-01f}, {9.854635793e-01f, 1.698868268e-01f}, {9.953955378e-01f, 9.585261276e-02f}, {9.985431764e-01f, 5.395854699e-02f}, {9.995392354e-01f, 3.035320100e-02f}, {9.998542858e-01f, 1.707065260e-02f},
  {-9.251475366e-01f, 3.796077390e-01f}, {-4.175648955e-01f, -9.086471032e-01f}, {7.372311535e-01f, -6.756406044e-01f}, {-2.944579810e-02f, -9.995663785e-01f}, {-9.623649317e-01f, -2.717604429e-01f}, {6.760008016e-01f, -7.369008863e-01f}, {-9.972496750e-01f, 7.411535468e-02f}, {-1.535250904e-01f, 9.881447498e-01f},
  {5.652995567e-01f, 8.248856958e-01f}, {8.548829836e-01f, 5.188208597e-01f}, {9.533227151e-01f, 3.019533092e-01f}, {9.851599158e-01f, 1.716389823e-01f}, {9.952991873e-01f, 9.684796223e-02f}, {9.985126755e-01f, 5.452005922e-02f}, {9.995295869e-01f, 3.066928249e-02f}, {9.998512343e-01f, 1.724845501e-02f},
  {-8.192882453e-01f, -5.733818720e-01f}, {1.312005053e-01f, -9.913558531e-01f}, {9.107885630e-01f, -4.128730962e-01f}, {1.478339325e-01f, -9.890121983e-01f}, {-9.304262022e-01f, -3.664793067e-01f}, {7.163492032e-01f, -6.977419430e-01f}, {-9.990944289e-01f, 4.254788036e-02f}, {-1.710718782e-01f, 9.852585511e-01f},
  {5.570225804e-01f, 8.304973479e-01f}, {8.519519448e-01f, 5.236199803e-01f}, {9.523630937e-01f, 3.049664534e-01f}, {9.848531345e-01f, 1.733906097e-01f}, {9.952018415e-01f, 9.784321484e-02f}, {9.984818586e-01f, 5.508155793e-02f}, {9.995198385e-01f, 3.098535905e-02f}, {9.998481513e-01f, 1.742625688e-02f},
  {3.982088039e-02f, -9.992068342e-01f}, {6.395552906e-01f, -7.687451010e-01f}, {9.940242463e-01f, -1.091595058e-01f}, {3.204510557e-01f, -9.472650743e-01f}, {-8.891908908e-01f, -4.575364026e-01f}, {7.544332398e-01f, -6.563767872e-01f}, {-9.999401824e-01f, 1.093762364e-02f}, {-1.885645696e-01f, 9.820607940e-01f},
  {5.486899024e-01f, 8.360259511e-01f}, {8.489939337e-01f, 5.284025933e-01f}, {9.513939397e-01f, 3.079765762e-01f}, {9.845432413e-01f, 1.751416741e-01f}, {9.951035005e-01f, 9.883836961e-02f}, {9.984507262e-01f, 5.564303550e-02f}, {9.995099901e-01f, 3.130143251e-02f}, {9.998450366e-01f, 1.760405633e-02f},
  {8.623188723e-01f, -5.063656411e-01f}, {9.509409315e-01f, -3.093725017e-01f}, {9.786828137e-01f, 2.053775797e-01f}, {4.829613148e-01f, -8.756416895e-01f}, {-8.390715291e-01f, -5.440211109e-01f}, {7.901318660e-01f, -6.129368926e-01f}, {-9.997860770e-01f, -2.068333150e-02f}, {-2.059976331e-01f, 9.785524897e-01f},
  {5.403023059e-01f, 8.414709848e-01f}, {8.460091064e-01f, 5.331684460e-01f}, {9.504152809e-01f, 3.109835909e-01f}, {9.842302348e-01f, 1.768921847e-01f}, {9.950041651e-01f, 9.983341813e-02f}, {9.984192780e-01f, 5.620449547e-02f}, {9.995000417e-01f, 3.161750470e-02f}, {9.998418903e-01f, 1.778185709e-02f},
  {8.920048698e-01f, 4.520257872e-01f}, {9.694527238e-01f, 2.452782427e-01f}, {8.662854932e-01f, 4.995492411e-01f}, {6.302406996e-01f, -7.763998072e-01f}, {-7.805679417e-01f, -6.250709467e-01f}, {8.233328271e-01f, -5.675588567e-01f}, {-9.986322645e-01f, -5.228384329e-02f}, {-2.233655562e-01f, 9.747347477e-01f},
  {5.318607295e-01f, 8.468318395e-01f}, {8.429975262e-01f, 5.379174387e-01f}, {9.494271181e-01f, 3.139874958e-01f}, {9.839141132e-01f, 1.786421505e-01f}, {9.949038340e-01f, 1.008283742e-01f}, {9.983875139e-01f, 5.676594140e-02f}, {9.994899934e-01f, 3.193357373e-02f}, {9.998387124e-01f, 1.795965543e-02f},
  {1.015857037e-01f, 9.948267914e-01f}, {6.893923357e-01f, 7.243881608e-01f}, {6.679785330e-01f, 7.441805423e-01f}, {7.576409417e-01f, -6.526715893e-01f}, {-7.142657855e-01f, -6.998745514e-01f}, {8.539305980e-01f, -5.203869078e-01f}, {-9.964799160e-01f, -8.383183766e-02f}, {-2.406628465e-01f, 9.706087751e-01f},
  {5.233659675e-01f, 8.521080120e-01f}, {8.399592882e-01f, 5.426494210e-01f}, {9.484294516e-01f, 3.169882891e-01f}, {9.835948828e-01f, 1.803915368e-01f}, {9.948025080e-01f, 1.018232295e-01f}, {9.983554343e-01f, 5.732736565e-02f}, {9.994798451e-01f, 3.224963957e-02f}, {9.998355028e-01f, 1.813745505e-02f},
  {-7.822308899e-01f, 6.229886314e-01f}, {1.970090633e-01f, 9.804016672e-01f}, {4.034298040e-01f, 9.150105973e-01f}, {8.611455722e-01f, -5.083584400e-01f}, {-6.408262712e-01f, -7.676859320e-01f}, {8.818289637e-01f, -4.715693786e-01f}, {-9.933311512e-01f, -1.152962447e-01f}, {-2.578840345e-01f, 9.661758767e-01f},
  {5.148188695e-01f, 8.572989745e-01f}, {8.368944560e-01f, 5.473642933e-01f}, {9.474223102e-01f, 3.199858843e-01f}, {9.832725421e-01f, 1.821403526e-01f}, {9.947001872e-01f, 1.028179829e-01f}, {9.983230390e-01f, 5.788877177e-02f}, {9.994695970e-01f, 3.256569846e-02f}, {9.998322617e-01f, 1.831525411e-02f},
  {-9.468680108e-01f, -3.216224032e-01f}, {-3.560463237e-01f, 9.344683063e-01f}, {9.887337000e-02f, 9.951000235e-01f}, {9.374901074e-01f, -3.480119230e-01f}, {-5.609837837e-01f, -8.278267901e-01f}, {9.069392526e-01f, -4.212614295e-01f}, {-9.891891661e-01f, -1.466451284e-01f}, {-2.750236744e-01f, 9.614374543e-01f},
  {5.062202901e-01f, 8.624042079e-01f}, {8.338031914e-01f, 5.520618064e-01f}, {9.464056851e-01f, 3.229803078e-01f}, {9.829470919e-01f, 1.838885924e-01f}, {9.945968724e-01f, 1.038126262e-01f}, {9.982903277e-01f, 5.845016330e-02f}, {9.994592488e-01f, 3.288175781e-02f}, {9.998289889e-01f, 1.849305072e-02f},
  {-2.409590492e-01f, -9.705352835e-01f}, {-7.994488075e-01f, 6.007342209e-01f}, {-2.154882311e-01f, 9.765064374e-01f}, {9.842666794e-01f, -1.766892861e-01f}, {-4.755369280e-01f, -8.796957600e-01f}, {9.291825053e-01f, -3.696212546e-01f}, {-9.840580399e-01f, -1.778476151e-01f}, {-2.920763464e-01f, 9.563950062e-01f},
  {4.975710893e-01f, 8.674232019e-01f}, {8.306855598e-01f, 5.567418619e-01f}, {9.453796055e-01f, 3.259714733e-01f}, {9.826185307e-01f, 1.856362654e-01f}, {9.944925623e-01f, 1.048071730e-01f}, {9.982573010e-01f, 5.901153264e-02f}, {9.994488007e-01f, 3.319781388e-02f}, {9.998256845e-01f, 1.867084861e-02f},
  {6.864865509e-01f, -7.271425001e-01f}, {-9.966333753e-01f, 8.198728756e-02f}, {-5.084800933e-01f, 8.610737453e-01f}, {9.999999788e-01f, 2.060413504e-04f}, {-3.853378388e-01f, -9.227755686e-01f}, {9.484880243e-01f, -3.168129854e-01f}, {-9.779429805e-01f, -2.088720345e-01f}, {-3.090365447e-01f, 9.510501638e-01f},
  {4.888721318e-01f, 8.723554544e-01f}, {8.275416598e-01f, 5.614043119e-01f}, {9.443440625e-01f, 3.289594073e-01f}, {9.822868650e-01f, 1.873833367e-01f}, {9.943872577e-01f, 1.058016150e-01f}, {9.982239586e-01f, 5.957288331e-02f}, {9.994382526e-01f, 3.351386663e-02f}, {9.998223485e-01f, 1.884864591e-02f},
  {9.827795820e-01f, 1.847817446e-01f}, {-8.868746619e-01f, -4.620101017e-01f}, {-7.510490434e-01f, 6.602464195e-01f}, {9.841937852e-01f, 1.770948704e-01f}, {-2.912894642e-01f, -9.566349607e-01f}, {9.647951032e-01f, -2.630026785e-01f}, {-9.708500105e-01f, -2.396878325e-01f}, {-3.258991334e-01f, 9.454045456e-01f},
  {4.801242876e-01f, 8.772004722e-01f}, {8.243715908e-01f, 5.660490088e-01f}, {9.432990858e-01f, 3.319440236e-01f}, {9.819520930e-01f, 1.891298155e-01f}, {9.942809587e-01f, 1.067959512e-01f}, {9.981903004e-01f, 6.013421886e-02f}, {9.994276047e-01f, 3.382991230e-02f}, {9.998189809e-01f, 1.902644076e-02f},
  {3.755095978e-01f, 9.268185054e-01f}, {-5.039728760e-01f, -8.637194801e-01f}, {-9.191339729e-01f, 3.939450974e-01f}, {9.373466181e-01f, 3.483982169e-01f}, {-1.943297194e-01f, -9.809362671e-01f}, {9.780520113e-01f, -2.083608964e-01f}, {-9.627863291e-01f, -2.702637314e-01f}, {-3.426586664e-01f, 9.394599717e-01f},
  {4.713284315e-01f, 8.819577709e-01f}, {8.211754191e-01f, 5.706758547e-01f}, {9.422446762e-01f, 3.349253204e-01f}, {9.816142129e-01f, 1.908757108e-01f}, {9.941736662e-01f, 1.077901732e-01f}, {9.981563267e-01f, 6.069553168e-02f}, {9.994168567e-01f, 3.414595831e-02f}, {9.998155816e-01f, 1.920423686e-02f},
  {-5.770021789e-01f, 8.167426066e-01f}, {3.414078174e-02f, -9.994170336e-01f}, {-9.960693628e-01f, 8.857665853e-02f}, {8.609360133e-01f, 5.087132600e-01f}, {-9.542828141e-02f, -9.954363079e-01f}, {9.882167644e-01f, -1.530608589e-01f}, {-9.537598777e-01f, -3.005696187e-01f}, {-3.593098438e-01f, 9.332183218e-01f},
  {4.624853373e-01f, 8.866269299e-01f}, {8.179533134e-01f, 5.752846053e-01f}, {9.411808341e-01f, 3.379032961e-01f}, {9.812732316e-01f, 1.926209879e-01f}, {9.940653787e-01f, 1.087842948e-01f}, {9.981220373e-01f, 6.125682530e-02f}, {9.994060088e-01f, 3.446200091e-02f}, {9.998121508e-01f, 1.938203235e-02f},
  {-9.990208133e-01f, -4.424267809e-02f}, {5.617429128e-01f, -8.273118516e-01f}, {-9.742256121e-01f, -2.255758335e-01f}, {7.573719227e-01f, 6.529837446e-01f}, {4.425697988e-03f, -9.999902066e-01f}, {9.952573993e-01f, -9.727645772e-02f}, {-9.437798181e-01f, -3.305747343e-01f}, {-3.758474003e-01f, 9.266815697e-01f},
  {4.535961002e-01f, 8.912073709e-01f}, {8.147053420e-01f, 5.798751639e-01f}, {9.401075903e-01f, 3.408778647e-01f}, {9.809291472e-01f, 1.943656558e-01f}, {9.939560972e-01f, 1.097783077e-01f}, {9.980874321e-01f, 6.181810327e-02f}, {9.993950610e-01f, 3.477804006e-02f}, {9.998086883e-01f, 1.955982537e-02f},
  {-5.025443191e-01f, -8.645514486e-01f}, {9.163355735e-01f, -4.004111845e-01f}, {-8.557689424e-01f, -5.173582098e-01f}, {6.299207052e-01f, 7.766594525e-01f}, {1.042364063e-01f, -9.945525484e-01f}, {9.991515381e-01f, -4.118499635e-02f}, {-9.328559791e-01f, -3.602495278e-01f}, {-3.922661065e-01f, 9.198517825e-01f},
  {4.446615039e-01f, 8.956986920e-01f}, {8.114316076e-01f, 5.844473854e-01f}, {9.390249353e-01f, 3.438490525e-01f}, {9.805819579e-01f, 1.961097238e-01f}, {9.938458217e-01f, 1.107722107e-01f}, {9.980525115e-01f, 6.237935797e-02f}, {9.993840133e-01f, 3.509407201e-02f}, {9.998051942e-01f, 1.973761964e-02f},
  {4.559691044e-01f, -8.899956044e-01f}, {9.887145094e-01f, 1.498119448e-01f}, {-6.524436848e-01f, -7.578372108e-01f}, {4.826021076e-01f, 8.758397147e-01f}, {2.030046771e-01f, -9.791777679e-01f}, {9.998869357e-01f, 1.503714472e-02f}, {-9.209993553e-01f, -3.895640993e-01f}, {-4.085607702e-01f, 9.127311198e-01f},
  {4.356824420e-01f, 9.001004443e-01f}, {8.081322136e-01f, 5.890011251e-01f}, {9.379329003e-01f, 3.468167738e-01f}, {9.802316707e-01f, 1.978531569e-01f}, {9.937345532e-01f, 1.117659956e-01f}, {9.980172753e-01f, 6.294059295e-02f}, {9.993728656e-01f, 3.541010418e-02f}, {9.998016685e-01f, 1.991541328e-02f},
  {9.952666362e-01f, -9.718190589e-02f}, {7.565874902e-01f, 6.538924757e-01f}, {-3.844182537e-01f, -9.231590362e-01f}, {3.200624839e-01f, 9.473964357e-01f}, {2.997455252e-01f, -9.540191927e-01f}, {9.974612549e-01f, 7.121127068e-02f}, {-9.082219023e-01f, -4.184889199e-01f}, {-4.247261310e-01f, 9.053218840e-01f},
  {4.266598122e-01f, 9.044121873e-01f}, {8.048072290e-01f, 5.935362871e-01f}, {9.368314756e-01f, 3.497810550e-01f}, {9.798782838e-01f, 1.995959644e-01f}, {9.936222901e-01f, 1.127596761e-01f}, {9.979817235e-01f, 6.350180803e-02f}, {9.993616180e-01f, 3.572613280e-02f}, {9.997981112e-01f, 2.009320443e-02f},
  {6.195206126e-01f, 7.849803887e-01f}, {2.914465538e-01f, 9.565871138e-01f}, {-7.827047274e-02f, -9.969321607e-01f}, {1.474282516e-01f, 9.890727530e-01f}, {3.934913924e-01f, -9.193283005e-01f}, {9.918821230e-01f, 1.271607411e-01f}, {-8.945362039e-01f, -4.469955032e-01f}, {-4.407574007e-01f, 8.976262662e-01f},
  {4.175945170e-01f, 9.086334901e-01f}, {8.014568295e-01f, 5.980526319e-01f}, {9.357206930e-01f, 3.527418104e-01f}, {9.795217952e-01f, 2.013381554e-01f}, {9.935090334e-01f, 1.137532439e-01f}, {9.979458556e-01f, 6.406301046e-02f}, {9.993502704e-01f, 3.604215785e-02f}, {9.997945222e-01f, 2.027099680e-02f},
  {-3.258098052e-01f, 9.454353340e-01f}, {-2.634541314e-01f, 9.646719238e-01f}, {2.356393079e-01f, -9.718405819e-01f}, {-2.985579311e-02f, 9.995542164e-01f}, {4.833047588e-01f, -8.754521747e-01f}, {9.831672727e-01f, 1.827077279e-01f}, {-8.799561509e-01f, -4.750549152e-01f}, {-4.566490802e-01f, 8.896469061e-01f},
  {4.084874626e-01f, 9.127639305e-01f}, {7.980810859e-01f, 6.025500646e-01f}, {9.346005532e-01f, 3.556990384e-01f}, {9.791622120e-01f, 2.030796950e-01f}, {9.933947841e-01f, 1.147466905e-01f}, {9.979096726e-01f, 6.462418519e-02f}, {9.993388230e-01f, 3.635817558e-02f}, {9.997909017e-01f, 2.044878854e-02f},
  {-9.715921906e-01f, 2.366613934e-01f}, {-7.372213326e-01f, 6.756513203e-01f}, {5.261809886e-01f, -8.503726049e-01f}, {-2.061982012e-01f, 9.785102461e-01f}, {5.682899437e-01f, -8.228283782e-01f}, {9.713441080e-01f, 2.376775627e-01f}, {-8.644961024e-01f, -5.026395219e-01f}, {-4.723965703e-01f, 8.813861131e-01f},
  {3.993395600e-01f, 9.168030954e-01f}, {7.946801049e-01f, 6.070284433e-01f}, {9.334710569e-01f, 3.586527372e-01f}, {9.787995325e-01f, 2.048205925e-01f}, {9.932795405e-01f, 1.157400297e-01f}, {9.978731741e-01f, 6.518533949e-02f}, {9.993272755e-01f, 3.667419339e-02f}, {9.997872495e-01f, 2.062657776e-02f},
  {-7.240971967e-01f, -6.896979409e-01f}, {-9.839316487e-01f, 1.785455423e-01f}, {7.645443186e-01f, -6.445711636e-01f}, {-3.760372225e-01f, 9.266045582e-01f}, {6.475961933e-01f, -7.619837074e-01f}, {9.564502073e-01f, 2.918955309e-01f}, {-8.481717500e-01f, -5.297213253e-01f}, {-4.879944690e-01f, 8.728467209e-01f},
  {3.901517238e-01f, 9.207505810e-01f}, {7.912539576e-01f, 6.114876732e-01f}, {9.323322365e-01f, 3.616028218e-01f}, {9.784337548e-01f, 2.065608568e-01f}, {9.931633036e-01f, 1.167332532e-01f}, {9.978363600e-01f, 6.574647317e-02f}, {9.993156281e-01f, 3.699020753e-02f}, {9.997835657e-01f, 2.080436820e-02f},
  {1.891294205e-01f, -9.819521690e-01f}, {-9.276105631e-01f, -3.735487159e-01f}, {9.270853567e-01f, -3.748502919e-01f}, {-5.340162202e-01f, 8.454742318e-01f}, {7.204326113e-01f, -6.935249474e-01f}, {9.385324046e-01f, 3.451911433e-01f}, {-8.309991709e-01f, -5.562736539e-01f}, {-5.034382623e-01f, 8.640312009e-01f},
  {3.809248729e-01f, 9.246059924e-01f}, {7.878028251e-01f, 6.159275191e-01f}, {9.311840821e-01f, 3.645493180e-01f}, {9.780648860e-01f, 2.083004533e-01f}, {9.930460735e-01f, 1.177263600e-01f}, {9.977992303e-01f, 6.630758607e-02f}, {9.993038808e-01f, 3.730621798e-02f}, {9.997798503e-01f, 2.098215797e-02f},
  {9.284713207e-01f, -3.714041014e-01f}, {-5.856038514e-01f, -8.105973903e-01f}, {9.976883249e-01f, -6.795591499e-02f}, {-6.751540238e-01f, 7.376767884e-01f}, {7.860706498e-01f, -6.181366624e-01f}, {9.176476495e-01f, 3.973950068e-01f}, {-8.129957948e-01f, -5.822695575e-01f}, {-5.187226524e-01f, 8.549425770e-01f},
  {3.716599298e-01f, 9.283689442e-01f}, {7.843267803e-01f, 6.203478877e-01f}, {9.300266266e-01f, 3.674921411e-01f}, {9.776929243e-01f, 2.100393912e-01f}, {9.929278513e-01f, 1.187193417e-01f}, {9.977617851e-01f, 6.686867800e-02f}, {9.992920336e-01f, 3.762222097e-02f}, {9.997761033e-01f, 2.115994522e-02f},
  {8.141809705e-01f, 5.806111842e-01f}, {-6.324278670e-02f, -9.979981713e-01f}, {9.693516017e-01f, 2.456775778e-01f}, {-7.949961987e-01f, 6.066144113e-01f}, {8.438539587e-01f, -5.365729180e-01f}, {8.938616142e-01f, 4.483429653e-01f}, {-7.941793525e-01f, -6.076834341e-01f}, {-5.338430142e-01f, 8.455836068e-01f},
  {3.623578211e-01f, 9.320390600e-01f}, {7.808259330e-01f, 6.247486393e-01f}, {9.288598600e-01f, 3.704313169e-01f}, {9.773178677e-01f, 2.117776794e-01f}, {9.928086353e-01f, 1.197122120e-01f}, {9.977240240e-01f, 6.742975621e-02f}, {9.992800864e-01f, 3.793822392e-02f}, {9.997723246e-01f, 2.133773367e-02f},
  {-4.866360920e-02f, 9.988152247e-01f}, {4.786024988e-01f, -8.780316897e-01f}, {8.448832693e-01f, 5.349507092e-01f}, {-8.897645961e-01f, 4.564197229e-01f}, {8.932062830e-01f, -4.496471238e-01f}, {8.672498998e-01f, 4.978730876e-01f}, {-7.745689422e-01f, -6.324894891e-01f}, {-5.487947659e-01f, 8.359571191e-01f},
  {3.530194771e-01f, 9.356159729e-01f}, {7.773003940e-01f, 6.291296348e-01f}, {9.276838157e-01f, 3.733667607e-01f}, {9.769397237e-01f, 2.135152833e-01f}, {9.926884264e-01f, 1.207049626e-01f}, {9.976859478e-01f, 6.799080567e-02f}, {9.992680393e-01f, 3.825422308e-02f}, {9.997685144e-01f, 2.151551958e-02f},
  {-8.667670911e-01f, 4.987131539e-01f}, {8.730401082e-01f, -4.876484076e-01f}, {6.366296978e-01f, 7.711696493e-01f}, {-9.564702688e-01f, 2.918297875e-01f}, {9.336335757e-01f, -3.582294603e-01f}, {8.378961870e-01f, 5.458296252e-01f}, {-7.541838773e-01f, -6.566632922e-01f}, {-5.635727784e-01f, 8.260664159e-01f},
  {3.436457194e-01f, 9.390993662e-01f}, {7.737502371e-01f, 6.334907818e-01f}, {9.264984948e-01f, 3.762984709e-01f}, {9.765584904e-01f, 2.152522121e-01f}, {9.925672249e-01f, 1.216975926e-01f}, {9.976475561e-01f, 6.855183363e-02f}, {9.992558923e-01f, 3.857021841e-02f}, {9.997646725e-01f, 2.169330666e-02f},
  {-8.879689067e-01f, -4.599034907e-01f}, {9.985987075e-01f, 5.292089673e-02f}, {3.652422354e-01f, 9.309125144e-01f}, {-9.930093536e-01f, 1.180356885e-01f}, {9.647326681e-01f, -2.632316074e-01f}, {8.058937730e-01f, 5.920601546e-01f}, {-7.330448482e-01f, -6.801803074e-01f}, {-5.781727749e-01f, 8.159143597e-01f},
  {3.342377091e-01f, 9.424888083e-01f}, {7.701756497e-01f, 6.378318498e-01f}, {9.253038976e-01f, 3.792264457e-01f}, {9.761741690e-01f, 2.169884602e-01f}, {9.924450317e-01f, 1.226900934e-01f}, {9.976088489e-01f, 6.911283990e-02f}, {9.992436454e-01f, 3.888620616e-02f}, {9.997607990e-01f, 2.187109307e-02f},
  {-9.277620460e-02f, -9.956869869e-01f}, {8.166087424e-01f, 5.771916162e-01f}, {5.763408854e-02f, 9.983377744e-01f}, {-9.982294262e-01f, -5.948119644e-02f}, {9.861923970e-01f, -1.656036111e-01f}, {7.713432897e-01f, 6.364193032e-01f}, {-7.111726737e-01f, -7.030173740e-01f}, {-5.925897472e-01f, 8.055044329e-01f},
  {3.247962754e-01f, 9.457840025e-01f}, {7.665767074e-01f, 6.421527480e-01f}, {9.241000586e-01f, 3.821506007e-01f}, {9.757867573e-01f, 2.187240366e-01f}, {9.923218452e-01f, 1.236824789e-01f}, {9.975698262e-01f, 6.967382433e-02f}, {9.992312986e-01f, 3.920219375e-02f}, {9.997568940e-01f, 2.204887692e-02f},
  {7.877145121e-01f, -6.160404592e-01f}, {3.831195069e-01f, 9.236987839e-01f}, {-2.556895696e-01f, 9.667589379e-01f}, {-9.719658482e-01f, -2.351220745e-01f}, {9.977982792e-01f, -6.632189735e-02f}, {7.343545514e-01f, 6.787660811e-01f}, {-6.885895538e-01f, -7.251513128e-01f}, {-6.068195228e-01f, 7.948396484e-01f},
  {3.153223624e-01f, 9.489846194e-01f}, {7.629535240e-01f, 6.464533396e-01f}, {9.228869673e-01f, 3.850709617e-01f}, {9.753962633e-01f, 2.204589068e-01f}, {9.921976672e-01f, 1.246747334e-01f}, {9.975304881e-01f, 7.023478672e-02f}, {9.992188517e-01f, 3.951817742e-02f}, {9.997529572e-01f, 2.222666193e-02f},
  {9.439841392e-01f, 3.299908257e-01f}, {-1.683704464e-01f, 9.857237913e-01f}, {-5.436599665e-01f, 8.393055706e-01f}, {-9.150469596e-01f, -4.033473215e-01f}, {9.994345727e-01f, 3.362342848e-02f}, {6.950438698e-01f, 7.189673282e-01f}, {-6.653177293e-01f, -7.465603252e-01f}, {-6.208572206e-01f, 7.839236644e-01f},
  {3.058169175e-01f, 9.520903387e-01f}, {7.593061752e-01f, 6.507335340e-01f}, {9.216646586e-01f, 3.879874445e-01f}, {9.750026847e-01f, 2.221930799e-01f}, {9.920724962e-01f, 1.256668706e-01f}, {9.974908340e-01f, 7.079573433e-02f}, {9.992063050e-01f, 3.983415713e-02f}, {9.997489889e-01f, 2.240444624e-02f},
  {2.323591020e-01f, 9.726300672e-01f}, {-6.679985997e-01f, 7.441625298e-01f}, {-7.777124942e-01f, 6.286201368e-01f}, {-8.292679533e-01f, -5.588511981e-01f}, {9.910848972e-01f, 1.332318524e-01f}, {6.535361888e-01f, 7.568952701e-01f}, {-6.413808207e-01f, -7.672226814e-01f}, {-6.346987778e-01f, 7.727596402e-01f},
  {2.962808911e-01f, 9.551008499e-01f}, {7.556348538e-01f, 6.549931051e-01f}, {9.204331217e-01f, 3.909000749e-01f}, {9.746060196e-01f, 2.239265649e-01f}, {9.919463330e-01f, 1.266588821e-01f}, {9.974508651e-01f, 7.135665213e-02f}, {9.991936585e-01f, 4.015012914e-02f}, {9.997449890e-01f, 2.258222798e-02f},
};

namespace pg8 {
#define PG8_LAS __attribute__((address_space(3)))
typedef unsigned short bf16_t;
typedef short bf16x8 __attribute__((ext_vector_type(8)));
typedef float f32x4 __attribute__((ext_vector_type(4)));
typedef unsigned u32x4 __attribute__((ext_vector_type(4)));
constexpr int BM = 256, BK = 64, HALF = 128, HTB = HALF * BK * 2  , STAGE_BYTES = 8 * HTB, NXCD = 8, WGM = 8;

__host__ __device__ __forceinline__ int lds_byte(int r, int c) { const int st = (r >> 4) * 2 + (c >> 5), rr = r & 15, cc = c & 31, ob = rr * 64 + cc * 2; return st * 1024 + (ob ^ (((ob >> 9) & 1) << 5)); }
__host__ __device__ __forceinline__ void stage_rc(int b, int& R, int& C) { const int st = b / 1024, sb = b % 1024, swz = sb ^ (((sb >> 9) & 1) << 5); R = (st >> 1) * 16 + swz / 64; C = (st & 1) * 32 + (swz % 64) / 2; }
__host__ __device__ __forceinline__ int perm32(int rho) { const int n = rho >> 4, i = rho & 15; return 8 * (i >> 2) + 4 * n + (i & 3); }

struct Unit { int pm, pn, ko, ks; };
struct Gemm { const bf16_t* A; const bf16_t* Bt; int M, N, K, ld; };

struct StaticOrder {
    int nM, nN, nwg, G, c;
    __host__ __device__ void init(int M, int N, int G_, int c_) { nM = M / BM; nN = N / BM; nwg = nM * nN; G = G_; c = c_; }
    __host__ __device__ bool next(int i, Unit& u) const {
        const int L = i * G + c; if (L >= nwg) return false;
        int wgid = L; { const int q = nwg / NXCD, r = nwg % NXCD, xcd = wgid % NXCD, off = wgid / NXCD; wgid = (xcd < r ? xcd * (q + 1) : r * (q + 1) + (xcd - r) * q) + off; }
        const int nig = WGM * nN, gid = wgid / nig, fm = gid * WGM, gsz = (nM - fm) < WGM ? (nM - fm) : WGM;
        u.pm = fm + ((wgid % nig) % gsz); u.pn = (wgid % nig) / gsz; u.ko = 0; u.ks = 0; return true;
    }
    __device__ __forceinline__ void a_ready(const Unit&) const {}
    __device__ __forceinline__ void done(const Unit&) const {}
};

struct SplitKOrder {
    int nN, nS, kchunk, G, c;
    __host__ __device__ void init(int N, int nS_, int kchunk_, int G_, int c_) { nN = N / BM; nS = nS_; kchunk = kchunk_; G = G_; c = c_; }
    __host__ __device__ bool next(int i, Unit& u) const { const int L = i * G + c; if (L >= nN * nS) return false; u.pm = 0; u.pn = L % nN; u.ks = L / nN; u.ko = u.ks * kchunk; return true; }
    __device__ __forceinline__ void a_ready(const Unit&) const {}
    __device__ __forceinline__ void done(const Unit&) const {}
};
__device__ __forceinline__ unsigned cvt_pk_bf16(float lo, float hi) { unsigned r; asm volatile("v_cvt_pk_bf16_f32 %0, %1, %2" : "=v"(r) : "v"(lo), "v"(hi)); return r; }
typedef float f32x2 __attribute__((ext_vector_type(2)));
typedef unsigned u32x2 __attribute__((ext_vector_type(2)));
typedef float f32x2 __attribute__((ext_vector_type(2)));
template <int MODE> struct EpiBf16R {
    static constexpr bool PERM = false, AFTER_DRAIN = false;
    bf16_t* O; bf16_t* O2; const f32x2* rope;
    __device__ __forceinline__ void operator()(const f32x4 (&acc)[2][2][4][2], const Unit& u, int wr, int wc, int fr, int fq) const {
        asm volatile("" : "+v"(fr), "+v"(fq));
#pragma unroll
        for (int bj = 0; bj < 2; ++bj) {
            const int cg0 = u.pn * BM + bj * HALF + wc * 32;
            bool dorope = false; int axis = 0; bf16_t* base = O; int ldc = 0, dcol = 0;
            if (MODE == 0) { dorope = (cg0 >= 1536 && cg0 < 2560) || (cg0 >= 5248 && cg0 < 5312); axis = (cg0 >> 5) & 1; ldc = 5376; dcol = cg0; }
            else if (MODE == 1) { const int w = cg0 % 192; dorope = w >= 128; axis = ((w - 128) >> 5) & 1; ldc = 768; dcol = cg0; }
            else { if (bj == 0) { base = O; ldc = 768; dcol = u.pn * 192 + wc * 32; } else { base = O2; ldc = 512; dcol = u.pn * 128 + wc * 32; } }
            dorope = dorope && (u.pm < 32);
#pragma unroll
            for (int ai = 0; ai < 2; ++ai)
#pragma unroll
                for (int m = 0; m < 4; ++m) {
                    const int row = u.pm * BM + ai * HALF + wr * 64 + m * 16 + fr;
                    f32x4 v0 = acc[ai][bj][m][0], v1 = acc[ai][bj][m][1];
                    if (dorope) {
                        const int pos = axis ? (row & 63) : (row >> 6);
                        const f32x2* rp = rope + pos * 16 + 4 * fq;
                        f32x4 o0, o1;
#pragma unroll
                        for (int i = 0; i < 4; ++i) { const f32x2 cs = rp[i]; o0[i] = v0[i] * cs.x - v1[i] * cs.y; o1[i] = v1[i] * cs.x + v0[i] * cs.y; }
                        v0 = o0; v1 = o1;
                    }
                    bf16_t* p = base + (size_t)row * ldc + dcol + 4 * fq;
                    u32x2 w0, w1; w0.x = cvt_pk_bf16(v0[0], v0[1]); w0.y = cvt_pk_bf16(v0[2], v0[3]); w1.x = cvt_pk_bf16(v1[0], v1[1]); w1.y = cvt_pk_bf16(v1[2], v1[3]);
                    *(u32x2*)p = w0; *(u32x2*)(p + 16) = w1;
                }
        }
    }
};
struct EpiResid {
    static constexpr bool PERM = false, AFTER_DRAIN = false;
    const float* xres; float* out; const float* gate_lat; const float* gate_ctx;
    __device__ __forceinline__ void operator()(const f32x4 (&acc)[2][2][4][2], const Unit& u, int wr, int wc, int fr, int fq) const {
        asm volatile("" : "+v"(fr), "+v"(fq));
        const int col0 = u.pn * BM + wc * 32 + 4 * fq;
        const float* gate = (u.pm >= 32) ? gate_ctx : gate_lat;
#pragma unroll
        for (int bj = 0; bj < 2; ++bj)
#pragma unroll
            for (int n = 0; n < 2; ++n) {
                const f32x4 gv = *(const f32x4*)(gate + col0 + bj * HALF + n * 16);
#pragma unroll
                for (int ai = 0; ai < 2; ++ai)
#pragma unroll
                    for (int m = 0; m < 4; ++m) {
                        const size_t off = (size_t)(u.pm * BM + ai * HALF + wr * 64 + m * 16 + fr) * 2048 + col0 + bj * HALF + n * 16;
                        const f32x4 xr = *(const f32x4*)(xres + off);
                        *(f32x4*)(out + off) = xr * 1.4142135623730951f + gv * acc[ai][bj][m][n];
                    }
            }
    }
};
struct EpiSwiglu {
    static constexpr bool PERM = true, AFTER_DRAIN = false;
    bf16_t* O;
    __device__ __forceinline__ void operator()(const f32x4 (&acc)[2][2][4][2], const Unit& u, int wr, int wc, int fr, int fq) const {
        asm volatile("" : "+v"(fr), "+v"(fq));
        const int col0 = u.pn * HALF + wc * 32 + 8 * fq;
#pragma unroll
        for (int ai = 0; ai < 2; ++ai)
#pragma unroll
            for (int m = 0; m < 4; ++m) {
                const int row = u.pm * BM + ai * HALF + wr * 64 + m * 16 + fr;
                float a[8];
#pragma unroll
                for (int n = 0; n < 2; ++n)
#pragma unroll
                    for (int i = 0; i < 4; ++i) { const float g = acc[ai][0][m][n][i], up = acc[ai][1][m][n][i]; a[n * 4 + i] = g / (1.0f + __expf(-g)) * up; }
                u32x4 w; w.x = cvt_pk_bf16(a[0], a[1]); w.y = cvt_pk_bf16(a[2], a[3]); w.z = cvt_pk_bf16(a[4], a[5]); w.w = cvt_pk_bf16(a[6], a[7]);
                *(u32x4*)(O + (size_t)row * 5632 + col0) = w;
            }
    }
};

struct EpiPart {
    static constexpr bool PERM = false, AFTER_DRAIN = false;
    float* part;
    __device__ __forceinline__ void operator()(const f32x4 (&acc)[2][2][4][2], const Unit& u, int wr, int wc, int fr, int fq) const {
        asm volatile("" : "+v"(fr), "+v"(fq));
        const int col0 = u.pn * BM + wc * 32 + 4 * fq;
        float* base = part + (size_t)u.ks * 256 * 2048;
#pragma unroll
        for (int bj = 0; bj < 2; ++bj)
#pragma unroll
            for (int n = 0; n < 2; ++n)
#pragma unroll
                for (int ai = 0; ai < 2; ++ai)
#pragma unroll
                    for (int m = 0; m < 4; ++m) {
                        const size_t off = (size_t)(ai * HALF + wr * 64 + m * 16 + fr) * 2048 + col0 + bj * HALF + n * 16;
                        *(f32x4*)(base + off) = acc[ai][bj][m][n];
                    }
    }
};

template <class Epi, class Sched, bool ALIGN_EPI = false, bool SP2 = false>
__device__ __forceinline__ void gemm_phase(PG8_LAS unsigned char* lds, const Gemm g, const Sched& S, const Epi& E) {
    const int tid = ltid(), wid = __builtin_amdgcn_readfirstlane(tid >> 6), lane = tid & 63, wr = wid >> 2, wc = wid & 3, fr = lane & 15, fq = lane >> 4;
    const int K = g.K, LD = g.ld, nt = K / BK;
    unsigned voffA[2], voffB[2];
#pragma unroll
    for (int i = 0; i < 2; ++i) { int R, C; stage_rc(tid * 16 + i * 8192, R, C); const int Rb = Epi::PERM ? ((R & ~31) + perm32(R & 31)) : R;
        voffA[i] = (unsigned)(R * LD + C) * 2u; voffB[i] = (unsigned)(Rb * LD + C) * 2u; }
    const size_t kstep = (size_t)(BK * 2);
    const size_t hstep = (size_t)HALF * LD * 2;
    const size_t tstep = 2 * hstep;
    const unsigned ldsw = (unsigned)wid * 1024u;
    const int aoff = lds_byte(wr * 64 + fr, fq * 8), boff = lds_byte(wc * 32 + fr, fq * 8);
#define PG8_SA(b, h) (((b) * 2 + (h)) * HTB)
#define PG8_SB(b, h) ((4 + (b) * 2 + (h)) * HTB)
#define PG8_STAGE(bufoff, gbase, voff) do { _Pragma("unroll") for (int _i = 0; _i < 2; ++_i) \
        __builtin_amdgcn_global_load_lds((const unsigned*)((const char*)(gbase) + (voff)[_i]), (PG8_LAS unsigned*)(lds + (bufoff) + ldsw + _i * 8192), 16, 0, 0); } while (0)
#define PG8_LDA(dst, b, h) do { _Pragma("unroll") for (int m = 0; m < 4; ++m) _Pragma("unroll") for (int k = 0; k < 2; ++k) dst[m][k] = *(const PG8_LAS bf16x8*)(lds + PG8_SA(b, h) + aoff + m * 2048 + k * 1024); } while (0)
#define PG8_LDB(dst, b, h) do { _Pragma("unroll") for (int n = 0; n < 2; ++n) _Pragma("unroll") for (int k = 0; k < 2; ++k) dst[n][k] = *(const PG8_LAS bf16x8*)(lds + PG8_SB(b, h) + boff + n * 2048 + k * 1024); } while (0)
#define PG8_MMA(ai, bj, At, Bt) do { __builtin_amdgcn_s_setprio(1); _Pragma("unroll") for (int m = 0; m < 4; ++m) _Pragma("unroll") for (int n = 0; n < 2; ++n) _Pragma("unroll") for (int k = 0; k < 2; ++k) \
        acc[ai][bj][m][n] = __builtin_amdgcn_mfma_f32_16x16x32_bf16(Bt[n][k], At[m][k], acc[ai][bj][m][n], 0, 0, 0); __builtin_amdgcn_s_setprio(0); } while (0)
#define PG8_WAIT_V(n) asm volatile("s_waitcnt vmcnt(" #n ")" ::: "memory")
#define PG8_WAIT_L(n) asm volatile("s_waitcnt lgkmcnt(" #n ")" ::: "memory")
#define PG8_BAR __builtin_amdgcn_s_barrier()
#define PG8_SCHED __builtin_amdgcn_sched_barrier(0)
    Unit cur, nxt; int ui = 0;
    if (!S.next(0, cur)) return;
    f32x4 acc[2][2][4][2];
#pragma unroll
    for (int a = 0; a < 2; ++a)
#pragma unroll
        for (int b = 0; b < 2; ++b)
#pragma unroll
            for (int m = 0; m < 4; ++m)
#pragma unroll
                for (int n = 0; n < 2; ++n) acc[a][b][m][n] = (f32x4){0.f, 0.f, 0.f, 0.f};
    bf16x8 At[4][2], B0[2][2], B1[2][2];
    const char* cA = (const char*)g.A + (size_t)cur.pm * tstep + (size_t)cur.ko * 2; const char* cB = (const char*)g.Bt + (size_t)cur.pn * tstep + (size_t)cur.ko * 2;
    S.a_ready(cur);
    if constexpr (SP2) {
        PG8_STAGE(PG8_SB(0, 0), cB, voffB); PG8_STAGE(PG8_SB(0, 1), cB + hstep, voffB); PG8_STAGE(PG8_SA(0, 0), cA, voffA); PG8_STAGE(PG8_SA(0, 1), cA + hstep, voffA);
        if (wr == 1) PG8_BAR;
        PG8_WAIT_V(2); PG8_BAR;
        PG8_STAGE(PG8_SB(1, 0), cB + kstep, voffB); PG8_STAGE(PG8_SA(1, 0), cA + kstep, voffA); PG8_STAGE(PG8_SB(1, 1), cB + hstep + kstep, voffB);
        PG8_WAIT_V(6); PG8_BAR;
    } else {
        PG8_STAGE(PG8_SB(0, 0), cB, voffB); PG8_STAGE(PG8_SA(0, 0), cA, voffA); PG8_STAGE(PG8_SB(0, 1), cB + hstep, voffB); PG8_STAGE(PG8_SA(0, 1), cA + hstep, voffA);
        if (wr == 1) PG8_BAR;
        PG8_WAIT_V(4); PG8_BAR;
        PG8_STAGE(PG8_SB(1, 0), cB + kstep, voffB); PG8_STAGE(PG8_SA(1, 0), cA + kstep, voffA); PG8_STAGE(PG8_SB(1, 1), cB + hstep + kstep, voffB);
        PG8_WAIT_V(6); PG8_BAR;
    }
    for (;;) {
        const bool has_next = S.next(ui + 1, nxt);
        const char* nA = has_next ? (const char*)g.A + (size_t)nxt.pm * tstep + (size_t)nxt.ko * 2 : cA; const char* nB = has_next ? (const char*)g.Bt + (size_t)nxt.pn * tstep + (size_t)nxt.ko * 2 : cB;
        for (int t = 0; t < nt; t += 2) {
            const bool last = (t == nt - 2);
            const char* a1 = cA + (size_t)(t + 1) * kstep;
            const char* a2 = last ? nA : cA + (size_t)(t + 2) * kstep; const char* b2 = last ? nB : cB + (size_t)(t + 2) * kstep;
            const char* a3 = a2 + kstep; const char* b3 = b2 + kstep;
            if (last && has_next) S.a_ready(nxt);
            if constexpr (SP2) {
            PG8_LDB(B0, 0, 0); PG8_LDB(B1, 0, 1); PG8_SCHED; PG8_LDA(At, 0, 0); PG8_STAGE(PG8_SA(1, 1), a1 + hstep, voffA);
            PG8_WAIT_V(8); PG8_WAIT_L(0); PG8_BAR; PG8_MMA(0, 0, At, B0); PG8_MMA(0, 1, At, B1); PG8_BAR; PG8_SCHED;
            PG8_LDA(At, 0, 1); PG8_STAGE(PG8_SB(0, 0), b2, voffB); PG8_STAGE(PG8_SB(0, 1), b2 + hstep, voffB); PG8_STAGE(PG8_SA(0, 0), a2, voffA);
            PG8_WAIT_V(8); PG8_WAIT_L(0); PG8_BAR; PG8_MMA(1, 0, At, B0); PG8_MMA(1, 1, At, B1); PG8_BAR; PG8_SCHED;
            PG8_LDB(B0, 1, 0); PG8_LDB(B1, 1, 1); PG8_SCHED; PG8_LDA(At, 1, 0); PG8_STAGE(PG8_SA(0, 1), a2 + hstep, voffA);
            PG8_WAIT_V(8); PG8_WAIT_L(0); PG8_BAR; PG8_MMA(0, 0, At, B0); PG8_MMA(0, 1, At, B1); PG8_BAR; PG8_SCHED;
            PG8_LDA(At, 1, 1); PG8_STAGE(PG8_SB(1, 0), b3, voffB); PG8_STAGE(PG8_SB(1, 1), b3 + hstep, voffB); PG8_STAGE(PG8_SA(1, 0), a3, voffA);
            PG8_WAIT_V(8); PG8_WAIT_L(0); PG8_BAR; PG8_MMA(1, 0, At, B0); PG8_MMA(1, 1, At, B1); PG8_BAR; PG8_SCHED;
            } else {
            PG8_LDB(B0, 0, 0); PG8_SCHED; PG8_LDA(At, 0, 0); PG8_STAGE(PG8_SA(1, 1), a1 + hstep, voffA);
            PG8_WAIT_L(8); PG8_BAR; PG8_WAIT_L(0); PG8_MMA(0, 0, At, B0); PG8_BAR; PG8_SCHED;
            PG8_LDB(B1, 0, 1); PG8_STAGE(PG8_SB(0, 0), b2, voffB);
            PG8_BAR; PG8_WAIT_L(0); PG8_MMA(0, 1, At, B1); PG8_BAR;
            PG8_LDA(At, 0, 1); PG8_STAGE(PG8_SA(0, 0), a2, voffA);
            PG8_BAR; PG8_WAIT_L(0); PG8_MMA(1, 0, At, B0); PG8_BAR; PG8_SCHED;
            PG8_STAGE(PG8_SB(0, 1), b2 + hstep, voffB);
            PG8_WAIT_V(6); PG8_BAR; PG8_MMA(1, 1, At, B1); PG8_BAR;
            PG8_LDB(B0, 1, 0); PG8_SCHED; PG8_LDA(At, 1, 0); PG8_STAGE(PG8_SA(0, 1), a2 + hstep, voffA);
            PG8_WAIT_L(8); PG8_BAR; PG8_WAIT_L(0); PG8_MMA(0, 0, At, B0); PG8_BAR; PG8_SCHED;
            PG8_LDB(B1, 1, 1); PG8_STAGE(PG8_SB(1, 0), b3, voffB);
            PG8_BAR; PG8_WAIT_L(0); PG8_MMA(0, 1, At, B1); PG8_BAR;
            PG8_LDA(At, 1, 1); PG8_STAGE(PG8_SA(1, 0), a3, voffA);
            PG8_BAR; PG8_WAIT_L(0); PG8_MMA(1, 0, At, B0); PG8_BAR; PG8_SCHED;
            PG8_STAGE(PG8_SB(1, 1), b3 + hstep, voffB);
            PG8_WAIT_V(6); PG8_BAR; PG8_MMA(1, 1, At, B1); PG8_BAR;
            }
        }
        if constexpr (ALIGN_EPI) { if (wr == 0) PG8_BAR; }
        if constexpr (!Epi::AFTER_DRAIN) { E(acc, cur, wr, wc, fr, fq); S.done(cur); }
        if (!has_next) break;
#pragma unroll
        for (int a = 0; a < 2; ++a)
#pragma unroll
            for (int b = 0; b < 2; ++b)
#pragma unroll
                for (int m = 0; m < 4; ++m)
#pragma unroll
                    for (int n = 0; n < 2; ++n) acc[a][b][m][n] = (f32x4){0.f, 0.f, 0.f, 0.f};
        cur = nxt; cA = nA; cB = nB; ++ui;
        if constexpr (ALIGN_EPI) { if (wr == 1) PG8_BAR; }
    }
    PG8_WAIT_V(0);
    if constexpr (!ALIGN_EPI) { if (wr == 0) PG8_BAR; }
    PG8_BAR;
    if constexpr (Epi::AFTER_DRAIN) { E.fused(acc, cur, wr, wc, fr, fq, lds, wid, lane); S.done(cur); }
#undef PG8_SA
#undef PG8_SB
#undef PG8_STAGE
#undef PG8_LDA
#undef PG8_LDB
#undef PG8_MMA
#undef PG8_WAIT_V
#undef PG8_WAIT_L
#undef PG8_BAR
#undef PG8_SCHED
}
}
namespace att {
typedef unsigned short bf16_t;
using bf16x8 = __attribute__((ext_vector_type(8))) short;
using s16x4  = __attribute__((ext_vector_type(4))) short;
using f32x16 = __attribute__((ext_vector_type(16))) float;
using u32x4  = __attribute__((ext_vector_type(4))) unsigned;
constexpr int NW = 8, QBLK = 32, KVBLK = 64, DV = 128;
constexpr float THR = 8.f;
#define SBAR() __builtin_amdgcn_sched_barrier(0)
__device__ __forceinline__ int crow(int r, int hi) { return (r & 3) + 8 * (r >> 2) + 4 * hi; }
__device__ __forceinline__ unsigned cvtpk(float lo, float hi) { unsigned r; asm volatile("v_cvt_pk_bf16_f32 %0, %1, %2" : "=v"(r) : "v"(lo), "v"(hi)); return r; }
template <int DQK> struct Cfg {
    static constexpr float SCALE = (DQK == 64) ? 0.125f : 0.07216878364870322f;
    static constexpr int KROWB = DQK * 2, SHM_K = KVBLK * DQK * 2, SHM_V = KVBLK * DV * 2, NP = DQK / 64, ND0 = DQK / 16;
    static constexpr int NQR = (DQK == 192) ? 12 : ND0;
    static constexpr int SHM_Q = (ND0 - NQR) * 16 * 2 * 256;
    static constexpr int SHM = 2 * SHM_V + 2 * SHM_K + NW * 64 * 4 + SHM_Q;
};
template <int DQK> __device__ __forceinline__ void partialSM(f32x16& p0, f32x16& p1, float& m_reg, float& mn, float& alpha) {
  constexpr float SCALE = Cfg<DQK>::SCALE; constexpr float C = SCALE * 1.4426950408889634f;
  float pmax = p0[0];
#pragma unroll
  for (int r = 1; r < 16; ++r) pmax = fmaxf(pmax, p0[r]);
#pragma unroll
  for (int r = 0; r < 16; ++r) pmax = fmaxf(pmax, p1[r]);
  { auto rr = __builtin_amdgcn_permlane32_swap(__float_as_uint(pmax), __float_as_uint(pmax), false, false);
    pmax = fmaxf(__uint_as_float(rr[0]), __uint_as_float(rr[1])); }
  if (__builtin_expect(__all(pmax - m_reg <= THR / SCALE), 1)) { mn = m_reg; alpha = 1.f; }
  else { mn = fmaxf(m_reg, pmax); alpha = __builtin_amdgcn_exp2f((m_reg - mn) * C); m_reg = mn; }
  float mnC = -mn * C;
#pragma unroll
  for (int r = 0; r < 16; ++r) p0[r] = fmaf(p0[r], C, mnC);
#pragma unroll
  for (int r = 0; r < 16; ++r) p1[r] = fmaf(p1[r], C, mnC);
#pragma unroll
  for (int r = 0; r < 16; ++r) p0[r] = __builtin_amdgcn_exp2f(p0[r]);
}
__device__ __forceinline__ void finishSM(f32x16& p0, f32x16& p1, float alpha, float& l_reg, bf16x8& pa0, bf16x8& pa1, bf16x8& pa2, bf16x8& pa3) {
#pragma unroll
  for (int r = 0; r < 16; ++r) p1[r] = __builtin_amdgcn_exp2f(p1[r]);
  float ps = 0;
#pragma unroll
  for (int r = 0; r < 16; ++r) ps += p0[r];
#pragma unroll
  for (int r = 0; r < 16; ++r) ps += p1[r];
  { auto rr = __builtin_amdgcn_permlane32_swap(__float_as_uint(ps), __float_as_uint(ps), false, false);
    ps = __uint_as_float(rr[0]) + __uint_as_float(rr[1]); }
  l_reg = l_reg * alpha + ps;
#define PK4(P, BASE, OUT) do { unsigned a0 = cvtpk(P[BASE + 0], P[BASE + 1]), a1 = cvtpk(P[BASE + 2], P[BASE + 3]);   \
    unsigned b0 = cvtpk(P[BASE + 4], P[BASE + 5]), b1 = cvtpk(P[BASE + 6], P[BASE + 7]);                              \
    auto r0 = __builtin_amdgcn_permlane32_swap(a0, b0, false, false); auto r1 = __builtin_amdgcn_permlane32_swap(a1, b1, false, false); \
    u32x4 w = {r0[0], r1[0], r0[1], r1[1]}; OUT = *reinterpret_cast<bf16x8*>(&w); } while (0)
  PK4(p0, 0, pa0); PK4(p0, 8, pa1); PK4(p1, 0, pa2); PK4(p1, 8, pa3);
#undef PK4
}
template <int DQK> __device__ __forceinline__ int kswz(int row, int colB) { return row * (DQK * 2) + (colB ^ ((row & 7) << 4)); }
template <int DQK> __device__ __forceinline__ void qkt(f32x16& p0, f32x16& p1, const char* Ks, const bf16x8* qr, const char* Qs, const int* kb, const int* qb, int r32, int hi) {
  constexpr int NQR = Cfg<DQK>::NQR; constexpr int KROWB = DQK * 2;
  p0 = f32x16{}; p1 = f32x16{};
#pragma unroll
  for (int g = 0; g < DQK / 64; ++g)
#pragma unroll
    for (int dd = 0; dd < 4; ++dd) { const int d0 = g * 4 + dd;
      bf16x8 b0 = *reinterpret_cast<const bf16x8*>(Ks + kb[dd] + g * 128);
      bf16x8 b1 = *reinterpret_cast<const bf16x8*>(Ks + kb[dd] + g * 128 + 32 * KROWB);
      bf16x8 q;
      if (d0 < NQR) q = qr[d0 < NQR ? d0 : 0]; else q = *reinterpret_cast<const bf16x8*>(Qs + qb[dd] + (g - NQR / 4) * 32768);
      p0 = __builtin_amdgcn_mfma_f32_32x32x16_bf16(b0, q, p0, 0, 0, 0);
      p1 = __builtin_amdgcn_mfma_f32_32x32x16_bf16(b1, q, p1, 0, 0, 0); }
}
__device__ __forceinline__ int v_st(int k, int c) { const int kk = (k & ~0xC) | ((k & 4) << 1) | ((k & 8) >> 1); return ((kk >> 3) * 4 + (c >> 5)) * 512 + ((kk & 7) * 32 + (c & 31)) * 2; }
__device__ __forceinline__ int v_rd_base(int lane) { return ((lane & 3) << 3) | (((lane >> 2) & 3) << 6) | (((lane >> 4) & 1) << 5) | (((lane >> 5) & 1) << 8); }
constexpr int v_rd_off(int d0, int ks, int half) { return d0 * 512 + ks * 4096 + half * 2048; }
template <int OFF> __device__ __forceinline__ s16x4 tr_read(int vb) {
  s16x4 r; asm volatile("ds_read_b64_tr_b16 %0, %1 offset:%2" : "=&v"(r) : "v"(vb), "i"(OFF) : "memory"); return r;
}
template <int D0> __device__ __forceinline__ void pv_one(f32x16& od, int vb, bf16x8 pa0, bf16x8 pa1, bf16x8 pa2, bf16x8 pa3) {
  const s16x4 l0 = tr_read<v_rd_off(D0, 0, 0)>(vb), h0 = tr_read<v_rd_off(D0, 0, 1)>(vb), l1 = tr_read<v_rd_off(D0, 1, 0)>(vb), h1 = tr_read<v_rd_off(D0, 1, 1)>(vb);
  const s16x4 l2 = tr_read<v_rd_off(D0, 2, 0)>(vb), h2 = tr_read<v_rd_off(D0, 2, 1)>(vb), l3 = tr_read<v_rd_off(D0, 3, 0)>(vb), h3 = tr_read<v_rd_off(D0, 3, 1)>(vb);
  asm volatile("s_waitcnt lgkmcnt(0)" ::: "memory"); SBAR();
#define PK(L, H) (bf16x8){L[0], L[1], L[2], L[3], H[0], H[1], H[2], H[3]}
  od = __builtin_amdgcn_mfma_f32_32x32x16_bf16(pa0, PK(l0, h0), od, 0, 0, 0);
  od = __builtin_amdgcn_mfma_f32_32x32x16_bf16(pa1, PK(l1, h1), od, 0, 0, 0);
  od = __builtin_amdgcn_mfma_f32_32x32x16_bf16(pa2, PK(l2, h2), od, 0, 0, 0);
  od = __builtin_amdgcn_mfma_f32_32x32x16_bf16(pa3, PK(l3, h3), od, 0, 0, 0);
#undef PK
}
__device__ __forceinline__ void pv_d0(f32x16* o, int vb, bf16x8 pa0, bf16x8 pa1, bf16x8 pa2, bf16x8 pa3) {
  pv_one<0>(o[0], vb, pa0, pa1, pa2, pa3); pv_one<1>(o[1], vb, pa0, pa1, pa2, pa3); pv_one<2>(o[2], vb, pa0, pa1, pa2, pa3); pv_one<3>(o[3], vb, pa0, pa1, pa2, pa3);
}
template <int DQK, bool OUT_BF16, int ldq, int ldk, int ldv, int ldo>
__device__ __forceinline__ void attn_dense_body(const bf16_t* __restrict__ Qb, const bf16_t* __restrict__ Kh, const bf16_t* __restrict__ Vh,
                                                float* __restrict__ Of, bf16_t* __restrict__ Ob, int seq, char* lds) {
  using C_ = Cfg<DQK>;
  constexpr int SHM_V = C_::SHM_V, SHM_K = C_::SHM_K, NP = C_::NP, ND0 = C_::ND0, NQR = C_::NQR;
  const int tid = ltid(), wid = tid >> 6, lane = tid & 63, r32 = lane & 31, hi = lane >> 5;
  char* V_lds = lds; char* K_lds = lds + 2 * SHM_V;
  float* ws = (float*)(lds + 2 * SHM_V + 2 * SHM_K) + wid * 64; float* li_l = ws; float* al_l = ws + 32;
  char* Q_lds = lds + 2 * SHM_V + 2 * SHM_K + NW * 64 * 4; const int qrow = wid * QBLK + r32;
  int kb[4], qb[4];
#pragma unroll
  for (int dd = 0; dd < 4; ++dd) { const int t = (dd * 32 + hi * 16) ^ ((r32 & 7) << 4); kb[dd] = r32 * (DQK * 2) + t; qb[dd] = qrow * 128 + t; }
  float m_reg = -1e30f, l_reg = 0; f32x16 o[4] = {}; bf16x8 qr[NQR];
  const bf16_t* Qw = Qb + (size_t)(wid * QBLK + r32) * ldq + hi * 8;
#pragma unroll
  for (int d0 = 0; d0 < NQR; ++d0) qr[d0] = *reinterpret_cast<const bf16x8*>(Qw + d0 * 16);
#pragma unroll
  for (int d0 = NQR; d0 < ND0; ++d0) *reinterpret_cast<bf16x8*>(Q_lds + qb[(d0 - NQR) & 3] + ((d0 - NQR) >> 2) * 32768) = *reinterpret_cast<const bf16x8*>(Qw + d0 * 16);
  const int sr = tid >> 4, sc = (tid & 15) * 8, vst0 = v_st(sr, sc), vst1 = v_st(32 + sr, sc);
  const int kr_ = tid >> 3, kc_ = (tid & 7) * 8;
  const int vb0 = (int)(uintptr_t)V_lds + v_rd_base(lane);
  bf16x8 vs0, vs1, ks[NP];
#define SLOAD(k0) do { vs0 = *reinterpret_cast<const bf16x8*>(&Vh[(size_t)((k0) + sr) * ldv + sc]); vs1 = *reinterpret_cast<const bf16x8*>(&Vh[(size_t)((k0) + 32 + sr) * ldv + sc]); \
    _Pragma("unroll") for (int i_ = 0; i_ < NP; ++i_) ks[i_] = *reinterpret_cast<const bf16x8*>(&Kh[(size_t)((k0) + kr_) * ldk + kc_ + 64 * i_]); } while (0)
#define SWRITE(b) do { *(bf16x8*)(V_lds + (b) * SHM_V + vst0) = vs0; *(bf16x8*)(V_lds + (b) * SHM_V + vst1) = vs1; \
    _Pragma("unroll") for (int i_ = 0; i_ < NP; ++i_) *(bf16x8*)(K_lds + (b) * SHM_K + kswz<DQK>(kr_, (kc_ + 64 * i_) * 2)) = ks[i_]; } while (0)
#define RESC(a) do { if (__any((a) < 1.f)) { if (hi == 0) al_l[r32] = (a); asm volatile("s_waitcnt lgkmcnt(0)" ::: "memory"); \
    _Pragma("unroll") for (int d = 0; d < 4; ++d) _Pragma("unroll") for (int r = 0; r < 16; ++r) o[d][r] *= al_l[crow(r, hi)]; } } while (0)
  const int NT = seq / KVBLK; bf16x8 pa0, pa1, pa2, pa3;
  if constexpr (DQK == 192) {
    f32x16 pA0, pA1; float mnA, alA;
    SLOAD(0); SWRITE(0); __syncthreads();
    for (int j = 0; j < NT; ++j) {
      const int buf = j & 1;
      if (j + 1 < NT) SLOAD((j + 1) * KVBLK);
      SBAR(); qkt<DQK>(pA0, pA1, K_lds + buf * SHM_K, qr, Q_lds, kb, qb, r32, hi);
      partialSM<DQK>(pA0, pA1, m_reg, mnA, alA);
      RESC(alA);
      finishSM(pA0, pA1, alA, l_reg, pa0, pa1, pa2, pa3); SBAR();
      pv_d0(o, vb0 + buf * (int)SHM_V, pa0, pa1, pa2, pa3);
      if (j + 1 < NT) SWRITE(buf ^ 1);
      __syncthreads();
    }
  } else {
  f32x16 pA0, pA1, pB0, pB1; float mnA, mnB, alA, alB;
  SLOAD(0); SWRITE(0); __syncthreads();
  qkt<DQK>(pA0, pA1, K_lds, qr, Q_lds, kb, qb, r32, hi); partialSM<DQK>(pA0, pA1, m_reg, mnA, alA);
  SLOAD(KVBLK);
  SWRITE(1); __syncthreads();
  for (int j = 1; j + 1 < NT; j += 2) {
    SBAR(); qkt<DQK>(pB0, pB1, K_lds + SHM_K, qr, Q_lds, kb, qb, r32, hi);
    finishSM(pA0, pA1, alA, l_reg, pa0, pa1, pa2, pa3); SBAR();
    SLOAD((j + 1) * KVBLK); SBAR();
    pv_d0(o, vb0, pa0, pa1, pa2, pa3); partialSM<DQK>(pB0, pB1, m_reg, mnB, alB);
    __syncthreads(); SWRITE(0);
    RESC(alB); __syncthreads();
    SBAR(); qkt<DQK>(pA0, pA1, K_lds, qr, Q_lds, kb, qb, r32, hi);
    finishSM(pB0, pB1, alB, l_reg, pa0, pa1, pa2, pa3); SBAR();
    SLOAD((j + 2) * KVBLK); SBAR();
    pv_d0(o, vb0 + (int)SHM_V, pa0, pa1, pa2, pa3); partialSM<DQK>(pA0, pA1, m_reg, mnA, alA);
    __syncthreads(); SWRITE(1);
    RESC(alA); __syncthreads();
  }
  SBAR(); qkt<DQK>(pB0, pB1, K_lds + SHM_K, qr, Q_lds, kb, qb, r32, hi);
  finishSM(pA0, pA1, alA, l_reg, pa0, pa1, pa2, pa3); SBAR();
  pv_d0(o, vb0, pa0, pa1, pa2, pa3); partialSM<DQK>(pB0, pB1, m_reg, mnB, alB);
  __syncthreads(); RESC(alB);
  finishSM(pB0, pB1, alB, l_reg, pa0, pa1, pa2, pa3); SBAR();
  pv_d0(o, vb0 + (int)SHM_V, pa0, pa1, pa2, pa3);
  }
  if (hi == 0) li_l[r32] = l_reg; asm volatile("s_waitcnt lgkmcnt(0)" ::: "memory");
  float rli[16];
#pragma unroll
  for (int r = 0; r < 16; ++r) rli[r] = __builtin_amdgcn_rcpf(li_l[crow(r, hi)]);
#pragma unroll
  for (int r = 0; r < 16; ++r) { const int orow = wid * QBLK + crow(r, hi);
#pragma unroll
    for (int d0 = 0; d0 < 4; ++d0) { const float v = o[d0][r] * rli[r];
      if (OUT_BF16) { const unsigned u = __float_as_uint(v); Ob[(size_t)orow * ldo + d0 * 32 + r32] = (bf16_t)((u + 0x7fffu + ((u >> 16) & 1u)) >> 16); }
      else Of[(size_t)orow * ldo + d0 * 32 + r32] = v; } }
  __syncthreads();
#undef SLOAD
#undef SWRITE
#undef RESC
}
#undef SBAR
}

#define LAS __attribute__((address_space(3)))
#ifndef PH_MASK
#define PH_MASK 0xffffffffu
#endif
#define PHON(id) ((PH_MASK >> (id)) & 1u)
#ifndef PROBE_MASK
#define PROBE_MASK 0u
#endif
#define PRB(id) ((PROBE_MASK >> (id)) & 1u)
typedef unsigned short bf16_t;
typedef unsigned v4u __attribute__((ext_vector_type(4)));
typedef unsigned v2u __attribute__((ext_vector_type(2)));
typedef float f32x4 __attribute__((ext_vector_type(4)));
typedef float f32x2 __attribute__((ext_vector_type(2)));
typedef short bf16x8 __attribute__((ext_vector_type(8)));
constexpr int NWAVES = 8, NTHR = 512;
constexpr int LDS_BYTES = 155648;
constexpr size_t MiB = 1u << 20;
constexpr size_t WS_CTL = 0, CTL_BYTES = 32768, WS_ROPE = 64 * 1024, WS_MOD = 128 * 1024, WS_MODP = 1 * MiB;
constexpr size_t WS_W0 = 4 * MiB, W_LAYER = 97 * MiB, WO_IN = 0, WO_Q = 21 * MiB, WO_KV = 22 * MiB, WO_OUT = 23 * MiB, WO_F1 = 31 * MiB, WO_F2 = 75 * MiB;
constexpr size_t WS_H = 198 * MiB, WS_P = 231 * MiB, WS_XBC = 318 * MiB, WS_ACT = 231 * MiB, WS_DT = 335 * MiB, WS_CQN = 336 * MiB, WS_CKVN = 343 * MiB;
constexpr size_t WS_QMLA = 348 * MiB, WS_KMLA = 361 * MiB, WS_VMLA = 374 * MiB, WS_ODIFF = 383 * MiB, WS_S = 416 * MiB, WS_R = 449 * MiB, WS_ATOT = 466 * MiB;
constexpr size_t WS_CAT = 467 * MiB, WS_PRE = 500 * MiB, WS_XA = 566 * MiB, WS_X1 = 632 * MiB, WS_PART = 698 * MiB, WS_END = 720 * MiB;

__device__ __forceinline__ float bf2f(bf16_t v) { return __uint_as_float((unsigned)v << 16); }
__device__ __forceinline__ unsigned f2bf(float f) { unsigned u = __float_as_uint(f); return (u + 0x7fffu + ((u >> 16) & 1u)) >> 16; }
__device__ __forceinline__ unsigned pk2(float lo, float hi) { return f2bf(lo) | (f2bf(hi) << 16); }
__device__ __forceinline__ void unpack8(v4u w, float* f) {
#pragma unroll
    for (int i = 0; i < 4; ++i) { f[2 * i] = __uint_as_float(w[i] << 16); f[2 * i + 1] = __uint_as_float(w[i] & 0xffff0000u); }
}
__device__ __forceinline__ v4u pack8(const float* f) { v4u w; w.x = pk2(f[0], f[1]); w.y = pk2(f[2], f[3]); w.z = pk2(f[4], f[5]); w.w = pk2(f[6], f[7]); return w; }
__device__ __forceinline__ v4u ld8(const bf16_t* p) { return *(const v4u*)p; }
__device__ __forceinline__ float wave_sum(float v) {
#pragma unroll
    for (int o = 1; o < 64; o <<= 1) v += __shfl_xor(v, o);
    return v;
}
__device__ __forceinline__ float siluf(float v) { return v / (1.0f + __expf(-v)); }

struct Args { const float* in[27]; float* out; unsigned char* ws; int ph_lo, ph_hi; };

struct Frame {
    LAS unsigned char* lds; char* ldsg;
    int tid, lane, wave, G, gw, NGW, bid;
    const __attribute__((address_space(4))) char* ka; float* out; unsigned char* ws;
};
#define INP(i) (*(const float* const __attribute__((address_space(4)))*)(F.ka + 8 * (i)))
#define WSP(T, off) ((T*)(F.ws + (off)))

__device__ __forceinline__ int srccol(int mode, int n) {
    if (mode == 0) return n;
    if (mode == 1) { if (n < 4608) return n; if (n < 5312) return n + 16; if (n < 5328) return n - 5312 + 4608; return -1; }
    const int t = n >> 8, r = n & 255; return r < 128 ? t * 128 + r : 5632 + t * 128 + (r - 128);
}
__device__ __forceinline__ void transpose_item(const float* W, int K, int Nsrc, bf16_t* WT, int nblk, int mode, LAS float* scr, int item, int lane) {
    const int kb = item / nblk, nb = item % nblk, k0 = 64 * kb, n0 = 64 * nb;
    const int kk = lane >> 4, c4 = (lane & 15) * 4;
    const int sc = srccol(mode, n0 + c4);
    f32x4 v[16];
#pragma unroll
    for (int i = 0; i < 16; ++i) v[i] = (sc >= 0) ? *(const f32x4*)(W + (size_t)(k0 + 4 * i + kk) * Nsrc + sc) : (f32x4){0.f, 0.f, 0.f, 0.f};
#pragma unroll
    for (int i = 0; i < 16; ++i) { LAS float* s = scr + (4 * i + kk) * 65 + c4; s[0] = v[i][0]; s[1] = v[i][1]; s[2] = v[i][2]; s[3] = v[i][3]; }
    asm volatile("s_waitcnt lgkmcnt(0)" ::: "memory");
    const int c = lane & 7;
#pragma unroll
    for (int j = 0; j < 8; ++j) { const int n = (lane >> 3) + 8 * j; const LAS float* s = scr + (8 * c) * 65 + n;
        v4u o; o.x = pk2(s[0 * 65], s[1 * 65]); o.y = pk2(s[2 * 65], s[3 * 65]); o.z = pk2(s[4 * 65], s[5 * 65]); o.w = pk2(s[6 * 65], s[7 * 65]);
        *(v4u*)(WT + (size_t)(n0 + n) * K + k0 + 8 * c) = o; }
    asm volatile("s_waitcnt lgkmcnt(0)" ::: "memory");
}
__device__ __forceinline__ void transpose_matrix(Frame& F, const float* W, int K, int Nsrc, bf16_t* WT, int Ndst, int mode) {
    LAS float* scr = (LAS float*)(F.lds + F.wave * 16896);
    const int nblk = Ndst / 64, nitems = (K / 64) * nblk;
    for (int it = F.gw; it < nitems; it += F.NGW) transpose_item(W, K, Nsrc, WT, nblk, mode, scr, it, F.lane);
}
__device__ __forceinline__ void phase_prologue(Frame& F) {
    {
        const float* c = INP(1); const float* cc = INP(3); const float* wada = INP(4);
        float* modp = WSP(float, WS_MODP);
        const int NT = F.G * NTHR;
        for (int item = F.bid * NTHR + F.tid; item < 2 * 16 * 3072; item += NT) {
            const int n4 = item % 3072, kc = (item / 3072) % 16, l = item / (3072 * 16);
            f32x4 a0 = {0.f, 0.f, 0.f, 0.f}, a1 = {0.f, 0.f, 0.f, 0.f};
            const float* wp = wada + ((size_t)l * 2048 + kc * 128) * 12288 + n4 * 4;
#pragma unroll 8
            for (int k = 0; k < 128; ++k) { const f32x4 w = *(const f32x4*)(wp + (size_t)k * 12288); const float s0 = siluf(c[kc * 128 + k]), s1 = siluf(cc[kc * 128 + k]); a0 += w * s0; a1 += w * s1; }
            *(f32x4*)(modp + ((size_t)((kc * 2 + l) * 2 + 0)) * 12288 + n4 * 4) = a0;
            *(f32x4*)(modp + ((size_t)((kc * 2 + l) * 2 + 1)) * 12288 + n4 * 4) = a1;
        }
    }
    {
        unsigned char* wb = F.ws + WS_W0;
        transpose_matrix(F, INP(6), 2048, 5328, (bf16_t*)(wb + WO_IN), INW, 1);
        transpose_matrix(F, INP(18), 384, 768, (bf16_t*)(wb + WO_Q), 768, 0);
        transpose_matrix(F, INP(19), 256, 1024, (bf16_t*)(wb + WO_KV), 1024, 0);
    }
}
constexpr int DT_N0 = 1024, DT_N1 = DT_N0 + 5632, DT_N2 = DT_N1 + 2816, DT_N3 = DT_N2 + 2688, DT_N4 = DT_N3 + 72, DT_N5 = DT_N4 + 64, DT_N6 = DT_N5 + 1024, DT_N7 = DT_N6 + 5632, DT_N8 = DT_N7 + 2816;
constexpr int DT_UNITS = (DT_N8 + 63) / 64;
__device__ __forceinline__ void deferred_transpose_unit(Frame& F, int tu) {
    LAS float* scr = (LAS float*)(F.lds + F.wave * 16896);
    unsigned char* w0 = F.ws + WS_W0; unsigned char* w1 = w0 + W_LAYER;
    for (int q = 0; q < 8; ++q) {
        int it = tu * 64 + q * 8 + F.wave;
        if (it >= DT_N8) break;
        const float* W; int K, Nsrc, Nd, mode; bf16_t* WT;
        if (it < DT_N0)      { W = INP(20); K = 2048; Nsrc = 2048; Nd = 2048; mode = 0; WT = (bf16_t*)(w0 + WO_OUT); }
        else if (it < DT_N1) { it -= DT_N0; W = INP(23); K = 2048; Nsrc = 11264; Nd = 11264; mode = 2; WT = (bf16_t*)(w0 + WO_F1); }
        else if (it < DT_N2) { it -= DT_N1; W = INP(24); K = 5632; Nsrc = 2048; Nd = 2048; mode = 0; WT = (bf16_t*)(w0 + WO_F2); }
        else if (it < DT_N3) { it -= DT_N2; W = INP(6) + (size_t)2048 * 5328; K = 2048; Nsrc = 5328; Nd = INW; mode = 1; WT = (bf16_t*)(w1 + WO_IN); }
        else if (it < DT_N4) { it -= DT_N3; W = INP(18) + (size_t)384 * 768; K = 384; Nsrc = 768; Nd = 768; mode = 0; WT = (bf16_t*)(w1 + WO_Q); }
        else if (it < DT_N5) { it -= DT_N4; W = INP(19) + (size_t)256 * 1024; K = 256; Nsrc = 1024; Nd = 1024; mode = 0; WT = (bf16_t*)(w1 + WO_KV); }
        else if (it < DT_N6) { it -= DT_N5; W = INP(20) + (size_t)2048 * 2048; K = 2048; Nsrc = 2048; Nd = 2048; mode = 0; WT = (bf16_t*)(w1 + WO_OUT); }
        else if (it < DT_N7) { it -= DT_N6; W = INP(23) + (size_t)2048 * 11264; K = 2048; Nsrc = 11264; Nd = 11264; mode = 2; WT = (bf16_t*)(w1 + WO_F1); }
        else                 { it -= DT_N7; W = INP(24) + (size_t)5632 * 2048; K = 5632; Nsrc = 2048; Nd = 2048; mode = 0; WT = (bf16_t*)(w1 + WO_F2); }
        transpose_item(W, K, Nsrc, WT, Nd / 64, mode, scr, it, F.lane);
    }
}
__device__ __forceinline__ void phase_modfinal(Frame& F) {
    const float* modp = WSP(float, WS_MODP); float* mod = WSP(float, WS_MOD); const float* bada = INP(5);
    const int NT = F.G * NTHR;
    for (int i = F.bid * NTHR + F.tid; i < 2 * 2 * 12288; i += NT) {
        const int l = i / 24576, v = (i / 12288) & 1, n = i % 12288;
        float s = bada[l * 12288 + n];
        for (int kc = 0; kc < 16; ++kc) s += modp[((size_t)((kc * 2 + l) * 2 + v)) * 12288 + n];
        mod[i] = s;
    }
    f32x2* rope = WSP(f32x2, WS_ROPE);
    for (int i = F.bid * NTHR + F.tid; i < 128 * 16; i += NT) { f32x2 cs; cs.x = ROPE_TAB[i].x; cs.y = ROPE_TAB[i].y; rope[i] = cs; }
}
__device__ __forceinline__ const float* modvec(Frame& F, int l, int v, int chunk) { return WSP(float, WS_MOD) + ((size_t)(l * 2 + v) * 6 + chunk) * 2048; }
__device__ __forceinline__ void phase_copy_mod(Frame& F) {
    bf16_t* H = WSP(bf16_t, WS_H);
    for (int r = F.gw; r < MROWS; r += F.NGW) {
        const int v = r >= SEQ; const float* src = v ? INP(2) + (size_t)(r - SEQ) * DM : INP(0) + (size_t)r * DM;
        const float* sh = modvec(F, 0, v, 0); const float* sc = modvec(F, 0, v, 1);
#pragma unroll
        for (int j = 0; j < 8; ++j) { const int c = 4 * F.lane + 256 * j; const f32x4 x = *(const f32x4*)(src + c);
            const f32x4 s = *(const f32x4*)(sc + c), b = *(const f32x4*)(sh + c); const f32x4 h = x * (1.0f + s) + b;
            v2u w; w.x = pk2(h[0], h[1]); w.y = pk2(h[2], h[3]); *(v2u*)(H + (size_t)r * DM + c) = w; }
    }
}
__device__ __forceinline__ float half_sum(float v) {
#pragma unroll
    for (int o = 1; o < 32; o <<= 1) v += __shfl_xor(v, o);
    return v;
}
template <int NPARTS>
__device__ __forceinline__ void ln_row(Frame& F, int r, int l32, const float* PRE, const float* g, const float* b, float* xo, const float* sh, const float* sc, bool writeH, const float* xres, const float* gate_ctx) {
    bf16_t* H = WSP(bf16_t, WS_H);
    f32x4 x[16]; float s = 0.f;
    if (NPARTS > 0) {
        float* PREw = const_cast<float*>(PRE);
#pragma unroll 1
        for (int j = 0; j < 16; ++j) { const int c = 4 * l32 + 128 * j; const float* pp = WSP(const float, WS_PART) + (size_t)(r - SEQ) * DM + c; f32x4 a = *(const f32x4*)pp;
#pragma unroll
            for (int t = 1; t < NPARTS; ++t) a += *(const f32x4*)(pp + (size_t)t * 256 * 2048);
            *(f32x4*)(PREw + (size_t)r * DM + c) = *(const f32x4*)(xres + (size_t)r * DM + c) * 1.4142135623730951f + *(const f32x4*)(gate_ctx + c) * a; }
        asm volatile("s_waitcnt vmcnt(0)" ::: "memory");
    }
#pragma unroll
    for (int j = 0; j < 16; ++j) { x[j] = *(const f32x4*)(PRE + (size_t)r * DM + 4 * l32 + 128 * j); s += (x[j][0] + x[j][1]) + (x[j][2] + x[j][3]); }
    const float mean = half_sum(s) * (1.0f / DM); float q = 0.f;
#pragma unroll
    for (int j = 0; j < 16; ++j) { x[j] = x[j] - mean; q += (x[j][0] * x[j][0] + x[j][1] * x[j][1]) + (x[j][2] * x[j][2] + x[j][3] * x[j][3]); }
    const float rstd = rsqrtf(half_sum(q) * (1.0f / DM) + 1e-5f);
#pragma unroll
    for (int j = 0; j < 16; ++j) { const int c = 4 * l32 + 128 * j; const f32x4 gg = *(const f32x4*)(g + c), bb = *(const f32x4*)(b + c);
        const f32x4 y = x[j] * rstd * gg + bb; *(f32x4*)(xo + (size_t)r * DM + c) = y;
        if (writeH) { const f32x4 s2 = *(const f32x4*)(sc + c), b2 = *(const f32x4*)(sh + c); const f32x4 h = y * (1.0f + s2) + b2;
            v2u w; w.x = pk2(h[0], h[1]); w.y = pk2(h[2], h[3]); *(v2u*)(H + (size_t)r * DM + c) = w; }
        if ((j & 3) == 3) asm volatile("" ::: "memory"); }
}
template <int NPARTS>
__device__ __forceinline__ void phase_ln(Frame& F, bool ctx_rows, const float* PRE, const float* g, const float* b, float* xout, int l_mod, int ch_sh, int ch_sc, bool writeH, const float* xres, const float* gate_ctx) {
    const int l32 = F.lane & 31, sub = F.lane >> 5;
    for (int r = 2 * F.gw + sub; r < SEQ; r += 2 * F.NGW)
        ln_row<0>(F, r, l32, PRE, g, b, xout, writeH ? modvec(F, l_mod, 0, ch_sh) : nullptr, writeH ? modvec(F, l_mod, 0, ch_sc) : nullptr, writeH, nullptr, nullptr);
    if (ctx_rows && F.wave == 0 && sub == 0)
        for (int r = SEQ + F.bid; r < MROWS; r += F.G)
            ln_row<NPARTS>(F, r, l32, PRE, g, b, xout, writeH ? modvec(F, l_mod, 1, ch_sh) : nullptr, writeH ? modvec(F, l_mod, 1, ch_sc) : nullptr, writeH, xres, gate_ctx);
}
__device__ __forceinline__ void phase_prep(Frame& F, int l) {
    const bf16_t* P = WSP(bf16_t, WS_P); bf16_t* CAT = WSP(bf16_t, WS_CAT); bf16_t* XBC = WSP(bf16_t, WS_XBC); float* DT = WSP(float, WS_DT);
    bf16_t* CQN = WSP(bf16_t, WS_CQN); bf16_t* CKVN = WSP(bf16_t, WS_CKVN); bf16_t* KMLA = WSP(bf16_t, WS_KMLA);
    const float* caw = INP(7) + (size_t)l * 3 * 512; const float* scw = INP(10) + (size_t)l * 3 * 1024; const float* scb = INP(11) + (size_t)l * 1024;
    const float* dtb = INP(12) + l * 16; const float* qnw = INP(16) + l * 384; const float* kvnw = INP(17) + l * 256;
    const int lane = F.lane;
    for (int r = F.gw; r < MROWS; r += F.NGW) {
        const bool hp = (r != 0 && r != SEQ), hn = (r != SEQ - 1 && r != MROWS - 1);
        const bf16_t* Pr = P + (size_t)r * INW; const bf16_t* Pp = Pr - INW; const bf16_t* Pn = Pr + INW;
        const v4u z4 = {0u, 0u, 0u, 0u};
        {
            const int ch = lane * 8; float bg[8], cg_[8], u_[8], cp[8], up[8], cn[8], un[8], y[8];
            unpack8(ld8(Pr + C_BG + ch), bg); unpack8(ld8(Pr + C_CG + ch), cg_); unpack8(ld8(Pr + C_U + ch), u_);
            unpack8(hp ? ld8(Pp + C_CG + ch) : z4, cp); unpack8(hp ? ld8(Pp + C_U + ch) : z4, up);
            unpack8(hn ? ld8(Pn + C_CG + ch) : z4, cn); unpack8(hn ? ld8(Pn + C_U + ch) : z4, un);
#pragma unroll
            for (int i = 0; i < 8; ++i) y[i] = bg[i] * (caw[ch + i] * cp[i] * up[i] + caw[512 + ch + i] * cg_[i] * u_[i] + caw[1024 + ch + i] * cn[i] * un[i]);
            *(v4u*)(CAT + (size_t)r * DM + ch) = pack8(y);
        }
#pragma unroll
        for (int q = 0; q < 2; ++q) {
            const int ch = lane * 8 + 512 * q; float x0[8], xp[8], xn[8], y[8];
            unpack8(ld8(Pr + C_XBC + ch), x0); unpack8(hp ? ld8(Pp + C_XBC + ch) : z4, xp); unpack8(hn ? ld8(Pn + C_XBC + ch) : z4, xn);
#pragma unroll
            for (int i = 0; i < 8; ++i) y[i] = siluf(scw[ch + i] * xp[i] + scw[1024 + ch + i] * x0[i] + scw[2048 + ch + i] * xn[i] + scb[ch + i]);
            *(v4u*)(XBC + (size_t)r * 1024 + ch) = pack8(y);
        }
        if (lane < 16) { const float v = bf2f(Pr[C_DT + lane]) + dtb[lane]; DT[(size_t)r * 16 + lane] = v > 20.f ? v : __logf(1.0f + __expf(v)); }
        {
            float x[8]; float ss = 0.f;
            if (lane < 48) { unpack8(ld8(Pr + C_CQ + lane * 8), x);
#pragma unroll
                for (int i = 0; i < 8; ++i) ss += x[i] * x[i]; }
            const float rs = rsqrtf(wave_sum(ss) * (1.0f / 384.f) + 1e-6f);
            if (lane < 48) {
#pragma unroll
                for (int i = 0; i < 8; ++i) x[i] = x[i] * rs * qnw[lane * 8 + i];
                *(v4u*)(CQN + (size_t)r * 384 + lane * 8) = pack8(x); }
        }
        {
            float x[8]; float ss = 0.f;
            if (lane < 32) { unpack8(ld8(Pr + C_CKV + lane * 8), x);
#pragma unroll
                for (int i = 0; i < 8; ++i) ss += x[i] * x[i]; }
            const float rs = rsqrtf(wave_sum(ss) * (1.0f / 256.f) + 1e-6f);
            if (lane < 32) {
#pragma unroll
                for (int i = 0; i < 8; ++i) x[i] = x[i] * rs * kvnw[lane * 8 + i];
                *(v4u*)(CKVN + (size_t)r * 256 + lane * 8) = pack8(x); }
        }
        if (lane < 32) { const int hh = lane >> 3, part = lane & 7; *(v4u*)(KMLA + (size_t)r * 768 + hh * 192 + 128 + part * 8) = ld8(Pr + C_KR + part * 8); }
    }
}
__device__ __forceinline__ int ssd_rowbase(int ci) { return ci < 2 ? SEQ + 128 * ci : 128 * (ci - 2); }
__device__ __forceinline__ void ssd_cum(const float* DT, const float* alog, int rb, int h, int d, int lane, float& a0, float& a1, float& ac0, float& ac1, float& total, float& dt0, float& dt1) {
    dt0 = DT[(size_t)(rb + 2 * lane) * 16 + d * 8 + h]; dt1 = DT[(size_t)(rb + 2 * lane + 1) * 16 + d * 8 + h];
    const float A = -__expf(alog[d * 8 + h]);
    a0 = dt0 * A; a1 = dt1 * A;
    const float pair = a0 + a1; float incl = pair;
#pragma unroll
    for (int o = 1; o < 64; o <<= 1) { const float t = __shfl_up(incl, o); if (lane >= o) incl += t; }
    const float excl = incl - pair;
    ac0 = excl + a0; ac1 = incl; total = __shfl(incl, 63);
}
constexpr int LP = 136;
__device__ __forceinline__ void phase_ssd1(Frame& F, int l) {
    const bf16_t* XBC = WSP(bf16_t, WS_XBC); const float* DT = WSP(float, WS_DT); float* S = WSP(float, WS_S); float* ATOT = WSP(float, WS_ATOT);
    const float* alog = INP(13) + l * 16;
    char* lds = F.ldsg;
    bf16_t* BT = (bf16_t*)lds; bf16_t* XT = (bf16_t*)(lds + 34816); float* WG = (float*)(lds + 69632);
    const int tid = F.tid, lane = F.lane, w = F.wave;
    for (int u = (F.G - 1 - F.bid); u < 132; u += F.G) {
        const int ci = u >> 1, g = u & 1, rb = ssd_rowbase(ci);
        {
            const int ll = tid >> 2, n0 = (tid & 3) * 32;
#pragma unroll
            for (int q = 0; q < 4; ++q) { const v4u v = ld8(XBC + (size_t)(rb + ll) * 1024 + 512 + g * 128 + n0 + 8 * q);
#pragma unroll
                for (int i = 0; i < 4; ++i) { BT[(n0 + 8 * q + 2 * i) * LP + ll] = (bf16_t)(v[i] & 0xffffu); BT[(n0 + 8 * q + 2 * i + 1) * LP + ll] = (bf16_t)(v[i] >> 16); } }
        }
        {
            const int hh = w >> 1, d = w & 1, h = g * 4 + hh; float a0, a1, ac0, ac1, total, dt0, dt1;
            ssd_cum(DT, alog, rb, h, d, lane, a0, a1, ac0, ac1, total, dt0, dt1);
            float e0, e1;
            if (d == 0) { e0 = __expf(total - ac0); e1 = __expf(total - ac1); } else { e0 = __expf(ac0 - a0); e1 = __expf(ac1 - a1); }
            WG[w * 128 + 2 * lane] = e0 * dt0; WG[w * 128 + 2 * lane + 1] = e1 * dt1;
            if (lane == 0) ATOT[(ci * 8 + h) * 2 + d] = total;
        }
        __syncthreads();
        for (int hh = 0; hh < 4; ++hh) {
            const int h = g * 4 + hh;
            {
                const int ll = tid >> 2, p0 = (tid & 3) * 16; const float w0 = WG[(hh * 2) * 128 + ll], w1 = WG[(hh * 2 + 1) * 128 + ll];
#pragma unroll
                for (int q = 0; q < 2; ++q) { float x[8]; unpack8(ld8(XBC + (size_t)(rb + ll) * 1024 + h * 64 + p0 + 8 * q), x);
#pragma unroll
                    for (int i = 0; i < 8; ++i) { XT[(p0 + 8 * q + i) * LP + ll] = (bf16_t)f2bf(x[i] * w0); XT[(64 + p0 + 8 * q + i) * LP + ll] = (bf16_t)f2bf(x[i] * w1); } }
            }
            __syncthreads();
            const int pt = w & 3, nh = w >> 2;
#pragma unroll
            for (int d = 0; d < 2; ++d) {
                f32x4 acc[4];
#pragma unroll
                for (int nt = 0; nt < 4; ++nt) acc[nt] = (f32x4){0.f, 0.f, 0.f, 0.f};
#pragma unroll
                for (int ks = 0; ks < 4; ++ks) {
                    const bf16x8 a = *(const bf16x8*)(XT + (d * 64 + pt * 16 + (lane & 15)) * LP + ks * 32 + (lane >> 4) * 8);
#pragma unroll
                    for (int nt = 0; nt < 4; ++nt) { const bf16x8 b = *(const bf16x8*)(BT + ((nh * 4 + nt) * 16 + (lane & 15)) * LP + ks * 32 + (lane >> 4) * 8);
                        acc[nt] = __builtin_amdgcn_mfma_f32_16x16x32_bf16(a, b, acc[nt], 0, 0, 0); }
                }
                float* Sp = S + (size_t)((ci * 8 + h) * 2 + d) * 8192;
#pragma unroll
                for (int nt = 0; nt < 4; ++nt)
#pragma unroll
                    for (int j = 0; j < 4; ++j) Sp[(pt * 16 + (lane >> 4) * 4 + j) * 128 + (nh * 4 + nt) * 16 + (lane & 15)] = acc[nt][j];
            }
            __syncthreads();
        }
    }
}
__device__ __forceinline__ void ssd_scan_unit(Frame& F, int su) {
    const float* S = WSP(float, WS_S); const float* ATOT = WSP(float, WS_ATOT); bf16_t* Rb = WSP(bf16_t, WS_R);
    const int hd = su >> 2, h = hd >> 1, d = hd & 1, e = (su & 3) * 2048 + F.tid * 4;
    f32x4 R = {0.f, 0.f, 0.f, 0.f};
#pragma unroll 4
    for (int step = 0; step < 66; ++step) {
        const int ci = (d == 0) ? step : (step == 0 ? 1 : (step == 1 ? 0 : 67 - step));
        const size_t base = (size_t)((ci * 8 + h) * 2 + d);
        v2u wv; wv.x = pk2(R[0], R[1]); wv.y = pk2(R[2], R[3]); *(v2u*)(Rb + base * 8192 + e) = wv;
        const float dec = __expf(ATOT[base]); const f32x4 sv = *(const f32x4*)(S + base * 8192 + e);
        R = R * dec + sv;
    }
}
__device__ __forceinline__ void phase_ssd2(Frame& F, int l, int ci_first) {
    const bf16_t* XBC = WSP(bf16_t, WS_XBC); const bf16_t* P = WSP(bf16_t, WS_P); const float* DT = WSP(float, WS_DT); const bf16_t* Rb = WSP(bf16_t, WS_R); bf16_t* CAT = WSP(bf16_t, WS_CAT);
    const float* alog = INP(13) + l * 16; const float* dskip = INP(14) + l * 8; const float* normw = INP(15) + l * 512;
    char* lds = F.ldsg;
    bf16_t* CL = (bf16_t*)lds; bf16_t* BL = (bf16_t*)(lds + 34816); bf16_t* XT = (bf16_t*)(lds + 34816); bf16_t* RL = (bf16_t*)(lds + 52224);
    const int tid = F.tid, lane = F.lane, w = F.wave;
    bf16_t* PW = (bf16_t*)(lds + 69632 + w * 4352); bf16_t* CW = (bf16_t*)(lds + 104448 + w * 4352); float* CUM = (float*)(lds + 139264); float* DTV = (float*)(lds + 143360);
    const int nunits = (66 - ci_first) * 2;
    for (int u = (F.G - 1 - F.bid); u < nunits; u += F.G) {
        const int ci = ci_first + (u >> 1), g = u & 1, rb = ssd_rowbase(ci);
        {
            const int row = tid >> 2, c0 = (tid & 3) * 32;
#pragma unroll
            for (int q = 0; q < 4; ++q) { *(v4u*)(CL + row * LP + c0 + 8 * q) = ld8(XBC + (size_t)(rb + row) * 1024 + 768 + g * 128 + c0 + 8 * q);
                *(v4u*)(BL + row * LP + c0 + 8 * q) = ld8(XBC + (size_t)(rb + row) * 1024 + 512 + g * 128 + c0 + 8 * q); }
        }
        {
            const int hh = w >> 1, d = w & 1, h = g * 4 + hh; float a0, a1, ac0, ac1, total, dt0, dt1;
            ssd_cum(DT, alog, rb, h, d, lane, a0, a1, ac0, ac1, total, dt0, dt1);
            float c0v, c1v;
            if (d == 0) { c0v = ac0; c1v = ac1; } else { c0v = total - (ac0 - a0); c1v = total - (ac1 - a1); }
            CUM[w * 128 + 2 * lane] = c0v; CUM[w * 128 + 2 * lane + 1] = c1v; DTV[w * 128 + 2 * lane] = dt0; DTV[w * 128 + 2 * lane + 1] = dt1;
        }
        __syncthreads();
        f32x4 gacc[8];
#pragma unroll
        for (int nt = 0; nt < 8; ++nt) gacc[nt] = (f32x4){0.f, 0.f, 0.f, 0.f};
#pragma unroll
        for (int ks = 0; ks < 4; ++ks) {
            const bf16x8 a = *(const bf16x8*)(CL + (16 * w + (lane & 15)) * LP + ks * 32 + (lane >> 4) * 8);
#pragma unroll
            for (int nt = 0; nt < 8; ++nt) { const bf16x8 b = *(const bf16x8*)(BL + (nt * 16 + (lane & 15)) * LP + ks * 32 + (lane >> 4) * 8);
                gacc[nt] = __builtin_amdgcn_mfma_f32_16x16x32_bf16(a, b, gacc[nt], 0, 0, 0); }
        }
        __syncthreads();
        f32x4 yacc[4][4];
#pragma unroll
        for (int a = 0; a < 4; ++a)
#pragma unroll
            for (int b = 0; b < 4; ++b) yacc[a][b] = (f32x4){0.f, 0.f, 0.f, 0.f};
#pragma unroll
        for (int hh = 0; hh < 4; ++hh) {
            const int h = g * 4 + hh;
#pragma unroll
            for (int d = 0; d < 2; ++d) {
                const int idx = hh * 2 + d;
                {
                    const int s = tid >> 2, p0 = (tid & 3) * 16; const float dtv = DTV[idx * 128 + s];
#pragma unroll
                    for (int q = 0; q < 2; ++q) { float x[8]; unpack8(ld8(XBC + (size_t)(rb + s) * 1024 + h * 64 + p0 + 8 * q), x);
#pragma unroll
                        for (int i = 0; i < 8; ++i) XT[(p0 + 8 * q + i) * LP + s] = (bf16_t)f2bf(x[i] * dtv); }
                }
                {
                    const int p = tid >> 3, n0 = (tid & 7) * 16; const bf16_t* src = Rb + (size_t)((ci * 8 + h) * 2 + d) * 8192 + p * 128 + n0;
                    *(v4u*)(RL + p * LP + n0) = ld8(src); *(v4u*)(RL + p * LP + n0 + 8) = ld8(src + 8);
                }
                {
#pragma unroll
                    for (int nt = 0; nt < 8; ++nt)
#pragma unroll
                        for (int j = 0; j < 4; ++j) { const int lrow = (lane >> 4) * 4 + j, lt = 16 * w + lrow, s = nt * 16 + (lane & 15);
                            const float e = CUM[idx * 128 + lt] - CUM[idx * 128 + s]; const bool ok = (d == 0) ? (s <= lt) : (s >= lt);
                            const float pv = ok ? gacc[nt][j] * __expf(e) : 0.f; PW[lrow * LP + s] = (bf16_t)f2bf(pv); }
                }
                {
                    const int rr = lane >> 2, c0 = (lane & 3) * 32; const float ex = __expf(CUM[idx * 128 + 16 * w + rr]);
#pragma unroll
                    for (int q = 0; q < 4; ++q) { float x[8]; unpack8(*(const v4u*)(CL + (16 * w + rr) * LP + c0 + 8 * q), x);
#pragma unroll
                        for (int i = 0; i < 8; ++i) x[i] *= ex;
                        *(v4u*)(CW + rr * LP + c0 + 8 * q) = pack8(x); }
                }
                __syncthreads();
#pragma unroll
                for (int ks = 0; ks < 4; ++ks) {
                    const bf16x8 ap = *(const bf16x8*)(PW + (lane & 15) * LP + ks * 32 + (lane >> 4) * 8);
                    const bf16x8 ac = *(const bf16x8*)(CW + (lane & 15) * LP + ks * 32 + (lane >> 4) * 8);
#pragma unroll
                    for (int pt = 0; pt < 4; ++pt) {
                        const bf16x8 bx = *(const bf16x8*)(XT + (pt * 16 + (lane & 15)) * LP + ks * 32 + (lane >> 4) * 8);
                        const bf16x8 br = *(const bf16x8*)(RL + (pt * 16 + (lane & 15)) * LP + ks * 32 + (lane >> 4) * 8);
                        yacc[hh][pt] = __builtin_amdgcn_mfma_f32_16x16x32_bf16(ap, bx, yacc[hh][pt], 0, 0, 0);
                        yacc[hh][pt] = __builtin_amdgcn_mfma_f32_16x16x32_bf16(ac, br, yacc[hh][pt], 0, 0, 0);
                    }
                }
                __syncthreads();
            }
        }
#pragma unroll
        for (int j = 0; j < 4; ++j) {
            const int row = rb + 16 * w + (lane >> 4) * 4 + j; float ssq = 0.f;
#pragma unroll
            for (int hh = 0; hh < 4; ++hh)
#pragma unroll
                for (int pt = 0; pt < 4; ++pt) { const int ch = hh * 64 + pt * 16 + (lane & 15);
                    const float xs = bf2f(XBC[(size_t)row * 1024 + g * 256 + ch]), z = bf2f(P[(size_t)row * INW + C_Z + g * 256 + ch]);
                    const float y = yacc[hh][pt][j] + xs * dskip[g * 4 + hh]; const float gv = y * siluf(z); yacc[hh][pt][j] = gv; ssq += gv * gv; }
            ssq += __shfl_xor(ssq, 1); ssq += __shfl_xor(ssq, 2); ssq += __shfl_xor(ssq, 4); ssq += __shfl_xor(ssq, 8);
            const float rs = rsqrtf(ssq * (1.0f / 256.f) + 1e-6f);
#pragma unroll
            for (int hh = 0; hh < 4; ++hh)
#pragma unroll
                for (int pt = 0; pt < 4; ++pt) { const int ch = hh * 64 + pt * 16 + (lane & 15);
                    CAT[(size_t)row * DM + 1024 + g * 256 + ch] = (bf16_t)f2bf(yacc[hh][pt][j] * rs * normw[g * 256 + ch]); }
        }
        __syncthreads();
    }
}
__device__ __forceinline__ void phase_diffcombine(Frame& F, int l, int nrows) {
    const float* OD = WSP(float, WS_ODIFF); bf16_t* CAT = WSP(bf16_t, WS_CAT);
    const float* lp = INP(8) + l * 256; const float* sub = INP(9) + l * 128;
    const int lane = F.lane;
    const float s1 = wave_sum(lp[lane] * lp[64 + lane]), s2 = wave_sum(lp[128 + lane] * lp[192 + lane]);
    int ll = l; asm volatile("" : "+s"(ll));
    const float lam_init = (ll == 0) ? 0.2f : 0.35550906759f;
    const float lam = __expf(s1) - __expf(s2) + lam_init;
    const int hh = lane >> 4, e0 = (lane & 15) * 8;
    float sw[8];
#pragma unroll
    for (int i = 0; i < 8; ++i) sw[i] = sub[e0 + i] * (1.0f - lam_init);
    for (int r = F.gw; r < nrows; r += F.NGW) {
        const float* o1 = OD + (size_t)r * 1024 + (hh * 2) * 128 + e0; const float* o2 = o1 + 128;
        const f32x4 a0 = *(const f32x4*)o1, a1 = *(const f32x4*)(o1 + 4), b0 = *(const f32x4*)o2, b1 = *(const f32x4*)(o2 + 4);
        float o[8]; float ss = 0.f;
#pragma unroll
        for (int i = 0; i < 4; ++i) { o[i] = a0[i] - lam * b0[i]; o[4 + i] = a1[i] - lam * b1[i]; }
#pragma unroll
        for (int i = 0; i < 8; ++i) ss += o[i] * o[i];
        ss += __shfl_xor(ss, 1); ss += __shfl_xor(ss, 2); ss += __shfl_xor(ss, 4); ss += __shfl_xor(ss, 8);
        const float rs = rsqrtf(ss * (1.0f / 128.f) + 1e-6f);
#pragma unroll
        for (int i = 0; i < 8; ++i) o[i] = o[i] * rs * sw[i];
        *(v4u*)(CAT + (size_t)r * DM + 512 + hh * 128 + e0) = pack8(o);
    }
}
__device__ __forceinline__ void phase_attn(Frame& F, int l, int rep) {
    unsigned* ctr = WSP(unsigned, WS_CTL) + 64 * (1 + l + 2 * rep);
    LAS unsigned* bc = (LAS unsigned*)(F.lds + LDS_BYTES - 64);
    const bf16_t* P = WSP(bf16_t, WS_P); const bf16_t* QM = WSP(bf16_t, WS_QMLA); const bf16_t* KM = WSP(bf16_t, WS_KMLA); const bf16_t* VM = WSP(bf16_t, WS_VMLA);
    float* OD = WSP(float, WS_ODIFF); bf16_t* CAT = WSP(bf16_t, WS_CAT);
    const int n_scan = 64, n_mla = 128, n_diff = 256, n_cm = (l == 0) ? 4 : 0, n_cd = (l == 0) ? 8 : 0;
    const int n_tr = (l == 0) ? DT_UNITS : 0;
    const int total = n_scan + n_mla + n_diff + n_cm + n_cd + n_tr;
#ifndef PROBE_FILT
#define PROBE_FILT 7
#endif
    const int filt = rep ? PROBE_FILT : 7;
    for (;;) {
        __syncthreads();
        if (F.tid == 0) bc[0] = atomicAdd(ctr, 1u);
        __syncthreads();
        int u = (int)bc[0];
        if (u >= total) break;
        if (u < n_mla) { if (!(filt & 2)) continue; const int h = u >> 5, qb = u & 31; const size_t q0 = (size_t)qb * 256;
            att::attn_dense_body<192, true, 768, 768, 512, DM>(QM + q0 * 768 + h * 192, KM + h * 192, VM + h * 128, nullptr, CAT + q0 * DM + 1536 + h * 128, MROWS, F.ldsg); continue; }
        u -= n_mla;
        if (u < n_diff) { if (!(filt & 4)) continue; const int mi = u >> 5, qb = u & 31; const size_t q0 = (size_t)qb * 256;
            att::attn_dense_body<64, false, INW, INW, INW, 1024>(P + q0 * INW + C_DQ + mi * 64, P + C_DK + mi * 64, P + C_DV + (mi >> 1) * 128, OD + q0 * 1024 + mi * 128, nullptr, MROWS, F.ldsg); continue; }
        u -= n_diff;
        if (u < n_scan) { if (filt & 1) ssd_scan_unit(F, u); continue; }
        u -= n_scan;
        if (u < n_cm) { if (!(filt & 2)) continue; const int h = u; const size_t q0 = SEQ;
            att::attn_dense_body<192, true, 768, 768, 512, DM>(QM + q0 * 768 + h * 192, KM + q0 * 768 + h * 192, VM + q0 * 512 + h * 128, nullptr, CAT + q0 * DM + 1536 + h * 128, NCTX, F.ldsg); continue; }
        u -= n_cm;
        if (u >= n_cd) { if (rep == 0) deferred_transpose_unit(F, u - n_cd); continue; }
        if (filt & 4) { const int mi = u; const size_t q0 = SEQ;
            att::attn_dense_body<64, false, INW, INW, INW, 1024>(P + q0 * INW + C_DQ + mi * 64, P + q0 * INW + C_DK + mi * 64, P + q0 * INW + C_DV + (mi >> 1) * 128, OD + q0 * 1024 + mi * 128, nullptr, NCTX, F.ldsg); }
    }
}

typedef __attribute__((address_space(1))) unsigned gu32;
#define XB_TMO      128
#define XB_XCNT(j)  (256  + 64 * (j))
#define XB_XSUB(j)  (1280 + 64 * (j))
#define XB_XGEN(j)  (2304 + 64 * (j))
#define XB_TOP      3328
#define XB_TOPGEN   3392
#define XCD_BAR_WORDS 3456
#define XB_SPIN_CAP (1u << 18)

__device__ __forceinline__ unsigned xb_ld(unsigned* p)              { return __hip_atomic_load(p, __ATOMIC_RELAXED, __HIP_MEMORY_SCOPE_AGENT); }
__device__ __forceinline__ unsigned xb_add(unsigned* p, unsigned v) { return __hip_atomic_fetch_add(p, v, __ATOMIC_RELAXED, __HIP_MEMORY_SCOPE_AGENT); }
__device__ __forceinline__ unsigned xb_xcc_id() { return (unsigned)__builtin_amdgcn_s_getreg((3 << 11) | 20) & 0xFu; }
#define XB_SPIN(cond, bar) do { unsigned _sp = 0; while (cond) { __builtin_amdgcn_s_sleep(1); \
    if ((++_sp & 255u) == 0u) { if (xb_ld(&(bar)[XB_TMO])) break; if (_sp > XB_SPIN_CAP) { atomicAdd(&(bar)[XB_TMO], 1u); break; } } } } while (0)

struct XcdBarrier {
    unsigned* bar; unsigned x;
    volatile LAS unsigned* st;
};

__device__ __forceinline__ XcdBarrier xcd_barrier_post(unsigned* bar, volatile LAS unsigned* st) {
    XcdBarrier b; b.bar = bar; b.x = xb_xcc_id(); b.st = st;
    if (threadIdx.x == 0) (void)xb_add(&bar[XB_XCNT(b.x)], 1u);
    return b;
}
__device__ __forceinline__ void xcd_barrier_complete(unsigned* bar, unsigned x, unsigned& nloc, unsigned& nx) {
    const unsigned G = gridDim.x * gridDim.y * gridDim.z;
    unsigned sum, cnt, mine, sp = 0u;
    for (;;) {
        sum = 0u; cnt = 0u; mine = 0u;
#pragma unroll
        for (unsigned j = 0; j < 16; ++j) { const unsigned c = xb_ld(&bar[XB_XCNT(j)]); sum += c; cnt += (c > 0u) ? 1u : 0u; mine = (j == x) ? c : mine; }
        if (sum == G) break;
        __builtin_amdgcn_s_sleep(1);
        if ((++sp & 255u) == 0u) { if (xb_ld(&bar[XB_TMO])) break; if (sp > XB_SPIN_CAP) { atomicAdd(&bar[XB_TMO], 1u); break; } }
    }
    nloc = mine > 0u ? mine : 1u; nx = cnt > 0u ? cnt : 1u;
}

__device__ __forceinline__ void xcd_barrier(const XcdBarrier& b) {
    asm volatile("s_waitcnt vmcnt(0)" ::: "memory");
    __syncthreads();
    if (threadIdx.x == 0) {
        unsigned* bar = b.bar;
        __builtin_amdgcn_s_waitcnt(0);
        unsigned bx_ = b.x; asm volatile("" : "+s"(bx_));
        unsigned nloc = b.st[0], nx = b.st[1];
        if (nloc == 0u) { xcd_barrier_complete(bar, bx_, nloc, nx); b.st[0] = nloc; b.st[1] = nx; }
        const unsigned old = xb_add(&bar[XB_XSUB(bx_)], 1u);
        const unsigned gen = old / nloc;
        if (old + 1u == (gen + 1u) * nloc) {
            __builtin_amdgcn_fence(__ATOMIC_RELEASE, "agent");
            asm volatile("s_waitcnt vmcnt(0)" ::: "memory");
            const unsigned og = xb_add(&bar[XB_TOP], 1u);
            const unsigned tg = og / nx;
            if (og + 1u == (tg + 1u) * nx) xb_add(&bar[XB_TOPGEN], 1u);
            else XB_SPIN(xb_ld(&bar[XB_TOPGEN]) == tg, bar);
            __builtin_amdgcn_fence(__ATOMIC_ACQUIRE, "agent");
            xb_add(&bar[XB_XGEN(bx_)], 1u);
            asm volatile("s_waitcnt vmcnt(0)" ::: "memory");
        } else {
            XB_SPIN(xb_ld(&bar[XB_XGEN(bx_)]) == gen, bar);
            __builtin_amdgcn_fence(__ATOMIC_ACQUIRE, "agent");
            asm volatile("s_waitcnt vmcnt(0)" ::: "memory");
        }
    }
    __syncthreads();
}


__global__ void __launch_bounds__(NTHR, 2) mk_fwd(Args args) {
    extern __shared__ __attribute__((aligned(16))) unsigned char lds_raw[];
    Frame F;
    F.lds = (LAS unsigned char*)lds_raw; F.ldsg = (char*)lds_raw;
    const int lo = args.ph_lo, hi = args.ph_hi;
    volatile LAS unsigned* bst = (volatile LAS unsigned*)((LAS unsigned char*)lds_raw + (LDS_BYTES - 32));
    if (threadIdx.x == 0) { bst[0] = 0u; bst[1] = 0u; }
    __syncthreads();
    XcdBarrier xbar = xcd_barrier_post((unsigned*)args.ws + 1024, bst);
    int nseam = 0;
    for (int ph = lo; ph < hi; ++ph) {
      int nrep = 1;
      if (PROBE_MASK) { const int sp_ = ph < 3 ? -1 : (ph - 3) % 10;
          const int ty = ph < 3 ? ph : (sp_ == 0 ? 3 : sp_ == 1 ? 4 : sp_ == 2 ? 5 : sp_ == 3 ? 7 : sp_ == 4 ? 10 : sp_ == 5 ? 12 : sp_ == 6 ? 13 : sp_ == 7 ? 14 : sp_ == 8 ? 15 : 13);
          if (PRB(ty)) nrep = 2; }
      for (int rep = 0; rep < nrep; ++rep) {
        if (ph > lo || rep > 0) { if (nseam == 0) cg::this_grid().sync(); else xcd_barrier(xbar); ++nseam; }
        { const __attribute__((address_space(4))) char* ka = (const __attribute__((address_space(4))) char*)__builtin_amdgcn_kernarg_segment_ptr(); asm volatile("" : "+s"(ka)); F.ka = ka;
          F.out = *(float* const __attribute__((address_space(4)))*)(ka + 216); F.ws = *(unsigned char* const __attribute__((address_space(4)))*)(ka + 224); }
        F.tid = ltid(); F.lane = F.tid & 63; F.wave = __builtin_amdgcn_readfirstlane(F.tid >> 6);
        F.bid = lbid(); F.G = gridDim.x; F.gw = F.bid * NWAVES + F.wave; F.NGW = F.G * NWAVES;
        if (ph == 0) { if (PHON(0)) phase_prologue(F); continue; }
        if (ph == 1) { if (PHON(1)) phase_modfinal(F); continue; }
        if (ph == 2) { if (PHON(2)) phase_copy_mod(F); continue; }
        const int l = (ph - 3) / 10, sp = (ph - 3) % 10;
        const bool last = (l == 1);
        int Kq = 384, Kkv = 256; asm volatile("" : "+s"(Kq), "+s"(Kkv));
        const int Mact = last ? SEQ : MROWS;
        unsigned char* wb = F.ws + WS_W0 + (size_t)l * W_LAYER;
        if (sp == 0) { if (PHON(3)) {
            pg8::Gemm g{WSP(const bf16_t, WS_H), (const bf16_t*)(wb + WO_IN), MROWS, INW, DM, DM}; pg8::StaticOrder S; S.init(MROWS, INW, F.G, F.bid);
            pg8::EpiBf16R<0> E{WSP(bf16_t, WS_P), nullptr, WSP(const pg8::f32x2, WS_ROPE)};
            pg8::gemm_phase<pg8::EpiBf16R<0>, pg8::StaticOrder, true, true>(F.lds, g, S, E); }
        } else if (sp == 1) {
            if (PHON(4)) phase_prep(F, l);
        } else if (sp == 2) {
            if (PHON(5)) { pg8::Gemm g{WSP(const bf16_t, WS_CQN), (const bf16_t*)(wb + WO_Q), Mact, 768, Kq, Kq}; pg8::StaticOrder S; S.init(Mact, 768, F.G, F.bid);
              pg8::EpiBf16R<1> E{WSP(bf16_t, WS_QMLA), nullptr, WSP(const pg8::f32x2, WS_ROPE)};
              pg8::gemm_phase<pg8::EpiBf16R<1>, pg8::StaticOrder, true, true>(F.lds, g, S, E); }
            __syncthreads();
            if (PHON(16)) { pg8::Gemm g{WSP(const bf16_t, WS_CKVN), (const bf16_t*)(wb + WO_KV), MROWS, 1024, Kkv, Kkv}; pg8::StaticOrder S; S.init(MROWS, 1024, F.G, F.bid);
              pg8::EpiBf16R<2> E{WSP(bf16_t, WS_KMLA), WSP(bf16_t, WS_VMLA), nullptr};
              pg8::gemm_phase<pg8::EpiBf16R<2>, pg8::StaticOrder, true, true>(F.lds, g, S, E); }
            __syncthreads();
            if (PHON(6)) phase_ssd1(F, l);
        } else if (sp == 3) {
            phase_attn(F, l, rep);
        } else if (sp == 4) {
            if (PHON(10)) phase_ssd2(F, l, last ? 2 : 0);
            if (PHON(11)) phase_diffcombine(F, l, Mact);
        } else if (sp == 5) { if (PHON(12)) {
            pg8::Gemm g{WSP(const bf16_t, WS_CAT), (const bf16_t*)(wb + WO_OUT), SEQ, DM, DM, DM}; pg8::StaticOrder S; S.init(SEQ, DM, F.G, F.bid);
            pg8::EpiResid E{last ? WSP(const float, WS_XA) : INP(0), WSP(float, WS_PRE), modvec(F, l, 0, 2), modvec(F, l, 1, 2)};
            pg8::gemm_phase<pg8::EpiResid, pg8::StaticOrder, true, true>(F.lds, g, S, E);
            if (!last) {
                __syncthreads();
                int kc = 256; asm volatile("" : "+s"(kc));
                pg8::Gemm g2{WSP(const bf16_t, WS_CAT) + (size_t)SEQ * DM, (const bf16_t*)(wb + WO_OUT), 256, DM, kc, DM}; pg8::SplitKOrder S2; S2.init(DM, 8, 256, F.G, (F.bid + 128) % F.G);
                pg8::EpiPart E2{WSP(float, WS_PART)};
                pg8::gemm_phase<pg8::EpiPart, pg8::SplitKOrder, true, true>(F.lds, g2, S2, E2);
            } }
        } else if (sp == 6) {
            if (PHON(13)) phase_ln<8>(F, !last, WSP(const float, WS_PRE), INP(21) + l * DM, INP(22) + l * DM, WSP(float, WS_X1), l, 3, 4, true, INP(2) - (size_t)SEQ * DM, modvec(F, l, 1, 2));
        } else if (sp == 7) { if (PHON(14)) {
            pg8::Gemm g{WSP(const bf16_t, WS_H), (const bf16_t*)(wb + WO_F1), Mact, 2 * DFF, DM, DM}; pg8::StaticOrder S; S.init(Mact, 2 * DFF, F.G, F.bid);
            pg8::EpiSwiglu E{WSP(bf16_t, WS_ACT)};
            pg8::gemm_phase<pg8::EpiSwiglu, pg8::StaticOrder, true, true>(F.lds, g, S, E); }
        } else if (sp == 8) { if (PHON(15)) {
            pg8::Gemm g{WSP(const bf16_t, WS_ACT), (const bf16_t*)(wb + WO_F2), SEQ, DM, DFF, DFF}; pg8::StaticOrder S; S.init(SEQ, DM, F.G, F.bid);
            pg8::EpiResid E{WSP(const float, WS_X1), WSP(float, WS_PRE), modvec(F, l, 0, 5), modvec(F, l, 1, 5)};
            pg8::gemm_phase<pg8::EpiResid, pg8::StaticOrder, true, true>(F.lds, g, S, E);
            if (!last) {
                __syncthreads();
                int kc = 512; asm volatile("" : "+s"(kc));
                pg8::Gemm g2{WSP(const bf16_t, WS_ACT) + (size_t)SEQ * DFF, (const bf16_t*)(wb + WO_F2), 256, DM, kc, DFF}; pg8::SplitKOrder S2; S2.init(DM, 11, 512, F.G, (F.bid + 128) % F.G);
                pg8::EpiPart E2{WSP(float, WS_PART)};
                pg8::gemm_phase<pg8::EpiPart, pg8::SplitKOrder, true, true>(F.lds, g2, S2, E2);
            } }
        } else if (PHON(13)) {
            if (!last) phase_ln<11>(F, true, WSP(const float, WS_PRE), INP(25) + l * DM, INP(26) + l * DM, WSP(float, WS_XA), l + 1, 0, 1, true, WSP(const float, WS_X1), modvec(F, l, 1, 5));
            else       phase_ln<1>(F, false, WSP(const float, WS_PRE), INP(25) + l * DM, INP(26) + l * DM, F.out, 0, 0, 1, false, nullptr, nullptr);
        }
      }
    }
}

extern "C" void kernel_launch(void* const* d_in, const int* in_sizes, int n_in, void* d_out, int out_size, void* d_ws, size_t ws_size, hipStream_t stream) {
    static int grid = 0;
    if (grid == 0) {
        if (n_in != 27 || in_sizes[0] != SEQ * DM || out_size != SEQ * DM || ws_size < WS_END) {
            fprintf(stderr, "kernel_launch: unexpected shapes: n_in %d in0 %d out %d ws %zu (need >= %zu)\n", n_in, n_in > 0 ? in_sizes[0] : -1, out_size, ws_size, (size_t)WS_END); grid = -1; return; }
        int dev = 0, cus = 0, per_cu = 0;
        if (hipGetDevice(&dev) != hipSuccess || hipDeviceGetAttribute(&cus, hipDeviceAttributeMultiprocessorCount, dev) != hipSuccess) { grid = -1; return; }
        if (hipFuncSetAttribute((const void*)mk_fwd, hipFuncAttributeMaxDynamicSharedMemorySize, LDS_BYTES) != hipSuccess) { fprintf(stderr, "kernel_launch: hipFuncSetAttribute failed\n"); grid = -1; return; }
        if (hipOccupancyMaxActiveBlocksPerMultiprocessor(&per_cu, (const void*)mk_fwd, NTHR, LDS_BYTES) != hipSuccess || per_cu < 1) { fprintf(stderr, "kernel_launch: occupancy query gave %d\n", per_cu); per_cu = 1; }
        (void)hipGetLastError();
        grid = cus * 1;
    }
    if (grid < 0) return;
    (void)hipMemsetAsync((char*)d_ws + WS_CTL, 0, CTL_BYTES, stream);
    Args a{};
    for (int i = 0; i < 27; ++i) a.in[i] = (const float*)d_in[i];
    a.out = (float*)d_out; a.ws = (unsigned char*)d_ws;
#if MK_ONE_LAUNCH
    a.ph_lo = 0; a.ph_hi = NPH;
    void* kargs[] = {&a};
    hipError_t e = hipLaunchCooperativeKernel((const void*)mk_fwd, dim3(grid), dim3(NTHR), kargs, LDS_BYTES, stream);
    if (e != hipSuccess) fprintf(stderr, "kernel_launch: cooperative launch failed: %s (grid %d)\n", hipGetErrorString(e), grid);
#else
    for (int ph = 0; ph < NPH; ++ph) { a.ph_lo = ph; a.ph_hi = ph + 1; hipLaunchKernelGGL(mk_fwd, dim3(grid), dim3(NTHR), LDS_BYTES, stream, a); }
    const hipError_t le = hipPeekAtLastError();
    if (le != hipSuccess) fprintf(stderr, "kernel_launch: launch failed: %s\n", hipGetErrorName(le));
#endif
}
```

```cpp
#include <hip/hip_runtime.h>
#include <hip/hip_cooperative_groups.h>
#include <cstdio>
#include <cstdint>
namespace cg = cooperative_groups;

#ifndef MK_ONE_LAUNCH
#define MK_ONE_LAUNCH 1
#endif

constexpr int DM = 2048, SEQ = 8192, NCTX = 256, MROWS = SEQ + NCTX;
constexpr int INW = 5376;
constexpr int DFF = 5632;
constexpr int NPH = 23;
constexpr int C_BG = 0, C_CG = 512, C_U = 1024, C_DQ = 1536, C_DK = 2048, C_DV = 2560, C_Z = 3072, C_XBC = 3584, C_CQ = 4608, C_CKV = 4992, C_KR = 5248, C_DT = 5312;
constexpr float ALPHA_F = 1.4142135623730951f;

__device__ __forceinline__ int ltid() { int t = threadIdx.x; asm volatile("" : "+v"(t)); return t; }
__device__ __forceinline__ int lbid() { int b = blockIdx.x; asm volatile("" : "+s"(b)); return b; }

__device__ const float2 ROPE_TAB[2048] = {
  {1.000000000e+00f, 0.000000000e+00f}, {1.000000000e+00f, 0.000000000e+00f}, {1.000000000e+00f, 0.000000000e+00f}, {1.000000000e+00f, 0.000000000e+00f}, {1.000000000e+00f, 0.000000000e+00f}, {1.000000000e+00f, 0.000000000e+00f}, {1.000000000e+00f, 0.000000000e+00f}, {1.000000000e+00f, 0.000000000e+00f},
  {1.000000000e+00f, 0.000000000e+00f}, {1.000000000e+00f, 0.000000000e+00f}, {1.000000000e+00f, 0.000000000e+00f}, {1.000000000e+00f, 0.000000000e+00f}, {1.000000000e+00f, 0.000000000e+00f}, {1.000000000e+00f, 0.000000000e+00f}, {1.000000000e+00f, 0.000000000e+00f}, {1.000000000e+00f, 0.000000000e+00f},
  {5.403023059e-01f, 8.414709848e-01f}, {8.460091064e-01f, 5.331684460e-01f}, {9.504152809e-01f, 3.109835909e-01f}, {9.842302348e-01f, 1.768921847e-01f}, {9.950041651e-01f, 9.983341813e-02f}, {9.984192778e-01f, 5.620449919e-02f}, {9.995000417e-01f, 3.161750470e-02f}, {9.998418903e-01f, 1.778185709e-02f},
  {9.999500004e-01f, 9.999833111e-03f}, {9.999841887e-01f, 5.623383612e-03f}, {9.999950000e-01f, 3.162272359e-03f}, {9.999984189e-01f, 1.778278494e-03f}, {9.999995000e-01f, 9.999998808e-04f}, {9.999998419e-01f, 5.623412721e-04f}, {9.999999500e-01f, 3.162277519e-04f}, {9.999999842e-01f, 1.778279393e-04f},
  {-4.161468365e-01f, 9.092974268e-01f}, {4.314628163e-01f, 9.021307212e-01f}, {8.065784124e-01f, 5.911271138e-01f}, {9.374183100e-01f, 3.482052729e-01f}, {9.800665772e-01f, 1.986693337e-01f}, {9.936821085e-01f, 1.122313110e-01f}, {9.980006668e-01f, 6.320339453e-02f}, {9.993676111e-01f, 3.555809121e-02f},
  {9.998000067e-01f, 1.999866625e-02f}, {9.999367551e-01f, 1.124658940e-02f}, {9.999800001e-01f, 6.324513096e-03f}, {9.999936755e-01f, 3.556551364e-03f}, {9.999980000e-01f, 1.999998762e-03f}, {9.999993675e-01f, 1.124682366e-03f}, {9.999998000e-01f, 6.324554721e-04f}, {9.999999368e-01f, 3.556558729e-04f},
  {-9.899924966e-01f, 1.411200081e-01f}, {-1.159661631e-01f, 9.932531646e-01f}, {5.827536401e-01f, 8.126488756e-01f}, {8.610406595e-01f, 5.085361174e-01f}, {9.553364856e-01f, 2.955202180e-01f}, {9.858034692e-01f, 1.679033061e-01f}, {9.955033745e-01f, 9.472608625e-02f}, {9.985773124e-01f, 5.332308304e-02f},
  {9.995500338e-01f, 2.999549953e-02f}, {9.998577009e-01f, 1.686943954e-02f}, {9.999550003e-01f, 9.486690354e-03f}, {9.999857698e-01f, 5.334812988e-03f}, {9.999955000e-01f, 2.999995526e-03f}, {9.999985770e-01f, 1.687023105e-03f}, {9.999995500e-01f, 9.486831000e-04f}, {9.999998577e-01f, 5.334837808e-04f},
  {-6.536436209e-01f, -7.568024953e-01f}, {-6.276796763e-01f, 7.784717233e-01f}, {3.011374707e-01f, 9.535807379e-01f}, {7.575061759e-01f, 6.528279969e-01f}, {9.210609917e-01f, 3.894183478e-01f}, {9.748082657e-01f, 2.230444915e-01f}, {9.920106618e-01f, 1.261540598e-01f}, {9.974712443e-01f, 7.107120934e-02f},
  {9.992001067e-01f, 3.998933329e-02f}, {9.997470285e-01f, 2.249175622e-02f}, {9.999200011e-01f, 1.264877321e-02f}, {9.999747019e-01f, 7.113057742e-03f}, {9.999920000e-01f, 3.999989523e-03f}, {9.999974702e-01f, 2.249363310e-03f}, {9.999992000e-01f, 1.264910691e-03f}, {9.999997470e-01f, 7.113117008e-04f},
  {2.836621855e-01f, -9.589242747e-01f}, {-9.460792425e-01f, 3.239352821e-01f}, {-1.034233808e-02f, 9.999465166e-01f}, {6.300802992e-01f, 7.765299843e-01f}, {8.775825619e-01f, 4.794255386e-01f}, {9.607312596e-01f, 2.774805341e-01f}, {9.875260225e-01f, 1.574558824e-01f}, {9.960497565e-01f, 8.879686156e-02f},
  {9.987502605e-01f, 4.997916629e-02f}, {9.996047413e-01f, 2.811336165e-02f}, {9.998750026e-01f, 1.581072865e-02f}, {9.999604718e-01f, 8.891280002e-03f}, {9.999875000e-01f, 4.999979521e-03f}, {9.999960472e-01f, 2.811702920e-03f}, {9.999987500e-01f, 1.581138156e-03f}, {9.999996047e-01f, 8.891395984e-04f},
  {9.601702867e-01f, -2.794154982e-01f}, {-9.731036980e-01f, -2.303675170e-01f}, {-3.207963899e-01f, 9.471481807e-01f}, {4.827820346e-01f, 8.757405478e-01f}, {8.253356014e-01f, 5.646424931e-01f}, {9.436169596e-01f, 3.310393232e-01f}, {9.820539372e-01f, 1.886002770e-01f}, {9.943132976e-01f, 1.064944419e-01f},
  {9.982005400e-01f, 5.996400514e-02f}, {9.994308440e-01f, 3.373407806e-02f}, {9.998200054e-01f, 1.897252691e-02f}, {9.999430795e-01f, 1.066947415e-02f}, {9.999820001e-01f, 5.999964052e-03f}, {9.999943079e-01f, 3.374041408e-03f}, {9.999982000e-01f, 1.897365346e-03f}, {9.999994308e-01f, 1.066967410e-03f},
  {7.539022543e-01f, 6.569865987e-01f}, {-7.004298139e-01f, -7.137212872e-01f}, {-5.994374526e-01f, 8.004216016e-01f}, {3.202570024e-01f, 9.473306986e-01f}, {7.648421950e-01f, 6.442176781e-01f}, {9.235194568e-01f, 3.835515778e-01f}, {9.755998794e-01f, 2.195560870e-01f}, {9.922624183e-01f, 1.241583392e-01f},
  {9.975510002e-01f, 6.994284763e-02f}, {9.992253421e-01f, 3.935372584e-02f}, {9.997550100e-01f, 2.213413545e-02f}, {9.999225252e-01f, 1.244763455e-02f}, {9.999755001e-01f, 6.999943050e-03f}, {9.999922524e-01f, 3.936378830e-03f}, {9.999975500e-01f, 2.213592463e-03f}, {9.999992252e-01f, 1.244795304e-03f},
  {-1.455000338e-01f, 9.893582466e-01f}, {-2.120364479e-01f, -9.772617586e-01f}, {-8.186324475e-01f, 5.743177830e-01f}, {1.476312130e-01f, 9.890424788e-01f}, {6.967067008e-01f, 7.173560992e-01f}, {9.005023096e-01f, 4.348512278e-01f}, {9.681703064e-01f, 2.502923447e-01f}, {9.898977664e-01f, 1.417829752e-01f},
  {9.968017064e-01f, 7.991469219e-02f}, {9.989882418e-01f, 4.497213288e-02f}, {9.996800171e-01f, 2.529552265e-02f}, {9.998988088e-01f, 1.422575559e-02f}, {9.999680002e-01f, 7.999915047e-03f}, {9.999898807e-01f, 4.498715239e-03f}, {9.999968000e-01f, 2.529819359e-03f}, {9.999989881e-01f, 1.422623042e-03f},
  {-9.111302619e-01f, 4.121184852e-01f}, {3.416602554e-01f, -9.398235313e-01f}, {-9.566441680e-01f, 2.912592245e-01f}, {-2.965079623e-02f, 9.995603185e-01f}, {6.216099403e-01f, 7.833269319e-01f}, {8.746382611e-01f, 4.847761465e-01f}, {9.597726443e-01f, 2.807783310e-01f}, {9.872200896e-01f, 1.593627767e-01f},
  {9.959527334e-01f, 8.987854534e-02f}, {9.987195508e-01f, 5.058911778e-02f}, {9.995950273e-01f, 2.845665689e-02f}, {9.998719305e-01f, 1.600383071e-02f}, {9.999595003e-01f, 8.999879044e-03f}, {9.999871928e-01f, 5.061050226e-03f}, {9.999959500e-01f, 2.846046001e-03f}, {9.999987193e-01f, 1.600450735e-03f},
  {-8.390715291e-01f, -5.440211109e-01f}, {7.901318660e-01f, -6.129368926e-01f}, {-9.997860721e-01f, -2.068356987e-02f}, {-2.059976331e-01f, 9.785524897e-01f}, {5.403023059e-01f, 8.414709848e-01f}, {8.460091064e-01f, 5.331684460e-01f}, {9.504152902e-01f, 3.109835626e-01f}, {9.842302348e-01f, 1.768921847e-01f},
  {9.950041659e-01f, 9.983341072e-02f}, {9.984192778e-01f, 5.620449919e-02f}, {9.995000417e-01f, 3.161750470e-02f}, {9.998418903e-01f, 1.778185709e-02f}, {9.999500004e-01f, 9.999834042e-03f}, {9.999841887e-01f, 5.623383612e-03f}, {9.999950000e-01f, 3.162272359e-03f}, {9.999984189e-01f, 1.778278494e-03f},
  {4.425697988e-03f, -9.999902066e-01f}, {9.952573993e-01f, -9.727645772e-02f}, {-9.437797393e-01f, -3.305749593e-01f}, {-3.758474003e-01f, 9.266815697e-01f}, {4.535961002e-01f, 8.912073709e-01f}, {8.147053420e-01f, 5.798751639e-01f}, {9.401075903e-01f, 3.408778647e-01f}, {9.809291472e-01f, 1.943656558e-01f},
  {9.939560980e-01f, 1.097783002e-01f}, {9.980874321e-01f, 6.181810327e-02f}, {9.993950610e-01f, 3.477804006e-02f}, {9.998086883e-01f, 1.955982724e-02f}, {9.999395006e-01f, 1.099977904e-02f}, {9.999808683e-01f, 6.185714754e-03f}, {9.999939500e-01f, 3.478498401e-03f}, {9.999980868e-01f, 1.956106080e-03f},
  {8.438539587e-01f, -5.365729180e-01f}, {8.938616142e-01f, 4.483429653e-01f}, {-7.941793525e-01f, -6.076834341e-01f}, {-5.338430142e-01f, 8.455836068e-01f}, {3.623577100e-01f, 9.320391032e-01f}, {7.808259330e-01f, 6.247486393e-01f}, {9.288598710e-01f, 3.704312892e-01f}, {9.773178677e-01f, 2.117776794e-01f},
  {9.928086362e-01f, 1.197122046e-01f}, {9.977240240e-01f, 6.742975621e-02f}, {9.992800864e-01f, 3.793822392e-02f}, {9.997723246e-01f, 2.133773367e-02f}, {9.999280009e-01f, 1.199971211e-02f}, {9.999772317e-01f, 6.748044406e-03f}, {9.999928000e-01f, 3.794723862e-03f}, {9.999977232e-01f, 2.133933605e-03f},
  {9.074467815e-01f, 4.201670368e-01f}, {5.171728454e-01f, 8.558809777e-01f}, {-5.658204930e-01f, -8.245284529e-01f}, {-6.750016657e-01f, 7.378162043e-01f}, {2.674987597e-01f, 9.635582046e-01f}, {7.444779872e-01f, 6.676470075e-01f}, {9.166833698e-01f, 3.996143135e-01f}, {9.733975442e-01f, 2.291227201e-01f},
  {9.915618943e-01f, 1.296341379e-01f}, {9.973290651e-01f, 7.303927684e-02f}, {9.991551190e-01f, 4.109803212e-02f}, {9.997327995e-01f, 2.311557262e-02f}, {9.999155012e-01f, 1.299963410e-02f}, {9.999732789e-01f, 7.310371924e-03f}, {9.999915500e-01f, 4.110949176e-03f}, {9.999973279e-01f, 2.311761062e-03f},
  {1.367372182e-01f, 9.906073557e-01f}, {-1.879615160e-02f, 9.998233367e-01f}, {-2.813494808e-01f, -9.596053718e-01f}, {-7.948709048e-01f, 6.067785796e-01f}, {1.699671664e-01f, 9.854497259e-01f}, {7.057763743e-01f, 7.084346897e-01f}, {9.035902493e-01f, 4.283977840e-01f}, {9.691694136e-01f, 2.463953078e-01f},
  {9.902159961e-01f, 1.395431152e-01f}, {9.969025685e-01f, 7.864648034e-02f}, {9.990201601e-01f, 4.425742562e-02f}, {9.996901128e-01f, 2.489334034e-02f}, {9.999020016e-01f, 1.399954310e-02f}, {9.999690098e-01f, 7.872696665e-03f}, {9.999902000e-01f, 4.427174080e-03f}, {9.999969010e-01f, 2.489588678e-03f},
  {-7.596879129e-01f, 6.502878402e-01f}, {-5.489754720e-01f, 8.358384600e-01f}, {3.102235090e-02f, -9.995186910e-01f}, {-8.896704271e-01f, 4.566032536e-01f}, {7.073720167e-02f, 9.974949866e-01f}, {6.648435293e-01f, 7.469826514e-01f}, {8.895936264e-01f, 4.567528653e-01f}, {9.646348168e-01f, 2.635899662e-01f},
  {9.887710793e-01f, 1.494381236e-01f}, {9.964445467e-01f, 8.425120425e-02f}, {9.988752109e-01f, 4.741638026e-02f}, {9.996442648e-01f, 2.667102934e-02f}, {9.998875021e-01f, 1.499943810e-02f}, {9.999644246e-01f, 8.435019847e-03f}, {9.999887500e-01f, 4.743398540e-03f}, {9.999964424e-01f, 2.667415984e-03f},
  {-9.576594803e-01f, -2.879033167e-01f}, {-9.100810896e-01f, 4.144302238e-01f}, {3.403181682e-01f, -9.403103447e-01f}, {-9.564100499e-01f, 2.920270818e-01f}, {-2.919954613e-02f, 9.995736023e-01f}, {6.218088193e-01f, 7.831690700e-01f}, {8.747074844e-01f, 4.846512321e-01f}, {9.597951759e-01f, 2.807013010e-01f},
  {9.872272839e-01f, 1.593182031e-01f}, {9.959550145e-01f, 8.985326392e-02f}, {9.987202731e-01f, 5.057485702e-02f}, {9.995952558e-01f, 2.844863214e-02f}, {9.998720027e-01f, 1.599931810e-02f}, {9.999595231e-01f, 8.997339431e-03f}, {9.999872000e-01f, 5.059622526e-03f}, {9.999959523e-01f, 2.845243204e-03f},
  {-2.751633381e-01f, -9.613974919e-01f}, {-9.908979596e-01f, -1.346151313e-01f}, {6.158647923e-01f, -7.878518627e-01f}, {-9.929849841e-01f, 1.182405237e-01f}, {-1.288445416e-01f, 9.916648043e-01f}, {5.768082960e-01f, 8.168795441e-01f}, {8.589467084e-01f, 5.120649883e-01f}, {9.546520286e-01f, 2.977238725e-01f},
  {9.855847666e-01f, 1.691823508e-01f}, {9.954339876e-01f, 9.545248218e-02f}, {9.985553481e-01f, 5.373282803e-02f}, {9.995430857e-01f, 3.022614497e-02f}, {9.998555035e-01f, 1.699918210e-02f}, {9.999543054e-01f, 9.559656169e-03f}, {9.999855500e-01f, 5.375846007e-03f}, {9.999954305e-01f, 3.023070335e-03f},
  {6.603167082e-01f, -7.509872468e-01f}, {-7.665365398e-01f, -6.422006954e-01f}, {8.303361283e-01f, -5.572628770e-01f}, {-9.982416606e-01f, -5.927551864e-02f}, {-2.272021643e-01f, 9.738476146e-01f}, {5.299841756e-01f, 8.480075316e-01f}, {8.423270577e-01f, 5.389667224e-01f}, {9.492070108e-01f, 3.146522695e-01f},
  {9.838436942e-01f, 1.790295658e-01f}, {9.948814823e-01f, 1.010486820e-01f}, {9.983804374e-01f, 5.689026544e-02f}, {9.994877548e-01f, 3.200356222e-02f}, {9.998380044e-01f, 1.799902910e-02f}, {9.999487715e-01f, 1.012197082e-02f}, {9.999838000e-01f, 5.692068949e-03f}, {9.999948771e-01f, 3.200897370e-03f},
  {9.887046182e-01f, 1.498772097e-01f}, {-3.060954058e-01f, -9.520008417e-01f}, {9.624637956e-01f, -2.714100995e-01f}, {-9.720142724e-01f, -2.349218044e-01f}, {-3.232895443e-01f, 9.463000954e-01f}, {4.814845890e-01f, 8.764545570e-01f}, {8.248651506e-01f, 5.653295351e-01f}, {9.434618259e-01f, 3.314811956e-01f},
  {9.820042356e-01f, 1.888588926e-01f}, {9.942975170e-01f, 1.066416789e-01f}, {9.981955430e-01f, 6.004713022e-02f}, {9.994292631e-01f, 3.378088199e-02f}, {9.998195054e-01f, 1.899885811e-02f}, {9.999429214e-01f, 1.068428133e-02f}, {9.999819501e-01f, 6.008291323e-03f}, {9.999942921e-01f, 3.378724537e-03f},
  {4.080820618e-01f, 9.129452507e-01f}, {2.486167313e-01f, -9.686019414e-01f}, {9.991443799e-01f, 4.135829015e-02f}, {-9.151299503e-01f, -4.031589936e-01f}, {-4.161468365e-01f, 9.092974268e-01f}, {4.314628163e-01f, 9.021307212e-01f}, {8.065784476e-01f, 5.911270657e-01f}, {9.374183100e-01f, 3.482052729e-01f},
  {9.800665802e-01f, 1.986693191e-01f}, {9.936821085e-01f, 1.122313110e-01f}, {9.980006668e-01f, 6.320339453e-02f}, {9.993676111e-01f, 3.555809121e-02f}, {9.998000066e-01f, 1.999866811e-02f}, {9.999367551e-01f, 1.124658940e-02f}, {9.999800001e-01f, 6.324513096e-03f}, {9.999936755e-01f, 3.556551364e-03f},
  {-5.477292602e-01f, 8.366556385e-01f}, {7.267602563e-01f, -6.868912067e-01f}, {9.367404516e-01f, 3.500247509e-01f}, {-8.293829489e-01f, -5.586805205e-01f}, {-5.048462281e-01f, 8.632092944e-01f}, {3.800769984e-01f, 9.249548504e-01f}, {7.874851971e-01f, 6.163335658e-01f}, {9.310783539e-01f, 3.648192688e-01f},
  {9.780309161e-01f, 2.084598934e-01f}, {9.930352772e-01f, 1.178173940e-01f}, {9.977958103e-01f, 6.635903053e-02f}, {9.993027988e-01f, 3.733518799e-02f}, {9.997795081e-01f, 2.099845811e-02f}, {9.999302726e-01f, 1.180889298e-02f}, {9.999779501e-01f, 6.640734236e-03f}, {9.999930272e-01f, 3.734378079e-03f},
  {-9.999608264e-01f, -8.851309290e-03f}, {9.810745815e-01f, -1.936302286e-01f}, {7.814403926e-01f, 6.239798978e-01f}, {-7.174774633e-01f, -6.965817179e-01f}, {-5.885011558e-01f, 8.084963758e-01f}, {3.274895886e-01f, 9.448547874e-01f}, {7.676045628e-01f, 6.409237359e-01f}, {9.244439837e-01f, 3.813178741e-01f},
  {9.758974496e-01f, 2.182296219e-01f}, {9.923570442e-01f, 1.233997439e-01f}, {9.975809759e-01f, 6.951400294e-02f}, {9.992348263e-01f, 3.911217043e-02f}, {9.997580097e-01f, 2.199822712e-02f}, {9.999234739e-01f, 1.237119282e-02f}, {9.999758001e-01f, 6.956954712e-03f}, {9.999923473e-01f, 3.912204676e-03f},
  {-5.328330203e-01f, -8.462204042e-01f}, {9.332357723e-01f, 3.592645171e-01f}, {5.486452564e-01f, 8.360552510e-01f}, {-5.829432350e-01f, -8.125128828e-01f}, {-6.662759857e-01f, 7.457052439e-01f}, {2.738668392e-01f, 9.617676197e-01f}, {7.469563882e-01f, 6.648730361e-01f}, {9.175172750e-01f, 3.976959268e-01f},
  {9.736663975e-01f, 2.279775131e-01f}, {9.916474294e-01f, 1.289781990e-01f}, {9.973561656e-01f, 7.266828020e-02f}, {9.991636941e-01f, 4.088902546e-02f}, {9.997355116e-01f, 2.299797413e-02f}, {9.999163589e-01f, 1.293348969e-02f}, {9.999735501e-01f, 7.273174492e-03f}, {9.999916358e-01f, 4.090031381e-03f},
  {4.241790073e-01f, -9.055783620e-01f}, {5.979771709e-01f, 8.015131335e-01f}, {2.614416878e-01f, 9.652192724e-01f}, {-4.300232723e-01f, -9.028178029e-01f}, {-7.373937800e-01f, 6.754631102e-01f}, {2.193782753e-01f, 9.756398784e-01f}, {7.255613200e-01f, 6.881575190e-01f}, {9.103004290e-01f, 4.139482201e-01f},
  {9.713379761e-01f, 2.377026212e-01f}, {9.909064560e-01f, 1.345525754e-01f}, {9.971213823e-01f, 7.582182336e-02f}, {9.990894022e-01f, 4.266575118e-02f}, {9.997120138e-01f, 2.399769627e-02f}, {9.999089278e-01f, 1.349578153e-02f}, {9.999712001e-01f, 7.589393080e-03f}, {9.999908927e-01f, 4.267857492e-03f},
  {9.912028119e-01f, -1.323517501e-01f}, {7.855226359e-02f, 9.969099969e-01f}, {-5.168932904e-02f, 9.986632131e-01f}, {-2.635405934e-01f, -9.646483067e-01f}, {-8.011436155e-01f, 5.984721441e-01f}, {1.641961594e-01f, 9.864277070e-01f}, {7.034407513e-01f, 7.107539022e-01f}, {9.027957408e-01f, 4.300695879e-01f},
  {9.689124217e-01f, 2.474039593e-01f}, {9.901341474e-01f, 1.401226969e-01f}, {9.968766273e-01f, 7.897461572e-02f}, {9.990119510e-01f, 4.444234199e-02f}, {9.996875163e-01f, 2.499739629e-02f}, {9.999011805e-01f, 1.405806910e-02f}, {9.999687502e-01f, 7.905611374e-03f}, {9.999901179e-01f, 4.445683934e-03f},
  {6.469193223e-01f, 7.625584505e-01f}, {-4.650644959e-01f, 8.852768012e-01f}, {-3.596943393e-01f, 9.330701915e-01f}, {-8.874550263e-02f, -9.960543337e-01f}, {-8.568888271e-01f, 5.155012492e-01f}, {1.084949468e-01f, 9.940970006e-01f}, {6.806168009e-01f, 7.326395911e-01f}, {8.950055582e-01f, 4.460549862e-01f},
  {9.663899806e-01f, 2.570805427e-01f}, {9.893305281e-01f, 1.456883874e-01f}, {9.966219035e-01f, 8.212661834e-02f}, {9.989313406e-01f, 4.621879226e-02f}, {9.996620190e-01f, 2.599707130e-02f}, {9.998931169e-01f, 1.462035317e-02f}, {9.999662002e-01f, 8.221828878e-03f}, {9.999893115e-01f, 4.623509769e-03f},
  {-2.921388087e-01f, 9.563759284e-01f}, {-8.654506342e-01f, 5.009942114e-01f}, {-6.320286307e-01f, 7.749450367e-01f}, {8.884811635e-02f, -9.960451858e-01f}, {-9.040721624e-01f, 4.273798371e-01f}, {5.245061444e-02f, 9.986235192e-01f}, {6.571122908e-01f, 7.537927018e-01f}, {8.869323709e-01f, 4.618993066e-01f},
  {9.637709015e-01f, 2.667314183e-01f}, {9.884956235e-01f, 1.512494708e-01f}, {9.963572141e-01f, 8.527779227e-02f}, {9.988475711e-01f, 4.799510009e-02f}, {9.996355221e-01f, 2.699672032e-02f}, {9.998847372e-01f, 1.518263167e-02f}, {9.999635502e-01f, 8.538045559e-03f}, {9.999884735e-01f, 4.801335923e-03f},
  {-9.626058663e-01f, 2.709057883e-01f}, {-9.992934094e-01f, -3.758566202e-02f}, {-8.416849393e-01f, 5.399689462e-01f}, {2.636395107e-01f, -9.646212772e-01f}, {-9.422223247e-01f, 3.349881951e-01f}, {-3.759419011e-03f, 9.999929334e-01f}, {6.329506774e-01f, 7.741921209e-01f}, {8.785787046e-01f, 4.775975920e-01f},
  {9.610554380e-01f, 2.763556497e-01f}, {9.876294623e-01f, 1.568057565e-01f}, {9.960825606e-01f, 8.842812085e-02f}, {9.987606432e-01f, 4.977125243e-02f}, {9.996080256e-01f, 2.799634234e-02f}, {9.998760413e-01f, 1.574490538e-02f}, {9.999608003e-01f, 8.854261387e-03f}, {9.999876039e-01f, 4.979161926e-03f},
  {-7.480575297e-01f, -6.636338842e-01f}, {-8.253716334e-01f, -5.645898217e-01f}, {-9.678715076e-01f, 2.514453117e-01f}, {4.301158485e-01f, -9.027737019e-01f}, {-9.709581880e-01f, 2.392492366e-01f}, {-5.995756728e-02f, 9.982009267e-01f}, {6.081562113e-01f, 7.938173736e-01f}, {8.699472142e-01f, 4.931448515e-01f},
  {9.582438779e-01f, 2.859522171e-01f}, {9.867320673e-01f, 1.623570984e-01f}, {9.957979462e-01f, 9.157756515e-02f}, {9.986705569e-01f, 5.154724737e-02f}, {9.995795294e-01f, 2.899593637e-02f}, {9.998670292e-01f, 1.630717503e-02f}, {9.999579503e-01f, 9.170476329e-03f}, {9.999867027e-01f, 5.156987306e-03f},
  {1.542514499e-01f, -9.880316241e-01f}, {-3.972518623e-01f, -9.177096261e-01f}, {-9.980752275e-01f, -6.201483913e-02f}, {5.830269376e-01f, -8.124528233e-01f}, {-9.899924966e-01f, 1.411200081e-01f}, {-1.159661631e-01f, 9.932531646e-01f}, {5.827536401e-01f, 8.126488756e-01f}, {8.610406595e-01f, 5.085361174e-01f},
  {9.553364944e-01f, 2.955201896e-01f}, {9.858034692e-01f, 1.679033061e-01f}, {9.955033738e-01f, 9.472609366e-02f}, {9.985773124e-01f, 5.332308304e-02f}, {9.995500337e-01f, 2.999550139e-02f}, {9.998577009e-01f, 1.686943954e-02f}, {9.999550003e-01f, 9.486690354e-03f}, {9.999857698e-01f, 5.334812988e-03f},
  {9.147423578e-01f, -4.040376453e-01f}, {1.532154756e-01f, -9.881928041e-01f}, {-9.293002953e-01f, -3.693250075e-01f}, {7.175492218e-01f, -6.965077991e-01f}, {-9.991351562e-01f, 4.158051951e-02f}, {-1.716081385e-01f, 9.851652891e-01f}, {5.567683641e-01f, 8.306677968e-01f}, {8.518617972e-01f, 5.237666260e-01f},
  {9.523335692e-01f, 3.050586387e-01f}, {9.848436973e-01f, 1.734442042e-01f}, {9.951988471e-01f, 9.787366751e-02f}, {9.984809103e-01f, 5.509874635e-02f}, {9.995195384e-01f, 3.099503643e-02f}, {9.998480564e-01f, 1.743169684e-02f}, {9.999519504e-01f, 9.802903431e-03f}, {9.999848053e-01f, 5.512638036e-03f},
  {8.342233605e-01f, 5.514266812e-01f}, {6.564951791e-01f, -7.543302193e-01f}, {-7.683670888e-01f, -6.400093881e-01f}, {8.294403670e-01f, -5.585952717e-01f}, {-9.982947730e-01f, -5.837419103e-02f}, {-2.267075845e-01f, 9.739628695e-01f}, {5.302263665e-01f, 8.478561200e-01f}, {8.424135592e-01f, 5.388315091e-01f},
  {9.492354203e-01f, 3.145665538e-01f}, {9.838527819e-01f, 1.789796175e-01f}, {9.948843677e-01f, 1.010202700e-01f}, {9.983813507e-01f, 5.687423543e-02f}, {9.994880436e-01f, 3.199454047e-02f}, {9.998380958e-01f, 1.799395049e-02f}, {9.999488004e-01f, 1.011911553e-02f}, {9.999838092e-01f, 5.690463375e-03f},
  {-1.327674722e-02f, 9.999118601e-01f}, {9.575860738e-01f, -2.881473778e-01f}, {-5.312352786e-01f, -8.472243379e-01f}, {9.151713830e-01f, -4.030649323e-01f}, {-9.874797774e-01f, -1.577456471e-01f}, {-2.810903074e-01f, 9.596813216e-01f}, {5.031541870e-01f, 8.641966582e-01f}, {8.326989334e-01f, 5.537260030e-01f},
  {9.460423489e-01f, 3.240430126e-01f}, {9.828307545e-01f, 1.845093711e-01f}, {9.945599394e-01f, 1.041658623e-01f}, {9.982786339e-01f, 5.864954466e-02f}, {9.994555494e-01f, 3.299401065e-02f}, {9.998278189e-01f, 1.855619846e-02f}, {9.999455505e-01f, 1.043532661e-02f}, {9.999827814e-01f, 5.868288535e-03f},
  {-8.485702748e-01f, 5.290826861e-01f}, {9.637575328e-01f, 2.667797179e-01f}, {-2.414211151e-01f, -9.704204476e-01f}, {9.720383571e-01f, -2.348221291e-01f}, {-9.667981682e-01f, -2.555411942e-01f}, {-3.345843792e-01f, 9.423657958e-01f}, {4.755788956e-01f, 8.796730723e-01f}, {8.227209915e-01f, 5.684453977e-01f},
  {9.427546643e-01f, 3.334870955e-01f}, {9.817776473e-01f, 1.900332899e-01f}, {9.942255664e-01f, 1.073104056e-01f}, {9.981727603e-01f, 6.042466843e-02f}, {9.994220556e-01f, 3.399345156e-02f}, {9.998172259e-01f, 1.911843869e-02f}, {9.999422006e-01f, 1.075153665e-02f}, {9.999817221e-01f, 6.046113043e-03f},
  {-9.036922051e-01f, -4.281826695e-01f}, {6.731102676e-01f, 7.395421338e-01f}, {7.233466718e-02f, -9.973804169e-01f}, {9.982477619e-01f, -5.917267879e-02f}, {-9.364566873e-01f, -3.507832277e-01f}, {-3.870206816e-01f, 9.220710342e-01f}, {4.475280652e-01f, 8.942698871e-01f}, {8.124829236e-01f, 5.829849902e-01f},
  {9.393727149e-01f, 3.428978019e-01f}, {9.806934936e-01f, 1.955511994e-01f}, {9.938812503e-01f, 1.104538832e-01f}, {9.980637300e-01f, 6.219960483e-02f}, {9.993875625e-01f, 3.499285475e-02f}, {9.998063168e-01f, 1.968067474e-02f}, {9.999387506e-01f, 1.106774562e-02f}, {9.999806311e-01f, 6.223937825e-03f},
  {-1.279636896e-01f, -9.917788534e-01f}, {1.751565337e-01f, 9.845405978e-01f}, {3.789161719e-01f, -9.254309994e-01f}, {9.929728258e-01f, 1.183425843e-01f}, {-8.967583530e-01f, -4.425205716e-01f}, {-4.382335472e-01f, 8.988611451e-01f}, {4.190297442e-01f, 9.079725070e-01f}, {8.019878986e-01f, 5.973402803e-01f},
  {9.358968291e-01f, 3.522742188e-01f}, {9.795783277e-01f, 2.010629250e-01f}, {9.935269954e-01f, 1.135962562e-01f}, {9.979515440e-01f, 6.397433710e-02f}, {9.993520699e-01f, 3.599222668e-02f}, {9.997950914e-01f, 2.024290457e-02f}, {9.999352007e-01f, 1.138395348e-02f}, {9.999795085e-01f, 6.401761945e-03f},
  {7.654140519e-01f, -6.435381334e-01f}, {-3.767422893e-01f, 9.263181135e-01f}, {6.479216888e-01f, -7.617069550e-01f}, {9.563800296e-01f, 2.921253822e-01f}, {-8.481000064e-01f, -5.298361813e-01f}, {-4.880608524e-01f, 8.728096037e-01f}, {3.901124287e-01f, 9.207672306e-01f}, {7.912392691e-01f, 6.115066795e-01f},
  {9.323273439e-01f, 3.616154364e-01f}, {9.784321880e-01f, 2.065682779e-01f}, {9.931628052e-01f, 1.167374932e-01f}, {9.978362017e-01f, 6.574887451e-02f}, {9.993155781e-01f, 3.699155889e-02f}, {9.997835499e-01f, 2.080512613e-02f}, {9.999315508e-01f, 1.170016020e-02f}, {9.999783543e-01f, 6.579586328e-03f},
  {9.550736440e-01f, 2.963685787e-01f}, {-8.126112051e-01f, 5.828061679e-01f}, {8.526731157e-01f, -5.224447891e-01f}, {8.896234916e-01f, 4.566946935e-01f}, {-7.909677411e-01f, -6.118578532e-01f}, {-5.363451811e-01f, 8.439987244e-01f}, {3.608050334e-01f, 9.326412643e-01f}, {7.802404339e-01f, 6.254797082e-01f},
  {9.286646373e-01f, 3.709204650e-01f}, {9.772551046e-01f, 2.120671131e-01f}, {9.927886843e-01f, 1.198775555e-01f}, {9.977177040e-01f, 6.752320399e-02f}, {9.992780868e-01f, 3.799085783e-02f}, {9.997716923e-01f, 2.136734297e-02f}, {9.999278009e-01f, 1.201636575e-02f}, {9.999771684e-01f, 6.757410504e-03f},
  {2.666429324e-01f, 9.637953863e-01f}, {-9.982103598e-01f, 5.980031485e-02f}, {9.728653499e-01f, -2.313720187e-01f}, {7.948083899e-01f, 6.068604645e-01f}, {-7.259322386e-01f, -6.877662284e-01f}, {-5.829338849e-01f, 8.125195911e-01f}, {3.311368634e-01f, 9.435827349e-01f}, {7.689949093e-01f, 6.392549018e-01f},
  {9.249090653e-01f, 3.801884019e-01f}, {9.760471178e-01f, 2.175592422e-01f}, {9.924046346e-01f, 1.230164264e-01f}, {9.975960518e-01f, 6.929731252e-02f}, {9.992395964e-01f, 3.899011506e-02f}, {9.997595184e-01f, 2.192955306e-02f}, {9.999239510e-01f, 1.233257010e-02f}, {9.999759510e-01f, 6.935234000e-03f},
  {-6.669380617e-01f, 7.451131605e-01f}, {-8.763794418e-01f, -4.816212973e-01f}, {9.965789837e-01f, 8.264580634e-02f}, {6.749256518e-01f, 7.378857395e-01f}, {-6.536436209e-01f, -7.568024953e-01f}, {-6.276796763e-01f, 7.784717233e-01f}, {3.011375844e-01f, 9.535807020e-01f}, {7.575061759e-01f, 6.528279969e-01f},
  {9.210610033e-01f, 3.894183203e-01f}, {9.748082657e-01f, 2.230444915e-01f}, {9.920106618e-01f, 1.261540598e-01f}, {9.974712443e-01f, 7.107120934e-02f}, {9.992001065e-01f, 3.998933702e-02f}, {9.997470285e-01f, 2.249175622e-02f}, {9.999200011e-01f, 1.264877321e-02f}, {9.999747019e-01f, 7.113057742e-03f},
  {-9.873392775e-01f, -1.586226688e-01f}, {-4.846393970e-01f, -8.747140418e-01f}, {9.214623472e-01f, 3.884676855e-01f}, {5.337561004e-01f, 8.456384720e-01f}, {-5.748240246e-01f, -8.182770562e-01f}, {-6.704410942e-01f, 7.419627614e-01f}, {2.708370782e-01f, 9.626252007e-01f}, {7.457779040e-01f, 6.661946547e-01f},
  {9.171208242e-01f, 3.986093247e-01f}, {9.735385875e-01f, 2.285226875e-01f}, {9.916067680e-01f, 1.292904390e-01f}, {9.973432826e-01f, 7.284488142e-02f}, {9.991596177e-01f, 4.098851526e-02f}, {9.997342224e-01f, 2.305395040e-02f}, {9.999159512e-01f, 1.296497506e-02f}, {9.999734212e-01f, 7.290880793e-03f},
  {-3.999853150e-01f, -9.165215479e-01f}, {5.636094028e-02f, -9.984104589e-01f}, {7.549653475e-01f, 6.557646866e-01f}, {3.757521519e-01f, 9.267201953e-01f}, {-4.902605720e-01f, -8.715759127e-01f}, {-7.110829506e-01f, 7.031081264e-01f}, {2.402658714e-01f, 9.707071191e-01f}, {7.338138022e-01f, 6.793506485e-01f},
  {9.130889457e-01f, 4.077604411e-01f}, {9.722381233e-01f, 2.339936570e-01f}, {9.911929581e-01f, 1.324255253e-01f}, {9.972121675e-01f, 7.461831571e-02f}, {9.991181295e-01f, 4.198765625e-02f}, {9.997211001e-01f, 2.361613915e-02f}, {9.999118013e-01f, 1.328117562e-02f}, {9.999721088e-01f, 7.468704080e-03f},
  {5.551133015e-01f, -8.317747426e-01f}, {5.800031129e-01f, -8.146142578e-01f}, {5.135984179e-01f, 8.580306901e-01f}, {2.058971709e-01f, 9.785736329e-01f}, {-4.007989973e-01f, -9.161660132e-01f}, {-7.494767587e-01f, 6.620306550e-01f}, {2.094544189e-01f, 9.778184118e-01f}, {7.216176540e-01f, 6.922918182e-01f},
  {9.089657591e-01f, 4.168707818e-01f}, {9.709069144e-01f, 2.394572270e-01f}, {9.907692363e-01f, 1.355592873e-01f}, {9.970778984e-01f, 7.639152146e-02f}, {9.990756424e-01f, 4.298675152e-02f}, {9.997076617e-01f, 2.417832043e-02f}, {9.999075514e-01f, 1.359737484e-02f}, {9.999707649e-01f, 7.646527131e-03f},
  {9.998433086e-01f, 1.770192511e-02f}, {9.250146691e-01f, -3.799313911e-01f}, {2.212981743e-01f, 9.752061926e-01f}, {2.954782069e-02f, 9.995633678e-01f}, {-3.073327792e-01f, -9.516021032e-01f}, {-7.855011387e-01f, 6.188602113e-01f}, {1.784335295e-01f, 9.839519681e-01f}, {7.091933579e-01f, 7.050140291e-01f},
  {9.047516642e-01f, 4.259394629e-01f}, {9.695450064e-01f, 2.449132102e-01f}, {9.903356068e-01f, 1.386916938e-01f}, {9.969404762e-01f, 7.816448565e-02f}, {9.990321560e-01f, 4.398580752e-02f}, {9.996939072e-01f, 2.474049220e-02f}, {9.999032016e-01f, 1.391357271e-02f}, {9.999693893e-01f, 7.824349474e-03f},
  {5.253219888e-01f, 8.509035245e-01f}, {9.851382016e-01f, 1.717635693e-01f}, {-9.294810554e-02f, 9.956709545e-01f}, {-1.477329862e-01f, 9.890272821e-01f}, {-2.107957994e-01f, -9.775301177e-01f}, {-8.190422014e-01f, 5.737332763e-01f}, {1.472342216e-01f, 9.891016550e-01f}, {6.965447594e-01f, 7.175133435e-01f},
  {9.004471075e-01f, 4.349655234e-01f}, {9.681524315e-01f, 2.503614776e-01f}, {9.898920739e-01f, 1.418227133e-01f}, {9.967999021e-01f, 7.993719522e-02f}, {9.989876708e-01f, 4.498481582e-02f}, {9.996798365e-01f, 2.530265802e-02f}, {9.998987517e-01f, 1.422976918e-02f}, {9.999679821e-01f, 8.002171569e-03f},
  {-4.321779449e-01f, 9.017883476e-01f}, {7.418580135e-01f, 6.705569982e-01f}, {-3.979767653e-01f, 9.173954950e-01f}, {-3.203543695e-01f, 9.472977768e-01f}, {-1.121526217e-01f, -9.936909929e-01f}, {-8.499939088e-01f, 5.267925161e-01f}, {1.158876918e-01f, 9.932623233e-01f}, {6.836758997e-01f, 7.297857660e-01f},
  {8.960525071e-01f, 4.439480877e-01f}, {9.667292484e-01f, 2.558017989e-01f}, {9.894386421e-01f, 1.449523146e-01f}, {9.966561752e-01f, 8.170965944e-02f}, {9.989421864e-01f, 4.598378286e-02f}, {9.996654497e-01f, 2.586481583e-02f}, {9.998942019e-01f, 1.454596424e-02f}, {9.999665433e-01f, 8.179994343e-03f},
  {-9.923354692e-01f, 1.235731227e-01f}, {2.700984580e-01f, 9.628327077e-01f}, {-6.635382560e-01f, 7.481423547e-01f}, {-4.828719382e-01f, 8.756909793e-01f}, {-1.238837738e-02f, -9.999232611e-01f}, {-8.782584087e-01f, 4.781863313e-01f}, {8.442528403e-02f, 9.964298126e-01f}, {6.705908480e-01f, 7.418274156e-01f},
  {8.915682887e-01f, 4.528862843e-01f}, {9.652754871e-01f, 2.612340599e-01f}, {9.889753181e-01f, 1.480804517e-01f}, {9.965092972e-01f, 8.348185785e-02f}, {9.988957032e-01f, 4.698270019e-02f}, {9.996507468e-01f, 2.642696360e-02f}, {9.998895520e-01f, 1.486215783e-02f}, {9.999650728e-01f, 8.357815927e-03f},
  {-6.401443395e-01f, -7.682546613e-01f}, {-2.848466063e-01f, 9.585731119e-01f}, {-8.632964878e-01f, 5.046971113e-01f}, {-6.301599705e-01f, 7.764653318e-01f}, {8.749917344e-02f, -9.961645921e-01f}, {-9.037463447e-01f, 4.280683876e-01f}, {5.287845807e-02f, 9.986009557e-01f}, {6.572937422e-01f, 7.536344847e-01f},
  {8.869949277e-01f, 4.617791660e-01f}, {9.637912089e-01f, 2.666580313e-01f}, {9.885021022e-01f, 1.512071226e-01f}, {9.963592674e-01f, 8.525379969e-02f}, {9.988482211e-01f, 4.798157054e-02f}, {9.996357278e-01f, 2.698910488e-02f}, {9.998848022e-01f, 1.517834901e-02f}, {9.999635708e-01f, 8.535637247e-03f},
  {3.005925437e-01f, -9.537526528e-01f}, {-7.520639951e-01f, 6.590900905e-01f}, {-9.774427254e-01f, 2.112006594e-01f}, {-7.575730765e-01f, 6.527503610e-01f}, {1.865124631e-01f, -9.824525948e-01f}, {-9.263771379e-01f, 3.765971301e-01f}, {2.127875808e-02f, 9.997735816e-01f}, {6.437888326e-01f, 7.652032012e-01f},
  {8.823328681e-01f, 4.706258703e-01f}, {9.622764532e-01f, 2.720735702e-01f}, {9.880190013e-01f, 1.543322815e-01f}, {9.962060867e-01f, 8.702547193e-02f}, {9.987997401e-01f, 4.898039663e-02f}, {9.996203926e-01f, 2.755123762e-02f}, {9.998799524e-01f, 1.549453961e-02f}, {9.999620371e-01f, 8.713459228e-03f},
  {9.649660285e-01f, -2.623748537e-01f}, {-9.876590838e-01f, 1.566190737e-01f}, {-9.946564265e-01f, -1.032404628e-01f}, {-8.610927113e-01f, 5.084479743e-01f}, {2.836621855e-01f, -9.589242747e-01f}, {-9.460792425e-01f, 3.239352821e-01f}, {-1.034221888e-02f, 9.999465178e-01f}, {6.300802992e-01f, 7.765299843e-01f},
  {8.775825619e-01f, 4.794255386e-01f}, {9.607312596e-01f, 2.774805341e-01f}, {9.875260201e-01f, 1.574558971e-01f}, {9.960497565e-01f, 8.879686156e-02f}, {9.987502604e-01f, 4.997917001e-02f}, {9.996047414e-01f, 2.811335979e-02f}, {9.998750026e-01f, 1.581072865e-02f}, {9.999604718e-01f, 8.891280002e-03f},
  {7.421541968e-01f, 6.702291758e-01f}, {-9.190735378e-01f, -3.940860720e-01f}, {-9.132301279e-01f, -4.074441477e-01f}, {-9.374542500e-01f, 3.481085020e-01f}, {3.779776544e-01f, -9.258147184e-01f}, {-9.627903713e-01f, 2.702493312e-01f}, {-4.195285448e-02f, 9.991195914e-01f}, {6.161725219e-01f, 7.876112133e-01f},
  {8.727445123e-01f, 4.881772386e-01f}, {9.591556934e-01f, 2.828786946e-01f}, {9.870231637e-01f, 1.605779382e-01f}, {9.958902758e-01f, 9.056797780e-02f}, {9.986997817e-01f, 5.097789714e-02f}, {9.995887740e-01f, 2.867547492e-02f}, {9.998699528e-01f, 1.612691704e-02f}, {9.999588749e-01f, 9.069100495e-03f},
  {-1.629907808e-01f, 9.866275920e-01f}, {-5.674300293e-01f, -8.234216185e-01f}, {-7.412399645e-01f, -6.712401321e-01f}, {-9.842484715e-01f, 1.767906850e-01f}, {4.685169241e-01f, -8.834545217e-01f}, {-9.764576931e-01f, 2.157090023e-01f}, {-7.352154075e-02f, 9.972936293e-01f}, {6.020698986e-01f, 7.984433839e-01f},
  {8.678191892e-01f, 4.968801213e-01f}, {9.575497876e-01f, 2.882679384e-01f}, {9.865104371e-01f, 1.636983734e-01f}, {9.957276465e-01f, 9.233880022e-02f}, {9.986483046e-01f, 5.197656957e-02f}, {9.995724905e-01f, 2.923758099e-02f}, {9.998648031e-01f, 1.644310196e-02f}, {9.999572463e-01f, 9.246920701e-03f},
  {-9.182827862e-01f, 3.959251502e-01f}, {-4.102818995e-02f, -9.991579893e-01f}, {-4.957418213e-01f, -8.684699457e-01f}, {-9.999999947e-01f, -1.030206758e-04f}, {5.543744949e-01f, -8.322673365e-01f}, {-9.870379993e-01f, 1.604867217e-01f}, {-1.050167117e-01f, 9.944704572e-01f}, {5.877769370e-01f, 8.090230357e-01f},
  {8.628070850e-01f, 5.055333165e-01f}, {9.559136100e-01f, 2.936480378e-01f}, {9.859878454e-01f, 1.668171717e-01f}, {9.955618677e-01f, 9.410933806e-02f}, {9.985958286e-01f, 5.297519375e-02f}, {9.995558910e-01f, 2.979967596e-02f}, {9.998595533e-01f, 1.675928710e-02f}, {9.999555861e-01f, 9.424741546e-03f},
  {-8.293098329e-01f, -5.587890489e-01f}, {4.980096003e-01f, -8.671715159e-01f}, {-2.010796199e-01f, -9.795749009e-01f}, {-9.842120244e-01f, -1.769934771e-01f}, {6.346929496e-01f, -7.727644270e-01f}, {-9.944978661e-01f, 1.047568344e-01f}, {-1.364068747e-01f, 9.906528981e-01f}, {5.732980611e-01f, 8.193468943e-01f},
  {8.577087010e-01f, 5.141359589e-01f}, {9.542471952e-01f, 2.990188798e-01f}, {9.854553963e-01f, 1.699342871e-01f}, {9.953929407e-01f, 9.587957830e-02f}, {9.985423542e-01f, 5.397376122e-02f}, {9.995389754e-01f, 3.036176336e-02f}, {9.998542036e-01f, 1.707546870e-02f}, {9.999538943e-01f, 9.602561162e-03f},
  {2.212675626e-02f, -9.997551734e-01f}, {8.836693140e-01f, -4.681116785e-01f}, {1.135217773e-01f, -9.935355082e-01f}, {-9.373825054e-01f, -3.483016489e-01f}, {7.086697743e-01f, -7.055403256e-01f}, {-9.988136461e-01f, 4.869599955e-02f}, {-1.676606422e-01f, 9.858447692e-01f}, {5.586378969e-01f, 8.294116591e-01f},
  {8.525245158e-01f, 5.226872391e-01f}, {9.525506134e-01f, 3.043802375e-01f}, {9.849130902e-01f, 1.730497178e-01f}, {9.952208667e-01f, 9.764950793e-02f}, {9.984878810e-01f, 5.497227845e-02f}, {9.995217437e-01f, 3.092384116e-02f}, {9.998487538e-01f, 1.739165045e-02f}, {9.999521709e-01f, 9.780380474e-03f},
  {8.532201077e-01f, -5.215510021e-01f}, {9.971746360e-01f, 7.511820869e-02f}, {4.168670742e-01f, -9.089674595e-01f}, {-8.609884168e-01f, -5.086245631e-01f}, {7.755658183e-01f, -6.312667118e-01f}, {-9.999717335e-01f, -7.518784889e-03f}, {-1.987468801e-01f, 9.800508546e-01f}, {5.438010803e-01f, 8.392141473e-01f},
  {8.472551097e-01f, 5.311861999e-01f}, {9.508239095e-01f, 3.097319700e-01f}, {9.843609349e-01f, 1.761634181e-01f}, {9.950456449e-01f, 9.941913618e-02f}, {9.984324096e-01f, 5.597073698e-02f}, {9.995041959e-01f, 3.148590732e-02f}, {9.998432041e-01f, 1.770782860e-02f}, {9.999504159e-01f, 9.958200408e-03f},
  {8.998668270e-01f, 4.361647552e-01f}, {8.035690866e-01f, 5.952114944e-01f}, {6.788702112e-01f, -7.342582900e-01f}, {-7.574391895e-01f, -6.529057162e-01f}, {8.347129424e-01f, -5.506853038e-01f}, {-9.979684672e-01f, -6.370979912e-02f}, {-2.296342702e-01f, 9.732769914e-01f}, {5.287923029e-01f, 8.487512594e-01f},
  {8.419009790e-01f, 5.396320427e-01f}, {9.490671287e-01f, 3.150739362e-01f}, {9.837989360e-01f, 1.792753567e-01f}, {9.948672764e-01f, 1.011884500e-01f}, {9.983759396e-01f, 5.696914326e-02f}, {9.994863320e-01f, 3.204796724e-02f}, {9.998375544e-01f, 1.802400685e-02f}, {9.999486292e-01f, 1.013601910e-02f},
  {1.191801354e-01f, 9.928726481e-01f}, {3.624766664e-01f, 9.319928467e-01f}, {8.735505105e-01f, -4.867335058e-01f}, {-6.300007138e-01f, -7.765945536e-01f}, {8.855196056e-01f, -4.646020105e-01f}, {-9.928101803e-01f, -1.196993984e-01f}, {-2.602920453e-01f, 9.655299328e-01f}, {5.136163109e-01f, 8.580199795e-01f},
  {8.364626591e-01f, 5.480239228e-01f}, {9.472803452e-01f, 3.204059106e-01f}, {9.832270991e-01f, 1.823855026e-01f}, {9.946857626e-01f, 1.029574365e-01f}, {9.983184713e-01f, 5.796748886e-02f}, {9.994681521e-01f, 3.261001331e-02f}, {9.998318047e-01f, 1.834018143e-02f}, {9.999468110e-01f, 1.031383746e-02f},
  {-7.710802230e-01f, 6.367380071e-01f}, {-1.902490958e-01f, 9.817358512e-01f}, {9.816020978e-01f, -1.909380047e-01f}, {-4.826923346e-01f, -8.757899920e-01f}, {9.274784664e-01f, -3.738765764e-01f}, {-9.845131804e-01f, -1.753105749e-01f}, {-2.906895502e-01f, 9.568174253e-01f}, {4.982779032e-01f, 8.670173765e-01f},
  {8.309406937e-01f, 5.563610011e-01f}, {9.454635966e-01f, 3.257277812e-01f}, {9.826454300e-01f, 1.854938246e-01f}, {9.945011026e-01f, 1.047261048e-01f}, {9.982600046e-01f, 5.896578020e-02f}, {9.994496561e-01f, 3.317204907e-02f}, {9.998259550e-01f, 1.865635603e-02f}, {9.999449611e-01f, 1.049165644e-02f},
  {-9.524129804e-01f, -3.048106211e-01f}, {-6.843819158e-01f, 7.291237161e-01f}, {9.923083195e-01f, 1.237909494e-01f}, {-3.201591802e-01f, -9.473637630e-01f}, {9.601702867e-01f, -2.794154982e-01f}, {-9.731036980e-01f, -2.303675170e-01f}, {-3.207963899e-01f, 9.471481807e-01f}, {4.827820346e-01f, 8.757405478e-01f},
  {8.253356351e-01f, 5.646424439e-01f}, {9.436169596e-01f, 3.310393232e-01f}, {9.820539344e-01f, 1.886002917e-01f}, {9.943132976e-01f, 1.064944419e-01f}, {9.982005398e-01f, 5.996400886e-02f}, {9.994308440e-01f, 3.373407806e-02f}, {9.998200054e-01f, 1.897252691e-02f}, {9.999430795e-01f, 1.066947415e-02f},
  {-2.581016359e-01f, -9.661177700e-01f}, {-9.677396624e-01f, 2.519522691e-01f}, {9.046075662e-01f, 4.262454119e-01f}, {-1.475292025e-01f, -9.890577002e-01f}, {9.832684211e-01f, -1.821625980e-01f}, {-9.586178037e-01f, -2.846961652e-01f}, {-3.505824602e-01f, 9.365318674e-01f}, {4.671333972e-01f, 8.841868520e-01f},
  {8.196480097e-01f, 5.728674718e-01f}, {9.417404730e-01f, 3.363404250e-01f}, {9.814526211e-01f, 1.917048581e-01f}, {9.941223492e-01f, 1.082624348e-01f}, {9.981400766e-01f, 6.096218127e-02f}, {9.994117160e-01f, 3.429609266e-02f}, {9.998139558e-01f, 1.928869776e-02f}, {9.999411664e-01f, 1.084729152e-02f},
  {6.735071623e-01f, -7.391806966e-01f}, {-9.530500361e-01f, -3.028128610e-01f}, {7.271980777e-01f, 6.864276770e-01f}, {2.975377145e-02f, -9.995572585e-01f}, {9.965421208e-01f, -8.308911770e-02f}, {-9.411012936e-01f, -3.381247627e-01f}, {-3.800179774e-01f, 9.249791008e-01f}, {4.513370430e-01f, 8.923535586e-01f},
  {8.138784539e-01f, 5.810351644e-01f}, {9.398342161e-01f, 3.416308626e-01f}, {9.808414904e-01f, 1.948075221e-01f}, {9.939282563e-01f, 1.100300928e-01f}, {9.980786154e-01f, 6.196028901e-02f}, {9.993922719e-01f, 3.485809641e-02f}, {9.998078062e-01f, 1.960486481e-02f}, {9.999392216e-01f, 1.102510855e-02f},
  {9.858965816e-01f, 1.673557003e-01f}, {-6.448370157e-01f, -7.643201052e-01f}, {4.776714527e-01f, 8.785385497e-01f}, {2.060983265e-01f, -9.785312871e-01f}, {9.998586332e-01f, 1.681409119e-02f}, {-9.206095453e-01f, -3.904843980e-01f}, {-4.090735085e-01f, 9.125014327e-01f}, {4.353979670e-01f, 9.002380853e-01f},
  {8.080275111e-01f, 5.891447541e-01f}, {9.378982288e-01f, 3.469105251e-01f}, {9.802205514e-01f, 1.979082381e-01f}, {9.937310211e-01f, 1.117973955e-01f}, {9.980161562e-01f, 6.295833478e-02f}, {9.993725116e-01f, 3.542009286e-02f}, {9.998015566e-01f, 1.992103176e-02f}, {9.999372453e-01f, 1.120292616e-02f},
  {3.918572304e-01f, 9.200260382e-01f}, {-1.380281595e-01f, -9.904283049e-01f}, {1.807759664e-01f, 9.835243006e-01f}, {3.759426448e-01f, -9.266429344e-01f}, {9.931849076e-01f, 1.165492996e-01f}, {-8.972073423e-01f, -4.416095391e-01f}, {-4.377200005e-01f, 8.991113397e-01f}, {4.193212096e-01f, 9.078379388e-01f},
  {8.020957664e-01f, 5.971954299e-01f}, {9.359325930e-01f, 3.521791893e-01f}, {9.795898101e-01f, 2.010069749e-01f}, {9.935306427e-01f, 1.135643520e-01f}, {9.979526988e-01f, 6.395632131e-02f}, {9.993524355e-01f, 3.598207439e-02f}, {9.997952070e-01f, 2.023719487e-02f}, {9.999352373e-01f, 1.138074248e-02f},
  {-5.624538512e-01f, 8.268286795e-01f}, {4.112906278e-01f, -9.115042619e-01f}, {-1.340468804e-01f, 9.909749915e-01f}, {5.339299224e-01f, -8.455287328e-01f}, {9.765876257e-01f, 2.151199881e-01f}, {-8.709686692e-01f, -4.913385567e-01f}, {-4.659289146e-01f, 8.848221553e-01f}, {4.031118544e-01f, 9.151507159e-01f},
  {7.960838130e-01f, 6.051863868e-01f}, {9.339373606e-01f, 3.574367167e-01f}, {9.789492729e-01f, 2.041037017e-01f}, {9.933271224e-01f, 1.153309494e-01f}, {9.978882433e-01f, 6.495424389e-02f}, {9.993320433e-01f, 3.654404454e-02f}, {9.997887575e-01f, 2.055335594e-02f}, {9.999331976e-01f, 1.155855845e-02f},
  {-9.996474560e-01f, -2.655115402e-02f}, {8.339421773e-01f, -5.518518324e-01f}, {-4.355781575e-01f, 9.001509144e-01f}, {6.750773206e-01f, -7.377469832e-01f}, {9.502326217e-01f, 3.115412729e-01f}, {-8.419764782e-01f, -5.395142354e-01f}, {-4.936717281e-01f, 8.696483340e-01f}, {3.867750272e-01f, 9.221741041e-01f},
  {7.899922520e-01f, 6.131168256e-01f}, {9.319125840e-01f, 3.626829688e-01f}, {9.782989462e-01f, 2.071983875e-01f}, {9.931204618e-01f, 1.170971747e-01f}, {9.978227905e-01f, 6.595209408e-02f}, {9.993113350e-01f, 3.710600686e-02f}, {9.997822079e-01f, 2.086951683e-02f}, {9.999311264e-01f, 1.173637498e-02f},
  {-5.177697998e-01f, -8.555199790e-01f}, {9.997526257e-01f, -2.224157018e-02f}, {-6.939117212e-01f, 7.200600830e-01f}, {7.949331221e-01f, -6.066970673e-01f}, {9.143830324e-01f, 4.048501822e-01f}, {-8.103224264e-01f, -5.859842705e-01f}, {-5.209211185e-01f, 8.536048197e-01f}, {3.703158941e-01f, 9.289058825e-01f},
  {7.838216925e-01f, 6.209859534e-01f}, {9.298583485e-01f, 3.679177241e-01f}, {9.776388366e-01f, 2.102910013e-01f}, {9.929106598e-01f, 1.188630370e-01f}, {9.977563394e-01f, 6.694988575e-02f}, {9.992903108e-01f, 3.766795372e-02f}, {9.997755584e-01f, 2.118567376e-02f}, {9.999290235e-01f, 1.191419021e-02f},
  {4.401430225e-01f, -8.979276807e-01f}, {8.576571642e-01f, 5.142219255e-01f}, {-8.834316904e-01f, 4.685599731e-01f}, {8.897171354e-01f, -4.565122331e-01f}, {8.693973961e-01f, 4.941135170e-01f}, {-7.761065864e-01f, -6.306017496e-01f}, {-5.476494281e-01f, 8.367078964e-01f}, {3.537396597e-01f, 9.353439224e-01f},
  {7.775727143e-01f, 6.287930296e-01f}, {9.277746974e-01f, 3.731408726e-01f}, {9.769689537e-01f, 2.133814976e-01f}, {9.926977189e-01f, 1.206285161e-01f}, {9.976888905e-01f, 6.794761047e-02f}, {9.992689706e-01f, 3.822988867e-02f}, {9.997688089e-01f, 2.150183044e-02f}, {9.999268890e-01f, 1.209200506e-02f},
  {9.933903797e-01f, -1.147848138e-01f}, {4.514202490e-01f, 8.923114696e-01f}, {-9.853413039e-01f, 1.705945920e-01f}, {9.564401992e-01f, -2.919283222e-01f}, {8.157250450e-01f, 5.784398422e-01f}, {-7.394371294e-01f, -6.732256172e-01f}, {-5.738303336e-01f, 8.189742048e-01f}, {3.370516780e-01f, 9.414861477e-01f},
  {7.712460165e-01f, 6.365371804e-01f}, {9.256617187e-01f, 3.783521937e-01f}, {9.762892980e-01f, 2.164698746e-01f}, {9.924816379e-01f, 1.223936212e-01f}, {9.976204439e-01f, 6.894526724e-02f}, {9.992473143e-01f, 3.879181525e-02f}, {9.997619595e-01f, 2.181798310e-02f}, {9.999247229e-01f, 1.226981954e-02f},
  {6.333192031e-01f, 7.738906816e-01f}, {-9.384513530e-02f, 9.955868072e-01f}, {-9.895353918e-01f, -1.442903610e-01f}, {9.929971882e-01f, -1.181379883e-01f}, {7.539022543e-01f, 6.569865987e-01f}, {-7.004299841e-01f, -7.137211202e-01f}, {-5.994372618e-01f, 8.004217446e-01f}, {3.202570024e-01f, 9.473306986e-01f},
  {7.648421950e-01f, 6.442176781e-01f}, {9.235194568e-01f, 3.835515778e-01f}, {9.755998794e-01f, 2.195560870e-01f}, {9.922624183e-01f, 1.241583392e-01f}, {9.975510002e-01f, 6.994284763e-02f}, {9.992253421e-01f, 3.935372584e-02f}, {9.997550100e-01f, 2.213413545e-02f}, {9.999225252e-01f, 1.244763455e-02f},
  {-3.090227282e-01f, 9.510546533e-01f}, {-6.102111043e-01f, 7.922388580e-01f}, {-8.955979808e-01f, -4.448643128e-01f}, {9.982355487e-01f, 5.937835785e-02f}, {6.845467360e-01f, 7.289689748e-01f}, {-6.592084691e-01f, -7.519602345e-01f}, {-6.244449937e-01f, 7.810687869e-01f}, {3.033610551e-01f, 9.528756846e-01f},
  {7.583618900e-01f, 6.518337547e-01f}, {9.213480022e-01f, 3.887388055e-01f}, {9.749007048e-01f, 2.226401038e-01f}, {9.920400619e-01f, 1.259226572e-01f}, {9.974805585e-01f, 7.094036552e-02f}, {9.992030539e-01f, 3.991562399e-02f}, {9.997479606e-01f, 2.245028372e-02f}, {9.999202959e-01f, 1.262544824e-02f},
  {-9.672505883e-01f, 2.538233628e-01f}, {-9.386403774e-01f, 3.448974367e-01f}, {-7.128450694e-01f, -7.013215433e-01f}, {9.719900655e-01f, 2.350219407e-01f}, {6.083510875e-01f, 7.936680379e-01f}, {-6.159027162e-01f, -7.878222161e-01f}, {-6.488281469e-01f, 7.609349747e-01f}, {2.863691790e-01f, 9.581193523e-01f},
  {7.518057496e-01f, 6.593846487e-01f}, {9.191474004e-01f, 3.939137677e-01f}, {9.741917812e-01f, 2.257218942e-01f}, {9.918145684e-01f, 1.276865770e-01f}, {9.974091192e-01f, 7.193781246e-02f}, {9.991804496e-01f, 4.047751324e-02f}, {9.997408112e-01f, 2.276643161e-02f}, {9.999180349e-01f, 1.280326153e-02f},
  {-7.361927182e-01f, -6.767719569e-01f}, {-9.779862647e-01f, -2.086692743e-01f}, {-4.593983755e-01f, -8.882303376e-01f}, {9.150885079e-01f, 4.032530506e-01f}, {5.260773552e-01f, 8.504367210e-01f}, {-5.706501970e-01f, -8.211932493e-01f}, {-6.725627078e-01f, 7.400401368e-01f}, {2.692867473e-01f, 9.630600437e-01f},
  {7.451744294e-01f, 6.668696048e-01f}, {9.169177444e-01f, 3.990762459e-01f}, {9.734731156e-01f, 2.288014274e-01f}, {9.915859366e-01f, 1.294501078e-01f}, {9.973366826e-01f, 7.293518747e-02f}, {9.991575295e-01f, 4.103938597e-02f}, {9.997335619e-01f, 2.308257536e-02f}, {9.999157423e-01f, 1.298107534e-02f},
  {1.717173418e-01f, -9.851462605e-01f}, {-7.161304948e-01f, -6.979664135e-01f}, {-1.603949705e-01f, -9.870529132e-01f}, {8.293255221e-01f, 5.587657634e-01f}, {4.385472419e-01f, 8.987081376e-01f}, {-5.235932086e-01f, -8.519683984e-01f}, {-6.956245860e-01f, 7.184054811e-01f}, {2.521191618e-01f, 9.676961963e-01f},
  {7.384685523e-01f, 6.742879187e-01f}, {9.146590931e-01f, 4.042261042e-01f}, {9.727447153e-01f, 2.318786725e-01f}, {9.913541710e-01f, 1.312132144e-01f}, {9.972632491e-01f, 7.393248211e-02f}, {9.991342935e-01f, 4.160124571e-02f}, {9.997262125e-01f, 2.339871866e-02f}, {9.999134181e-01f, 1.315888782e-02f},
  {9.217512697e-01f, -3.877816354e-01f}, {-2.337207587e-01f, -9.723037627e-01f}, {1.545165179e-01f, -9.879902053e-01f}, {7.174060294e-01f, 6.966552871e-01f}, {3.466353178e-01f, 9.379999768e-01f}, {-4.748813157e-01f, -8.800498486e-01f}, {-7.179910692e-01f, 6.960523145e-01f}, {2.348718512e-01f, 9.720263441e-01f},
  {7.316888689e-01f, 6.816387600e-01f}, {9.123715058e-01f, 4.093632071e-01f}, {9.720065911e-01f, 2.349535844e-01f}, {9.911192705e-01f, 1.329759061e-01f}, {9.971888179e-01f, 7.492971024e-02f}, {9.991107413e-01f, 4.216309603e-02f}, {9.997187632e-01f, 2.371485776e-02f}, {9.999110623e-01f, 1.333669988e-02f},
  {8.243313311e-01f, 5.661076369e-01f}, {3.206739413e-01f, -9.471896449e-01f}, {4.541028846e-01f, -8.909492523e-01f}, {5.828599138e-01f, 8.125726558e-01f}, {2.512599349e-01f, 9.679196481e-01f}, {-4.246676935e-01f, -9.053492973e-01f}, {-7.396394557e-01f, 6.730033251e-01f}, {2.175502694e-01f, 9.760491178e-01f},
  {7.248360173e-01f, 6.889214382e-01f}, {9.100550791e-01f, 4.144873377e-01f}, {9.712587434e-01f, 2.380261612e-01f}, {9.908812338e-01f, 1.347381921e-01f}, {9.971133894e-01f, 7.592686345e-02f}, {9.990868733e-01f, 4.272492929e-02f}, {9.997112139e-01f, 2.403099635e-02f}, {9.999086748e-01f, 1.351451244e-02f},
  {-3.097503173e-02f, 9.995201586e-01f}, {7.763037288e-01f, -6.303590411e-01f}, {7.086563507e-01f, -7.055538084e-01f}, {4.299306917e-01f, 9.028618944e-01f}, {1.533735793e-01f, 9.881682778e-01f}, {-3.731119396e-01f, -9.277863334e-01f}, {-7.605484252e-01f, 6.492812125e-01f}, {2.001598939e-01f, 9.797632453e-01f},
  {7.179106829e-01f, 6.961352249e-01f}, {9.077098615e-01f, 4.195983881e-01f}, {9.705011830e-01f, 2.410963578e-01f}, {9.906400657e-01f, 1.365000372e-01f}, {9.970369639e-01f, 7.692394073e-02f}, {9.990626894e-01f, 4.328674904e-02f}, {9.997035647e-01f, 2.434713068e-02f}, {9.999062557e-01f, 1.369232365e-02f},
  {-8.578030932e-01f, 5.139784560e-01f}, {9.928478447e-01f, -1.193865876e-01f}, {8.929339780e-01f, -4.501876398e-01f}, {2.634407533e-01f, 9.646755773e-01f}, {5.395523011e-02f, 9.985433557e-01f}, {-3.203761718e-01f, -9.472904035e-01f}, {-7.806967553e-01f, 6.249100545e-01f}, {1.827063410e-01f, 9.831675305e-01f},
  {7.109135581e-01f, 7.032793989e-01f}, {9.053359523e-01f, 4.246961426e-01f}, {9.697339177e-01f, 2.441641434e-01f}, {9.903957650e-01f, 1.382614507e-01f}, {9.969595419e-01f, 7.792093366e-02f}, {9.990381894e-01f, 4.384855882e-02f}, {9.996958154e-01f, 2.466326443e-02f}, {9.999038051e-01f, 1.387013443e-02f},
  {-8.959709468e-01f, -4.441126687e-01f}, {9.036121431e-01f, 4.283516019e-01f}, {9.886589454e-01f, -1.501781928e-01f}, {8.864288797e-02f, 9.960634711e-01f}, {-4.600222091e-02f, 9.989413375e-01f}, {-2.666280039e-01f, -9.637995163e-01f}, {-8.000646032e-01f, 5.999138528e-01f}, {1.651948960e-01f, 9.862609423e-01f},
  {7.038453428e-01f, 7.103532456e-01f}, {9.029334011e-01f, 4.297804941e-01f}, {9.689569550e-01f, 2.472294874e-01f}, {9.901483302e-01f, 1.400224418e-01f}, {9.968811223e-01f, 7.891785610e-02f}, {9.990133736e-01f, 4.441035101e-02f}, {9.996879663e-01f, 2.497939386e-02f}, {9.999013228e-01f, 1.404794477e-02f},
  {-1.103872438e-01f, -9.938886539e-01f}, {5.360818520e-01f, 8.441660073e-01f}, {9.863393414e-01f, 1.647261474e-01f}, {-8.895072913e-02f, 9.960360274e-01f}, {-1.455000338e-01f, 9.893582466e-01f}, {-2.120364479e-01f, -9.772617586e-01f}, {-8.186323106e-01f, 5.743179782e-01f}, {1.476312130e-01f, 9.890424788e-01f},
  {6.967067436e-01f, 7.173560577e-01f}, {9.005023096e-01f, 4.348512278e-01f}, {9.681703064e-01f, 2.502923447e-01f}, {9.898977664e-01f, 1.417829752e-01f}, {9.968017059e-01f, 7.991469961e-02f}, {9.989882418e-01f, 4.497213288e-02f}, {9.996800171e-01f, 2.529552265e-02f}, {9.998988088e-01f, 1.422575559e-02f},
  {7.766859820e-01f, -6.298879943e-01f}, {3.445185325e-03f, 9.999940653e-01f}, {8.862052262e-01f, 4.632928847e-01f}, {-2.637388853e-01f, 9.645941117e-01f}, {-2.435445237e-01f, 9.698897179e-01f}, {-1.567750159e-01f, -9.876343424e-01f}, {-8.363815912e-01f, 5.481476388e-01f}, {1.300208462e-01f, 9.915112604e-01f},
  {6.894984312e-01f, 7.242871760e-01f}, {8.980427419e-01f, 4.399082105e-01f}, {9.673739687e-01f, 2.533527278e-01f}, {9.896440723e-01f, 1.435430604e-01f}, {9.967212932e-01f, 8.091145579e-02f}, {9.989627942e-01f, 4.553389681e-02f}, {9.996719680e-01f, 2.561164704e-02f}, {9.998962633e-01f, 1.440356503e-02f},
  {9.496776979e-01f, 3.132287824e-01f}, {-5.302493098e-01f, 8.478417715e-01f}, {6.981857146e-01f, 7.159166906e-01f}, {-4.302088505e-01f, 9.027293863e-01f}, {-3.391546816e-01f, 9.407306214e-01f}, {-1.010174785e-01f, -9.948846511e-01f}, {-8.532945541e-01f, 5.214291936e-01f}, {1.123693641e-01f, 9.936665064e-01f},
  {6.822212125e-01f, 7.311458248e-01f}, {8.955547626e-01f, 4.449513088e-01f}, {9.665679648e-01f, 2.564105487e-01f}, {9.893872465e-01f, 1.453027063e-01f}, {9.966398832e-01f, 8.190813848e-02f}, {9.989370307e-01f, 4.609564634e-02f}, {9.996638188e-01f, 2.592777074e-02f}, {9.998936861e-01f, 1.458137402e-02f},
  {2.495401180e-01f, 9.683644611e-01f}, {-9.006392088e-01f, 4.345676190e-01f}, {4.409287511e-01f, 8.975421084e-01f}, {-5.831102465e-01f, 8.123930332e-01f}, {-4.313770170e-01f, 9.021717515e-01f}, {-4.494105369e-02f, -9.989896404e-01f}, {-8.693541698e-01f, 4.941895663e-01f}, {9.468234863e-02f, 9.955075353e-01f},
  {6.748757724e-01f, 7.379313598e-01f}, {8.930384766e-01f, 4.499803098e-01f}, {9.657522875e-01f, 2.594658342e-01f}, {9.891272942e-01f, 1.470618780e-01f}, {9.965574766e-01f, 8.290473926e-02f}, {9.989109512e-01f, 4.665738502e-02f}, {9.996555698e-01f, 2.624388999e-02f}, {9.998910773e-01f, 1.475918348e-02f},
  {-6.800234956e-01f, 7.331903201e-01f}, {-9.936468888e-01f, -1.125427045e-01f}, {1.399453517e-01f, 9.901592289e-01f}, {-7.176206406e-01f, 6.964342152e-01f}, {-5.192891431e-01f, 8.545986109e-01f}, {1.127792530e-02f, -9.999364022e-01f}, {-8.845446221e-01f, 4.664555837e-01f}, {7.696539271e-02f, 9.970337649e-01f},
  {6.674628454e-01f, 7.446431025e-01f}, {8.904939370e-01f, 4.549951079e-01f}, {9.649269605e-01f, 2.625184963e-01f}, {9.888642139e-01f, 1.488205847e-01f}, {9.964740734e-01f, 8.390125714e-02f}, {9.988845559e-01f, 4.721910521e-02f}, {9.996472207e-01f, 2.656000847e-02f}, {9.998884369e-01f, 1.493699154e-02f},
  {-9.843766434e-01f, -1.760756199e-01f}, {-7.806286820e-01f, -6.249950886e-01f}, {-1.749181574e-01f, 9.845829768e-01f}, {-8.294976431e-01f, 5.585102148e-01f}, {-6.020119027e-01f, 7.984871126e-01f}, {6.746077372e-02f, -9.977219272e-01f}, {-8.988504928e-01f, 4.382553955e-01f}, {5.922409879e-02f, 9.982447125e-01f},
  {6.599831728e-01f, 7.512803815e-01f}, {8.879212510e-01f, 4.599954913e-01f}, {9.640919764e-01f, 2.655685619e-01f}, {9.885980044e-01f, 1.505788355e-01f}, {9.963896744e-01f, 8.489768369e-02f}, {9.988578448e-01f, 4.778081048e-02f}, {9.996387718e-01f, 2.687612243e-02f}, {9.998857649e-01f, 1.511479913e-02f},
  {-3.836984449e-01f, -9.234584470e-01f}, {-3.271927780e-01f, -9.449576107e-01f}, {-4.724333302e-01f, 8.813664099e-01f}, {-9.152127100e-01f, 4.029710850e-01f}, {-6.787203275e-01f, 7.343968390e-01f}, {1.234308237e-01f, -9.923531789e-01f}, {-9.122576928e-01f, 4.096167744e-01f}, {4.146407704e-02f, 9.991399954e-01f},
  {6.524375025e-01f, 7.578425333e-01f}, {8.853204729e-01f, 4.649813548e-01f}, {9.632473592e-01f, 2.686159432e-01f}, {9.883286709e-01f, 1.523365953e-01f}, {9.963042784e-01f, 8.589403277e-02f}, {9.988308176e-01f, 4.834250436e-02f}, {9.996302228e-01f, 2.719223557e-02f}, {9.998830612e-01f, 1.529260717e-02f},
  {5.697503343e-01f, -8.218178366e-01f}, {2.270120019e-01f, -9.738919606e-01f}, {-7.230991089e-01f, 6.907442932e-01f}, {-9.720626554e-01f, 2.347215243e-01f}, {-7.486465191e-01f, 6.629693729e-01f}, {1.790106509e-01f, -9.838471359e-01f}, {-9.247526141e-01f, 3.805687884e-01f}, {2.369106270e-02f, 9.997193274e-01f},
  {6.448265436e-01f, 7.643289401e-01f}, {8.826917124e-01f, 4.699524879e-01f}, {9.623931097e-01f, 2.716606383e-01f}, {9.880562120e-01f, 1.540938735e-01f}, {9.962178860e-01f, 8.689029596e-02f}, {9.988034748e-01f, 4.890417923e-02f}, {9.996215739e-01f, 2.750834413e-02f}, {9.998803260e-01f, 1.547041379e-02f},
  {9.993732837e-01f, 3.539830273e-02f}, {7.113042761e-01f, -7.028842200e-01f}, {-9.020542361e-01f, 4.316226999e-01f}, {-9.982538526e-01f, 5.906983832e-02f}, {-8.110931256e-01f, 5.849170382e-01f}, {2.340240777e-01f, -9.722308013e-01f}, {-9.363229511e-01f, 3.511400451e-01f}, {5.910437661e-03f, 9.999825332e-01f},
  {6.371511479e-01f, 7.707388759e-01f}, {8.800350389e-01f, 4.749087600e-01f}, {9.615292282e-01f, 2.747026454e-01f}, {9.877806264e-01f, 1.558506791e-01f}, {9.961304975e-01f, 8.788647225e-02f}, {9.987758161e-01f, 4.946583863e-02f}, {9.996128250e-01f, 2.782445179e-02f}, {9.998775591e-01f, 1.564821993e-02f},
  {5.101770449e-01f, 8.600694058e-01f}, {9.765252486e-01f, -2.154029687e-01f}, {-9.915538504e-01f, 1.296956507e-01f}, {-9.929606288e-01f, -1.184448804e-01f}, {-8.654354959e-01f, 5.010203613e-01f}, {2.882981135e-01f, -9.575407029e-01f}, {-9.469569600e-01f, 3.213604143e-01f}, {-1.187205637e-02f, 9.999295247e-01f},
  {6.294120377e-01f, 7.770717385e-01f}, {8.773505365e-01f, 4.798500142e-01f}, {9.606557395e-01f, 2.777418769e-01f}, {9.875019194e-01f, 1.576069771e-01f}, {9.960421134e-01f, 8.888255324e-02f}, {9.987478414e-01f, 5.002748612e-02f}, {9.996039762e-01f, 2.814055482e-02f}, {9.998747606e-01f, 1.582602650e-02f},
  {-4.480736161e-01f, 8.939966636e-01f}, {9.409945525e-01f, 3.384217076e-01f}, {-9.827212994e-01f, -1.850914579e-01f}, {-9.563499296e-01f, -2.922239076e-01f}, {-9.111302619e-01f, 4.121184852e-01f}, {3.416602554e-01f, -9.398235313e-01f}, {-9.566441680e-01f, 2.912592245e-01f}, {-2.965079623e-02f, 9.995603185e-01f},
  {6.216099869e-01f, 7.833268948e-01f}, {8.746382611e-01f, 4.847761465e-01f}, {9.597726360e-01f, 2.807783596e-01f}, {9.872200896e-01f, 1.593627767e-01f}, {9.959527327e-01f, 8.987855276e-02f}, {9.987195510e-01f, 5.058911406e-02f}, {9.995950273e-01f, 2.845665689e-02f}, {9.998719305e-01f, 1.600383071e-02f},
  {-9.943674609e-01f, 1.059875118e-01f}, {6.156554058e-01f, 7.880154956e-01f}, {-8.764333210e-01f, -4.815232433e-01f}, {-8.895764379e-01f, -4.567863407e-01f}, {-9.477217239e-01f, 3.190980008e-01f}, {3.939427052e-01f, -9.191349983e-01f}, {-9.653747427e-01f, 2.608670278e-01f}, {-4.742015991e-02f, 9.988750314e-01f},
  {6.137457758e-01f, 7.895037192e-01f}, {8.718983561e-01f, 4.896868966e-01f}, {9.588799431e-01f, 2.838120059e-01f}, {9.869351381e-01f, 1.611180724e-01f}, {9.958623560e-01f, 9.087446241e-02f}, {9.986909448e-01f, 5.115072601e-02f}, {9.995859786e-01f, 2.877275425e-02f}, {9.998690688e-01f, 1.618163628e-02f},
  {-6.264444479e-01f, -7.794660696e-01f}, {1.007066243e-01f, 9.949161652e-01f}, {-6.832289885e-01f, -7.302041832e-01f}, {-7.947461559e-01f, -6.069419640e-01f}, {-9.748435789e-01f, 2.228901000e-01f}, {4.449792900e-01f, -8.955408598e-01f}, {-9.731400858e-01f, 2.302137560e-01f}, {-6.517452839e-02f, 9.978738802e-01f},
  {6.058201908e-01f, 7.956015940e-01f}, {8.691308793e-01f, 4.945821616e-01f}, {9.579776530e-01f, 2.868428427e-01f}, {9.866470631e-01f, 1.628728733e-01f}, {9.957709834e-01f, 9.187028118e-02f}, {9.986620226e-01f, 5.171232550e-02f}, {9.995768298e-01f, 2.908885060e-02f}, {9.998661754e-01f, 1.635944133e-02f},
  {3.174287015e-01f, -9.482821413e-01f}, {-4.452612126e-01f, 8.954007218e-01f}, {-4.222704815e-01f, -9.064698784e-01f}, {-6.748499826e-01f, -7.379549451e-01f}, {-9.922253492e-01f, 1.244542343e-01f}, {4.946095243e-01f, -8.691153079e-01f}, {-9.799323156e-01f, 1.993305216e-01f}, {-8.290828739e-02f, 9.965571814e-01f},
  {5.978339766e-01f, 8.016199452e-01f}, {8.663359185e-01f, 4.994617866e-01f}, {9.570657916e-01f, 2.898707825e-01f}, {9.863558705e-01f, 1.646271445e-01f}, {9.956786158e-01f, 9.286600066e-02f}, {9.986327848e-01f, 5.227390491e-02f}, {9.995675812e-01f, 2.940494218e-02f}, {9.998632504e-01f, 1.653724401e-02f},
  {9.694593667e-01f, -2.452519855e-01f}, {-8.540936460e-01f, 5.201192593e-01f}, {-1.194339657e-01f, -9.928421465e-01f}, {-5.336693826e-01f, -8.456932009e-01f}, {-9.996930562e-01f, 2.477485342e-02f}, {5.426756651e-01f, -8.399423329e-01f}, {-9.857447428e-01f, 1.682477399e-01f}, {-1.006158291e-01f, 9.949253514e-01f},
  {5.897880270e-01f, 8.075580990e-01f}, {8.635135319e-01f, 5.043256689e-01f}, {9.561443597e-01f, 2.928958236e-01f}, {9.860615588e-01f, 1.663808950e-01f}, {9.955852518e-01f, 9.386163469e-02f}, {9.986032312e-01f, 5.283546780e-02f}, {9.995582325e-01f, 2.972103268e-02f}, {9.998602938e-01f, 1.671504802e-02f},
  {7.301735610e-01f, 6.832617147e-01f}, {-9.998821447e-01f, -1.535241693e-02f}, {1.952449607e-01f, -9.807545082e-01f}, {-3.756571205e-01f, -9.267587215e-01f}, {-9.971721562e-01f, -7.515112046e-02f}, {5.890265674e-01f, -8.081136695e-01f}, {-9.905714679e-01f, 1.369969595e-01f}, {-1.182915542e-01f, 9.929789062e-01f},
  {5.816830992e-01f, 8.134154979e-01f}, {8.606638685e-01f, 5.091735514e-01f}, {9.552133576e-01f, 2.959179642e-01f}, {9.857641264e-01f, 1.681341341e-01f}, {9.954908922e-01f, 9.485717486e-02f}, {9.985733616e-01f, 5.339701770e-02f}, {9.995487840e-01f, 3.003711834e-02f}, {9.998573056e-01f, 1.689285151e-02f},
  {-1.804304493e-01f, 9.835877454e-01f}, {-8.377248218e-01f, -5.460925956e-01f}, {4.905616517e-01f, -8.714064872e-01f}, {-2.057968231e-01f, -9.785947412e-01f}, {-9.846877893e-01f, -1.743271569e-01f}, {6.335149110e-01f, -7.737304812e-01f}, {-9.944077373e-01f, 1.056089575e-01f}, {-1.359298730e-01f, 9.907184613e-01f},
  {5.735200037e-01f, 8.191915560e-01f}, {8.577869887e-01f, 5.140053326e-01f}, {9.542728121e-01f, 2.989371172e-01f}, {9.854635793e-01f, 1.698868268e-01f}, {9.953955378e-01f, 9.585261276e-02f}, {9.985431764e-01f, 5.395854699e-02f}, {9.995392354e-01f, 3.035320100e-02f}, {9.998542858e-01f, 1.707065260e-02f},
  {-9.251475366e-01f, 3.796077390e-01f}, {-4.175648955e-01f, -9.086471032e-01f}, {7.372311535e-01f, -6.756406044e-01f}, {-2.944579810e-02f, -9.995663785e-01f}, {-9.623649317e-01f, -2.717604429e-01f}, {6.760008016e-01f, -7.369008863e-01f}, {-9.972496750e-01f, 7.411535468e-02f}, {-1.535250904e-01f, 9.881447498e-01f},
  {5.652995567e-01f, 8.248856958e-01f}, {8.548829836e-01f, 5.188208597e-01f}, {9.533227151e-01f, 3.019533092e-01f}, {9.851599158e-01f, 1.716389823e-01f}, {9.952991873e-01f, 9.684796223e-02f}, {9.985126755e-01f, 5.452005922e-02f}, {9.995295869e-01f, 3.066928249e-02f}, {9.998512343e-01f, 1.724845501e-02f},
  {-8.192882453e-01f, -5.733818720e-01f}, {1.312005053e-01f, -9.913558531e-01f}, {9.107885630e-01f, -4.128730962e-01f}, {1.478339325e-01f, -9.890121983e-01f}, {-9.304262022e-01f, -3.664793067e-01f}, {7.163492032e-01f, -6.977419430e-01f}, {-9.990944289e-01f, 4.254788036e-02f}, {-1.710718782e-01f, 9.852585511e-01f},
  {5.570225804e-01f, 8.304973479e-01f}, {8.519519448e-01f, 5.236199803e-01f}, {9.523630937e-01f, 3.049664534e-01f}, {9.848531345e-01f, 1.733906097e-01f}, {9.952018415e-01f, 9.784321484e-02f}, {9.984818586e-01f, 5.508155793e-02f}, {9.995198385e-01f, 3.098535905e-02f}, {9.998481513e-01f, 1.742625688e-02f},
  {3.982088039e-02f, -9.992068342e-01f}, {6.395552906e-01f, -7.687451010e-01f}, {9.940242463e-01f, -1.091595058e-01f}, {3.204510557e-01f, -9.472650743e-01f}, {-8.891908908e-01f, -4.575364026e-01f}, {7.544332398e-01f, -6.563767872e-01f}, {-9.999401824e-01f, 1.093762364e-02f}, {-1.885645696e-01f, 9.820607940e-01f},
  {5.486899024e-01f, 8.360259511e-01f}, {8.489939337e-01f, 5.284025933e-01f}, {9.513939397e-01f, 3.079765762e-01f}, {9.845432413e-01f, 1.751416741e-01f}, {9.951035005e-01f, 9.883836961e-02f}, {9.984507262e-01f, 5.564303550e-02f}, {9.995099901e-01f, 3.130143251e-02f}, {9.998450366e-01f, 1.760405633e-02f},
  {8.623188723e-01f, -5.063656411e-01f}, {9.509409315e-01f, -3.093725017e-01f}, {9.786828137e-01f, 2.053775797e-01f}, {4.829613148e-01f, -8.756416895e-01f}, {-8.390715291e-01f, -5.440211109e-01f}, {7.901318660e-01f, -6.129368926e-01f}, {-9.997860770e-01f, -2.068333150e-02f}, {-2.059976331e-01f, 9.785524897e-01f},
  {5.403023059e-01f, 8.414709848e-01f}, {8.460091064e-01f, 5.331684460e-01f}, {9.504152809e-01f, 3.109835909e-01f}, {9.842302348e-01f, 1.768921847e-01f}, {9.950041651e-01f, 9.983341813e-02f}, {9.984192780e-01f, 5.620449547e-02f}, {9.995000417e-01f, 3.161750470e-02f}, {9.998418903e-01f, 1.778185709e-02f},
  {8.920048698e-01f, 4.520257872e-01f}, {9.694527238e-01f, 2.452782427e-01f}, {8.662854932e-01f, 4.995492411e-01f}, {6.302406996e-01f, -7.763998072e-01f}, {-7.805679417e-01f, -6.250709467e-01f}, {8.233328271e-01f, -5.675588567e-01f}, {-9.986322645e-01f, -5.228384329e-02f}, {-2.233655562e-01f, 9.747347477e-01f},
  {5.318607295e-01f, 8.468318395e-01f}, {8.429975262e-01f, 5.379174387e-01f}, {9.494271181e-01f, 3.139874958e-01f}, {9.839141132e-01f, 1.786421505e-01f}, {9.949038340e-01f, 1.008283742e-01f}, {9.983875139e-01f, 5.676594140e-02f}, {9.994899934e-01f, 3.193357373e-02f}, {9.998387124e-01f, 1.795965543e-02f},
  {1.015857037e-01f, 9.948267914e-01f}, {6.893923357e-01f, 7.243881608e-01f}, {6.679785330e-01f, 7.441805423e-01f}, {7.576409417e-01f, -6.526715893e-01f}, {-7.142657855e-01f, -6.998745514e-01f}, {8.539305980e-01f, -5.203869078e-01f}, {-9.964799160e-01f, -8.383183766e-02f}, {-2.406628465e-01f, 9.706087751e-01f},
  {5.233659675e-01f, 8.521080120e-01f}, {8.399592882e-01f, 5.426494210e-01f}, {9.484294516e-01f, 3.169882891e-01f}, {9.835948828e-01f, 1.803915368e-01f}, {9.948025080e-01f, 1.018232295e-01f}, {9.983554343e-01f, 5.732736565e-02f}, {9.994798451e-01f, 3.224963957e-02f}, {9.998355028e-01f, 1.813745505e-02f},
  {-7.822308899e-01f, 6.229886314e-01f}, {1.970090633e-01f, 9.804016672e-01f}, {4.034298040e-01f, 9.150105973e-01f}, {8.611455722e-01f, -5.083584400e-01f}, {-6.408262712e-01f, -7.676859320e-01f}, {8.818289637e-01f, -4.715693786e-01f}, {-9.933311512e-01f, -1.152962447e-01f}, {-2.578840345e-01f, 9.661758767e-01f},
  {5.148188695e-01f, 8.572989745e-01f}, {8.368944560e-01f, 5.473642933e-01f}, {9.474223102e-01f, 3.199858843e-01f}, {9.832725421e-01f, 1.821403526e-01f}, {9.947001872e-01f, 1.028179829e-01f}, {9.983230390e-01f, 5.788877177e-02f}, {9.994695970e-01f, 3.256569846e-02f}, {9.998322617e-01f, 1.831525411e-02f},
  {-9.468680108e-01f, -3.216224032e-01f}, {-3.560463237e-01f, 9.344683063e-01f}, {9.887337000e-02f, 9.951000235e-01f}, {9.374901074e-01f, -3.480119230e-01f}, {-5.609837837e-01f, -8.278267901e-01f}, {9.069392526e-01f, -4.212614295e-01f}, {-9.891891661e-01f, -1.466451284e-01f}, {-2.750236744e-01f, 9.614374543e-01f},
  {5.062202901e-01f, 8.624042079e-01f}, {8.338031914e-01f, 5.520618064e-01f}, {9.464056851e-01f, 3.229803078e-01f}, {9.829470919e-01f, 1.838885924e-01f}, {9.945968724e-01f, 1.038126262e-01f}, {9.982903277e-01f, 5.845016330e-02f}, {9.994592488e-01f, 3.288175781e-02f}, {9.998289889e-01f, 1.849305072e-02f},
  {-2.409590492e-01f, -9.705352835e-01f}, {-7.994488075e-01f, 6.007342209e-01f}, {-2.154882311e-01f, 9.765064374e-01f}, {9.842666794e-01f, -1.766892861e-01f}, {-4.755369280e-01f, -8.796957600e-01f}, {9.291825053e-01f, -3.696212546e-01f}, {-9.840580399e-01f, -1.778476151e-01f}, {-2.920763464e-01f, 9.563950062e-01f},
  {4.975710893e-01f, 8.674232019e-01f}, {8.306855598e-01f, 5.567418619e-01f}, {9.453796055e-01f, 3.259714733e-01f}, {9.826185307e-01f, 1.856362654e-01f}, {9.944925623e-01f, 1.048071730e-01f}, {9.982573010e-01f, 5.901153264e-02f}, {9.994488007e-01f, 3.319781388e-02f}, {9.998256845e-01f, 1.867084861e-02f},
  {6.864865509e-01f, -7.271425001e-01f}, {-9.966333753e-01f, 8.198728756e-02f}, {-5.084800933e-01f, 8.610737453e-01f}, {9.999999788e-01f, 2.060413504e-04f}, {-3.853378388e-01f, -9.227755686e-01f}, {9.484880243e-01f, -3.168129854e-01f}, {-9.779429805e-01f, -2.088720345e-01f}, {-3.090365447e-01f, 9.510501638e-01f},
  {4.888721318e-01f, 8.723554544e-01f}, {8.275416598e-01f, 5.614043119e-01f}, {9.443440625e-01f, 3.289594073e-01f}, {9.822868650e-01f, 1.873833367e-01f}, {9.943872577e-01f, 1.058016150e-01f}, {9.982239586e-01f, 5.957288331e-02f}, {9.994382526e-01f, 3.351386663e-02f}, {9.998223485e-01f, 1.884864591e-02f},
  {9.827795820e-01f, 1.847817446e-01f}, {-8.868746619e-01f, -4.620101017e-01f}, {-7.510490434e-01f, 6.602464195e-01f}, {9.841937852e-01f, 1.770948704e-01f}, {-2.912894642e-01f, -9.566349607e-01f}, {9.647951032e-01f, -2.630026785e-01f}, {-9.708500105e-01f, -2.396878325e-01f}, {-3.258991334e-01f, 9.454045456e-01f},
  {4.801242876e-01f, 8.772004722e-01f}, {8.243715908e-01f, 5.660490088e-01f}, {9.432990858e-01f, 3.319440236e-01f}, {9.819520930e-01f, 1.891298155e-01f}, {9.942809587e-01f, 1.067959512e-01f}, {9.981903004e-01f, 6.013421886e-02f}, {9.994276047e-01f, 3.382991230e-02f}, {9.998189809e-01f, 1.902644076e-02f},
  {3.755095978e-01f, 9.268185054e-01f}, {-5.039728760e-01f, -8.637194801e-01f}, {-9.191339729e-01f, 3.939450974e-01f}, {9.373466181e-01f, 3.483982169e-01f}, {-1.943297194e-01f, -9.809362671e-01f}, {9.780520113e-01f, -2.083608964e-01f}, {-9.627863291e-01f, -2.702637314e-01f}, {-3.426586664e-01f, 9.394599717e-01f},
  {4.713284315e-01f, 8.819577709e-01f}, {8.211754191e-01f, 5.706758547e-01f}, {9.422446762e-01f, 3.349253204e-01f}, {9.816142129e-01f, 1.908757108e-01f}, {9.941736662e-01f, 1.077901732e-01f}, {9.981563267e-01f, 6.069553168e-02f}, {9.994168567e-01f, 3.414595831e-02f}, {9.998155816e-01f, 1.920423686e-02f},
  {-5.770021789e-01f, 8.167426066e-01f}, {3.414078174e-02f, -9.994170336e-01f}, {-9.960693628e-01f, 8.857665853e-02f}, {8.609360133e-01f, 5.087132600e-01f}, {-9.542828141e-02f, -9.954363079e-01f}, {9.882167644e-01f, -1.530608589e-01f}, {-9.537598777e-01f, -3.005696187e-01f}, {-3.593098438e-01f, 9.332183218e-01f},
  {4.624853373e-01f, 8.866269299e-01f}, {8.179533134e-01f, 5.752846053e-01f}, {9.411808341e-01f, 3.379032961e-01f}, {9.812732316e-01f, 1.926209879e-01f}, {9.940653787e-01f, 1.087842948e-01f}, {9.981220373e-01f, 6.125682530e-02f}, {9.994060088e-01f, 3.446200091e-02f}, {9.998121508e-01f, 1.938203235e-02f},
  {-9.990208133e-01f, -4.424267809e-02f}, {5.617429128e-01f, -8.273118516e-01f}, {-9.742256121e-01f, -2.255758335e-01f}, {7.573719227e-01f, 6.529837446e-01f}, {4.425697988e-03f, -9.999902066e-01f}, {9.952573993e-01f, -9.727645772e-02f}, {-9.437798181e-01f, -3.305747343e-01f}, {-3.758474003e-01f, 9.266815697e-01f},
  {4.535961002e-01f, 8.912073709e-01f}, {8.147053420e-01f, 5.798751639e-01f}, {9.401075903e-01f, 3.408778647e-01f}, {9.809291472e-01f, 1.943656558e-01f}, {9.939560972e-01f, 1.097783077e-01f}, {9.980874321e-01f, 6.181810327e-02f}, {9.993950610e-01f, 3.477804006e-02f}, {9.998086883e-01f, 1.955982537e-02f},
  {-5.025443191e-01f, -8.645514486e-01f}, {9.163355735e-01f, -4.004111845e-01f}, {-8.557689424e-01f, -5.173582098e-01f}, {6.299207052e-01f, 7.766594525e-01f}, {1.042364063e-01f, -9.945525484e-01f}, {9.991515381e-01f, -4.118499635e-02f}, {-9.328559791e-01f, -3.602495278e-01f}, {-3.922661065e-01f, 9.198517825e-01f},
  {4.446615039e-01f, 8.956986920e-01f}, {8.114316076e-01f, 5.844473854e-01f}, {9.390249353e-01f, 3.438490525e-01f}, {9.805819579e-01f, 1.961097238e-01f}, {9.938458217e-01f, 1.107722107e-01f}, {9.980525115e-01f, 6.237935797e-02f}, {9.993840133e-01f, 3.509407201e-02f}, {9.998051942e-01f, 1.973761964e-02f},
  {4.559691044e-01f, -8.899956044e-01f}, {9.887145094e-01f, 1.498119448e-01f}, {-6.524436848e-01f, -7.578372108e-01f}, {4.826021076e-01f, 8.758397147e-01f}, {2.030046771e-01f, -9.791777679e-01f}, {9.998869357e-01f, 1.503714472e-02f}, {-9.209993553e-01f, -3.895640993e-01f}, {-4.085607702e-01f, 9.127311198e-01f},
  {4.356824420e-01f, 9.001004443e-01f}, {8.081322136e-01f, 5.890011251e-01f}, {9.379329003e-01f, 3.468167738e-01f}, {9.802316707e-01f, 1.978531569e-01f}, {9.937345532e-01f, 1.117659956e-01f}, {9.980172753e-01f, 6.294059295e-02f}, {9.993728656e-01f, 3.541010418e-02f}, {9.998016685e-01f, 1.991541328e-02f},
  {9.952666362e-01f, -9.718190589e-02f}, {7.565874902e-01f, 6.538924757e-01f}, {-3.844182537e-01f, -9.231590362e-01f}, {3.200624839e-01f, 9.473964357e-01f}, {2.997455252e-01f, -9.540191927e-01f}, {9.974612549e-01f, 7.121127068e-02f}, {-9.082219023e-01f, -4.184889199e-01f}, {-4.247261310e-01f, 9.053218840e-01f},
  {4.266598122e-01f, 9.044121873e-01f}, {8.048072290e-01f, 5.935362871e-01f}, {9.368314756e-01f, 3.497810550e-01f}, {9.798782838e-01f, 1.995959644e-01f}, {9.936222901e-01f, 1.127596761e-01f}, {9.979817235e-01f, 6.350180803e-02f}, {9.993616180e-01f, 3.572613280e-02f}, {9.997981112e-01f, 2.009320443e-02f},
  {6.195206126e-01f, 7.849803887e-01f}, {2.914465538e-01f, 9.565871138e-01f}, {-7.827047274e-02f, -9.969321607e-01f}, {1.474282516e-01f, 9.890727530e-01f}, {3.934913924e-01f, -9.193283005e-01f}, {9.918821230e-01f, 1.271607411e-01f}, {-8.945362039e-01f, -4.469955032e-01f}, {-4.407574007e-01f, 8.976262662e-01f},
  {4.175945170e-01f, 9.086334901e-01f}, {8.014568295e-01f, 5.980526319e-01f}, {9.357206930e-01f, 3.527418104e-01f}, {9.795217952e-01f, 2.013381554e-01f}, {9.935090334e-01f, 1.137532439e-01f}, {9.979458556e-01f, 6.406301046e-02f}, {9.993502704e-01f, 3.604215785e-02f}, {9.997945222e-01f, 2.027099680e-02f},
  {-3.258098052e-01f, 9.454353340e-01f}, {-2.634541314e-01f, 9.646719238e-01f}, {2.356393079e-01f, -9.718405819e-01f}, {-2.985579311e-02f, 9.995542164e-01f}, {4.833047588e-01f, -8.754521747e-01f}, {9.831672727e-01f, 1.827077279e-01f}, {-8.799561509e-01f, -4.750549152e-01f}, {-4.566490802e-01f, 8.896469061e-01f},
  {4.084874626e-01f, 9.127639305e-01f}, {7.980810859e-01f, 6.025500646e-01f}, {9.346005532e-01f, 3.556990384e-01f}, {9.791622120e-01f, 2.030796950e-01f}, {9.933947841e-01f, 1.147466905e-01f}, {9.979096726e-01f, 6.462418519e-02f}, {9.993388230e-01f, 3.635817558e-02f}, {9.997909017e-01f, 2.044878854e-02f},
  {-9.715921906e-01f, 2.366613934e-01f}, {-7.372213326e-01f, 6.756513203e-01f}, {5.261809886e-01f, -8.503726049e-01f}, {-2.061982012e-01f, 9.785102461e-01f}, {5.682899437e-01f, -8.228283782e-01f}, {9.713441080e-01f, 2.376775627e-01f}, {-8.644961024e-01f, -5.026395219e-01f}, {-4.723965703e-01f, 8.813861131e-01f},
  {3.993395600e-01f, 9.168030954e-01f}, {7.946801049e-01f, 6.070284433e-01f}, {9.334710569e-01f, 3.586527372e-01f}, {9.787995325e-01f, 2.048205925e-01f}, {9.932795405e-01f, 1.157400297e-01f}, {9.978731741e-01f, 6.518533949e-02f}, {9.993272755e-01f, 3.667419339e-02f}, {9.997872495e-01f, 2.062657776e-02f},
  {-7.240971967e-01f, -6.896979409e-01f}, {-9.839316487e-01f, 1.785455423e-01f}, {7.645443186e-01f, -6.445711636e-01f}, {-3.760372225e-01f, 9.266045582e-01f}, {6.475961933e-01f, -7.619837074e-01f}, {9.564502073e-01f, 2.918955309e-01f}, {-8.481717500e-01f, -5.297213253e-01f}, {-4.879944690e-01f, 8.728467209e-01f},
  {3.901517238e-01f, 9.207505810e-01f}, {7.912539576e-01f, 6.114876732e-01f}, {9.323322365e-01f, 3.616028218e-01f}, {9.784337548e-01f, 2.065608568e-01f}, {9.931633036e-01f, 1.167332532e-01f}, {9.978363600e-01f, 6.574647317e-02f}, {9.993156281e-01f, 3.699020753e-02f}, {9.997835657e-01f, 2.080436820e-02f},
  {1.891294205e-01f, -9.819521690e-01f}, {-9.276105631e-01f, -3.735487159e-01f}, {9.270853567e-01f, -3.748502919e-01f}, {-5.340162202e-01f, 8.454742318e-01f}, {7.204326113e-01f, -6.935249474e-01f}, {9.385324046e-01f, 3.451911433e-01f}, {-8.309991709e-01f, -5.562736539e-01f}, {-5.034382623e-01f, 8.640312009e-01f},
  {3.809248729e-01f, 9.246059924e-01f}, {7.878028251e-01f, 6.159275191e-01f}, {9.311840821e-01f, 3.645493180e-01f}, {9.780648860e-01f, 2.083004533e-01f}, {9.930460735e-01f, 1.177263600e-01f}, {9.977992303e-01f, 6.630758607e-02f}, {9.993038808e-01f, 3.730621798e-02f}, {9.997798503e-01f, 2.098215797e-02f},
  {9.284713207e-01f, -3.714041014e-01f}, {-5.856038514e-01f, -8.105973903e-01f}, {9.976883249e-01f, -6.795591499e-02f}, {-6.751540238e-01f, 7.376767884e-01f}, {7.860706498e-01f, -6.181366624e-01f}, {9.176476495e-01f, 3.973950068e-01f}, {-8.129957948e-01f, -5.822695575e-01f}, {-5.187226524e-01f, 8.549425770e-01f},
  {3.716599298e-01f, 9.283689442e-01f}, {7.843267803e-01f, 6.203478877e-01f}, {9.300266266e-01f, 3.674921411e-01f}, {9.776929243e-01f, 2.100393912e-01f}, {9.929278513e-01f, 1.187193417e-01f}, {9.977617851e-01f, 6.686867800e-02f}, {9.992920336e-01f, 3.762222097e-02f}, {9.997761033e-01f, 2.115994522e-02f},
  {8.141809705e-01f, 5.806111842e-01f}, {-6.324278670e-02f, -9.979981713e-01f}, {9.693516017e-01f, 2.456775778e-01f}, {-7.949961987e-01f, 6.066144113e-01f}, {8.438539587e-01f, -5.365729180e-01f}, {8.938616142e-01f, 4.483429653e-01f}, {-7.941793525e-01f, -6.076834341e-01f}, {-5.338430142e-01f, 8.455836068e-01f},
  {3.623578211e-01f, 9.320390600e-01f}, {7.808259330e-01f, 6.247486393e-01f}, {9.288598600e-01f, 3.704313169e-01f}, {9.773178677e-01f, 2.117776794e-01f}, {9.928086353e-01f, 1.197122120e-01f}, {9.977240240e-01f, 6.742975621e-02f}, {9.992800864e-01f, 3.793822392e-02f}, {9.997723246e-01f, 2.133773367e-02f},
  {-4.866360920e-02f, 9.988152247e-01f}, {4.786024988e-01f, -8.780316897e-01f}, {8.448832693e-01f, 5.349507092e-01f}, {-8.897645961e-01f, 4.564197229e-01f}, {8.932062830e-01f, -4.496471238e-01f}, {8.672498998e-01f, 4.978730876e-01f}, {-7.745689422e-01f, -6.324894891e-01f}, {-5.487947659e-01f, 8.359571191e-01f},
  {3.530194771e-01f, 9.356159729e-01f}, {7.773003940e-01f, 6.291296348e-01f}, {9.276838157e-01f, 3.733667607e-01f}, {9.769397237e-01f, 2.135152833e-01f}, {9.926884264e-01f, 1.207049626e-01f}, {9.976859478e-01f, 6.799080567e-02f}, {9.992680393e-01f, 3.825422308e-02f}, {9.997685144e-01f, 2.151551958e-02f},
  {-8.667670911e-01f, 4.987131539e-01f}, {8.730401082e-01f, -4.876484076e-01f}, {6.366296978e-01f, 7.711696493e-01f}, {-9.564702688e-01f, 2.918297875e-01f}, {9.336335757e-01f, -3.582294603e-01f}, {8.378961870e-01f, 5.458296252e-01f}, {-7.541838773e-01f, -6.566632922e-01f}, {-5.635727784e-01f, 8.260664159e-01f},
  {3.436457194e-01f, 9.390993662e-01f}, {7.737502371e-01f, 6.334907818e-01f}, {9.264984948e-01f, 3.762984709e-01f}, {9.765584904e-01f, 2.152522121e-01f}, {9.925672249e-01f, 1.216975926e-01f}, {9.976475561e-01f, 6.855183363e-02f}, {9.992558923e-01f, 3.857021841e-02f}, {9.997646725e-01f, 2.169330666e-02f},
  {-8.879689067e-01f, -4.599034907e-01f}, {9.985987075e-01f, 5.292089673e-02f}, {3.652422354e-01f, 9.309125144e-01f}, {-9.930093536e-01f, 1.180356885e-01f}, {9.647326681e-01f, -2.632316074e-01f}, {8.058937730e-01f, 5.920601546e-01f}, {-7.330448482e-01f, -6.801803074e-01f}, {-5.781727749e-01f, 8.159143597e-01f},
  {3.342377091e-01f, 9.424888083e-01f}, {7.701756497e-01f, 6.378318498e-01f}, {9.253038976e-01f, 3.792264457e-01f}, {9.761741690e-01f, 2.169884602e-01f}, {9.924450317e-01f, 1.226900934e-01f}, {9.976088489e-01f, 6.911283990e-02f}, {9.992436454e-01f, 3.888620616e-02f}, {9.997607990e-01f, 2.187109307e-02f},
  {-9.277620460e-02f, -9.956869869e-01f}, {8.166087424e-01f, 5.771916162e-01f}, {5.763408854e-02f, 9.983377744e-01f}, {-9.982294262e-01f, -5.948119644e-02f}, {9.861923970e-01f, -1.656036111e-01f}, {7.713432897e-01f, 6.364193032e-01f}, {-7.111726737e-01f, -7.030173740e-01f}, {-5.925897472e-01f, 8.055044329e-01f},
  {3.247962754e-01f, 9.457840025e-01f}, {7.665767074e-01f, 6.421527480e-01f}, {9.241000586e-01f, 3.821506007e-01f}, {9.757867573e-01f, 2.187240366e-01f}, {9.923218452e-01f, 1.236824789e-01f}, {9.975698262e-01f, 6.967382433e-02f}, {9.992312986e-01f, 3.920219375e-02f}, {9.997568940e-01f, 2.204887692e-02f},
  {7.877145121e-01f, -6.160404592e-01f}, {3.831195069e-01f, 9.236987839e-01f}, {-2.556895696e-01f, 9.667589379e-01f}, {-9.719658482e-01f, -2.351220745e-01f}, {9.977982792e-01f, -6.632189735e-02f}, {7.343545514e-01f, 6.787660811e-01f}, {-6.885895538e-01f, -7.251513128e-01f}, {-6.068195228e-01f, 7.948396484e-01f},
  {3.153223624e-01f, 9.489846194e-01f}, {7.629535240e-01f, 6.464533396e-01f}, {9.228869673e-01f, 3.850709617e-01f}, {9.753962633e-01f, 2.204589068e-01f}, {9.921976672e-01f, 1.246747334e-01f}, {9.975304881e-01f, 7.023478672e-02f}, {9.992188517e-01f, 3.951817742e-02f}, {9.997529572e-01f, 2.222666193e-02f},
  {9.439841392e-01f, 3.299908257e-01f}, {-1.683704464e-01f, 9.857237913e-01f}, {-5.436599665e-01f, 8.393055706e-01f}, {-9.150469596e-01f, -4.033473215e-01f}, {9.994345727e-01f, 3.362342848e-02f}, {6.950438698e-01f, 7.189673282e-01f}, {-6.653177293e-01f, -7.465603252e-01f}, {-6.208572206e-01f, 7.839236644e-01f},
  {3.058169175e-01f, 9.520903387e-01f}, {7.593061752e-01f, 6.507335340e-01f}, {9.216646586e-01f, 3.879874445e-01f}, {9.750026847e-01f, 2.221930799e-01f}, {9.920724962e-01f, 1.256668706e-01f}, {9.974908340e-01f, 7.079573433e-02f}, {9.992063050e-01f, 3.983415713e-02f}, {9.997489889e-01f, 2.240444624e-02f},
  {2.323591020e-01f, 9.726300672e-01f}, {-6.679985997e-01f, 7.441625298e-01f}, {-7.777124942e-01f, 6.286201368e-01f}, {-8.292679533e-01f, -5.588511981e-01f}, {9.910848972e-01f, 1.332318524e-01f}, {6.535361888e-01f, 7.568952701e-01f}, {-6.413808207e-01f, -7.672226814e-01f}, {-6.346987778e-01f, 7.727596402e-01f},
  {2.962808911e-01f, 9.551008499e-01f}, {7.556348538e-01f, 6.549931051e-01f}, {9.204331217e-01f, 3.909000749e-01f}, {9.746060196e-01f, 2.239265649e-01f}, {9.919463330e-01f, 1.266588821e-01f}, {9.974508651e-01f, 7.135665213e-02f}, {9.991936585e-01f, 4.015012914e-02f}, {9.997449890e-01f, 2.258222798e-02f},
};

namespace pg8 {
#define PG8_LAS __attribute__((address_space(3)))
typedef unsigned short bf16_t;
typedef short bf16x8 __attribute__((ext_vector_type(8)));
typedef float f32x4 __attribute__((ext_vector_type(4)));
typedef unsigned u32x4 __attribute__((ext_vector_type(4)));
constexpr int BM = 256, BK = 64, HALF = 128, HTB = HALF * BK * 2  , STAGE_BYTES = 8 * HTB, NXCD = 8, WGM = 8;

__host__ __device__ __forceinline__ int lds_byte(int r, int c) { const int st = (r >> 4) * 2 + (c >> 5), rr = r & 15, cc = c & 31, ob = rr * 64 + cc * 2; return st * 1024 + (ob ^ (((ob >> 9) & 1) << 5)); }
__host__ __device__ __forceinline__ void stage_rc(int b, int& R, int& C) { const int st = b / 1024, sb = b % 1024, swz = sb ^ (((sb >> 9) & 1) << 5); R = (st >> 1) * 16 + swz / 64; C = (st & 1) * 32 + (swz % 64) / 2; }
__host__ __device__ __forceinline__ int perm32(int rho) { const int n = rho >> 4, i = rho & 15; return 8 * (i >> 2) + 4 * n + (i & 3); }

struct Unit { int pm, pn, ko, ks; };
struct Gemm { const bf16_t* A; const bf16_t* Bt; int M, N, K, ld; };

struct StaticOrder {
    int nM, nN, nwg, G, c;
    __host__ __device__ void init(int M, int N, int G_, int c_) { nM = M / BM; nN = N / BM; nwg = nM * nN; G = G_; c = c_; }
    __host__ __device__ bool next(int i, Unit& u) const {
        const int L = i * G + c; if (L >= nwg) return false;
        int wgid = L; { const int q = nwg / NXCD, r = nwg % NXCD, xcd = wgid % NXCD, off = wgid / NXCD; wgid = (xcd < r ? xcd * (q + 1) : r * (q + 1) + (xcd - r) * q) + off; }
        const int nig = WGM * nN, gid = wgid / nig, fm = gid * WGM, gsz = (nM - fm) < WGM ? (nM - fm) : WGM;
        u.pm = fm + ((wgid % nig) % gsz); u.pn = (wgid % nig) / gsz; u.ko = 0; u.ks = 0; return true;
    }
    __device__ __forceinline__ void a_ready(const Unit&) const {}
    __device__ __forceinline__ void done(const Unit&) const {}
};

struct SplitKOrder {
    int nN, nS, kchunk, G, c;
    __host__ __device__ void init(int N, int nS_, int kchunk_, int G_, int c_) { nN = N / BM; nS = nS_; kchunk = kchunk_; G = G_; c = c_; }
    __host__ __device__ bool next(int i, Unit& u) const { const int L = i * G + c; if (L >= nN * nS) return false; u.pm = 0; u.pn = L % nN; u.ks = L / nN; u.ko = u.ks * kchunk; return true; }
    __device__ __forceinline__ void a_ready(const Unit&) const {}
    __device__ __forceinline__ void done(const Unit&) const {}
};
__device__ __forceinline__ unsigned cvt_pk_bf16(float lo, float hi) { unsigned r; asm volatile("v_cvt_pk_bf16_f32 %0, %1, %2" : "=v"(r) : "v"(lo), "v"(hi)); return r; }
typedef float f32x2 __attribute__((ext_vector_type(2)));
typedef unsigned u32x2 __attribute__((ext_vector_type(2)));
typedef float f32x2 __attribute__((ext_vector_type(2)));
template <int MODE> struct EpiBf16R {
    static constexpr bool PERM = false, AFTER_DRAIN = false;
    bf16_t* O; bf16_t* O2; const f32x2* rope;
    __device__ __forceinline__ void operator()(const f32x4 (&acc)[2][2][4][2], const Unit& u, int wr, int wc, int fr, int fq) const {
        asm volatile("" : "+v"(fr), "+v"(fq));
#pragma unroll
        for (int bj = 0; bj < 2; ++bj) {
            const int cg0 = u.pn * BM + bj * HALF + wc * 32;
            bool dorope = false; int axis = 0; bf16_t* base = O; int ldc = 0, dcol = 0;
            if (MODE == 0) { dorope = (cg0 >= 1536 && cg0 < 2560) || (cg0 >= 5248 && cg0 < 5312); axis = (cg0 >> 5) & 1; ldc = 5376; dcol = cg0; }
            else if (MODE == 1) { const int w = cg0 % 192; dorope = w >= 128; axis = ((w - 128) >> 5) & 1; ldc = 768; dcol = cg0; }
            else { if (bj == 0) { base = O; ldc = 768; dcol = u.pn * 192 + wc * 32; } else { base = O2; ldc = 512; dcol = u.pn * 128 + wc * 32; } }
            dorope = dorope && (u.pm < 32);
            const float qscale = (MODE == 0) ? ((cg0 >= 1536 && cg0 < 2048) ? 0.125f * 1.4426950408889634f : 1.0f) : (MODE == 1 ? 0.07216878364870322f * 1.4426950408889634f : 1.0f);
#pragma unroll
            for (int ai = 0; ai < 2; ++ai)
#pragma unroll
                for (int m = 0; m < 4; ++m) {
                    const int row = u.pm * BM + ai * HALF + wr * 64 + m * 16 + fr;
                    f32x4 v0 = acc[ai][bj][m][0], v1 = acc[ai][bj][m][1];
                    if (dorope) {
                        const int pos = axis ? (row & 63) : (row >> 6);
                        const f32x2* rp = rope + pos * 16 + 4 * fq;
                        f32x4 o0, o1;
#pragma unroll
                        for (int i = 0; i < 4; ++i) { const f32x2 cs = rp[i]; o0[i] = v0[i] * cs.x - v1[i] * cs.y; o1[i] = v1[i] * cs.x + v0[i] * cs.y; }
                        v0 = o0; v1 = o1;
                    }
                    if (qscale != 1.0f) { v0 = v0 * qscale; v1 = v1 * qscale; }
                    bf16_t* p = base + (size_t)row * ldc + dcol + 4 * fq;
                    u32x2 w0, w1; w0.x = cvt_pk_bf16(v0[0], v0[1]); w0.y = cvt_pk_bf16(v0[2], v0[3]); w1.x = cvt_pk_bf16(v1[0], v1[1]); w1.y = cvt_pk_bf16(v1[2], v1[3]);
                    *(u32x2*)p = w0; *(u32x2*)(p + 16) = w1;
                }
        }
    }
};
struct EpiResid {
    static constexpr bool PERM = false, AFTER_DRAIN = false;
    const float* xres; float* out; const float* gate_lat; const float* gate_ctx;
    __device__ __forceinline__ void operator()(const f32x4 (&acc)[2][2][4][2], const Unit& u, int wr, int wc, int fr, int fq) const {
        asm volatile("" : "+v"(fr), "+v"(fq));
        const int col0 = u.pn * BM + wc * 32 + 4 * fq;
        const float* gate = (u.pm >= 32) ? gate_ctx : gate_lat;
#pragma unroll
        for (int bj = 0; bj < 2; ++bj)
#pragma unroll
            for (int n = 0; n < 2; ++n) {
                const f32x4 gv = *(const f32x4*)(gate + col0 + bj * HALF + n * 16);
#pragma unroll
                for (int ai = 0; ai < 2; ++ai)
#pragma unroll
                    for (int m = 0; m < 4; ++m) {
                        const size_t off = (size_t)(u.pm * BM + ai * HALF + wr * 64 + m * 16 + fr) * 2048 + col0 + bj * HALF + n * 16;
                        const f32x4 xr = *(const f32x4*)(xres + off);
                        *(f32x4*)(out + off) = xr * 1.4142135623730951f + gv * acc[ai][bj][m][n];
                    }
            }
    }
};
struct EpiSwiglu {
    static constexpr bool PERM = true, AFTER_DRAIN = false;
    bf16_t* O;
    __device__ __forceinline__ void operator()(const f32x4 (&acc)[2][2][4][2], const Unit& u, int wr, int wc, int fr, int fq) const {
        asm volatile("" : "+v"(fr), "+v"(fq));
        const int col0 = u.pn * HALF + wc * 32 + 8 * fq;
#pragma unroll
        for (int ai = 0; ai < 2; ++ai)
#pragma unroll
            for (int m = 0; m < 4; ++m) {
                const int row = u.pm * BM + ai * HALF + wr * 64 + m * 16 + fr;
                float a[8];
#pragma unroll
                for (int n = 0; n < 2; ++n)
#pragma unroll
                    for (int i = 0; i < 4; ++i) { const float g = acc[ai][0][m][n][i], up = acc[ai][1][m][n][i]; a[n * 4 + i] = g / (1.0f + __expf(-g)) * up; }
                u32x4 w; w.x = cvt_pk_bf16(a[0], a[1]); w.y = cvt_pk_bf16(a[2], a[3]); w.z = cvt_pk_bf16(a[4], a[5]); w.w = cvt_pk_bf16(a[6], a[7]);
                *(u32x4*)(O + (size_t)row * 5632 + col0) = w;
            }
    }
};

struct EpiPart {
    static constexpr bool PERM = false, AFTER_DRAIN = false;
    float* part;
    __device__ __forceinline__ void operator()(const f32x4 (&acc)[2][2][4][2], const Unit& u, int wr, int wc, int fr, int fq) const {
        asm volatile("" : "+v"(fr), "+v"(fq));
        const int col0 = u.pn * BM + wc * 32 + 4 * fq;
        float* base = part + (size_t)u.ks * 256 * 2048;
#pragma unroll
        for (int bj = 0; bj < 2; ++bj)
#pragma unroll
            for (int n = 0; n < 2; ++n)
#pragma unroll
                for (int ai = 0; ai < 2; ++ai)
#pragma unroll
                    for (int m = 0; m < 4; ++m) {
                        const size_t off = (size_t)(ai * HALF + wr * 64 + m * 16 + fr) * 2048 + col0 + bj * HALF + n * 16;
                        *(f32x4*)(base + off) = acc[ai][bj][m][n];
                    }
    }
};

template <class Epi, class Sched, bool ALIGN_EPI = false, bool SP2 = false>
__device__ __forceinline__ void gemm_phase(PG8_LAS unsigned char* lds, const Gemm g, const Sched& S, const Epi& E) {
    const int tid = ltid(), wid = __builtin_amdgcn_readfirstlane(tid >> 6), lane = tid & 63, wr = wid >> 2, wc = wid & 3, fr = lane & 15, fq = lane >> 4;
    const int K = g.K, LD = g.ld, nt = K / BK;
    unsigned voffA[2], voffB[2];
#pragma unroll
    for (int i = 0; i < 2; ++i) { int R, C; stage_rc(tid * 16 + i * 8192, R, C); const int Rb = Epi::PERM ? ((R & ~31) + perm32(R & 31)) : R;
        voffA[i] = (unsigned)(R * LD + C) * 2u; voffB[i] = (unsigned)(Rb * LD + C) * 2u; }
    const size_t kstep = (size_t)(BK * 2);
    const size_t hstep = (size_t)HALF * LD * 2;
    const size_t tstep = 2 * hstep;
    const unsigned ldsw = (unsigned)wid * 1024u;
    const int aoff = lds_byte(wr * 64 + fr, fq * 8), boff = lds_byte(wc * 32 + fr, fq * 8);
#define PG8_SA(b, h) (((b) * 2 + (h)) * HTB)
#define PG8_SB(b, h) ((4 + (b) * 2 + (h)) * HTB)
#define PG8_STAGE(bufoff, gbase, voff) do { _Pragma("unroll") for (int _i = 0; _i < 2; ++_i) \
        __builtin_amdgcn_global_load_lds((const unsigned*)((const char*)(gbase) + (voff)[_i]), (PG8_LAS unsigned*)(lds + (bufoff) + ldsw + _i * 8192), 16, 0, 0); } while (0)
#define PG8_LDA(dst, b, h) do { _Pragma("unroll") for (int m = 0; m < 4; ++m) _Pragma("unroll") for (int k = 0; k < 2; ++k) dst[m][k] = *(const PG8_LAS bf16x8*)(lds + PG8_SA(b, h) + aoff + m * 2048 + k * 1024); } while (0)
#define PG8_LDB(dst, b, h) do { _Pragma("unroll") for (int n = 0; n < 2; ++n) _Pragma("unroll") for (int k = 0; k < 2; ++k) dst[n][k] = *(const PG8_LAS bf16x8*)(lds + PG8_SB(b, h) + boff + n * 2048 + k * 1024); } while (0)
#define PG8_MMA(ai, bj, At, Bt) do { __builtin_amdgcn_s_setprio(1); _Pragma("unroll") for (int m = 0; m < 4; ++m) _Pragma("unroll") for (int n = 0; n < 2; ++n) _Pragma("unroll") for (int k = 0; k < 2; ++k) \
        acc[ai][bj][m][n] = __builtin_amdgcn_mfma_f32_16x16x32_bf16(Bt[n][k], At[m][k], acc[ai][bj][m][n], 0, 0, 0); __builtin_amdgcn_s_setprio(0); } while (0)
#define PG8_WAIT_V(n) asm volatile("s_waitcnt vmcnt(" #n ")" ::: "memory")
#define PG8_WAIT_L(n) asm volatile("s_waitcnt lgkmcnt(" #n ")" ::: "memory")
#define PG8_BAR __builtin_amdgcn_s_barrier()
#define PG8_SCHED __builtin_amdgcn_sched_barrier(0)
    Unit cur, nxt; int ui = 0;
    if (!S.next(0, cur)) return;
    f32x4 acc[2][2][4][2];
#pragma unroll
    for (int a = 0; a < 2; ++a)
#pragma unroll
        for (int b = 0; b < 2; ++b)
#pragma unroll
            for (int m = 0; m < 4; ++m)
#pragma unroll
                for (int n = 0; n < 2; ++n) acc[a][b][m][n] = (f32x4){0.f, 0.f, 0.f, 0.f};
    bf16x8 At[4][2], B0[2][2], B1[2][2];
    const char* cA = (const char*)g.A + (size_t)cur.pm * tstep + (size_t)cur.ko * 2; const char* cB = (const char*)g.Bt + (size_t)cur.pn * tstep + (size_t)cur.ko * 2;
    S.a_ready(cur);
    if constexpr (SP2) {
        PG8_STAGE(PG8_SB(0, 0), cB, voffB); PG8_STAGE(PG8_SB(0, 1), cB + hstep, voffB); PG8_STAGE(PG8_SA(0, 0), cA, voffA); PG8_STAGE(PG8_SA(0, 1), cA + hstep, voffA);
        if (wr == 1) PG8_BAR;
        PG8_WAIT_V(2); PG8_BAR;
        PG8_STAGE(PG8_SB(1, 0), cB + kstep, voffB); PG8_STAGE(PG8_SA(1, 0), cA + kstep, voffA); PG8_STAGE(PG8_SB(1, 1), cB + hstep + kstep, voffB);
        PG8_WAIT_V(6); PG8_BAR;
    } else {
        PG8_STAGE(PG8_SB(0, 0), cB, voffB); PG8_STAGE(PG8_SA(0, 0), cA, voffA); PG8_STAGE(PG8_SB(0, 1), cB + hstep, voffB); PG8_STAGE(PG8_SA(0, 1), cA + hstep, voffA);
        if (wr == 1) PG8_BAR;
        PG8_WAIT_V(4); PG8_BAR;
        PG8_STAGE(PG8_SB(1, 0), cB + kstep, voffB); PG8_STAGE(PG8_SA(1, 0), cA + kstep, voffA); PG8_STAGE(PG8_SB(1, 1), cB + hstep + kstep, voffB);
        PG8_WAIT_V(6); PG8_BAR;
    }
    for (;;) {
        const bool has_next = S.next(ui + 1, nxt);
        const char* nA = has_next ? (const char*)g.A + (size_t)nxt.pm * tstep + (size_t)nxt.ko * 2 : cA; const char* nB = has_next ? (const char*)g.Bt + (size_t)nxt.pn * tstep + (size_t)nxt.ko * 2 : cB;
        for (int t = 0; t < nt; t += 2) {
            const bool last = (t == nt - 2);
            const char* a1 = cA + (size_t)(t + 1) * kstep;
            const char* a2 = last ? nA : cA + (size_t)(t + 2) * kstep; const char* b2 = last ? nB : cB + (size_t)(t + 2) * kstep;
            const char* a3 = a2 + kstep; const char* b3 = b2 + kstep;
            if (last && has_next) S.a_ready(nxt);
            if constexpr (SP2) {
            PG8_LDB(B0, 0, 0); PG8_LDB(B1, 0, 1); PG8_SCHED; PG8_LDA(At, 0, 0); PG8_STAGE(PG8_SA(1, 1), a1 + hstep, voffA);
            PG8_WAIT_V(8); PG8_WAIT_L(0); PG8_BAR; PG8_MMA(0, 0, At, B0); PG8_MMA(0, 1, At, B1); PG8_BAR; PG8_SCHED;
            PG8_LDA(At, 0, 1); PG8_STAGE(PG8_SB(0, 0), b2, voffB); PG8_STAGE(PG8_SB(0, 1), b2 + hstep, voffB); PG8_STAGE(PG8_SA(0, 0), a2, voffA);
            PG8_WAIT_V(8); PG8_WAIT_L(0); PG8_BAR; PG8_MMA(1, 0, At, B0); PG8_MMA(1, 1, At, B1); PG8_BAR; PG8_SCHED;
            PG8_LDB(B0, 1, 0); PG8_LDB(B1, 1, 1); PG8_SCHED; PG8_LDA(At, 1, 0); PG8_STAGE(PG8_SA(0, 1), a2 + hstep, voffA);
            PG8_WAIT_V(8); PG8_WAIT_L(0); PG8_BAR; PG8_MMA(0, 0, At, B0); PG8_MMA(0, 1, At, B1); PG8_BAR; PG8_SCHED;
            PG8_LDA(At, 1, 1); PG8_STAGE(PG8_SB(1, 0), b3, voffB); PG8_STAGE(PG8_SB(1, 1), b3 + hstep, voffB); PG8_STAGE(PG8_SA(1, 0), a3, voffA);
            PG8_WAIT_V(8); PG8_WAIT_L(0); PG8_BAR; PG8_MMA(1, 0, At, B0); PG8_MMA(1, 1, At, B1); PG8_BAR; PG8_SCHED;
            } else {
            PG8_LDB(B0, 0, 0); PG8_SCHED; PG8_LDA(At, 0, 0); PG8_STAGE(PG8_SA(1, 1), a1 + hstep, voffA);
            PG8_WAIT_L(8); PG8_BAR; PG8_WAIT_L(0); PG8_MMA(0, 0, At, B0); PG8_BAR; PG8_SCHED;
            PG8_LDB(B1, 0, 1); PG8_STAGE(PG8_SB(0, 0), b2, voffB);
            PG8_BAR; PG8_WAIT_L(0); PG8_MMA(0, 1, At, B1); PG8_BAR;
            PG8_LDA(At, 0, 1); PG8_STAGE(PG8_SA(0, 0), a2, voffA);
            PG8_BAR; PG8_WAIT_L(0); PG8_MMA(1, 0, At, B0); PG8_BAR; PG8_SCHED;
            PG8_STAGE(PG8_SB(0, 1), b2 + hstep, voffB);
            PG8_WAIT_V(6); PG8_BAR; PG8_MMA(1, 1, At, B1); PG8_BAR;
            PG8_LDB(B0, 1, 0); PG8_SCHED; PG8_LDA(At, 1, 0); PG8_STAGE(PG8_SA(0, 1), a2 + hstep, voffA);
            PG8_WAIT_L(8); PG8_BAR; PG8_WAIT_L(0); PG8_MMA(0, 0, At, B0); PG8_BAR; PG8_SCHED;
            PG8_LDB(B1, 1, 1); PG8_STAGE(PG8_SB(1, 0), b3, voffB);
            PG8_BAR; PG8_WAIT_L(0); PG8_MMA(0, 1, At, B1); PG8_BAR;
            PG8_LDA(At, 1, 1); PG8_STAGE(PG8_SA(1, 0), a3, voffA);
            PG8_BAR; PG8_WAIT_L(0); PG8_MMA(1, 0, At, B0); PG8_BAR; PG8_SCHED;
            PG8_STAGE(PG8_SB(1, 1), b3 + hstep, voffB);
            PG8_WAIT_V(6); PG8_BAR; PG8_MMA(1, 1, At, B1); PG8_BAR;
            }
        }
        if constexpr (ALIGN_EPI) { if (wr == 0) PG8_BAR; }
        if constexpr (!Epi::AFTER_DRAIN) { E(acc, cur, wr, wc, fr, fq); S.done(cur); }
        if (!has_next) break;
#pragma unroll
        for (int a = 0; a < 2; ++a)
#pragma unroll
            for (int b = 0; b < 2; ++b)
#pragma unroll
                for (int m = 0; m < 4; ++m)
#pragma unroll
                    for (int n = 0; n < 2; ++n) acc[a][b][m][n] = (f32x4){0.f, 0.f, 0.f, 0.f};
        cur = nxt; cA = nA; cB = nB; ++ui;
        if constexpr (ALIGN_EPI) { if (wr == 1) PG8_BAR; }
    }
    PG8_WAIT_V(0);
    if constexpr (!ALIGN_EPI) { if (wr == 0) PG8_BAR; }
    PG8_BAR;
    if constexpr (Epi::AFTER_DRAIN) { E.fused(acc, cur, wr, wc, fr, fq, lds, wid, lane); S.done(cur); }
#undef PG8_SA
#undef PG8_SB
#undef PG8_STAGE
#undef PG8_LDA
#undef PG8_LDB
#undef PG8_MMA
#undef PG8_WAIT_V
#undef PG8_WAIT_L
#undef PG8_BAR
#undef PG8_SCHED
}
}
namespace att {
typedef unsigned short bf16_t;
using bf16x8 = __attribute__((ext_vector_type(8))) short;
using s16x4  = __attribute__((ext_vector_type(4))) short;
using f32x16 = __attribute__((ext_vector_type(16))) float;
using u32x4  = __attribute__((ext_vector_type(4))) unsigned;
constexpr int NW = 8, QBLK = 32, KVBLK = 64, DV = 128;
constexpr float THR = 8.f;
#define SBAR() __builtin_amdgcn_sched_barrier(0)
__device__ __forceinline__ int crow(int r, int hi) { return (r & 3) + 8 * (r >> 2) + 4 * hi; }
__device__ __forceinline__ unsigned cvtpk(float lo, float hi) { unsigned r; asm volatile("v_cvt_pk_bf16_f32 %0, %1, %2" : "=v"(r) : "v"(lo), "v"(hi)); return r; }
template <int DQK> struct Cfg {
    static constexpr float SCALE = (DQK == 64) ? 0.125f : 0.07216878364870322f;
    static constexpr int KROWB = DQK * 2, SHM_K = KVBLK * DQK * 2, SHM_V = KVBLK * DV * 2, NP = DQK / 64, ND0 = DQK / 16;
    static constexpr int NQR = (DQK == 192) ? 12 : ND0;
    static constexpr int SHM_Q = (ND0 - NQR) * 16 * 2 * 256;
    static constexpr int SHM = 2 * SHM_V + 2 * SHM_K + NW * 64 * 4 + SHM_Q;
};
constexpr float THRL = THR * 1.4426950408889634f;
template <bool FIRST> __device__ __forceinline__ void partialSM(f32x16& p0, f32x16& p1, float& mhat, f32x16& negm, float& alpha) {
  float pmax = p0[0];
#pragma unroll
  for (int r = 1; r < 16; ++r) pmax = fmaxf(pmax, p0[r]);
#pragma unroll
  for (int r = 0; r < 16; ++r) pmax = fmaxf(pmax, p1[r]);
  { auto rr = __builtin_amdgcn_permlane32_swap(__float_as_uint(pmax), __float_as_uint(pmax), false, false);
    pmax = fmaxf(__uint_as_float(rr[0]), __uint_as_float(rr[1])); }
  if (!FIRST && __builtin_expect(__all(pmax <= THRL), 1)) { alpha = 1.f; }
  else { const float dl = FIRST ? pmax : fmaxf(pmax, 0.f); mhat += dl;
#pragma unroll
    for (int r = 0; r < 16; ++r) { p0[r] -= dl; p1[r] -= dl; }
#pragma unroll
    for (int r = 0; r < 16; ++r) negm[r] = -mhat;
    alpha = FIRST ? 1.f : __builtin_amdgcn_exp2f(-dl); }
#pragma unroll
  for (int r = 0; r < 16; ++r) p0[r] = __builtin_amdgcn_exp2f(p0[r]);
}
__device__ __forceinline__ void finishSM(f32x16& p0, f32x16& p1, float alpha, float& l_reg, bf16x8& pa0, bf16x8& pa1, bf16x8& pa2, bf16x8& pa3) {
#pragma unroll
  for (int r = 0; r < 16; ++r) p1[r] = __builtin_amdgcn_exp2f(p1[r]);
  float ps = 0;
#pragma unroll
  for (int r = 0; r < 16; ++r) ps += p0[r];
#pragma unroll
  for (int r = 0; r < 16; ++r) ps += p1[r];
  { auto rr = __builtin_amdgcn_permlane32_swap(__float_as_uint(ps), __float_as_uint(ps), false, false);
    ps = __uint_as_float(rr[0]) + __uint_as_float(rr[1]); }
  l_reg = l_reg * alpha + ps;
#define PK4(P, BASE, OUT) do { unsigned a0 = cvtpk(P[BASE + 0], P[BASE + 1]), a1 = cvtpk(P[BASE + 2], P[BASE + 3]);   \
    unsigned b0 = cvtpk(P[BASE + 4], P[BASE + 5]), b1 = cvtpk(P[BASE + 6], P[BASE + 7]);                              \
    auto r0 = __builtin_amdgcn_permlane32_swap(a0, b0, false, false); auto r1 = __builtin_amdgcn_permlane32_swap(a1, b1, false, false); \
    u32x4 w = {r0[0], r1[0], r0[1], r1[1]}; OUT = *reinterpret_cast<bf16x8*>(&w); } while (0)
  PK4(p0, 0, pa0); PK4(p0, 8, pa1); PK4(p1, 0, pa2); PK4(p1, 8, pa3);
#undef PK4
}
template <int DQK> __device__ __forceinline__ int kswz(int row, int colB) { return row * (DQK * 2) + (colB ^ ((row & 7) << 4)); }
template <int DQK> __device__ __forceinline__ void qkt(f32x16& p0, f32x16& p1, const char* Ks, const bf16x8* qr, const char* Qs, const int* kb, const int* qb, int r32, int hi, const f32x16& negm) {
  constexpr int NQR = Cfg<DQK>::NQR; constexpr int KROWB = DQK * 2;
#pragma unroll
  for (int g = 0; g < DQK / 64; ++g)
#pragma unroll
    for (int dd = 0; dd < 4; ++dd) { const int d0 = g * 4 + dd;
      bf16x8 b0 = *reinterpret_cast<const bf16x8*>(Ks + kb[dd] + g * 128);
      bf16x8 b1 = *reinterpret_cast<const bf16x8*>(Ks + kb[dd] + g * 128 + 32 * KROWB);
      bf16x8 q;
      if (d0 < NQR) q = qr[d0 < NQR ? d0 : 0]; else q = *reinterpret_cast<const bf16x8*>(Qs + qb[dd] + (g - NQR / 4) * 32768);
      if (d0 == 0) { p0 = __builtin_amdgcn_mfma_f32_32x32x16_bf16(b0, q, negm, 0, 0, 0); p1 = __builtin_amdgcn_mfma_f32_32x32x16_bf16(b1, q, negm, 0, 0, 0); }
      else { p0 = __builtin_amdgcn_mfma_f32_32x32x16_bf16(b0, q, p0, 0, 0, 0); p1 = __builtin_amdgcn_mfma_f32_32x32x16_bf16(b1, q, p1, 0, 0, 0); } }
}
__device__ __forceinline__ int v_st(int k, int c) { const int kk = (k & ~0xC) | ((k & 4) << 1) | ((k & 8) >> 1); return ((kk >> 3) * 4 + (c >> 5)) * 512 + ((kk & 7) * 32 + (c & 31)) * 2; }
__device__ __forceinline__ int v_rd_base(int lane) { return ((lane & 3) << 3) | (((lane >> 2) & 3) << 6) | (((lane >> 4) & 1) << 5) | (((lane >> 5) & 1) << 8); }
constexpr int v_rd_off(int d0, int ks, int half) { return d0 * 512 + ks * 4096 + half * 2048; }
template <int OFF> __device__ __forceinline__ s16x4 tr_read(int vb) {
  s16x4 r; asm volatile("ds_read_b64_tr_b16 %0, %1 offset:%2" : "=&v"(r) : "v"(vb), "i"(OFF) : "memory"); return r;
}
template <int D0> __device__ __forceinline__ void pv_one(f32x16& od, int vb, bf16x8 pa0, bf16x8 pa1, bf16x8 pa2, bf16x8 pa3) {
  const s16x4 l0 = tr_read<v_rd_off(D0, 0, 0)>(vb), h0 = tr_read<v_rd_off(D0, 0, 1)>(vb), l1 = tr_read<v_rd_off(D0, 1, 0)>(vb), h1 = tr_read<v_rd_off(D0, 1, 1)>(vb);
  const s16x4 l2 = tr_read<v_rd_off(D0, 2, 0)>(vb), h2 = tr_read<v_rd_off(D0, 2, 1)>(vb), l3 = tr_read<v_rd_off(D0, 3, 0)>(vb), h3 = tr_read<v_rd_off(D0, 3, 1)>(vb);
  asm volatile("s_waitcnt lgkmcnt(0)" ::: "memory"); SBAR();
#define PK(L, H) (bf16x8){L[0], L[1], L[2], L[3], H[0], H[1], H[2], H[3]}
  od = __builtin_amdgcn_mfma_f32_32x32x16_bf16(pa0, PK(l0, h0), od, 0, 0, 0);
  od = __builtin_amdgcn_mfma_f32_32x32x16_bf16(pa1, PK(l1, h1), od, 0, 0, 0);
  od = __builtin_amdgcn_mfma_f32_32x32x16_bf16(pa2, PK(l2, h2), od, 0, 0, 0);
  od = __builtin_amdgcn_mfma_f32_32x32x16_bf16(pa3, PK(l3, h3), od, 0, 0, 0);
#undef PK
}
__device__ __forceinline__ void pv_d0(f32x16* o, int vb, bf16x8 pa0, bf16x8 pa1, bf16x8 pa2, bf16x8 pa3) {
  pv_one<0>(o[0], vb, pa0, pa1, pa2, pa3); pv_one<1>(o[1], vb, pa0, pa1, pa2, pa3); pv_one<2>(o[2], vb, pa0, pa1, pa2, pa3); pv_one<3>(o[3], vb, pa0, pa1, pa2, pa3);
}
template <int DQK, bool OUT_BF16, int ldq, int ldk, int ldv, int ldo>
__device__ __forceinline__ void attn_dense_body(const bf16_t* __restrict__ Qb, const bf16_t* __restrict__ Kh, const bf16_t* __restrict__ Vh,
                                                float* __restrict__ Of, bf16_t* __restrict__ Ob, int seq, char* lds) {
  using C_ = Cfg<DQK>;
  constexpr int SHM_V = C_::SHM_V, SHM_K = C_::SHM_K, NP = C_::NP, ND0 = C_::ND0, NQR = C_::NQR;
  const int tid = ltid(), wid = tid >> 6, lane = tid & 63, r32 = lane & 31, hi = lane >> 5;
  char* V_lds = lds; char* K_lds = lds + 2 * SHM_V;
  float* ws = (float*)(lds + 2 * SHM_V + 2 * SHM_K) + wid * 64; float* li_l = ws; float* al_l = ws + 32;
  char* Q_lds = lds + 2 * SHM_V + 2 * SHM_K + NW * 64 * 4; const int qrow = wid * QBLK + r32;
  int kb[4], qb[4];
#pragma unroll
  for (int dd = 0; dd < 4; ++dd) { const int t = (dd * 32 + hi * 16) ^ ((r32 & 7) << 4); kb[dd] = r32 * (DQK * 2) + t; qb[dd] = qrow * 128 + t; }
  float m_reg = 0.f, l_reg = 0; f32x16 o[4] = {}; bf16x8 qr[NQR]; f32x16 negm = {}; asm volatile("" : "+v"(negm));
  const bf16_t* Qw = Qb + (size_t)(wid * QBLK + r32) * ldq + hi * 8;
#pragma unroll
  for (int d0 = 0; d0 < NQR; ++d0) qr[d0] = *reinterpret_cast<const bf16x8*>(Qw + d0 * 16);
#pragma unroll
  for (int d0 = NQR; d0 < ND0; ++d0) *reinterpret_cast<bf16x8*>(Q_lds + qb[(d0 - NQR) & 3] + ((d0 - NQR) >> 2) * 32768) = *reinterpret_cast<const bf16x8*>(Qw + d0 * 16);
  const int sr = tid >> 4, sc = (tid & 15) * 8, vst0 = v_st(sr, sc), vst1 = v_st(32 + sr, sc);
  const int kr_ = tid >> 3, kc_ = (tid & 7) * 8;
  const int vb0 = (int)(uintptr_t)V_lds + v_rd_base(lane);
  bf16x8 vs0, vs1, ks[NP];
#define SLOAD(k0) do { vs0 = *reinterpret_cast<const bf16x8*>(&Vh[(size_t)((k0) + sr) * ldv + sc]); vs1 = *reinterpret_cast<const bf16x8*>(&Vh[(size_t)((k0) + 32 + sr) * ldv + sc]); \
    _Pragma("unroll") for (int i_ = 0; i_ < NP; ++i_) ks[i_] = *reinterpret_cast<const bf16x8*>(&Kh[(size_t)((k0) + kr_) * ldk + kc_ + 64 * i_]); } while (0)
#define SWRITE(b) do { *(bf16x8*)(V_lds + (b) * SHM_V + vst0) = vs0; *(bf16x8*)(V_lds + (b) * SHM_V + vst1) = vs1; \
    _Pragma("unroll") for (int i_ = 0; i_ < NP; ++i_) *(bf16x8*)(K_lds + (b) * SHM_K + kswz<DQK>(kr_, (kc_ + 64 * i_) * 2)) = ks[i_]; } while (0)
#define RESC(a) do { if (__any((a) < 1.f)) { if (hi == 0) al_l[r32] = (a); asm volatile("s_waitcnt lgkmcnt(0)" ::: "memory"); \
    _Pragma("unroll") for (int d = 0; d < 4; ++d) _Pragma("unroll") for (int r = 0; r < 16; ++r) o[d][r] *= al_l[crow(r, hi)]; } } while (0)
  const int NT = seq / KVBLK; bf16x8 pa0, pa1, pa2, pa3;
  if constexpr (DQK == 192) {
    f32x16 pA0, pA1; float mnA, alA;
    SLOAD(0); SWRITE(0); __syncthreads();
    for (int j = 0; j < NT; ++j) {
      const int buf = j & 1;
      if (j + 1 < NT) SLOAD((j + 1) * KVBLK);
      SBAR(); qkt<DQK>(pA0, pA1, K_lds + buf * SHM_K, qr, Q_lds, kb, qb, r32, hi, negm);
      if (j == 0) partialSM<true>(pA0, pA1, m_reg, negm, alA); else partialSM<false>(pA0, pA1, m_reg, negm, alA);
      RESC(alA);
      finishSM(pA0, pA1, alA, l_reg, pa0, pa1, pa2, pa3); SBAR();
      pv_d0(o, vb0 + buf * (int)SHM_V, pa0, pa1, pa2, pa3);
      if (j + 1 < NT) SWRITE(buf ^ 1);
      __syncthreads();
    }
  } else {
  f32x16 pA0, pA1, pB0, pB1; float mnA, mnB, alA, alB;
  SLOAD(0); SWRITE(0); __syncthreads();
  qkt<DQK>(pA0, pA1, K_lds, qr, Q_lds, kb, qb, r32, hi, negm); partialSM<true>(pA0, pA1, m_reg, negm, alA);
  SLOAD(KVBLK);
  SWRITE(1); __syncthreads();
  for (int j = 1; j + 1 < NT; j += 2) {
    SBAR(); qkt<DQK>(pB0, pB1, K_lds + SHM_K, qr, Q_lds, kb, qb, r32, hi, negm);
    finishSM(pA0, pA1, alA, l_reg, pa0, pa1, pa2, pa3); SBAR();
    SLOAD((j + 1) * KVBLK); SBAR();
    pv_d0(o, vb0, pa0, pa1, pa2, pa3); partialSM<false>(pB0, pB1, m_reg, negm, alB);
    __syncthreads(); SWRITE(0);
    RESC(alB); __syncthreads();
    SBAR(); qkt<DQK>(pA0, pA1, K_lds, qr, Q_lds, kb, qb, r32, hi, negm);
    finishSM(pB0, pB1, alB, l_reg, pa0, pa1, pa2, pa3); SBAR();
    SLOAD((j + 2) * KVBLK); SBAR();
    pv_d0(o, vb0 + (int)SHM_V, pa0, pa1, pa2, pa3); partialSM<false>(pA0, pA1, m_reg, negm, alA);
    __syncthreads(); SWRITE(1);
    RESC(alA); __syncthreads();
  }
  SBAR(); qkt<DQK>(pB0, pB1, K_lds + SHM_K, qr, Q_lds, kb, qb, r32, hi, negm);
  finishSM(pA0, pA1, alA, l_reg, pa0, pa1, pa2, pa3); SBAR();
  pv_d0(o, vb0, pa0, pa1, pa2, pa3); partialSM<false>(pB0, pB1, m_reg, negm, alB);
  __syncthreads(); RESC(alB);
  finishSM(pB0, pB1, alB, l_reg, pa0, pa1, pa2, pa3); SBAR();
  pv_d0(o, vb0 + (int)SHM_V, pa0, pa1, pa2, pa3);
  }
  if (hi == 0) li_l[r32] = l_reg; asm volatile("s_waitcnt lgkmcnt(0)" ::: "memory");
  float rli[16];
#pragma unroll
  for (int r = 0; r < 16; ++r) rli[r] = __builtin_amdgcn_rcpf(li_l[crow(r, hi)]);
#pragma unroll
  for (int r = 0; r < 16; ++r) { const int orow = wid * QBLK + crow(r, hi);
#pragma unroll
    for (int d0 = 0; d0 < 4; ++d0) { const float v = o[d0][r] * rli[r];
      if (OUT_BF16) { const unsigned u = __float_as_uint(v); Ob[(size_t)orow * ldo + d0 * 32 + r32] = (bf16_t)((u + 0x7fffu + ((u >> 16) & 1u)) >> 16); }
      else Of[(size_t)orow * ldo + d0 * 32 + r32] = v; } }
  __syncthreads();
#undef SLOAD
#undef SWRITE
#undef RESC
}
#undef SBAR
}

#define LAS __attribute__((address_space(3)))
#ifndef PH_MASK
#define PH_MASK 0xffffffffu
#endif
#define PHON(id) ((PH_MASK >> (id)) & 1u)
#ifndef PROBE_MASK
#define PROBE_MASK 0u
#endif
#define PRB(id) ((PROBE_MASK >> (id)) & 1u)
typedef unsigned short bf16_t;
typedef unsigned v4u __attribute__((ext_vector_type(4)));
typedef unsigned v2u __attribute__((ext_vector_type(2)));
typedef float f32x4 __attribute__((ext_vector_type(4)));
typedef float f32x2 __attribute__((ext_vector_type(2)));
typedef short bf16x8 __attribute__((ext_vector_type(8)));
constexpr int NWAVES = 8, NTHR = 512;
constexpr int LDS_BYTES = 155648;
constexpr size_t MiB = 1u << 20;
constexpr size_t WS_CTL = 0, CTL_BYTES = 32768, WS_ROPE = 64 * 1024, WS_MOD = 128 * 1024, WS_MODP = 1 * MiB;
constexpr size_t WS_W0 = 4 * MiB, W_LAYER = 97 * MiB, WO_IN = 0, WO_Q = 21 * MiB, WO_KV = 22 * MiB, WO_OUT = 23 * MiB, WO_F1 = 31 * MiB, WO_F2 = 75 * MiB;
constexpr size_t WS_H = 198 * MiB, WS_P = 231 * MiB, WS_XBC = 318 * MiB, WS_ACT = 231 * MiB, WS_DT = 335 * MiB, WS_CQN = 336 * MiB, WS_CKVN = 343 * MiB;
constexpr size_t WS_QMLA = 348 * MiB, WS_KMLA = 361 * MiB, WS_VMLA = 374 * MiB, WS_ODIFF = 383 * MiB, WS_S = 416 * MiB, WS_R = 449 * MiB, WS_ATOT = 466 * MiB;
constexpr size_t WS_CAT = 467 * MiB, WS_PRE = 500 * MiB, WS_XA = 566 * MiB, WS_X1 = 632 * MiB, WS_PART = 698 * MiB, WS_END = 720 * MiB;

__device__ __forceinline__ float bf2f(bf16_t v) { return __uint_as_float((unsigned)v << 16); }
__device__ __forceinline__ unsigned f2bf(float f) { unsigned u = __float_as_uint(f); return (u + 0x7fffu + ((u >> 16) & 1u)) >> 16; }
__device__ __forceinline__ unsigned pk2(float lo, float hi) { return f2bf(lo) | (f2bf(hi) << 16); }
__device__ __forceinline__ void unpack8(v4u w, float* f) {
#pragma unroll
    for (int i = 0; i < 4; ++i) { f[2 * i] = __uint_as_float(w[i] << 16); f[2 * i + 1] = __uint_as_float(w[i] & 0xffff0000u); }
}
__device__ __forceinline__ v4u pack8(const float* f) { v4u w; w.x = pk2(f[0], f[1]); w.y = pk2(f[2], f[3]); w.z = pk2(f[4], f[5]); w.w = pk2(f[6], f[7]); return w; }
__device__ __forceinline__ v4u ld8(const bf16_t* p) { return *(const v4u*)p; }
__device__ __forceinline__ float wave_sum(float v) {
#pragma unroll
    for (int o = 1; o < 64; o <<= 1) v += __shfl_xor(v, o);
    return v;
}
__device__ __forceinline__ float siluf(float v) { return v / (1.0f + __expf(-v)); }

struct Args { const float* in[27]; float* out; unsigned char* ws; int ph_lo, ph_hi; };

struct Frame {
    LAS unsigned char* lds; char* ldsg;
    int tid, lane, wave, G, gw, NGW, bid;
    const __attribute__((address_space(4))) char* ka; float* out; unsigned char* ws;
};
#define INP(i) (*(const float* const __attribute__((address_space(4)))*)(F.ka + 8 * (i)))
#define WSP(T, off) ((T*)(F.ws + (off)))

__device__ __forceinline__ int srccol(int mode, int n) {
    if (mode == 0) return n;
    if (mode == 1) { if (n < 4608) return n; if (n < 5312) return n + 16; if (n < 5328) return n - 5312 + 4608; return -1; }
    const int t = n >> 8, r = n & 255; return r < 128 ? t * 128 + r : 5632 + t * 128 + (r - 128);
}
__device__ __forceinline__ void transpose_item(const float* W, int K, int Nsrc, bf16_t* WT, int nblk, int mode, LAS float* scr, int item, int lane) {
    const int kb = item / nblk, nb = item % nblk, k0 = 64 * kb, n0 = 64 * nb;
    const int kk = lane >> 4, c4 = (lane & 15) * 4;
    const int sc = srccol(mode, n0 + c4);
    f32x4 v[16];
#pragma unroll
    for (int i = 0; i < 16; ++i) v[i] = (sc >= 0) ? *(const f32x4*)(W + (size_t)(k0 + 4 * i + kk) * Nsrc + sc) : (f32x4){0.f, 0.f, 0.f, 0.f};
#pragma unroll
    for (int i = 0; i < 16; ++i) { LAS float* s = scr + (4 * i + kk) * 65 + c4; s[0] = v[i][0]; s[1] = v[i][1]; s[2] = v[i][2]; s[3] = v[i][3]; }
    asm volatile("s_waitcnt lgkmcnt(0)" ::: "memory");
    const int c = lane & 7;
#pragma unroll
    for (int j = 0; j < 8; ++j) { const int n = (lane >> 3) + 8 * j; const LAS float* s = scr + (8 * c) * 65 + n;
        v4u o; o.x = pk2(s[0 * 65], s[1 * 65]); o.y = pk2(s[2 * 65], s[3 * 65]); o.z = pk2(s[4 * 65], s[5 * 65]); o.w = pk2(s[6 * 65], s[7 * 65]);
        *(v4u*)(WT + (size_t)(n0 + n) * K + k0 + 8 * c) = o; }
    asm volatile("s_waitcnt lgkmcnt(0)" ::: "memory");
}
__device__ __forceinline__ void transpose_matrix(Frame& F, const float* W, int K, int Nsrc, bf16_t* WT, int Ndst, int mode) {
    LAS float* scr = (LAS float*)(F.lds + F.wave * 16896);
    const int nblk = Ndst / 64, nitems = (K / 64) * nblk;
    for (int it = F.gw; it < nitems; it += F.NGW) transpose_item(W, K, Nsrc, WT, nblk, mode, scr, it, F.lane);
}
__device__ __forceinline__ void phase_prologue(Frame& F) {
    {
        const float* c = INP(1); const float* cc = INP(3); const float* wada = INP(4);
        float* modp = WSP(float, WS_MODP);
        const int NT = F.G * NTHR;
        for (int item = F.bid * NTHR + F.tid; item < 2 * 16 * 3072; item += NT) {
            const int n4 = item % 3072, kc = (item / 3072) % 16, l = item / (3072 * 16);
            f32x4 a0 = {0.f, 0.f, 0.f, 0.f}, a1 = {0.f, 0.f, 0.f, 0.f};
            const float* wp = wada + ((size_t)l * 2048 + kc * 128) * 12288 + n4 * 4;
#pragma unroll 8
            for (int k = 0; k < 128; ++k) { const f32x4 w = *(const f32x4*)(wp + (size_t)k * 12288); const float s0 = siluf(c[kc * 128 + k]), s1 = siluf(cc[kc * 128 + k]); a0 += w * s0; a1 += w * s1; }
            *(f32x4*)(modp + ((size_t)((kc * 2 + l) * 2 + 0)) * 12288 + n4 * 4) = a0;
            *(f32x4*)(modp + ((size_t)((kc * 2 + l) * 2 + 1)) * 12288 + n4 * 4) = a1;
        }
    }
    {
        unsigned char* wb = F.ws + WS_W0;
        transpose_matrix(F, INP(6), 2048, 5328, (bf16_t*)(wb + WO_IN), INW, 1);
        transpose_matrix(F, INP(18), 384, 768, (bf16_t*)(wb + WO_Q), 768, 0);
        transpose_matrix(F, INP(19), 256, 1024, (bf16_t*)(wb + WO_KV), 1024, 0);
    }
}
constexpr int DT_N0 = 1024, DT_N1 = DT_N0 + 5632, DT_N2 = DT_N1 + 2816, DT_N3 = DT_N2 + 2688, DT_N4 = DT_N3 + 72, DT_N5 = DT_N4 + 64, DT_N6 = DT_N5 + 1024, DT_N7 = DT_N6 + 5632, DT_N8 = DT_N7 + 2816;
constexpr int DT_UNITS = (DT_N8 + 63) / 64;
__device__ __forceinline__ void deferred_transpose_unit(Frame& F, int tu) {
    LAS float* scr = (LAS float*)(F.lds + F.wave * 16896);
    unsigned char* w0 = F.ws + WS_W0; unsigned char* w1 = w0 + W_LAYER;
    for (int q = 0; q < 8; ++q) {
        int it = tu * 64 + q * 8 + F.wave;
        if (it >= DT_N8) break;
        const float* W; int K, Nsrc, Nd, mode; bf16_t* WT;
        if (it < DT_N0)      { W = INP(20); K = 2048; Nsrc = 2048; Nd = 2048; mode = 0; WT = (bf16_t*)(w0 + WO_OUT); }
        else if (it < DT_N1) { it -= DT_N0; W = INP(23); K = 2048; Nsrc = 11264; Nd = 11264; mode = 2; WT = (bf16_t*)(w0 + WO_F1); }
        else if (it < DT_N2) { it -= DT_N1; W = INP(24); K = 5632; Nsrc = 2048; Nd = 2048; mode = 0; WT = (bf16_t*)(w0 + WO_F2); }
        else if (it < DT_N3) { it -= DT_N2; W = INP(6) + (size_t)2048 * 5328; K = 2048; Nsrc = 5328; Nd = INW; mode = 1; WT = (bf16_t*)(w1 + WO_IN); }
        else if (it < DT_N4) { it -= DT_N3; W = INP(18) + (size_t)384 * 768; K = 384; Nsrc = 768; Nd = 768; mode = 0; WT = (bf16_t*)(w1 + WO_Q); }
        else if (it < DT_N5) { it -= DT_N4; W = INP(19) + (size_t)256 * 1024; K = 256; Nsrc = 1024; Nd = 1024; mode = 0; WT = (bf16_t*)(w1 + WO_KV); }
        else if (it < DT_N6) { it -= DT_N5; W = INP(20) + (size_t)2048 * 2048; K = 2048; Nsrc = 2048; Nd = 2048; mode = 0; WT = (bf16_t*)(w1 + WO_OUT); }
        else if (it < DT_N7) { it -= DT_N6; W = INP(23) + (size_t)2048 * 11264; K = 2048; Nsrc = 11264; Nd = 11264; mode = 2; WT = (bf16_t*)(w1 + WO_F1); }
        else                 { it -= DT_N7; W = INP(24) + (size_t)5632 * 2048; K = 5632; Nsrc = 2048; Nd = 2048; mode = 0; WT = (bf16_t*)(w1 + WO_F2); }
        transpose_item(W, K, Nsrc, WT, Nd / 64, mode, scr, it, F.lane);
    }
}
__device__ __forceinline__ void phase_modfinal(Frame& F) {
    const float* modp = WSP(float, WS_MODP); float* mod = WSP(float, WS_MOD); const float* bada = INP(5);
    const int NT = F.G * NTHR;
    for (int i = F.bid * NTHR + F.tid; i < 2 * 2 * 12288; i += NT) {
        const int l = i / 24576, v = (i / 12288) & 1, n = i % 12288;
        float s = bada[l * 12288 + n];
        for (int kc = 0; kc < 16; ++kc) s += modp[((size_t)((kc * 2 + l) * 2 + v)) * 12288 + n];
        mod[i] = s;
    }
    f32x2* rope = WSP(f32x2, WS_ROPE);
    for (int i = F.bid * NTHR + F.tid; i < 128 * 16; i += NT) { f32x2 cs; cs.x = ROPE_TAB[i].x; cs.y = ROPE_TAB[i].y; rope[i] = cs; }
}
__device__ __forceinline__ const float* modvec(Frame& F, int l, int v, int chunk) { return WSP(float, WS_MOD) + ((size_t)(l * 2 + v) * 6 + chunk) * 2048; }
__device__ __forceinline__ void phase_copy_mod(Frame& F) {
    bf16_t* H = WSP(bf16_t, WS_H);
    for (int r = F.gw; r < MROWS; r += F.NGW) {
        const int v = r >= SEQ; const float* src = v ? INP(2) + (size_t)(r - SEQ) * DM : INP(0) + (size_t)r * DM;
        const float* sh = modvec(F, 0, v, 0); const float* sc = modvec(F, 0, v, 1);
#pragma unroll
        for (int j = 0; j < 8; ++j) { const int c = 4 * F.lane + 256 * j; const f32x4 x = *(const f32x4*)(src + c);
            const f32x4 s = *(const f32x4*)(sc + c), b = *(const f32x4*)(sh + c); const f32x4 h = x * (1.0f + s) + b;
            v2u w; w.x = pk2(h[0], h[1]); w.y = pk2(h[2], h[3]); *(v2u*)(H + (size_t)r * DM + c) = w; }
    }
}
__device__ __forceinline__ float half_sum(float v) {
#pragma unroll
    for (int o = 1; o < 32; o <<= 1) v += __shfl_xor(v, o);
    return v;
}
template <int NPARTS>
__device__ __forceinline__ void ln_row(Frame& F, int r, int l32, const float* PRE, const float* g, const float* b, float* xo, const float* sh, const float* sc, bool writeH, const float* xres, const float* gate_ctx) {
    bf16_t* H = WSP(bf16_t, WS_H);
    f32x4 x[16]; float s = 0.f;
    if (NPARTS > 0) {
        float* PREw = const_cast<float*>(PRE);
#pragma unroll 1
        for (int j = 0; j < 16; ++j) { const int c = 4 * l32 + 128 * j; const float* pp = WSP(const float, WS_PART) + (size_t)(r - SEQ) * DM + c; f32x4 a = *(const f32x4*)pp;
#pragma unroll
            for (int t = 1; t < NPARTS; ++t) a += *(const f32x4*)(pp + (size_t)t * 256 * 2048);
            *(f32x4*)(PREw + (size_t)r * DM + c) = *(const f32x4*)(xres + (size_t)r * DM + c) * 1.4142135623730951f + *(const f32x4*)(gate_ctx + c) * a; }
        asm volatile("s_waitcnt vmcnt(0)" ::: "memory");
    }
#pragma unroll
    for (int j = 0; j < 16; ++j) { x[j] = *(const f32x4*)(PRE + (size_t)r * DM + 4 * l32 + 128 * j); s += (x[j][0] + x[j][1]) + (x[j][2] + x[j][3]); }
    const float mean = half_sum(s) * (1.0f / DM); float q = 0.f;
#pragma unroll
    for (int j = 0; j < 16; ++j) { x[j] = x[j] - mean; q += (x[j][0] * x[j][0] + x[j][1] * x[j][1]) + (x[j][2] * x[j][2] + x[j][3] * x[j][3]); }
    const float rstd = rsqrtf(half_sum(q) * (1.0f / DM) + 1e-5f);
#pragma unroll
    for (int j = 0; j < 16; ++j) { const int c = 4 * l32 + 128 * j; const f32x4 gg = *(const f32x4*)(g + c), bb = *(const f32x4*)(b + c);
        const f32x4 y = x[j] * rstd * gg + bb; *(f32x4*)(xo + (size_t)r * DM + c) = y;
        if (writeH) { const f32x4 s2 = *(const f32x4*)(sc + c), b2 = *(const f32x4*)(sh + c); const f32x4 h = y * (1.0f + s2) + b2;
            v2u w; w.x = pk2(h[0], h[1]); w.y = pk2(h[2], h[3]); *(v2u*)(H + (size_t)r * DM + c) = w; }
        if ((j & 3) == 3) asm volatile("" ::: "memory"); }
}
template <int NPARTS>
__device__ __forceinline__ void phase_ln(Frame& F, bool ctx_rows, const float* PRE, const float* g, const float* b, float* xout, int l_mod, int ch_sh, int ch_sc, bool writeH, const float* xres, const float* gate_ctx) {
    const int l32 = F.lane & 31, sub = F.lane >> 5;
    for (int r = 2 * F.gw + sub; r < SEQ; r += 2 * F.NGW)
        ln_row<0>(F, r, l32, PRE, g, b, xout, writeH ? modvec(F, l_mod, 0, ch_sh) : nullptr, writeH ? modvec(F, l_mod, 0, ch_sc) : nullptr, writeH, nullptr, nullptr);
    if (ctx_rows && F.wave == 0 && sub == 0)
        for (int r = SEQ + F.bid; r < MROWS; r += F.G)
            ln_row<NPARTS>(F, r, l32, PRE, g, b, xout, writeH ? modvec(F, l_mod, 1, ch_sh) : nullptr, writeH ? modvec(F, l_mod, 1, ch_sc) : nullptr, writeH, xres, gate_ctx);
}
__device__ __forceinline__ void phase_prep(Frame& F, int l) {
    const bf16_t* P = WSP(bf16_t, WS_P); bf16_t* CAT = WSP(bf16_t, WS_CAT); bf16_t* XBC = WSP(bf16_t, WS_XBC); float* DT = WSP(float, WS_DT);
    bf16_t* CQN = WSP(bf16_t, WS_CQN); bf16_t* CKVN = WSP(bf16_t, WS_CKVN); bf16_t* KMLA = WSP(bf16_t, WS_KMLA);
    const float* caw = INP(7) + (size_t)l * 3 * 512; const float* scw = INP(10) + (size_t)l * 3 * 1024; const float* scb = INP(11) + (size_t)l * 1024;
    const float* dtb = INP(12) + l * 16; const float* qnw = INP(16) + l * 384; const float* kvnw = INP(17) + l * 256;
    const int lane = F.lane;
    for (int r = F.gw; r < MROWS; r += F.NGW) {
        const bool hp = (r != 0 && r != SEQ), hn = (r != SEQ - 1 && r != MROWS - 1);
        const bf16_t* Pr = P + (size_t)r * INW; const bf16_t* Pp = Pr - INW; const bf16_t* Pn = Pr + INW;
        const v4u z4 = {0u, 0u, 0u, 0u};
        {
            const int ch = lane * 8; float bg[8], cg_[8], u_[8], cp[8], up[8], cn[8], un[8], y[8];
            unpack8(ld8(Pr + C_BG + ch), bg); unpack8(ld8(Pr + C_CG + ch), cg_); unpack8(ld8(Pr + C_U + ch), u_);
            unpack8(hp ? ld8(Pp + C_CG + ch) : z4, cp); unpack8(hp ? ld8(Pp + C_U + ch) : z4, up);
            unpack8(hn ? ld8(Pn + C_CG + ch) : z4, cn); unpack8(hn ? ld8(Pn + C_U + ch) : z4, un);
#pragma unroll
            for (int i = 0; i < 8; ++i) y[i] = bg[i] * (caw[ch + i] * cp[i] * up[i] + caw[512 + ch + i] * cg_[i] * u_[i] + caw[1024 + ch + i] * cn[i] * un[i]);
            *(v4u*)(CAT + (size_t)r * DM + ch) = pack8(y);
        }
#pragma unroll
        for (int q = 0; q < 2; ++q) {
            const int ch = lane * 8 + 512 * q; float x0[8], xp[8], xn[8], y[8];
            unpack8(ld8(Pr + C_XBC + ch), x0); unpack8(hp ? ld8(Pp + C_XBC + ch) : z4, xp); unpack8(hn ? ld8(Pn + C_XBC + ch) : z4, xn);
#pragma unroll
            for (int i = 0; i < 8; ++i) y[i] = siluf(scw[ch + i] * xp[i] + scw[1024 + ch + i] * x0[i] + scw[2048 + ch + i] * xn[i] + scb[ch + i]);
            *(v4u*)(XBC + (size_t)r * 1024 + ch) = pack8(y);
        }
        if (lane < 16) { const float v = bf2f(Pr[C_DT + lane]) + dtb[lane]; DT[(size_t)r * 16 + lane] = v > 20.f ? v : __logf(1.0f + __expf(v)); }
        {
            float x[8]; float ss = 0.f;
            if (lane < 48) { unpack8(ld8(Pr + C_CQ + lane * 8), x);
#pragma unroll
                for (int i = 0; i < 8; ++i) ss += x[i] * x[i]; }
            const float rs = rsqrtf(wave_sum(ss) * (1.0f / 384.f) + 1e-6f);
            if (lane < 48) {
#pragma unroll
                for (int i = 0; i < 8; ++i) x[i] = x[i] * rs * qnw[lane * 8 + i];
                *(v4u*)(CQN + (size_t)r * 384 + lane * 8) = pack8(x); }
        }
        {
            float x[8]; float ss = 0.f;
            if (lane < 32) { unpack8(ld8(Pr + C_CKV + lane * 8), x);
#pragma unroll
                for (int i = 0; i < 8; ++i) ss += x[i] * x[i]; }
            const float rs = rsqrtf(wave_sum(ss) * (1.0f / 256.f) + 1e-6f);
            if (lane < 32) {
#pragma unroll
                for (int i = 0; i < 8; ++i) x[i] = x[i] * rs * kvnw[lane * 8 + i];
                *(v4u*)(CKVN + (size_t)r * 256 + lane * 8) = pack8(x); }
        }
        if (lane < 32) { const int hh = lane >> 3, part = lane & 7; *(v4u*)(KMLA + (size_t)r * 768 + hh * 192 + 128 + part * 8) = ld8(Pr + C_KR + part * 8); }
    }
}
__device__ __forceinline__ int ssd_rowbase(int ci) { return ci < 2 ? SEQ + 128 * ci : 128 * (ci - 2); }
__device__ __forceinline__ void ssd_cum(const float* DT, const float* alog, int rb, int h, int d, int lane, float& a0, float& a1, float& ac0, float& ac1, float& total, float& dt0, float& dt1) {
    dt0 = DT[(size_t)(rb + 2 * lane) * 16 + d * 8 + h]; dt1 = DT[(size_t)(rb + 2 * lane + 1) * 16 + d * 8 + h];
    const float A = -__expf(alog[d * 8 + h]);
    a0 = dt0 * A; a1 = dt1 * A;
    const float pair = a0 + a1; float incl = pair;
#pragma unroll
    for (int o = 1; o < 64; o <<= 1) { const float t = __shfl_up(incl, o); if (lane >= o) incl += t; }
    const float excl = incl - pair;
    ac0 = excl + a0; ac1 = incl; total = __shfl(incl, 63);
}
constexpr int LP = 136;
__device__ __forceinline__ void phase_ssd1(Frame& F, int l) {
    const bf16_t* XBC = WSP(bf16_t, WS_XBC); const float* DT = WSP(float, WS_DT); float* S = WSP(float, WS_S); float* ATOT = WSP(float, WS_ATOT);
    const float* alog = INP(13) + l * 16;
    char* lds = F.ldsg;
    bf16_t* BT = (bf16_t*)lds; bf16_t* XT = (bf16_t*)(lds + 34816); float* WG = (float*)(lds + 69632);
    const int tid = F.tid, lane = F.lane, w = F.wave;
    for (int u = (F.G - 1 - F.bid); u < 132; u += F.G) {
        const int ci = u >> 1, g = u & 1, rb = ssd_rowbase(ci);
        {
            const int ll = tid >> 2, n0 = (tid & 3) * 32;
#pragma unroll
            for (int q = 0; q < 4; ++q) { const v4u v = ld8(XBC + (size_t)(rb + ll) * 1024 + 512 + g * 128 + n0 + 8 * q);
#pragma unroll
                for (int i = 0; i < 4; ++i) { BT[(n0 + 8 * q + 2 * i) * LP + ll] = (bf16_t)(v[i] & 0xffffu); BT[(n0 + 8 * q + 2 * i + 1) * LP + ll] = (bf16_t)(v[i] >> 16); } }
        }
        {
            const int hh = w >> 1, d = w & 1, h = g * 4 + hh; float a0, a1, ac0, ac1, total, dt0, dt1;
            ssd_cum(DT, alog, rb, h, d, lane, a0, a1, ac0, ac1, total, dt0, dt1);
            float e0, e1;
            if (d == 0) { e0 = __expf(total - ac0); e1 = __expf(total - ac1); } else { e0 = __expf(ac0 - a0); e1 = __expf(ac1 - a1); }
            WG[w * 128 + 2 * lane] = e0 * dt0; WG[w * 128 + 2 * lane + 1] = e1 * dt1;
            if (lane == 0) ATOT[(ci * 8 + h) * 2 + d] = total;
        }
        __syncthreads();
        for (int hh = 0; hh < 4; ++hh) {
            const int h = g * 4 + hh;
            {
                const int ll = tid >> 2, p0 = (tid & 3) * 16; const float w0 = WG[(hh * 2) * 128 + ll], w1 = WG[(hh * 2 + 1) * 128 + ll];
#pragma unroll
                for (int q = 0; q < 2; ++q) { float x[8]; unpack8(ld8(XBC + (size_t)(rb + ll) * 1024 + h * 64 + p0 + 8 * q), x);
#pragma unroll
                    for (int i = 0; i < 8; ++i) { XT[(p0 + 8 * q + i) * LP + ll] = (bf16_t)f2bf(x[i] * w0); XT[(64 + p0 + 8 * q + i) * LP + ll] = (bf16_t)f2bf(x[i] * w1); } }
            }
            __syncthreads();
            const int pt = w & 3, nh = w >> 2;
#pragma unroll
            for (int d = 0; d < 2; ++d) {
                f32x4 acc[4];
#pragma unroll
                for (int nt = 0; nt < 4; ++nt) acc[nt] = (f32x4){0.f, 0.f, 0.f, 0.f};
#pragma unroll
                for (int ks = 0; ks < 4; ++ks) {
                    const bf16x8 a = *(const bf16x8*)(XT + (d * 64 + pt * 16 + (lane & 15)) * LP + ks * 32 + (lane >> 4) * 8);
#pragma unroll
                    for (int nt = 0; nt < 4; ++nt) { const bf16x8 b = *(const bf16x8*)(BT + ((nh * 4 + nt) * 16 + (lane & 15)) * LP + ks * 32 + (lane >> 4) * 8);
                        acc[nt] = __builtin_amdgcn_mfma_f32_16x16x32_bf16(a, b, acc[nt], 0, 0, 0); }
                }
                float* Sp = S + (size_t)((ci * 8 + h) * 2 + d) * 8192;
#pragma unroll
                for (int nt = 0; nt < 4; ++nt)
#pragma unroll
                    for (int j = 0; j < 4; ++j) Sp[(pt * 16 + (lane >> 4) * 4 + j) * 128 + (nh * 4 + nt) * 16 + (lane & 15)] = acc[nt][j];
            }
            __syncthreads();
        }
    }
}
__device__ __forceinline__ void ssd_scan_unit(Frame& F, int su) {
    const float* S = WSP(float, WS_S); const float* ATOT = WSP(float, WS_ATOT); bf16_t* Rb = WSP(bf16_t, WS_R);
    const int hd = su >> 2, h = hd >> 1, d = hd & 1, e = (su & 3) * 2048 + F.tid * 4;
    f32x4 R = {0.f, 0.f, 0.f, 0.f};
#pragma unroll 4
    for (int step = 0; step < 66; ++step) {
        const int ci = (d == 0) ? step : (step == 0 ? 1 : (step == 1 ? 0 : 67 - step));
        const size_t base = (size_t)((ci * 8 + h) * 2 + d);
        v2u wv; wv.x = pk2(R[0], R[1]); wv.y = pk2(R[2], R[3]); *(v2u*)(Rb + base * 8192 + e) = wv;
        const float dec = __expf(ATOT[base]); const f32x4 sv = *(const f32x4*)(S + base * 8192 + e);
        R = R * dec + sv;
    }
}
__device__ __forceinline__ void phase_ssd2(Frame& F, int l, int ci_first) {
    const bf16_t* XBC = WSP(bf16_t, WS_XBC); const bf16_t* P = WSP(bf16_t, WS_P); const float* DT = WSP(float, WS_DT); const bf16_t* Rb = WSP(bf16_t, WS_R); bf16_t* CAT = WSP(bf16_t, WS_CAT);
    const float* alog = INP(13) + l * 16; const float* dskip = INP(14) + l * 8; const float* normw = INP(15) + l * 512;
    char* lds = F.ldsg;
    bf16_t* CL = (bf16_t*)lds; bf16_t* BL = (bf16_t*)(lds + 34816); bf16_t* XT = (bf16_t*)(lds + 34816); bf16_t* RL = (bf16_t*)(lds + 52224);
    const int tid = F.tid, lane = F.lane, w = F.wave;
    bf16_t* PW = (bf16_t*)(lds + 69632 + w * 4352); bf16_t* CW = (bf16_t*)(lds + 104448 + w * 4352); float* CUM = (float*)(lds + 139264); float* DTV = (float*)(lds + 143360);
    const int nunits = (66 - ci_first) * 2;
    for (int u = (F.G - 1 - F.bid); u < nunits; u += F.G) {
        const int ci = ci_first + (u >> 1), g = u & 1, rb = ssd_rowbase(ci);
        {
            const int row = tid >> 2, c0 = (tid & 3) * 32;
#pragma unroll
            for (int q = 0; q < 4; ++q) { *(v4u*)(CL + row * LP + c0 + 8 * q) = ld8(XBC + (size_t)(rb + row) * 1024 + 768 + g * 128 + c0 + 8 * q);
                *(v4u*)(BL + row * LP + c0 + 8 * q) = ld8(XBC + (size_t)(rb + row) * 1024 + 512 + g * 128 + c0 + 8 * q); }
        }
        {
            const int hh = w >> 1, d = w & 1, h = g * 4 + hh; float a0, a1, ac0, ac1, total, dt0, dt1;
            ssd_cum(DT, alog, rb, h, d, lane, a0, a1, ac0, ac1, total, dt0, dt1);
            float c0v, c1v;
            if (d == 0) { c0v = ac0; c1v = ac1; } else { c0v = total - (ac0 - a0); c1v = total - (ac1 - a1); }
            CUM[w * 128 + 2 * lane] = c0v; CUM[w * 128 + 2 * lane + 1] = c1v; DTV[w * 128 + 2 * lane] = dt0; DTV[w * 128 + 2 * lane + 1] = dt1;
        }
        __syncthreads();
        f32x4 gacc[8];
#pragma unroll
        for (int nt = 0; nt < 8; ++nt) gacc[nt] = (f32x4){0.f, 0.f, 0.f, 0.f};
#pragma unroll
        for (int ks = 0; ks < 4; ++ks) {
            const bf16x8 a = *(const bf16x8*)(CL + (16 * w + (lane & 15)) * LP + ks * 32 + (lane >> 4) * 8);
#pragma unroll
            for (int nt = 0; nt < 8; ++nt) { const bf16x8 b = *(const bf16x8*)(BL + (nt * 16 + (lane & 15)) * LP + ks * 32 + (lane >> 4) * 8);
                gacc[nt] = __builtin_amdgcn_mfma_f32_16x16x32_bf16(a, b, gacc[nt], 0, 0, 0); }
        }
        __syncthreads();
        f32x4 yacc[4][4];
#pragma unroll
        for (int a = 0; a < 4; ++a)
#pragma unroll
            for (int b = 0; b < 4; ++b) yacc[a][b] = (f32x4){0.f, 0.f, 0.f, 0.f};
#pragma unroll
        for (int hh = 0; hh < 4; ++hh) {
            const int h = g * 4 + hh;
#pragma unroll
            for (int d = 0; d < 2; ++d) {
                const int idx = hh * 2 + d;
                {
                    const int s = tid >> 2, p0 = (tid & 3) * 16; const float dtv = DTV[idx * 128 + s];
#pragma unroll
                    for (int q = 0; q < 2; ++q) { float x[8]; unpack8(ld8(XBC + (size_t)(rb + s) * 1024 + h * 64 + p0 + 8 * q), x);
#pragma unroll
                        for (int i = 0; i < 8; ++i) XT[(p0 + 8 * q + i) * LP + s] = (bf16_t)f2bf(x[i] * dtv); }
                }
                {
                    const int p = tid >> 3, n0 = (tid & 7) * 16; const bf16_t* src = Rb + (size_t)((ci * 8 + h) * 2 + d) * 8192 + p * 128 + n0;
                    *(v4u*)(RL + p * LP + n0) = ld8(src); *(v4u*)(RL + p * LP + n0 + 8) = ld8(src + 8);
                }
                {
#pragma unroll
                    for (int nt = 0; nt < 8; ++nt)
#pragma unroll
                        for (int j = 0; j < 4; ++j) { const int lrow = (lane >> 4) * 4 + j, lt = 16 * w + lrow, s = nt * 16 + (lane & 15);
                            const float e = CUM[idx * 128 + lt] - CUM[idx * 128 + s]; const bool ok = (d == 0) ? (s <= lt) : (s >= lt);
                            const float pv = ok ? gacc[nt][j] * __expf(e) : 0.f; PW[lrow * LP + s] = (bf16_t)f2bf(pv); }
                }
                {
                    const int rr = lane >> 2, c0 = (lane & 3) * 32; const float ex = __expf(CUM[idx * 128 + 16 * w + rr]);
#pragma unroll
                    for (int q = 0; q < 4; ++q) { float x[8]; unpack8(*(const v4u*)(CL + (16 * w + rr) * LP + c0 + 8 * q), x);
#pragma unroll
                        for (int i = 0; i < 8; ++i) x[i] *= ex;
                        *(v4u*)(CW + rr * LP + c0 + 8 * q) = pack8(x); }
                }
                __syncthreads();
#pragma unroll
                for (int ks = 0; ks < 4; ++ks) {
                    const bf16x8 ap = *(const bf16x8*)(PW + (lane & 15) * LP + ks * 32 + (lane >> 4) * 8);
                    const bf16x8 ac = *(const bf16x8*)(CW + (lane & 15) * LP + ks * 32 + (lane >> 4) * 8);
#pragma unroll
                    for (int pt = 0; pt < 4; ++pt) {
                        const bf16x8 bx = *(const bf16x8*)(XT + (pt * 16 + (lane & 15)) * LP + ks * 32 + (lane >> 4) * 8);
                        const bf16x8 br = *(const bf16x8*)(RL + (pt * 16 + (lane & 15)) * LP + ks * 32 + (lane >> 4) * 8);
                        yacc[hh][pt] = __builtin_amdgcn_mfma_f32_16x16x32_bf16(ap, bx, yacc[hh][pt], 0, 0, 0);
                        yacc[hh][pt] = __builtin_amdgcn_mfma_f32_16x16x32_bf16(ac, br, yacc[hh][pt], 0, 0, 0);
                    }
                }
                __syncthreads();
            }
        }
#pragma unroll
        for (int j = 0; j < 4; ++j) {
            const int row = rb + 16 * w + (lane >> 4) * 4 + j; float ssq = 0.f;
#pragma unroll
            for (int hh = 0; hh < 4; ++hh)
#pragma unroll
                for (int pt = 0; pt < 4; ++pt) { const int ch = hh * 64 + pt * 16 + (lane & 15);
                    const float xs = bf2f(XBC[(size_t)row * 1024 + g * 256 + ch]), z = bf2f(P[(size_t)row * INW + C_Z + g * 256 + ch]);
                    const float y = yacc[hh][pt][j] + xs * dskip[g * 4 + hh]; const float gv = y * siluf(z); yacc[hh][pt][j] = gv; ssq += gv * gv; }
            ssq += __shfl_xor(ssq, 1); ssq += __shfl_xor(ssq, 2); ssq += __shfl_xor(ssq, 4); ssq += __shfl_xor(ssq, 8);
            const float rs = rsqrtf(ssq * (1.0f / 256.f) + 1e-6f);
#pragma unroll
            for (int hh = 0; hh < 4; ++hh)
#pragma unroll
                for (int pt = 0; pt < 4; ++pt) { const int ch = hh * 64 + pt * 16 + (lane & 15);
                    CAT[(size_t)row * DM + 1024 + g * 256 + ch] = (bf16_t)f2bf(yacc[hh][pt][j] * rs * normw[g * 256 + ch]); }
        }
        __syncthreads();
    }
}
__device__ __forceinline__ void phase_diffcombine(Frame& F, int l, int nrows) {
    const float* OD = WSP(float, WS_ODIFF); bf16_t* CAT = WSP(bf16_t, WS_CAT);
    const float* lp = INP(8) + l * 256; const float* sub = INP(9) + l * 128;
    const int lane = F.lane;
    const float s1 = wave_sum(lp[lane] * lp[64 + lane]), s2 = wave_sum(lp[128 + lane] * lp[192 + lane]);
    int ll = l; asm volatile("" : "+s"(ll));
    const float lam_init = (ll == 0) ? 0.2f : 0.35550906759f;
    const float lam = __expf(s1) - __expf(s2) + lam_init;
    const int hh = lane >> 4, e0 = (lane & 15) * 8;
    float sw[8];
#pragma unroll
    for (int i = 0; i < 8; ++i) sw[i] = sub[e0 + i] * (1.0f - lam_init);
    for (int r = F.gw; r < nrows; r += F.NGW) {
        const float* o1 = OD + (size_t)r * 1024 + (hh * 2) * 128 + e0; const float* o2 = o1 + 128;
        const f32x4 a0 = *(const f32x4*)o1, a1 = *(const f32x4*)(o1 + 4), b0 = *(const f32x4*)o2, b1 = *(const f32x4*)(o2 + 4);
        float o[8]; float ss = 0.f;
#pragma unroll
        for (int i = 0; i < 4; ++i) { o[i] = a0[i] - lam * b0[i]; o[4 + i] = a1[i] - lam * b1[i]; }
#pragma unroll
        for (int i = 0; i < 8; ++i) ss += o[i] * o[i];
        ss += __shfl_xor(ss, 1); ss += __shfl_xor(ss, 2); ss += __shfl_xor(ss, 4); ss += __shfl_xor(ss, 8);
        const float rs = rsqrtf(ss * (1.0f / 128.f) + 1e-6f);
#pragma unroll
        for (int i = 0; i < 8; ++i) o[i] = o[i] * rs * sw[i];
        *(v4u*)(CAT + (size_t)r * DM + 512 + hh * 128 + e0) = pack8(o);
    }
}
__device__ __forceinline__ void phase_attn(Frame& F, int l, int rep) {
    unsigned* ctr = WSP(unsigned, WS_CTL) + 64 * (1 + l + 2 * rep);
    LAS unsigned* bc = (LAS unsigned*)(F.lds + LDS_BYTES - 64);
    const bf16_t* P = WSP(bf16_t, WS_P); const bf16_t* QM = WSP(bf16_t, WS_QMLA); const bf16_t* KM = WSP(bf16_t, WS_KMLA); const bf16_t* VM = WSP(bf16_t, WS_VMLA);
    float* OD = WSP(float, WS_ODIFF); bf16_t* CAT = WSP(bf16_t, WS_CAT);
    const int n_scan = 64, n_mla = 128, n_diff = 256, n_cm = (l == 0) ? 4 : 0, n_cd = (l == 0) ? 8 : 0;
    const int n_tr = (l == 0) ? DT_UNITS : 0;
    const int total = n_scan + n_mla + n_diff + n_cm + n_cd + n_tr;
#ifndef PROBE_FILT
#define PROBE_FILT 7
#endif
    const int filt = rep ? PROBE_FILT : 7;
    for (;;) {
        __syncthreads();
        if (F.tid == 0) bc[0] = atomicAdd(ctr, 1u);
        __syncthreads();
        int u = (int)bc[0];
        if (u >= total) break;
        if (u < n_mla) { if (!(filt & 2)) continue; const int h = u >> 5, qb = u & 31; const size_t q0 = (size_t)qb * 256;
            att::attn_dense_body<192, true, 768, 768, 512, DM>(QM + q0 * 768 + h * 192, KM + h * 192, VM + h * 128, nullptr, CAT + q0 * DM + 1536 + h * 128, MROWS, F.ldsg); continue; }
        u -= n_mla;
        if (u < n_diff) { if (!(filt & 4)) continue; const int mi = u >> 5, qb = u & 31; const size_t q0 = (size_t)qb * 256;
            att::attn_dense_body<64, false, INW, INW, INW, 1024>(P + q0 * INW + C_DQ + mi * 64, P + C_DK + mi * 64, P + C_DV + (mi >> 1) * 128, OD + q0 * 1024 + mi * 128, nullptr, MROWS, F.ldsg); continue; }
        u -= n_diff;
        if (u < n_scan) { if (filt & 1) ssd_scan_unit(F, u); continue; }
        u -= n_scan;
        if (u < n_cm) { if (!(filt & 2)) continue; const int h = u; const size_t q0 = SEQ;
            att::attn_dense_body<192, true, 768, 768, 512, DM>(QM + q0 * 768 + h * 192, KM + q0 * 768 + h * 192, VM + q0 * 512 + h * 128, nullptr, CAT + q0 * DM + 1536 + h * 128, NCTX, F.ldsg); continue; }
        u -= n_cm;
        if (u >= n_cd) { if (rep == 0) deferred_transpose_unit(F, u - n_cd); continue; }
        if (filt & 4) { const int mi = u; const size_t q0 = SEQ;
            att::attn_dense_body<64, false, INW, INW, INW, 1024>(P + q0 * INW + C_DQ + mi * 64, P + q0 * INW + C_DK + mi * 64, P + q0 * INW + C_DV + (mi >> 1) * 128, OD + q0 * 1024 + mi * 128, nullptr, NCTX, F.ldsg); }
    }
}

typedef __attribute__((address_space(1))) unsigned gu32;
#define XB_TMO      128
#define XB_XCNT(j)  (256  + 64 * (j))
#define XB_XSUB(j)  (1280 + 64 * (j))
#define XB_XGEN(j)  (2304 + 64 * (j))
#define XB_TOP      3328
#define XB_TOPGEN   3392
#define XCD_BAR_WORDS 3456
#define XB_SPIN_CAP (1u << 18)

__device__ __forceinline__ unsigned xb_ld(unsigned* p)              { return __hip_atomic_load(p, __ATOMIC_RELAXED, __HIP_MEMORY_SCOPE_AGENT); }
__device__ __forceinline__ unsigned xb_add(unsigned* p, unsigned v) { return __hip_atomic_fetch_add(p, v, __ATOMIC_RELAXED, __HIP_MEMORY_SCOPE_AGENT); }
__device__ __forceinline__ unsigned xb_xcc_id() { return (unsigned)__builtin_amdgcn_s_getreg((3 << 11) | 20) & 0xFu; }
#define XB_SPIN(cond, bar) do { unsigned _sp = 0; while (cond) { __builtin_amdgcn_s_sleep(1); \
    if ((++_sp & 255u) == 0u) { if (xb_ld(&(bar)[XB_TMO])) break; if (_sp > XB_SPIN_CAP) { atomicAdd(&(bar)[XB_TMO], 1u); break; } } } } while (0)

struct XcdBarrier {
    unsigned* bar; unsigned x;
    volatile LAS unsigned* st;
};

__device__ __forceinline__ XcdBarrier xcd_barrier_post(unsigned* bar, volatile LAS unsigned* st) {
    XcdBarrier b; b.bar = bar; b.x = xb_xcc_id(); b.st = st;
    if (threadIdx.x == 0) (void)xb_add(&bar[XB_XCNT(b.x)], 1u);
    return b;
}
__device__ __forceinline__ void xcd_barrier_complete(unsigned* bar, unsigned x, unsigned& nloc, unsigned& nx) {
    const unsigned G = gridDim.x * gridDim.y * gridDim.z;
    unsigned sum, cnt, mine, sp = 0u;
    for (;;) {
        sum = 0u; cnt = 0u; mine = 0u;
#pragma unroll
        for (unsigned j = 0; j < 16; ++j) { const unsigned c = xb_ld(&bar[XB_XCNT(j)]); sum += c; cnt += (c > 0u) ? 1u : 0u; mine = (j == x) ? c : mine; }
        if (sum == G) break;
        __builtin_amdgcn_s_sleep(1);
        if ((++sp & 255u) == 0u) { if (xb_ld(&bar[XB_TMO])) break; if (sp > XB_SPIN_CAP) { atomicAdd(&bar[XB_TMO], 1u); break; } }
    }
    nloc = mine > 0u ? mine : 1u; nx = cnt > 0u ? cnt : 1u;
}

__device__ __forceinline__ void xcd_barrier(const XcdBarrier& b) {
    asm volatile("s_waitcnt vmcnt(0)" ::: "memory");
    __syncthreads();
    if (threadIdx.x == 0) {
        unsigned* bar = b.bar;
        __builtin_amdgcn_s_waitcnt(0);
        unsigned bx_ = b.x; asm volatile("" : "+s"(bx_));
        unsigned nloc = b.st[0], nx = b.st[1];
        if (nloc == 0u) { xcd_barrier_complete(bar, bx_, nloc, nx); b.st[0] = nloc; b.st[1] = nx; }
        const unsigned old = xb_add(&bar[XB_XSUB(bx_)], 1u);
        const unsigned gen = old / nloc;
        if (old + 1u == (gen + 1u) * nloc) {
            __builtin_amdgcn_fence(__ATOMIC_RELEASE, "agent");
            asm volatile("s_waitcnt vmcnt(0)" ::: "memory");
            const unsigned og = xb_add(&bar[XB_TOP], 1u);
            const unsigned tg = og / nx;
            if (og + 1u == (tg + 1u) * nx) xb_add(&bar[XB_TOPGEN], 1u);
            else XB_SPIN(xb_ld(&bar[XB_TOPGEN]) == tg, bar);
            __builtin_amdgcn_fence(__ATOMIC_ACQUIRE, "agent");
            xb_add(&bar[XB_XGEN(bx_)], 1u);
            asm volatile("s_waitcnt vmcnt(0)" ::: "memory");
        } else {
            XB_SPIN(xb_ld(&bar[XB_XGEN(bx_)]) == gen, bar);
            __builtin_amdgcn_fence(__ATOMIC_ACQUIRE, "agent");
            asm volatile("s_waitcnt vmcnt(0)" ::: "memory");
        }
    }
    __syncthreads();
}


__global__ void __launch_bounds__(NTHR, 2) mk_fwd(Args args) {
    extern __shared__ __attribute__((aligned(16))) unsigned char lds_raw[];
    Frame F;
    F.lds = (LAS unsigned char*)lds_raw; F.ldsg = (char*)lds_raw;
    const int lo = args.ph_lo, hi = args.ph_hi;
    volatile LAS unsigned* bst = (volatile LAS unsigned*)((LAS unsigned char*)lds_raw + (LDS_BYTES - 32));
    if (threadIdx.x == 0) { bst[0] = 0u; bst[1] = 0u; }
    __syncthreads();
    XcdBarrier xbar = xcd_barrier_post((unsigned*)args.ws + 1024, bst);
    int nseam = 0;
    for (int ph = lo; ph < hi; ++ph) {
      int nrep = 1;
      if (PROBE_MASK) { const int sp_ = ph < 3 ? -1 : (ph - 3) % 10;
          const int ty = ph < 3 ? ph : (sp_ == 0 ? 3 : sp_ == 1 ? 4 : sp_ == 2 ? 5 : sp_ == 3 ? 7 : sp_ == 4 ? 10 : sp_ == 5 ? 12 : sp_ == 6 ? 13 : sp_ == 7 ? 14 : sp_ == 8 ? 15 : 13);
          if (PRB(ty)) nrep = 2; }
      for (int rep = 0; rep < nrep; ++rep) {
        if (ph > lo || rep > 0) { if (nseam == 0) cg::this_grid().sync(); else xcd_barrier(xbar); ++nseam; }
        { const __attribute__((address_space(4))) char* ka = (const __attribute__((address_space(4))) char*)__builtin_amdgcn_kernarg_segment_ptr(); asm volatile("" : "+s"(ka)); F.ka = ka;
          F.out = *(float* const __attribute__((address_space(4)))*)(ka + 216); F.ws = *(unsigned char* const __attribute__((address_space(4)))*)(ka + 224); }
        F.tid = ltid(); F.lane = F.tid & 63; F.wave = __builtin_amdgcn_readfirstlane(F.tid >> 6);
        F.bid = lbid(); F.G = gridDim.x; F.gw = F.bid * NWAVES + F.wave; F.NGW = F.G * NWAVES;
        if (ph == 0) { if (PHON(0)) phase_prologue(F); continue; }
        if (ph == 1) { if (PHON(1)) phase_modfinal(F); continue; }
        if (ph == 2) { if (PHON(2)) phase_copy_mod(F); continue; }
        const int l = (ph - 3) / 10, sp = (ph - 3) % 10;
        const bool last = (l == 1);
        int Kq = 384, Kkv = 256; asm volatile("" : "+s"(Kq), "+s"(Kkv));
        const int Mact = last ? SEQ : MROWS;
        unsigned char* wb = F.ws + WS_W0 + (size_t)l * W_LAYER;
        if (sp == 0) { if (PHON(3)) {
            pg8::Gemm g{WSP(const bf16_t, WS_H), (const bf16_t*)(wb + WO_IN), MROWS, INW, DM, DM}; pg8::StaticOrder S; S.init(MROWS, INW, F.G, F.bid);
            pg8::EpiBf16R<0> E{WSP(bf16_t, WS_P), nullptr, WSP(const pg8::f32x2, WS_ROPE)};
            pg8::gemm_phase<pg8::EpiBf16R<0>, pg8::StaticOrder, true, true>(F.lds, g, S, E); }
        } else if (sp == 1) {
            if (PHON(4)) phase_prep(F, l);
        } else if (sp == 2) {
            if (PHON(5)) { pg8::Gemm g{WSP(const bf16_t, WS_CQN), (const bf16_t*)(wb + WO_Q), Mact, 768, Kq, Kq}; pg8::StaticOrder S; S.init(Mact, 768, F.G, F.bid);
              pg8::EpiBf16R<1> E{WSP(bf16_t, WS_QMLA), nullptr, WSP(const pg8::f32x2, WS_ROPE)};
              pg8::gemm_phase<pg8::EpiBf16R<1>, pg8::StaticOrder, true, true>(F.lds, g, S, E); }
            __syncthreads();
            if (PHON(16)) { pg8::Gemm g{WSP(const bf16_t, WS_CKVN), (const bf16_t*)(wb + WO_KV), MROWS, 1024, Kkv, Kkv}; pg8::StaticOrder S; S.init(MROWS, 1024, F.G, F.bid);
              pg8::EpiBf16R<2> E{WSP(bf16_t, WS_KMLA), WSP(bf16_t, WS_VMLA), nullptr};
              pg8::gemm_phase<pg8::EpiBf16R<2>, pg8::StaticOrder, true, true>(F.lds, g, S, E); }
            __syncthreads();
            if (PHON(6)) phase_ssd1(F, l);
        } else if (sp == 3) {
            phase_attn(F, l, rep);
        } else if (sp == 4) {
            if (PHON(10)) phase_ssd2(F, l, last ? 2 : 0);
            if (PHON(11)) phase_diffcombine(F, l, Mact);
        } else if (sp == 5) { if (PHON(12)) {
            pg8::Gemm g{WSP(const bf16_t, WS_CAT), (const bf16_t*)(wb + WO_OUT), SEQ, DM, DM, DM}; pg8::StaticOrder S; S.init(SEQ, DM, F.G, F.bid);
            pg8::EpiResid E{last ? WSP(const float, WS_XA) : INP(0), WSP(float, WS_PRE), modvec(F, l, 0, 2), modvec(F, l, 1, 2)};
            pg8::gemm_phase<pg8::EpiResid, pg8::StaticOrder, true, true>(F.lds, g, S, E);
            if (!last) {
                __syncthreads();
                int kc = 256; asm volatile("" : "+s"(kc));
                pg8::Gemm g2{WSP(const bf16_t, WS_CAT) + (size_t)SEQ * DM, (const bf16_t*)(wb + WO_OUT), 256, DM, kc, DM}; pg8::SplitKOrder S2; S2.init(DM, 8, 256, F.G, (F.bid + 128) % F.G);
                pg8::EpiPart E2{WSP(float, WS_PART)};
                pg8::gemm_phase<pg8::EpiPart, pg8::SplitKOrder, true, true>(F.lds, g2, S2, E2);
            } }
        } else if (sp == 6) {
            if (PHON(13)) phase_ln<8>(F, !last, WSP(const float, WS_PRE), INP(21) + l * DM, INP(22) + l * DM, WSP(float, WS_X1), l, 3, 4, true, INP(2) - (size_t)SEQ * DM, modvec(F, l, 1, 2));
        } else if (sp == 7) { if (PHON(14)) {
            pg8::Gemm g{WSP(const bf16_t, WS_H), (const bf16_t*)(wb + WO_F1), Mact, 2 * DFF, DM, DM}; pg8::StaticOrder S; S.init(Mact, 2 * DFF, F.G, F.bid);
            pg8::EpiSwiglu E{WSP(bf16_t, WS_ACT)};
            pg8::gemm_phase<pg8::EpiSwiglu, pg8::StaticOrder, true, true>(F.lds, g, S, E); }
        } else if (sp == 8) { if (PHON(15)) {
            pg8::Gemm g{WSP(const bf16_t, WS_ACT), (const bf16_t*)(wb + WO_F2), SEQ, DM, DFF, DFF}; pg8::StaticOrder S; S.init(SEQ, DM, F.G, F.bid);
            pg8::EpiResid E{WSP(const float, WS_X1), WSP(float, WS_PRE), modvec(F, l, 0, 5), modvec(F, l, 1, 5)};
            pg8::gemm_phase<pg8::EpiResid, pg8::StaticOrder, true, true>(F.lds, g, S, E);
            if (!last) {
                __syncthreads();
                int kc = 512; asm volatile("" : "+s"(kc));
                pg8::Gemm g2{WSP(const bf16_t, WS_ACT) + (size_t)SEQ * DFF, (const bf16_t*)(wb + WO_F2), 256, DM, kc, DFF}; pg8::SplitKOrder S2; S2.init(DM, 11, 512, F.G, (F.bid + 128) % F.G);
                pg8::EpiPart E2{WSP(float, WS_PART)};
                pg8::gemm_phase<pg8::EpiPart, pg8::SplitKOrder, true, true>(F.lds, g2, S2, E2);
            } }
        } else if (PHON(13)) {
            if (!last) phase_ln<11>(F, true, WSP(const float, WS_PRE), INP(25) + l * DM, INP(26) + l * DM, WSP(float, WS_XA), l + 1, 0, 1, true, WSP(const float, WS_X1), modvec(F, l, 1, 5));
            else       phase_ln<1>(F, false, WSP(const float, WS_PRE), INP(25) + l * DM, INP(26) + l * DM, F.out, 0, 0, 1, false, nullptr, nullptr);
        }
      }
    }
}

extern "C" void kernel_launch(void* const* d_in, const int* in_sizes, int n_in, void* d_out, int out_size, void* d_ws, size_t ws_size, hipStream_t stream) {
    static int grid = 0;
    if (grid == 0) {
        if (n_in != 27 || in_sizes[0] != SEQ * DM || out_size != SEQ * DM || ws_size < WS_END) {
            fprintf(stderr, "kernel_launch: unexpected shapes: n_in %d in0 %d out %d ws %zu (need >= %zu)\n", n_in, n_in > 0 ? in_sizes[0] : -1, out_size, ws_size, (size_t)WS_END); grid = -1; return; }
        int dev = 0, cus = 0, per_cu = 0;
        if (hipGetDevice(&dev) != hipSuccess || hipDeviceGetAttribute(&cus, hipDeviceAttributeMultiprocessorCount, dev) != hipSuccess) { grid = -1; return; }
        if (hipFuncSetAttribute((const void*)mk_fwd, hipFuncAttributeMaxDynamicSharedMemorySize, LDS_BYTES) != hipSuccess) { fprintf(stderr, "kernel_launch: hipFuncSetAttribute failed\n"); grid = -1; return; }
        if (hipOccupancyMaxActiveBlocksPerMultiprocessor(&per_cu, (const void*)mk_fwd, NTHR, LDS_BYTES) != hipSuccess || per_cu < 1) { fprintf(stderr, "kernel_launch: occupancy query gave %d\n", per_cu); per_cu = 1; }
        (void)hipGetLastError();
        grid = cus * 1;
    }
    if (grid < 0) return;
    (void)hipMemsetAsync((char*)d_ws + WS_CTL, 0, CTL_BYTES, stream);
    Args a{};
    for (int i = 0; i < 27; ++i) a.in[i] = (const float*)d_in[i];
    a.out = (float*)d_out; a.ws = (unsigned char*)d_ws;
#if MK_ONE_LAUNCH
    a.ph_lo = 0; a.ph_hi = NPH;
    void* kargs[] = {&a};
    hipError_t e = hipLaunchCooperativeKernel((const void*)mk_fwd, dim3(grid), dim3(NTHR), kargs, LDS_BYTES, stream);
    if (e != hipSuccess) fprintf(stderr, "kernel_launch: cooperative launch failed: %s (grid %d)\n", hipGetErrorString(e), grid);
#else
    for (int ph = 0; ph < NPH; ++ph) { a.ph_lo = ph; a.ph_hi = ph + 1; hipLaunchKernelGGL(mk_fwd, dim3(grid), dim3(NTHR), LDS_BYTES, stream, a); }
    const hipError_t le = hipPeekAtLastError();
    if (le != hipSuccess) fprintf(stderr, "kernel_launch: launch failed: %s\n", hipGetErrorName(le));
#endif
}
```
